# Optimizing an MI355X kernel written in HIP

```python
import math
import jax
import jax.numpy as jnp
from jax import lax
import numpy as np

D_MODEL = 2048
BATCH = 8
SEQ = 2048
DEPTH = 1
DEC_BATCH = 8
DEC_SEQ = 16
PAST_LEN = 1024

CHUNK = 64
D_MIX = D_MODEL
D_A = D_MIX // 2
D_B = D_MIX - D_A
A_HEADS = 4
A_DV = D_A // A_HEADS
A_DQK = A_DV // 2
QK_W = 2 * A_HEADS * A_DQK
CONV_W = 4
B_GROUP = 16
B_GROUPS = D_B // B_GROUP
B_STATE = 64
D_FF = -(-8 * D_MODEL // (3 * 256)) * 256
N_IN = QK_W + 2 * D_A + 2 * A_HEADS + D_B
EPS = 1e-6

kernel_name = 'hymba_mlstm_s5_stream_step'


def rmsnorm(x, g):
    xf = x.astype(jnp.float32)
    y = xf * lax.rsqrt(jnp.mean(xf * xf, axis=-1, keepdims=True) + EPS)
    return (y * g.astype(jnp.float32)).astype(x.dtype)


def causal_conv(x, buf, w, b):
    seqlen = x.shape[1]
    xp = jnp.concatenate([buf.astype(x.dtype), x], axis=1)
    out = b
    for j in range(CONV_W):
        out = out + xp[:, j:j + seqlen] * w[j]
    return jax.nn.silu(out), xp[:, xp.shape[1] - (CONV_W - 1):]


def mlstm_chunk(c0, n0, m0, q, k, v, li, lf):
    seqlen = q.shape[1]
    li = jnp.swapaxes(li, 1, 2)
    fcum = jnp.cumsum(jnp.swapaxes(lf, 1, 2), axis=-1)
    causal = jnp.tril(jnp.ones((seqlen, seqlen), dtype=bool))
    dmat = jnp.where(causal, fcum[..., :, None] - fcum[..., None, :] + li[..., None, :], -jnp.inf)
    inter = fcum + m0[..., None]
    m_t = jnp.maximum(jnp.max(dmat, axis=-1), inter)
    s = jnp.einsum('bthd,bshd->bhts', q, k) * jnp.exp(dmat - m_t[..., None])
    g_inter = jnp.exp(inter - m_t)
    num = jnp.einsum('bhts,bshv->bthv', s, v) + jnp.einsum('bht,bhvd,bthd->bthv', g_inter, c0, q)
    den = jnp.sum(s, axis=-1) + g_inter * jnp.einsum('bhd,bthd->bht', n0, q)
    scale = jnp.maximum(jnp.abs(den), jnp.exp(-m_t))
    h = num / jnp.swapaxes(scale, 1, 2)[..., None]
    f_last = fcum[..., -1]
    lw = f_last[..., None] - fcum + li
    m_new = jnp.maximum(f_last + m0, jnp.max(lw, axis=-1))
    ws = jnp.exp(lw - m_new[..., None])
    decay = jnp.exp(f_last + m0 - m_new)
    c_new = decay[..., None, None] * c0 + jnp.einsum('bhs,bshv,bshd->bhvd', ws, v, k)
    n_new = decay[..., None] * n0 + jnp.einsum('bhs,bshd->bhd', ws, k)
    return c_new, n_new, m_new, h


def s5_discretise(lam_re, lam_im, log_dt, b_re, b_im):
    f32 = jnp.float32
    lam_re = lam_re.astype(f32)
    lam_im = lam_im.astype(f32)
    b_re = b_re.astype(f32)
    b_im = b_im.astype(f32)
    dt = jnp.exp(log_dt.astype(f32))[:, None]
    mag = jnp.exp(lam_re * dt)
    ang = lam_im * dt
    lb_re = mag * jnp.cos(ang)
    lb_im = mag * jnp.sin(ang)
    den = lam_re * lam_re + lam_im * lam_im
    nr = lb_re - 1.0
    f_re = (nr * lam_re + lb_im * lam_im) / den
    f_im = (lb_im * lam_re - nr * lam_im) / den
    bb_re = f_re[..., None] * b_re - f_im[..., None] * b_im
    bb_im = f_re[..., None] * b_im + f_im[..., None] * b_re
    return lb_re, lb_im, bb_re, bb_im


def _affine_combine(e1, e2):
    a1r, a1i, b1r, b1i = e1
    a2r, a2i, b2r, b2i = e2
    return (a1r * a2r - a1i * a2i,
            a1r * a2i + a1i * a2r,
            a2r * b1r - a2i * b1i + b2r,
            a2r * b1i + a2i * b1r + b2i)


def s5_chunk(x_re, x_im, u, lb_re, lb_im, bb_re, bb_im, c_re, c_im, d_skip):
    bu_re = jnp.einsum('blgi,gpi->blgp', u, bb_re)
    bu_im = jnp.einsum('blgi,gpi->blgp', u, bb_im)
    bu_re = bu_re.at[:, 0].add(lb_re * x_re - lb_im * x_im)
    bu_im = bu_im.at[:, 0].add(lb_re * x_im + lb_im * x_re)
    a_re = jnp.broadcast_to(lb_re, bu_re.shape)
    a_im = jnp.broadcast_to(lb_im, bu_im.shape)
    _, _, s_re, s_im = lax.associative_scan(_affine_combine, (a_re, a_im, bu_re, bu_im), axis=1)
    y = (jnp.einsum('gip,blgp->blgi', c_re, s_re)
         - jnp.einsum('gip,blgp->blgi', c_im, s_im) + d_skip * u)
    return s_re[:, -1], s_im[:, -1], y


def token_mixers(h, conv_buf, c0, n0, m0, sr0, si0, p):
    f32 = jnp.float32
    bt, seqlen, _ = h.shape
    cl = min(seqlen, CHUNK)
    nc = seqlen // cl
    proj = h @ p['w_in']
    o1 = QK_W
    o2 = o1 + D_A
    o3 = o2 + D_A
    o4 = o3 + A_HEADS
    o5 = o4 + A_HEADS
    qk, conv_new = causal_conv(proj[..., :o1], conv_buf, p['w_conv'], p['b_conv'])
    qk = qk.astype(f32)
    q = qk[..., :QK_W // 2].reshape(bt, seqlen, A_HEADS, A_DQK) * (A_DQK ** -0.5)
    k = qk[..., QK_W // 2:].reshape(bt, seqlen, A_HEADS, A_DQK)
    v = proj[..., o1:o2].astype(f32).reshape(bt, seqlen, A_HEADS, A_DV)
    og = proj[..., o2:o3].astype(f32).reshape(bt, seqlen, A_HEADS, A_DV)
    li = proj[..., o3:o4].astype(f32) + p['b_igate'].astype(f32)
    lf = jax.nn.log_sigmoid(proj[..., o4:o5].astype(f32) + p['b_fgate'].astype(f32))
    u = proj[..., o5:].astype(f32).reshape(bt, seqlen, B_GROUPS, B_GROUP)
    d_skip = p['s5_d'].astype(f32).reshape(B_GROUPS, B_GROUP)
    c_re = p['s5_c_re'].astype(f32)
    c_im = p['s5_c_im'].astype(f32)

    def to_chunks(a):
        return jnp.moveaxis(a.reshape((bt, nc, cl) + a.shape[2:]), 1, 0)

    xs = tuple(to_chunks(a) for a in (q, k, v, li, lf, u))

    def step(carry, xc):
        c, n, m, sr, si = carry
        qc, kc, vc, lic, lfc, uc = xc
        c, n, m, hc = mlstm_chunk(c, n, m, qc, kc, vc, lic, lfc)
        sr, si, yc = s5_chunk(sr, si, uc, p['lb_re'], p['lb_im'], p['bb_re'], p['bb_im'],
                              c_re, c_im, d_skip)
        return (c, n, m, sr, si), (hc, yc)

    init = (c0.astype(f32), n0.astype(f32), m0.astype(f32), sr0.astype(f32), si0.astype(f32))
    (c1, n1, m1, sr1, si1), (hs, ys) = lax.scan(step, init, xs)
    hs = jnp.moveaxis(hs, 0, 1).reshape(bt, seqlen, A_HEADS, A_DV)
    ys = jnp.moveaxis(ys, 0, 1).reshape(bt, seqlen, D_B)
    g_mh = p['g_mh'].astype(f32).reshape(A_HEADS, A_DV)
    hn = hs * lax.rsqrt(jnp.mean(hs * hs, axis=-1, keepdims=True) + EPS) * g_mh
    out_a = (hn * jax.nn.sigmoid(og)).reshape(bt, seqlen, D_A)
    z = jax.nn.gelu(ys)
    gate = jax.nn.sigmoid((z.astype(h.dtype) @ p['w_glu'] + p['b_glu']).astype(f32))
    out_b = z * gate
    mix = jnp.concatenate([out_a, out_b], axis=-1).astype(h.dtype) @ p['w_out']
    return mix, (conv_new, c1, n1, m1, sr1, si1)


def layer(x, conv_buf, c0, n0, m0, sr0, si0, p):
    hm = rmsnorm(x, p['g_pre_mix'])
    mix, st = token_mixers(hm, conv_buf, c0, n0, m0, sr0, si0, p)
    x = x + rmsnorm(mix, p['g_post_mix'])
    hf = rmsnorm(x, p['g_pre_ffn'])
    ff = (jax.nn.silu(hf @ p['w_gate']) * (hf @ p['w_up'])) @ p['w_down']
    x = x + rmsnorm(ff, p['g_post_ffn'])
    return x, st


def setup_inputs(seed: int = 0) -> dict:
    key = jax.random.key(seed)
    ks = jax.random.split(key, 32)
    f32 = jnp.float32

    def nrm(k, shape, s):
        return jax.random.normal(k, shape, f32) * s

    L = DEPTH
    n_idx = jnp.arange(B_STATE, dtype=f32)
    return {
        'x_prompt': nrm(ks[0], (BATCH, SEQ, D_MODEL), 1.0),
        'x_sample': nrm(ks[1], (DEC_BATCH, DEC_SEQ, D_MODEL), 1.0),
        'state_conv': nrm(ks[2], (L, DEC_BATCH, CONV_W - 1, QK_W), 1.0),
        'state_mlstm_c': nrm(ks[3], (L, DEC_BATCH, A_HEADS, A_DV, A_DQK), 0.5),
        'state_mlstm_n': nrm(ks[4], (L, DEC_BATCH, A_HEADS, A_DQK), 0.5),
        'state_mlstm_m': nrm(ks[5], (L, DEC_BATCH, A_HEADS), 1.0),
        'state_s5_re': nrm(ks[6], (L, DEC_BATCH, B_GROUPS, B_STATE), 0.5),
        'state_s5_im': nrm(ks[7], (L, DEC_BATCH, B_GROUPS, B_STATE), 0.5),
        'g_pre_mix': 1.0 + nrm(ks[8], (L, D_MODEL), 0.02),
        'w_in': nrm(ks[9], (L, D_MODEL, N_IN), D_MODEL ** -0.5),
        'w_conv': nrm(ks[10], (L, CONV_W, QK_W), CONV_W ** -0.5),
        'b_conv': nrm(ks[11], (L, QK_W), 0.02),
        'b_igate': nrm(ks[12], (L, A_HEADS), 0.1),
        'b_fgate': jnp.linspace(3.0, 6.0, A_HEADS, dtype=f32)[None] + nrm(ks[13], (L, A_HEADS), 0.1),
        'g_mh': 1.0 + nrm(ks[14], (L, D_A), 0.02),
        's5_lam_re': -0.5 + nrm(ks[15], (L, B_GROUPS, B_STATE), 0.01),
        's5_lam_im': math.pi * n_idx + nrm(ks[16], (L, B_GROUPS, B_STATE), 0.01),
        's5_log_dt': jax.random.uniform(ks[17], (L, B_GROUPS), f32, math.log(1e-3), math.log(1e-1)),
        's5_b_re': nrm(ks[18], (L, B_GROUPS, B_STATE, B_GROUP), (2 * B_GROUP) ** -0.5),
        's5_b_im': nrm(ks[19], (L, B_GROUPS, B_STATE, B_GROUP), (2 * B_GROUP) ** -0.5),
        's5_c_re': nrm(ks[20], (L, B_GROUPS, B_GROUP, B_STATE), B_STATE ** -0.5),
        's5_c_im': nrm(ks[21], (L, B_GROUPS, B_GROUP, B_STATE), B_STATE ** -0.5),
        's5_d': nrm(ks[22], (L, D_B), 1.0),
        'w_glu': nrm(ks[23], (L, D_B, D_B), D_B ** -0.5),
        'b_glu': nrm(ks[24], (L, D_B), 0.02),
        'w_out': nrm(ks[25], (L, D_MIX, D_MODEL), D_MIX ** -0.5),
        'g_post_mix': 1.0 + nrm(ks[26], (L, D_MODEL), 0.02),
        'g_pre_ffn': 1.0 + nrm(ks[27], (L, D_MODEL), 0.02),
        'w_gate': nrm(ks[28], (L, D_MODEL, D_FF), D_MODEL ** -0.5),
        'w_up': nrm(ks[29], (L, D_MODEL, D_FF), D_MODEL ** -0.5),
        'w_down': nrm(ks[30], (L, D_FF, D_MODEL), D_FF ** -0.5),
        'g_post_ffn': 1.0 + nrm(ks[31], (L, D_MODEL), 0.02),
    }


def reference(x_prompt, x_sample, state_conv, state_mlstm_c, state_mlstm_n, state_mlstm_m,
              state_s5_re, state_s5_im, g_pre_mix, w_in, w_conv, b_conv, b_igate, b_fgate,
              g_mh, s5_lam_re, s5_lam_im, s5_log_dt, s5_b_re, s5_b_im, s5_c_re, s5_c_im,
              s5_d, w_glu, b_glu, w_out, g_post_mix, g_pre_ffn, w_gate, w_up, w_down,
              g_post_ffn):
    f32 = jnp.float32
    yp = x_prompt
    ys = x_sample
    bp = x_prompt.shape[0]
    new_p = [[] for _ in range(6)]
    new_s = [[] for _ in range(6)]
    for l in range(DEPTH):
        lb_re, lb_im, bb_re, bb_im = s5_discretise(s5_lam_re[l], s5_lam_im[l], s5_log_dt[l],
                                                   s5_b_re[l], s5_b_im[l])
        p = {
            'g_pre_mix': g_pre_mix[l], 'w_in': w_in[l], 'w_conv': w_conv[l], 'b_conv': b_conv[l],
            'b_igate': b_igate[l], 'b_fgate': b_fgate[l], 'g_mh': g_mh[l],
            'lb_re': lb_re, 'lb_im': lb_im, 'bb_re': bb_re, 'bb_im': bb_im,
            's5_c_re': s5_c_re[l], 's5_c_im': s5_c_im[l], 's5_d': s5_d[l],
            'w_glu': w_glu[l], 'b_glu': b_glu[l], 'w_out': w_out[l], 'g_post_mix': g_post_mix[l],
            'g_pre_ffn': g_pre_ffn[l], 'w_gate': w_gate[l], 'w_up': w_up[l], 'w_down': w_down[l],
            'g_post_ffn': g_post_ffn[l],
        }
        yp, st_p = layer(yp,
                         jnp.zeros((bp, CONV_W - 1, QK_W), yp.dtype),
                         jnp.zeros((bp, A_HEADS, A_DV, A_DQK), f32),
                         jnp.zeros((bp, A_HEADS, A_DQK), f32),
                         jnp.zeros((bp, A_HEADS), f32),
                         jnp.zeros((bp, B_GROUPS, B_STATE), f32),
                         jnp.zeros((bp, B_GROUPS, B_STATE), f32),
                         p)
        ys, st_s = layer(ys, state_conv[l], state_mlstm_c[l], state_mlstm_n[l], state_mlstm_m[l],
                         state_s5_re[l], state_s5_im[l], p)
        for i in range(6):
            new_p[i].append(st_p[i])
            new_s[i].append(st_s[i])
    conv_p, c_p, n_p, m_p, s5re_p, s5im_p = [jnp.stack(a) for a in new_p]
    conv_s, c_s, n_s, m_s, s5re_s, s5im_s = [jnp.stack(a) for a in new_s]
    return (yp, ys, conv_p, c_p, n_p, m_p, s5re_p, s5im_p,
            conv_s, c_s, n_s, m_s, s5re_s, s5im_s)
```

```cpp
#define MK_N_LAUNCHES 10
#include <hip/hip_runtime.h>
#include <cstdio>
#include <cstdint>
#include <cmath>
namespace pg8 {
#define PG8_LAS __attribute__((address_space(3)))
typedef unsigned short bf16_t;
typedef short bf16x8 __attribute__((ext_vector_type(8)));
typedef float f32x4 __attribute__((ext_vector_type(4)));
typedef unsigned u32x4 __attribute__((ext_vector_type(4)));
constexpr int BM = 256, BK = 64, HALF = 128, HTB = HALF * BK * 2  , STAGE_BYTES = 8 * HTB, NXCD = 8, WGM = 8;

__host__ __device__ __forceinline__ int lds_byte(int r, int c) { const int st = (r >> 4) * 2 + (c >> 5), rr = r & 15, cc = c & 31, ob = rr * 64 + cc * 2; return st * 1024 + (ob ^ (((ob >> 9) & 1) << 5)); }
__host__ __device__ __forceinline__ void stage_rc(int b, int& R, int& C) { const int st = b / 1024, sb = b % 1024, swz = sb ^ (((sb >> 9) & 1) << 5); R = (st >> 1) * 16 + swz / 64; C = (st & 1) * 32 + (swz % 64) / 2; }
__host__ __device__ __forceinline__ int perm32(int rho) { const int n = rho >> 4, i = rho & 15; return 8 * (i >> 2) + 4 * n + (i & 3); }

struct Unit { int pm, pn; };
struct Gemm { const bf16_t* A; const bf16_t* Bt; int M, N, K; };

struct StaticOrder {
    int nM, nN, nwg, G, c;
    __host__ __device__ void init(int M, int N, int G_, int c_) { nM = M / BM; nN = N / BM; nwg = nM * nN; G = G_; c = c_; }
    __host__ __device__ bool next(int i, Unit& u) const {
        const long L = (long)i * G + c; if (L >= nwg) return false;
        int wgid = (int)L; { const int q = nwg / NXCD, r = nwg % NXCD, xcd = wgid % NXCD, off = wgid / NXCD; wgid = (xcd < r ? xcd * (q + 1) : r * (q + 1) + (xcd - r) * q) + off; }
        const int nig = WGM * nN, gid = wgid / nig, fm = gid * WGM, gsz = (nM - fm) < WGM ? (nM - fm) : WGM;
        u.pm = fm + ((wgid % nig) % gsz); u.pn = (wgid % nig) / gsz; return true;
    }
    __device__ __forceinline__ void a_ready(const Unit&) const {}
    __device__ __forceinline__ void done(const Unit&) const {}
};

__device__ __forceinline__ unsigned cvt_pk_bf16(float lo, float hi) { unsigned r; asm volatile("v_cvt_pk_bf16_f32 %0, %1, %2" : "=v"(r) : "v"(lo), "v"(hi)); return r; }
typedef float f32x2 __attribute__((ext_vector_type(2)));
__device__ __forceinline__ f32x2 gelu_pk(f32x2 v) {
    const f32x2 av = __builtin_elementwise_abs(v), d = av * 0.2316418882f + 1.0f;
    f32x2 t; t.x = __builtin_amdgcn_rcpf(d.x); t.y = __builtin_amdgcn_rcpf(d.y);
    f32x2 q = t * 0.5307027145f + (-0.7265760135f); q = q * t + 0.7107068705f; q = q * t + (-0.142248368f); q = q * t + 0.127414796f; q = q * t;
    const f32x2 s = (v * v) * (-0.72134752044f);
    f32x2 e; e.x = __builtin_amdgcn_exp2f(s.x); e.y = __builtin_amdgcn_exp2f(s.y);
    const f32x2 m = v * (q * e), r = v - m;
    f32x2 o; o.x = v.x < 0.f ? m.x : r.x; o.y = v.y < 0.f ? m.y : r.y; return o;
}

template <int ACT  > struct EpiBf16 {
    static constexpr bool PERM = true, AFTER_DRAIN = false; static_assert(ACT == 0 || ACT == 1, "EpiBf16: ACT is 0 (none) or 1 (gelu_pk)");
    bf16_t* O; int ldc; const float* bias; int split_cols; size_t split_stride; float scale0;
    __device__ __forceinline__ void operator()(const f32x4 (&acc)[2][2][4][2], const Unit& u, int wr, int wc, int fr, int fq) const {
        const int row0 = u.pm * BM + wr * 64 + fr; int colt = u.pn * BM; bf16_t* base = O;
        float sc = 1.f; if (split_cols) { const int t = colt / split_cols; base += (size_t)t * split_stride; colt -= t * split_cols; if (t == 0) sc = scale0; }
        const int col0 = colt + wc * 32 + 8 * fq, bcol0 = u.pn * BM + wc * 32 + 8 * fq;
        f32x4 bv[2][2];
#pragma unroll
        for (int bj = 0; bj < 2; ++bj)
#pragma unroll
            for (int n = 0; n < 2; ++n) bv[bj][n] = bias ? *(const f32x4*)(bias + bcol0 + bj * HALF + 4 * n) : (f32x4){0.f, 0.f, 0.f, 0.f};
#pragma unroll
        for (int ai = 0; ai < 2; ++ai)
#pragma unroll
            for (int m = 0; m < 4; ++m) { bf16_t* rowp = base + (size_t)(row0 + ai * HALF + m * 16) * ldc + col0;
#pragma unroll
                for (int bj = 0; bj < 2; ++bj) { f32x4 v0 = acc[ai][bj][m][0] + bv[bj][0], v1 = acc[ai][bj][m][1] + bv[bj][1];
                    if (ACT == 1) { f32x2 a = gelu_pk((f32x2){v0[0], v0[1]}), b = gelu_pk((f32x2){v0[2], v0[3]}), c = gelu_pk((f32x2){v1[0], v1[1]}), d = gelu_pk((f32x2){v1[2], v1[3]});
                        v0 = (f32x4){a.x, a.y, b.x, b.y}; v1 = (f32x4){c.x, c.y, d.x, d.y}; }
                    v0 = v0 * sc; v1 = v1 * sc; u32x4 w; w.x = cvt_pk_bf16(v0[0], v0[1]); w.y = cvt_pk_bf16(v0[2], v0[3]); w.z = cvt_pk_bf16(v1[0], v1[1]); w.w = cvt_pk_bf16(v1[2], v1[3]);
                    *(u32x4*)(rowp + bj * HALF) = w; } }
    }
};
__device__ __forceinline__ float fast_sigmoid(float v) { return __builtin_amdgcn_rcpf(1.0f + __expf(-v)); }
__device__ __forceinline__ float bf_lo(unsigned w) { return __uint_as_float(w << 16); }
__device__ __forceinline__ float bf_hi(unsigned w) { return __uint_as_float(w & 0xffff0000u); }
struct EpiGlu {
    static constexpr bool PERM = true, AFTER_DRAIN = false;
    const bf16_t* Z; bf16_t* O; const float* bias;
    __device__ __forceinline__ void operator()(const f32x4 (&acc)[2][2][4][2], const Unit& u, int wr, int wc, int fr, int fq) const {
        const int row0 = u.pm * BM + wr * 64 + fr, col0 = u.pn * BM + wc * 32 + 8 * fq;
        f32x4 bv[2][2];
#pragma unroll
        for (int bj = 0; bj < 2; ++bj)
#pragma unroll
            for (int n = 0; n < 2; ++n) bv[bj][n] = *(const f32x4*)(bias + col0 + bj * HALF + 4 * n);
#pragma unroll
        for (int ai = 0; ai < 2; ++ai)
#pragma unroll
            for (int m = 0; m < 4; ++m) { const size_t row = (size_t)(row0 + ai * HALF + m * 16);
#pragma unroll
                for (int bj = 0; bj < 2; ++bj) { const int col = col0 + bj * HALF;
                    const u32x4 z = *(const u32x4*)(Z + row * 1024 + col);
                    const f32x4 v0 = acc[ai][bj][m][0] + bv[bj][0], v1 = acc[ai][bj][m][1] + bv[bj][1];
                    u32x4 w;
                    w.x = cvt_pk_bf16(bf_lo(z.x) * fast_sigmoid(v0[0]), bf_hi(z.x) * fast_sigmoid(v0[1]));
                    w.y = cvt_pk_bf16(bf_lo(z.y) * fast_sigmoid(v0[2]), bf_hi(z.y) * fast_sigmoid(v0[3]));
                    w.z = cvt_pk_bf16(bf_lo(z.z) * fast_sigmoid(v1[0]), bf_hi(z.z) * fast_sigmoid(v1[1]));
                    w.w = cvt_pk_bf16(bf_lo(z.w) * fast_sigmoid(v1[2]), bf_hi(z.w) * fast_sigmoid(v1[3]));
                    *(u32x4*)(O + row * 2048 + 1024 + col) = w; } }
    }
};
struct EpiSS {
    static constexpr bool PERM = true, AFTER_DRAIN = false;
    bf16_t* O; int ldc; float* SS;
    __device__ __forceinline__ void operator()(const f32x4 (&acc)[2][2][4][2], const Unit& u, int wr, int wc, int fr, int fq) const {
        const int row0 = u.pm * BM + wr * 64 + fr, col0 = u.pn * BM + wc * 32 + 8 * fq;
#pragma unroll
        for (int ai = 0; ai < 2; ++ai)
#pragma unroll
            for (int m = 0; m < 4; ++m) { const size_t row = (size_t)(row0 + ai * HALF + m * 16); float s = 0.f;
#pragma unroll
                for (int bj = 0; bj < 2; ++bj) { const f32x4 v0 = acc[ai][bj][m][0], v1 = acc[ai][bj][m][1];
                    s += (v0[0] * v0[0] + v0[1] * v0[1]) + (v0[2] * v0[2] + v0[3] * v0[3]) + (v1[0] * v1[0] + v1[1] * v1[1]) + (v1[2] * v1[2] + v1[3] * v1[3]);
                    u32x4 w; w.x = cvt_pk_bf16(v0[0], v0[1]); w.y = cvt_pk_bf16(v0[2], v0[3]); w.z = cvt_pk_bf16(v1[0], v1[1]); w.w = cvt_pk_bf16(v1[2], v1[3]);
                    *(u32x4*)(O + row * ldc + col0 + bj * HALF) = w; }
                s += __shfl_xor(s, 16); s += __shfl_xor(s, 32);
                if (fq == 0) SS[row * 32 + u.pn * 4 + wc] = s; }
    }
};
struct EpiGU {
    static constexpr bool PERM = true, AFTER_DRAIN = false;
    bf16_t* O; int ldc;
    __device__ __forceinline__ void operator()(const f32x4 (&acc)[2][2][4][2], const Unit& u, int wr, int wc, int fr, int fq) const {
        const int row0 = u.pm * BM + wr * 64 + fr, col0 = u.pn * HALF + wc * 32 + 8 * fq;
#pragma unroll
        for (int ai = 0; ai < 2; ++ai)
#pragma unroll
            for (int m = 0; m < 4; ++m) { const size_t row = (size_t)(row0 + ai * HALF + m * 16);
                const f32x4 g0 = acc[ai][0][m][0], g1 = acc[ai][0][m][1], u0 = acc[ai][1][m][0], u1 = acc[ai][1][m][1];
                u32x4 w;
                w.x = cvt_pk_bf16(g0[0] * fast_sigmoid(g0[0]) * u0[0], g0[1] * fast_sigmoid(g0[1]) * u0[1]);
                w.y = cvt_pk_bf16(g0[2] * fast_sigmoid(g0[2]) * u0[2], g0[3] * fast_sigmoid(g0[3]) * u0[3]);
                w.z = cvt_pk_bf16(g1[0] * fast_sigmoid(g1[0]) * u1[0], g1[1] * fast_sigmoid(g1[1]) * u1[1]);
                w.w = cvt_pk_bf16(g1[2] * fast_sigmoid(g1[2]) * u1[2], g1[3] * fast_sigmoid(g1[3]) * u1[3]);
                *(u32x4*)(O + row * ldc + col0) = w; }
    }
};
template <class Epi, class Sched, bool ALIGN_EPI = false, bool SP2 = false>
__device__ __forceinline__ void gemm_phase(PG8_LAS unsigned char* lds, const Gemm g, const Sched& S, const Epi& E) {
    const int tid = threadIdx.x, wid = __builtin_amdgcn_readfirstlane(tid >> 6), lane = tid & 63, wr = wid >> 2, wc = wid & 3, fr = lane & 15, fq = lane >> 4;
    const int K = g.K, nt = K / BK;
    unsigned voffA[2], voffB[2];
#pragma unroll
    for (int i = 0; i < 2; ++i) { int R, C; stage_rc(tid * 16 + i * 8192, R, C); const int Rb = Epi::PERM ? ((R & ~31) + perm32(R & 31)) : R;
        voffA[i] = (unsigned)(R * K + C) * 2u; voffB[i] = (unsigned)(Rb * K + C) * 2u; }
    const size_t kstep = (size_t)(BK * 2);
    const size_t hstep = (size_t)HALF * K * 2;
    const size_t tstep = 2 * hstep;
    const unsigned ldsw = (unsigned)wid * 1024u;
    const int aoff = lds_byte(wr * 64 + fr, fq * 8), boff = lds_byte(wc * 32 + fr, fq * 8);
#define PG8_SA(b, h) (((b) * 2 + (h)) * HTB)
#define PG8_SB(b, h) ((4 + (b) * 2 + (h)) * HTB)
#define PG8_STAGE(bufoff, gbase, voff) do { _Pragma("unroll") for (int _i = 0; _i < 2; ++_i) \
        __builtin_amdgcn_global_load_lds((const unsigned*)((const char*)(gbase) + (voff)[_i]), (PG8_LAS unsigned*)(lds + (bufoff) + ldsw + _i * 8192), 16, 0, 0); } while (0)
#define PG8_LDA(dst, b, h) do { _Pragma("unroll") for (int m = 0; m < 4; ++m) _Pragma("unroll") for (int k = 0; k < 2; ++k) dst[m][k] = *(const PG8_LAS bf16x8*)(lds + PG8_SA(b, h) + aoff + m * 2048 + k * 1024); } while (0)
#define PG8_LDB(dst, b, h) do { _Pragma("unroll") for (int n = 0; n < 2; ++n) _Pragma("unroll") for (int k = 0; k < 2; ++k) dst[n][k] = *(const PG8_LAS bf16x8*)(lds + PG8_SB(b, h) + boff + n * 2048 + k * 1024); } while (0)
#define PG8_MMA(ai, bj, At, Bt) do { __builtin_amdgcn_s_setprio(1); _Pragma("unroll") for (int m = 0; m < 4; ++m) _Pragma("unroll") for (int n = 0; n < 2; ++n) _Pragma("unroll") for (int k = 0; k < 2; ++k) \
        acc[ai][bj][m][n] = __builtin_amdgcn_mfma_f32_16x16x32_bf16(Bt[n][k], At[m][k], acc[ai][bj][m][n], 0, 0, 0); __builtin_amdgcn_s_setprio(0); } while (0)
#define PG8_WAIT_V(n) asm volatile("s_waitcnt vmcnt(" #n ")" ::: "memory")
#define PG8_WAIT_L(n) asm volatile("s_waitcnt lgkmcnt(" #n ")" ::: "memory")
#define PG8_BAR __builtin_amdgcn_s_barrier()
#define PG8_SCHED __builtin_amdgcn_sched_barrier(0)
    Unit cur, nxt; int ui = 0;
    if (!S.next(0, cur)) return;
    f32x4 acc[2][2][4][2];
#pragma unroll
    for (int a = 0; a < 2; ++a)
#pragma unroll
        for (int b = 0; b < 2; ++b)
#pragma unroll
            for (int m = 0; m < 4; ++m)
#pragma unroll
                for (int n = 0; n < 2; ++n) acc[a][b][m][n] = (f32x4){0.f, 0.f, 0.f, 0.f};
    bf16x8 At[4][2], B0[2][2], B1[2][2];
    const char* cA = (const char*)g.A + (size_t)cur.pm * tstep; const char* cB = (const char*)g.Bt + (size_t)cur.pn * tstep;
    S.a_ready(cur);
    if constexpr (SP2) {
        PG8_STAGE(PG8_SB(0, 0), cB, voffB); PG8_STAGE(PG8_SB(0, 1), cB + hstep, voffB); PG8_STAGE(PG8_SA(0, 0), cA, voffA); PG8_STAGE(PG8_SA(0, 1), cA + hstep, voffA);
        if (wr == 1) PG8_BAR;
        PG8_WAIT_V(2); PG8_BAR;
        PG8_STAGE(PG8_SB(1, 0), cB + kstep, voffB); PG8_STAGE(PG8_SA(1, 0), cA + kstep, voffA); PG8_STAGE(PG8_SB(1, 1), cB + hstep + kstep, voffB);
        PG8_WAIT_V(6); PG8_BAR;
    } else {
        PG8_STAGE(PG8_SB(0, 0), cB, voffB); PG8_STAGE(PG8_SA(0, 0), cA, voffA); PG8_STAGE(PG8_SB(0, 1), cB + hstep, voffB); PG8_STAGE(PG8_SA(0, 1), cA + hstep, voffA);
        if (wr == 1) PG8_BAR;
        PG8_WAIT_V(4); PG8_BAR;
        PG8_STAGE(PG8_SB(1, 0), cB + kstep, voffB); PG8_STAGE(PG8_SA(1, 0), cA + kstep, voffA); PG8_STAGE(PG8_SB(1, 1), cB + hstep + kstep, voffB);
        PG8_WAIT_V(6); PG8_BAR;
    }
    for (;;) {
        const bool has_next = S.next(ui + 1, nxt);
        const char* nA = has_next ? (const char*)g.A + (size_t)nxt.pm * tstep : cA; const char* nB = has_next ? (const char*)g.Bt + (size_t)nxt.pn * tstep : cB;
        for (int t = 0; t < nt; t += 2) {
            const bool last = (t == nt - 2);
            const char* a1 = cA + (size_t)(t + 1) * kstep;
            const char* a2 = last ? nA : cA + (size_t)(t + 2) * kstep; const char* b2 = last ? nB : cB + (size_t)(t + 2) * kstep;
            const char* a3 = a2 + kstep; const char* b3 = b2 + kstep;
            if (last && has_next) S.a_ready(nxt);
            if constexpr (SP2) {
            PG8_LDB(B0, 0, 0); PG8_LDB(B1, 0, 1); PG8_SCHED; PG8_LDA(At, 0, 0); PG8_STAGE(PG8_SA(1, 1), a1 + hstep, voffA);
            PG8_WAIT_V(8); PG8_WAIT_L(0); PG8_BAR; PG8_MMA(0, 0, At, B0); PG8_MMA(0, 1, At, B1); PG8_BAR; PG8_SCHED;
            PG8_LDA(At, 0, 1); PG8_STAGE(PG8_SB(0, 0), b2, voffB); PG8_STAGE(PG8_SB(0, 1), b2 + hstep, voffB); PG8_STAGE(PG8_SA(0, 0), a2, voffA);
            PG8_WAIT_V(8); PG8_WAIT_L(0); PG8_BAR; PG8_MMA(1, 0, At, B0); PG8_MMA(1, 1, At, B1); PG8_BAR; PG8_SCHED;
            PG8_LDB(B0, 1, 0); PG8_LDB(B1, 1, 1); PG8_SCHED; PG8_LDA(At, 1, 0); PG8_STAGE(PG8_SA(0, 1), a2 + hstep, voffA);
            PG8_WAIT_V(8); PG8_WAIT_L(0); PG8_BAR; PG8_MMA(0, 0, At, B0); PG8_MMA(0, 1, At, B1); PG8_BAR; PG8_SCHED;
            PG8_LDA(At, 1, 1); PG8_STAGE(PG8_SB(1, 0), b3, voffB); PG8_STAGE(PG8_SB(1, 1), b3 + hstep, voffB); PG8_STAGE(PG8_SA(1, 0), a3, voffA);
            PG8_WAIT_V(8); PG8_WAIT_L(0); PG8_BAR; PG8_MMA(1, 0, At, B0); PG8_MMA(1, 1, At, B1); PG8_BAR; PG8_SCHED;
            } else {
            PG8_LDB(B0, 0, 0); PG8_SCHED; PG8_LDA(At, 0, 0); PG8_STAGE(PG8_SA(1, 1), a1 + hstep, voffA);
            PG8_WAIT_L(8); PG8_BAR; PG8_WAIT_L(0); PG8_MMA(0, 0, At, B0); PG8_BAR; PG8_SCHED;
            PG8_LDB(B1, 0, 1); PG8_STAGE(PG8_SB(0, 0), b2, voffB);
            PG8_BAR; PG8_WAIT_L(0); PG8_MMA(0, 1, At, B1); PG8_BAR;
            PG8_LDA(At, 0, 1); PG8_STAGE(PG8_SA(0, 0), a2, voffA);
            PG8_BAR; PG8_WAIT_L(0); PG8_MMA(1, 0, At, B0); PG8_BAR; PG8_SCHED;
            PG8_STAGE(PG8_SB(0, 1), b2 + hstep, voffB);
            PG8_WAIT_V(6); PG8_BAR; PG8_MMA(1, 1, At, B1); PG8_BAR;
            PG8_LDB(B0, 1, 0); PG8_SCHED; PG8_LDA(At, 1, 0); PG8_STAGE(PG8_SA(0, 1), a2 + hstep, voffA);
            PG8_WAIT_L(8); PG8_BAR; PG8_WAIT_L(0); PG8_MMA(0, 0, At, B0); PG8_BAR; PG8_SCHED;
            PG8_LDB(B1, 1, 1); PG8_STAGE(PG8_SB(1, 0), b3, voffB);
            PG8_BAR; PG8_WAIT_L(0); PG8_MMA(0, 1, At, B1); PG8_BAR;
            PG8_LDA(At, 1, 1); PG8_STAGE(PG8_SA(1, 0), a3, voffA);
            PG8_BAR; PG8_WAIT_L(0); PG8_MMA(1, 0, At, B0); PG8_BAR; PG8_SCHED;
            PG8_STAGE(PG8_SB(1, 1), b3 + hstep, voffB);
            PG8_WAIT_V(6); PG8_BAR; PG8_MMA(1, 1, At, B1); PG8_BAR;
            }
        }
        if constexpr (ALIGN_EPI) { if (wr == 0) PG8_BAR; }
        if constexpr (!Epi::AFTER_DRAIN) { E(acc, cur, wr, wc, fr, fq); S.done(cur); }
        if (!has_next) break;
#pragma unroll
        for (int a = 0; a < 2; ++a)
#pragma unroll
            for (int b = 0; b < 2; ++b)
#pragma unroll
                for (int m = 0; m < 4; ++m)
#pragma unroll
                    for (int n = 0; n < 2; ++n) acc[a][b][m][n] = (f32x4){0.f, 0.f, 0.f, 0.f};
        cur = nxt; cA = nA; cB = nB; ++ui;
        if constexpr (ALIGN_EPI) { if (wr == 1) PG8_BAR; }
    }
    PG8_WAIT_V(0);
    if constexpr (!ALIGN_EPI) { if (wr == 0) PG8_BAR; }
    PG8_BAR;
    if constexpr (Epi::AFTER_DRAIN) { E.fused(acc, cur, wr, wc, fr, fq, lds, wid, lane); S.done(cur); }
#undef PG8_SA
#undef PG8_SB
#undef PG8_STAGE
#undef PG8_LDA
#undef PG8_LDB
#undef PG8_MMA
#undef PG8_WAIT_V
#undef PG8_WAIT_L
#undef PG8_BAR
#undef PG8_SCHED
}
}
#define GAS __attribute__((address_space(1)))
#define LAS __attribute__((address_space(3)))
typedef unsigned short bf16;
typedef unsigned v4u __attribute__((ext_vector_type(4)));
typedef float f32x4 __attribute__((ext_vector_type(4)));
typedef short bf16x8 __attribute__((ext_vector_type(8)));
typedef GAS unsigned gu32;
typedef GAS unsigned long long gu64;
#define RLX_AGENT __ATOMIC_RELAXED, __HIP_MEMORY_SCOPE_AGENT
#define LDS_WAIT() asm volatile("s_waitcnt lgkmcnt(0)" ::: "memory")
#define VM_WAIT() asm volatile("s_waitcnt vmcnt(0)" ::: "memory")
__device__ __forceinline__ unsigned long long rt() { return __builtin_amdgcn_s_memrealtime(); }
__device__ __forceinline__ unsigned f2bf(float f) { unsigned u = __builtin_bit_cast(unsigned, f); return (u + 0x7fffu + ((u >> 16) & 1u)) >> 16; }
__device__ __forceinline__ unsigned pk2(float lo, float hi) { return f2bf(lo) | (f2bf(hi) << 16); }
#define XB_TMO      128
#define XB_XCNT(j)  (256  + 64 * (j))
#define XB_XSUB(j)  (1280 + 64 * (j))
#define XB_XGEN(j)  (2304 + 64 * (j))
#define XB_TOP      3328
#define XB_TOPGEN   3392
#define XCD_BAR_WORDS 3456
#define XB_SPIN_CAP (1u << 18)

__device__ __forceinline__ unsigned xb_ld(unsigned* p)              { return __hip_atomic_load(p, __ATOMIC_RELAXED, __HIP_MEMORY_SCOPE_AGENT); }
__device__ __forceinline__ unsigned xb_add(unsigned* p, unsigned v) { return __hip_atomic_fetch_add(p, v, __ATOMIC_RELAXED, __HIP_MEMORY_SCOPE_AGENT); }
__device__ __forceinline__ unsigned xb_xcc_id() { return (unsigned)__builtin_amdgcn_s_getreg((3 << 11) | 20) & 0xFu; }
#define XB_SPIN(cond, bar) do { unsigned _sp = 0; while (cond) { __builtin_amdgcn_s_sleep(1); \
    if ((++_sp & 255u) == 0u) { if (xb_ld(&(bar)[XB_TMO])) break; if (_sp > XB_SPIN_CAP) { atomicAdd(&(bar)[XB_TMO], 1u); break; } } } } while (0)

struct XcdBarrier {
    unsigned* bar; unsigned x;
    volatile LAS unsigned* st;
};

__device__ __forceinline__ XcdBarrier xcd_barrier_post(unsigned* bar, volatile LAS unsigned* st) {
    XcdBarrier b; b.bar = bar; b.x = xb_xcc_id(); b.st = st;
    if (threadIdx.x == 0) (void)xb_add(&bar[XB_XCNT(b.x)], 1u);
    return b;
}
__device__ __forceinline__ void xcd_barrier_complete(unsigned* bar, unsigned x, unsigned& nloc, unsigned& nx) {
    const unsigned G = gridDim.x * gridDim.y * gridDim.z;
    unsigned sum, cnt, mine, sp = 0u;
    for (;;) {
        sum = 0u; cnt = 0u; mine = 0u;
#pragma unroll
        for (unsigned j = 0; j < 16; ++j) { const unsigned c = xb_ld(&bar[XB_XCNT(j)]); sum += c; cnt += (c > 0u) ? 1u : 0u; mine = (j == x) ? c : mine; }
        if (sum == G) break;
        __builtin_amdgcn_s_sleep(1);
        if ((++sp & 255u) == 0u) { if (xb_ld(&bar[XB_TMO])) break; if (sp > XB_SPIN_CAP) { atomicAdd(&bar[XB_TMO], 1u); break; } }
    }
    nloc = mine > 0u ? mine : 1u; nx = cnt > 0u ? cnt : 1u;
}

__device__ __forceinline__ void xcd_barrier(const XcdBarrier& b) {
    asm volatile("s_waitcnt vmcnt(0)" ::: "memory");
    __syncthreads();
    if (threadIdx.x == 0) {
        unsigned* bar = b.bar;
        __builtin_amdgcn_s_waitcnt(0);
        unsigned nloc = b.st[0], nx = b.st[1];
        if (nloc == 0u) { xcd_barrier_complete(bar, b.x, nloc, nx); b.st[0] = nloc; b.st[1] = nx; }
        const unsigned old = xb_add(&bar[XB_XSUB(b.x)], 1u);
        const unsigned gen = old / nloc;
        if (old + 1u == (gen + 1u) * nloc) {
            __builtin_amdgcn_fence(__ATOMIC_RELEASE, "agent");
            asm volatile("s_waitcnt vmcnt(0)" ::: "memory");
            const unsigned og = xb_add(&bar[XB_TOP], 1u);
            const unsigned tg = og / nx;
            if (og + 1u == (tg + 1u) * nx) xb_add(&bar[XB_TOPGEN], 1u);
            else XB_SPIN(xb_ld(&bar[XB_TOPGEN]) == tg, bar);
            __builtin_amdgcn_fence(__ATOMIC_ACQUIRE, "agent");
            xb_add(&bar[XB_XGEN(b.x)], 1u);
            asm volatile("s_waitcnt vmcnt(0)" ::: "memory");
        } else {
            XB_SPIN(xb_ld(&bar[XB_XGEN(b.x)]) == gen, bar);
            __builtin_amdgcn_fence(__ATOMIC_ACQUIRE, "agent");
            asm volatile("s_waitcnt vmcnt(0)" ::: "memory");
        }
    }
    __syncthreads();
}
constexpr int NWAVES = 8;
#ifndef MK_N_LAUNCHES
#define MK_N_LAUNCHES 1
#endif
constexpr int N_PHASES = 10;
constexpr int N_LAUNCHES = MK_N_LAUNCHES;

constexpr int DM = 2048, NBATCH = 8, SEQ = 2048, MP = NBATCH * SEQ, SBATCH = 8, SLEN = 16, MS = SBATCH * SLEN, MT = MP + MS;
constexpr int NH = 4, DV = 256, DQK = 128, QKW = 1024, NG = 64, GCH = 16, PST = 64, DFF = 5632, NIN = 4104;
constexpr int CH = 64, NCH = SEQ / CH;
constexpr int NSC = NBATCH * NCH + SBATCH;
constexpr float EPS = 1e-6f;
constexpr int DVS = 64, NSL = DV / DVS;

constexpr size_t O_Y = 0, O_CONVP = (size_t)MT * DM, O_CP = O_CONVP + 8 * 3 * 1024, O_NP = O_CP + 8 * 4 * 256 * 128, O_MP = O_NP + 8 * 4 * 128,
                 O_SRP = O_MP + 32, O_SIP = O_SRP + 8 * 64 * 64, O_CONVS = O_SIP + 8 * 64 * 64, O_CS = O_CONVS + 8 * 3 * 1024, O_NS = O_CS + 8 * 4 * 256 * 128,
                 O_MS = O_NS + 8 * 4 * 128, O_SRS = O_MS + 32, O_SIS = O_SRS + 8 * 64 * 64, O_END = O_SIS + 8 * 64 * 64;
static_assert(O_END == 36102208, "d_out map");

constexpr size_t MiB = 1u << 20;
constexpr size_t WS_CTL = 0, CTL_ZERO_BYTES = 1 * MiB;
constexpr size_t WS_WIN = 2 * MiB, WS_WGLU = 18 * MiB, WS_WOUT = 20 * MiB, WS_WGU = 28 * MiB, WS_WD = 72 * MiB;
constexpr size_t WS_XN = 96 * MiB;
constexpr size_t WS_R0 = 162 * MiB, WS_RSTRIDE = 33 * MiB;
constexpr size_t WS_QKRAW = WS_R0, WS_V = WS_R0 + WS_RSTRIDE, WS_OG = WS_R0 + 2 * WS_RSTRIDE, WS_U = WS_R0 + 3 * WS_RSTRIDE;
constexpr size_t WS_Q = 294 * MiB, WS_K = 311 * MiB, WS_KT = 328 * MiB, WS_VT = 345 * MiB;
constexpr size_t WS_Z = WS_QKRAW;
constexpr size_t WS_HS = WS_V;
constexpr size_t WS_MIXIN = WS_Q;
constexpr size_t WS_MIX = WS_R0;
constexpr size_t WS_ACT = WS_R0;
constexpr size_t WS_FF = WS_XN;
constexpr size_t WS_GATES = 378 * MiB, WS_HSS = 379 * MiB, WS_SS1 = 382 * MiB, WS_SS2 = 385 * MiB, WS_S5P = 388 * MiB, WS_SSS = 389 * MiB, WS_END = 390 * MiB;
static_assert(WS_XN + (size_t)MT * DM * 2 <= WS_R0 && WS_QKRAW + (size_t)MT * 1024 * 2 <= WS_V && WS_U + (size_t)MT * 1024 * 2 <= WS_Q && WS_Q + (size_t)MT * 512 * 2 <= WS_K &&
              WS_K + (size_t)MT * 512 * 2 <= WS_KT && WS_KT + (size_t)NSC * 4 * 128 * 64 * 2 <= WS_VT && WS_VT + (size_t)NSC * 4 * 256 * 64 * 2 <= WS_GATES &&
              WS_MIXIN + (size_t)MT * DM * 2 <= WS_GATES && WS_MIX + (size_t)MT * DM * 2 <= WS_OG && WS_ACT + (size_t)MT * DFF * 2 <= WS_GATES &&
              WS_WD + (size_t)DM * DFF * 2 <= WS_XN && WS_WGU + (size_t)2 * DFF * DM * 2 <= WS_WD && WS_HSS + (size_t)MT * 32 * 4 <= WS_SS1 && WS_SS1 + (size_t)MT * 32 * 4 <= WS_SS2 &&
              WS_SS2 + (size_t)MT * 32 * 4 <= WS_S5P && WS_GATES + (size_t)MT * 8 * 4 <= WS_HSS, "d_ws map");
constexpr size_t S5P_LAM = 0, S5P_BBT = 64 * 1024, S5P_CC = S5P_BBT + 64 * 128 * 16 * 2;
constexpr size_t SSS_1 = 0, SSS_2 = 128 * 128 * 4;
constexpr int CW_TMO = 0, CW_CODE = 1, CW_BAR = 4096;

constexpr int RING_OFF = 0, RING_BYTES = 131072;
constexpr int LDSCTL_OFF = RING_BYTES, MISC_OFF = LDSCTL_OFF + 320;
constexpr int LDS_BYTES = 147456;
typedef short s16x4 __attribute__((ext_vector_type(4)));
typedef unsigned u32x2 __attribute__((ext_vector_type(2)));
struct Frame {
    LAS unsigned char* lds;
    volatile LAS unsigned* MISC;
    gu32* ctl;
    int tid, lane, wave;
    int vcu, G;
    const float* const* in;
    float* out; unsigned char* ws;
};
__device__ __forceinline__ float wave_sum(float v) {
#pragma unroll
    for (int o = 1; o < 64; o <<= 1) v += __shfl_xor(v, o);
    return v;
}
__device__ __forceinline__ unsigned cvtpk(float lo, float hi) { unsigned r; asm volatile("v_cvt_pk_bf16_f32 %0, %1, %2" : "=v"(r) : "v"(lo), "v"(hi)); return r; }
typedef __bf16 bf16x2n_t __attribute__((ext_vector_type(2)));
__device__ __forceinline__ unsigned cvtpk_n(float lo, float hi) { const bf16x2n_t v = {(__bf16)lo, (__bf16)hi}; return __builtin_bit_cast(unsigned, v); }
__device__ __forceinline__ float bflo(unsigned w) { return __uint_as_float(w << 16); }
__device__ __forceinline__ float bfhi(unsigned w) { return __uint_as_float(w & 0xffff0000u); }
__device__ __forceinline__ float bf2f(bf16 h) { return __uint_as_float((unsigned)h << 16); }
__device__ __forceinline__ float sigmoidf_(float v) { return __builtin_amdgcn_rcpf(1.0f + __expf(-v)); }
__device__ __forceinline__ f32x4 mfma16(bf16x8 a, bf16x8 b, f32x4 c) { return __builtin_amdgcn_mfma_f32_16x16x32_bf16(a, b, c, 0, 0, 0); }
#define WAVE_SYNC() do { asm volatile("s_waitcnt lgkmcnt(0)" ::: "memory"); __builtin_amdgcn_wave_barrier(); } while (0)

struct Args { const float* in[32]; float* out; unsigned char* ws; int ph_lo, ph_hi, li, pad; };

__device__ __forceinline__ void p0_transpose_item(const float* W, int ldw, int src_col0, int k0, bf16* WT, int K, int out_row0, LAS float* scr, int lane) {
#pragma unroll 8
    for (int i = 0; i < 32; ++i) { const int kk = 2 * i + (lane >> 5); scr[kk * 33 + (lane & 31)] = W[(size_t)(k0 + kk) * ldw + src_col0 + (lane & 31)]; }
    LDS_WAIT(); asm volatile("" ::: "memory");
    const int c = lane & 7;
#pragma unroll
    for (int j = 0; j < 4; ++j) { const int n = (lane >> 3) + 8 * j; const LAS float* s = scr + (8 * c) * 33 + n;
        v4u o; o.x = pk2(s[0 * 33], s[1 * 33]); o.y = pk2(s[2 * 33], s[3 * 33]); o.z = pk2(s[4 * 33], s[5 * 33]); o.w = pk2(s[6 * 33], s[7 * 33]);
        *(GAS v4u*)(WT + (size_t)(out_row0 + n) * K + k0 + 8 * c) = o; }
    LDS_WAIT(); asm volatile("" ::: "memory");
}
__device__ __forceinline__ float log_sigmoid(float x) { return fminf(x, 0.f) - log1pf(__expf(-fabsf(x))); }

__device__ __forceinline__ void p0_prologue(const Args& A, LAS unsigned char* lds, int tid, int lane, int wave, int vcu, int G) {
    unsigned char* ws = A.ws;
    LAS float* WG = (LAS float*)lds;
    LAS float* scr = (LAS float*)(lds + wave * 8448);
    const int gw = vcu * NWAVES + wave, NGW = G * NWAVES;
    constexpr int I_IN = (DM / 64) * (4096 / 32), I_GLU = (1024 / 64) * (1024 / 32), I_OUT = (DM / 64) * (DM / 32), I_GU = (DM / 64) * (2 * DFF / 32), I_D = (DFF / 64) * (DM / 32);
    constexpr int NITEMS = I_IN + I_GLU + I_OUT + I_GU + I_D;
    for (int it = gw; it < NITEMS; it += NGW) {
        int r = it;
        if (r < I_IN) { const int nnb = 4096 / 32, kb = r / nnb, nb = r % nnb, orow = 32 * nb; const int sc = orow < 3072 ? orow : orow + 8;
            p0_transpose_item(A.in[9], NIN, sc, 64 * kb, (bf16*)(ws + WS_WIN), DM, orow, scr, lane); continue; } r -= I_IN;
        if (r < I_GLU) { const int nnb = 1024 / 32, kb = r / nnb, nb = r % nnb; p0_transpose_item(A.in[23], 1024, 32 * nb, 64 * kb, (bf16*)(ws + WS_WGLU), 1024, 32 * nb, scr, lane); continue; } r -= I_GLU;
        if (r < I_OUT) { const int nnb = DM / 32, kb = r / nnb, nb = r % nnb; p0_transpose_item(A.in[25], DM, 32 * nb, 64 * kb, (bf16*)(ws + WS_WOUT), DM, 32 * nb, scr, lane); continue; } r -= I_OUT;
        if (r < I_GU) { const int nnb = 2 * DFF / 32, kb = r / nnb, nb = r % nnb, orow = 32 * nb, pn = orow >> 8, c = orow & 255;
            p0_transpose_item(c < 128 ? A.in[28] : A.in[29], DFF, 128 * pn + (c & 127), 64 * kb, (bf16*)(ws + WS_WGU), DM, orow, scr, lane); continue; } r -= I_GU;
        { const int nnb = DM / 32, kb = r / nnb, nb = r % nnb; p0_transpose_item(A.in[30], DM, 32 * nb, 64 * kb, (bf16*)(ws + WS_WD), DFF, 32 * nb, scr, lane); }
    }
    { const int gt = vcu * (NWAVES * 64) + tid;
      if (gt < NG * PST) {
        const int g = gt >> 6, p = gt & 63;
        const double lr = (double)A.in[15][gt], li = (double)A.in[16][gt], dt = exp((double)A.in[17][g]);
        const double mag = exp(lr * dt), ang = li * dt, lbr = mag * cos(ang), lbi = mag * sin(ang);
        const double den = lr * lr + li * li, nr = lbr - 1.0, fre = (nr * lr + lbi * li) / den, fim = (lbi * lr - nr * li) / den;
        float* LAM = (float*)(ws + WS_S5P + S5P_LAM); LAM[gt * 2] = (float)lbr; LAM[gt * 2 + 1] = (float)lbi;
        bf16* BBT = (bf16*)(ws + WS_S5P + S5P_BBT); bf16* CC = (bf16*)(ws + WS_S5P + S5P_CC);
        const float* bre = A.in[18] + (size_t)gt * 16; const float* bim = A.in[19] + (size_t)gt * 16;
#pragma unroll
        for (int i = 0; i < 16; ++i) { const double br = bre[i], bi = bim[i];
            BBT[((size_t)g * 128 + p) * 16 + i] = (bf16)f2bf((float)(fre * br - fim * bi));
            BBT[((size_t)g * 128 + 64 + p) * 16 + i] = (bf16)f2bf((float)(fre * bi + fim * br));
            CC[((size_t)g * 16 + i) * 128 + p] = (bf16)f2bf(A.in[20][((size_t)g * 16 + i) * 64 + p]);
            CC[((size_t)g * 16 + i) * 128 + 64 + p] = (bf16)f2bf(-A.in[21][((size_t)g * 16 + i) * 64 + p]); }
      } }
    __syncthreads();
    { const float* win = A.in[9];
      for (int e = tid; e < 8 * 2048; e += NWAVES * 64) { const int k = e >> 3, c = e & 7; WG[c * 2048 + k] = win[(size_t)k * NIN + 3072 + c]; } }
    __syncthreads();
    { const GAS f32x4* gp = (const GAS f32x4*)A.in[8] + lane; f32x4 gv[8];
#pragma unroll
      for (int j = 0; j < 8; ++j) gv[j] = gp[64 * j];
      bf16* XN = (bf16*)(ws + WS_XN); float* GATES = (float*)(ws + WS_GATES);
      for (int m = gw; m < MT; m += NGW) {
        const float* xrow = m < MP ? A.in[0] + (size_t)m * DM : A.in[1] + (size_t)(m - MP) * DM;
        const GAS f32x4* xr = (const GAS f32x4*)xrow + lane;
        f32x4 v[8]; float s = 0.f;
#pragma unroll
        for (int j = 0; j < 8; ++j) { v[j] = xr[64 * j]; s += (v[j].x * v[j].x + v[j].y * v[j].y) + (v[j].z * v[j].z + v[j].w * v[j].w); }
        const float rstd = 1.0f / sqrtf(wave_sum(s) * (1.0f / DM) + EPS);
        GAS u32x2* o8 = (GAS u32x2*)(XN + (size_t)m * DM) + lane;
        float ga[8] = {0.f, 0.f, 0.f, 0.f, 0.f, 0.f, 0.f, 0.f};
#pragma unroll
        for (int j = 0; j < 8; ++j) { v[j] = v[j] * rstd * gv[j]; u32x2 o; o.x = cvtpk(v[j].x, v[j].y); o.y = cvtpk(v[j].z, v[j].w); o8[64 * j] = o;
#pragma unroll
            for (int c = 0; c < 8; ++c) { const f32x4 w = *(const LAS f32x4*)(WG + c * 2048 + 256 * j + 4 * lane); ga[c] += (v[j].x * w.x + v[j].y * w.y) + (v[j].z * w.z + v[j].w * w.w); } }
#pragma unroll
        for (int c = 0; c < 8; ++c) ga[c] = wave_sum(ga[c]);
        if (lane < 8) { float val = 0.f;
#pragma unroll
            for (int c = 0; c < 8; ++c) if (lane == c) val = ga[c];
            if (lane < 4) val += A.in[12][lane]; else val = log_sigmoid(val + A.in[13][lane - 4]);
            GATES[(size_t)m * 8 + lane] = val; }
      } }
}

template <int NACC, class RowMap, class Epi>
__device__ __forceinline__ void skinny_gemm(const bf16* Arows, const bf16* Bt, int K, int nitems, int first, int stride, int wave, int lane, RowMap rm, Epi epi) {
    const int fr = lane & 15, fq = lane >> 4;
    const bf16* arow = Arows + (size_t)(16 * wave + fr) * K + 8 * fq;
    for (int it = first; it < nitems; it += stride) {
        const bf16* brow[NACC]; f32x4 acc[NACC];
#pragma unroll
        for (int a = 0; a < NACC; ++a) { brow[a] = Bt + (size_t)rm(it, a, fr) * K + 8 * fq; acc[a] = (f32x4){0.f, 0.f, 0.f, 0.f}; }
#pragma unroll 4
        for (int k = 0; k < K; k += 32) {
            const bf16x8 av = *(const bf16x8*)(arow + k);
#pragma unroll
            for (int a = 0; a < NACC; ++a) { const bf16x8 bv = *(const bf16x8*)(brow[a] + k); acc[a] = mfma16(bv, av, acc[a]); }
        }
        epi(it, 16 * wave + fr, fq, acc);
    }
}

__device__ __forceinline__ void p2_prep(const Args& A, LAS unsigned char* lds, int tid, int vcu, int G) {
    unsigned char* ws = A.ws;
    const bf16* QKRAW = (const bf16*)(ws + WS_QKRAW); const bf16* V = (const bf16*)(ws + WS_V);
    bf16* Q = (bf16*)(ws + WS_Q); bf16* Kb = (bf16*)(ws + WS_K); bf16* KT = (bf16*)(ws + WS_KT); bf16* VT = (bf16*)(ws + WS_VT);
    LAS float* Xs = (LAS float*)lds;
    LAS bf16* Ts = (LAS bf16*)(lds + 40960);
    for (int it = vcu; it < NSC * 12; it += G) {
        const int sc = it / 12, j = it % 12;
        int row0, L, b; bool first, lastc;
        if (sc < NBATCH * NCH) { b = sc / NCH; const int c = sc % NCH; row0 = b * SEQ + c * CH; L = CH; first = (c == 0); lastc = (c == NCH - 1); }
        else { b = sc - NBATCH * NCH; row0 = MP + b * SLEN; L = SLEN; first = true; lastc = true; }
        const bool sample = sc >= NBATCH * NCH;
        if (j < 8) {
            const int c0 = 128 * j;
            for (int e = tid; e < (L + 3) * 16; e += NWAVES * 64) { const int r = (e >> 4) - 3, ch = e & 15; float f[8];
                if (r >= 0 || !first) { const v4u w = *(const GAS v4u*)(QKRAW + (size_t)(row0 + r) * 1024 + c0 + 8 * ch);
                    f[0] = bflo(w.x); f[1] = bfhi(w.x); f[2] = bflo(w.y); f[3] = bfhi(w.y); f[4] = bflo(w.z); f[5] = bfhi(w.z); f[6] = bflo(w.w); f[7] = bfhi(w.w); }
                else if (sample) { const float* sp = A.in[2] + ((size_t)b * 3 + (r + 3)) * 1024 + c0 + 8 * ch;
#pragma unroll
                    for (int i = 0; i < 8; ++i) f[i] = sp[i]; }
                else {
#pragma unroll
                    for (int i = 0; i < 8; ++i) f[i] = 0.f; }
#pragma unroll
                for (int i = 0; i < 8; ++i) Xs[(r + 3) * 129 + 8 * ch + i] = f[i]; }
            __syncthreads();
            const int c = tid & 127, rg = tid >> 7, col = c0 + c;
            const float w0 = A.in[10][col], w1 = A.in[10][1024 + col], w2 = A.in[10][2048 + col], w3 = A.in[10][3072 + col], bc = A.in[11][col];
            const int t0 = 16 * rg;
            if (j >= 4 && L < CH) { for (int t = t0; t < t0 + 16; ++t) if (t >= L) Ts[c * 72 + t] = 0; }
            if (t0 < L) {
                float x0 = Xs[(t0 + 0) * 129 + c], x1 = Xs[(t0 + 1) * 129 + c], x2 = Xs[(t0 + 2) * 129 + c];
                for (int t = t0; t < t0 + 16 && t < L; ++t) {
                    const float x3 = Xs[(t + 3) * 129 + c];
                    const float val = bc + w0 * x0 + w1 * x1 + w2 * x2 + w3 * x3;
                    float s = val * sigmoidf_(val);
                    if (j < 4) { s *= 0.08838834764831845f; Q[(size_t)(row0 + t) * 512 + col] = (bf16)f2bf(s); }
                    else { const bf16 hb = (bf16)f2bf(s); Kb[(size_t)(row0 + t) * 512 + (col - 512)] = hb; Ts[c * 72 + t] = hb; }
                    if (lastc && t >= L - 3) { float* cv = A.out + (sample ? O_CONVS : O_CONVP) + ((size_t)b * 3 + (t - (L - 3))) * 1024 + col; *cv = x3; }
                    x0 = x1; x1 = x2; x2 = x3;
                }
            }
            __syncthreads();
            if (j >= 4) {
                bf16* dst = KT + ((size_t)sc * 4 + (j - 4)) * 128 * 64;
                for (int e = tid; e < 128 * 8; e += NWAVES * 64) { const int d = e >> 3, ch = e & 7; *(GAS v4u*)(dst + d * 64 + 8 * ch) = *(const LAS v4u*)(Ts + d * 72 + 8 * ch); }
                __syncthreads();
            }
        } else {
            const int h = j - 8;
            for (int e = tid; e < 64 * 32; e += NWAVES * 64) { const int s = e >> 5, ch = e & 31;
                v4u w = (v4u){0u, 0u, 0u, 0u};
                if (s < L) w = *(const GAS v4u*)(V + (size_t)(row0 + s) * 1024 + 256 * h + 8 * ch);
                const int v0 = 8 * ch;
                Ts[(v0 + 0) * 72 + s] = (bf16)(w.x & 0xffffu); Ts[(v0 + 1) * 72 + s] = (bf16)(w.x >> 16); Ts[(v0 + 2) * 72 + s] = (bf16)(w.y & 0xffffu); Ts[(v0 + 3) * 72 + s] = (bf16)(w.y >> 16);
                Ts[(v0 + 4) * 72 + s] = (bf16)(w.z & 0xffffu); Ts[(v0 + 5) * 72 + s] = (bf16)(w.z >> 16); Ts[(v0 + 6) * 72 + s] = (bf16)(w.w & 0xffffu); Ts[(v0 + 7) * 72 + s] = (bf16)(w.w >> 16); }
            __syncthreads();
            bf16* dst = VT + ((size_t)sc * 4 + h) * 256 * 64;
            for (int e = tid; e < 256 * 8; e += NWAVES * 64) { const int v = e >> 3, ch = e & 7; *(GAS v4u*)(dst + v * 64 + 8 * ch) = *(const LAS v4u*)(Ts + v * 72 + 8 * ch); }
            __syncthreads();
        }
    }
}
constexpr int ML_QS = 0, ML_KS = 17408, ML_KT = 34816, ML_VT = 53248, ML_SS = 64768, ML_CB = 73984, ML_SC = 95744;
constexpr int SC_A = 0, SC_MM = 64, SC_GI = 128, SC_EN = 192, SC_WS = 256, SC_ISC = 320, SC_MISC = 384;
__device__ __forceinline__ bf16x8 ldsfrag(const LAS unsigned char* p) { return *(const LAS bf16x8*)p; }

__device__ __forceinline__ void mlstm_item(const Args& A, LAS unsigned char* lds, int tid, int lane, int wave, int item) {
    unsigned char* ws = A.ws;
    const int fr = lane & 15, fq = lane >> 4;
    const bool sample = item >= NBATCH * NH * NSL; const int ii = sample ? item - NBATCH * NH * NSL : item;
    const int b = ii / (NH * NSL), h = (ii / NSL) % NH, sl = ii % NSL;
    const int nch = sample ? 1 : NCH, L = sample ? SLEN : CH;
    const int row0 = sample ? MP + b * SLEN : b * SEQ, sc0 = sample ? NBATCH * NCH + b : b * NCH;
    const bf16* Qg = (const bf16*)(ws + WS_Q); const bf16* Kg = (const bf16*)(ws + WS_K); const bf16* KTg = (const bf16*)(ws + WS_KT); const bf16* VTg = (const bf16*)(ws + WS_VT);
    const float* GATES = (const float*)(ws + WS_GATES); bf16* HS = (bf16*)(ws + WS_HS); float* HSS = (float*)(ws + WS_HSS);
    LAS float* SC = (LAS float*)(lds + ML_SC);
    for (int e = tid; e < 16 * 72; e += NWAVES * 64) { const int r = e / 72; ((LAS bf16*)(lds + ML_VT))[64 * 72 + e] = (r == 0) ? (bf16)0x3F80 : (bf16)0; }
    f32x4 Cst[5];
    float m0;
    if (sample) {
        const float* c0 = A.in[3] + ((size_t)(b * NH + h) * DV + DVS * sl) * DQK; const float* n0 = A.in[4] + (size_t)(b * NH + h) * DQK;
#pragma unroll
        for (int vb = 0; vb < 4; ++vb) Cst[vb] = *(const f32x4*)(c0 + (size_t)(16 * vb + fr) * DQK + 16 * wave + 4 * fq);
        Cst[4] = (fr == 0) ? *(const f32x4*)(n0 + 16 * wave + 4 * fq) : (f32x4){0.f, 0.f, 0.f, 0.f};
        m0 = A.in[5][b * NH + h];
    } else {
#pragma unroll
        for (int vb = 0; vb < 5; ++vb) Cst[vb] = (f32x4){0.f, 0.f, 0.f, 0.f};
        m0 = 0.f;
    }
#pragma unroll
    for (int vb = 0; vb < 5; ++vb) { u32x2 w; w.x = cvtpk_n(Cst[vb][0], Cst[vb][1]); w.y = cvtpk_n(Cst[vb][2], Cst[vb][3]); *(LAS u32x2*)(lds + ML_CB + (16 * vb + fr) * 272 + (16 * wave + 4 * fq) * 2) = w; }
    v4u pq[2], pk[2], pkt[2], pvt; float pli = 0.f, plf = 0.f;
#define ML_ISSUE(c_) do { \
        const size_t r0_ = (size_t)row0 + (size_t)(c_) * CH; \
        _Pragma("unroll") for (int i = 0; i < 2; ++i) { const int e = tid + 512 * i, r = e >> 4, ch = e & 15; \
            if (r < L) { pq[i] = *(const GAS v4u*)(Qg + (r0_ + r) * 512 + 128 * h + 8 * ch); pk[i] = *(const GAS v4u*)(Kg + (r0_ + r) * 512 + 128 * h + 8 * ch); } \
            else { pq[i] = (v4u){0u, 0u, 0u, 0u}; pk[i] = (v4u){0u, 0u, 0u, 0u}; } } \
        const bf16* ktb_ = KTg + ((size_t)(sc0 + (c_)) * 4 + h) * 128 * 64; \
        _Pragma("unroll") for (int i = 0; i < 2; ++i) { const int e = tid + 512 * i; pkt[i] = *(const GAS v4u*)(ktb_ + (size_t)e * 8); } \
        const bf16* vtb_ = VTg + (((size_t)(sc0 + (c_)) * 4 + h) * 256 + DVS * sl) * 64; \
        pvt = *(const GAS v4u*)(vtb_ + (size_t)tid * 8); \
        if (wave == 0) { if (lane < L) { pli = GATES[(r0_ + lane) * 8 + h]; plf = GATES[(r0_ + lane) * 8 + 4 + h]; } else { pli = -INFINITY; plf = 0.f; } } \
    } while (0)
    float cli = 0.f, clf = 0.f;
#define ML_COMMIT() do { \
        _Pragma("unroll") for (int i = 0; i < 2; ++i) { const int e = tid + 512 * i, r = e >> 4, ch = e & 15; \
            *(LAS v4u*)(lds + ML_QS + r * 272 + ch * 16) = pq[i]; *(LAS v4u*)(lds + ML_KS + r * 272 + ch * 16) = pk[i]; } \
        _Pragma("unroll") for (int i = 0; i < 2; ++i) { const int e = tid + 512 * i, r = e >> 3, ch = e & 7; *(LAS v4u*)(lds + ML_KT + r * 144 + ch * 16) = pkt[i]; } \
        { const int r = tid >> 3, ch = tid & 7; *(LAS v4u*)(lds + ML_VT + r * 144 + ch * 16) = pvt; } \
        cli = pli; clf = plf; \
    } while (0)
    ML_ISSUE(0); ML_COMMIT();
    __syncthreads();
    const int tb = wave & 3, wh = wave >> 2;
    for (int c = 0; c < nch; ++c) {
        if (c + 1 < nch) ML_ISSUE(c + 1);
        if (wave == 0) {
            float fc = clf;
#pragma unroll
            for (int d = 1; d < 64; d <<= 1) { const float o = __shfl_up(fc, d); if (lane >= d) fc += o; }
            const float a = cli - fc;
            float pm = a;
#pragma unroll
            for (int d = 1; d < 64; d <<= 1) { const float o = __shfl_up(pm, d); if (lane >= d) pm = fmaxf(pm, o); }
            const float mm = fmaxf(pm, m0);
            const float flast = __shfl(fc, 63), mml = __shfl(mm, 63);
            SC[SC_A + lane] = a; SC[SC_MM + lane] = mm; SC[SC_GI + lane] = __expf(m0 - mm); SC[SC_EN + lane] = __expf(-(fc + mm)); SC[SC_WS + lane] = __expf(a - mml);
            if (lane == 0) SC[SC_MISC] = __expf(m0 - mml);
            m0 = flast + mml;
        }
        f32x4 g[2];
#pragma unroll
        for (int i = 0; i < 2; ++i) { g[i] = (f32x4){0.f, 0.f, 0.f, 0.f}; const int sb = 2 * wh + i;
#pragma unroll
            for (int ks = 0; ks < 4; ++ks) g[i] = mfma16(ldsfrag(lds + ML_KS + (16 * sb + fr) * 272 + ks * 64 + fq * 16), ldsfrag(lds + ML_QS + (16 * tb + fr) * 272 + ks * 64 + fq * 16), g[i]); }
        __syncthreads();
        { const int t = 16 * tb + fr; const float mmt = SC[SC_MM + t];
#pragma unroll
          for (int i = 0; i < 2; ++i) { const int sb = 2 * wh + i, s0 = 16 * sb + 4 * fq; const f32x4 a4 = *(const LAS f32x4*)(SC + SC_A + s0); float v[4];
#pragma unroll
              for (int r = 0; r < 4; ++r) v[r] = (s0 + r <= t) ? g[i][r] * __expf(a4[r] - mmt) : 0.f;
              u32x2 w; w.x = cvtpk(v[0], v[1]); w.y = cvtpk(v[2], v[3]); *(LAS u32x2*)(lds + ML_SS + t * 144 + s0 * 2) = w; } }
        __syncthreads();
        f32x4 hh[3];
        { const int t = 16 * tb + fr; const float git = SC[SC_GI + t];
#pragma unroll
          for (int i = 0; i < 3; ++i) { if (i == 2 && wave >= 4) { hh[2] = (f32x4){0.f, 0.f, 0.f, 0.f}; continue; }
              const int vb = (i == 2) ? 4 : 2 * wh + i; f32x4 ai = (f32x4){0.f, 0.f, 0.f, 0.f}, ae = (f32x4){0.f, 0.f, 0.f, 0.f};
#pragma unroll
              for (int ks = 0; ks < 2; ++ks) ai = mfma16(ldsfrag(lds + ML_VT + (16 * vb + fr) * 144 + ks * 64 + fq * 16), ldsfrag(lds + ML_SS + t * 144 + ks * 64 + fq * 16), ai);
#pragma unroll
              for (int ks = 0; ks < 4; ++ks) ae = mfma16(ldsfrag(lds + ML_CB + (16 * vb + fr) * 272 + ks * 64 + fq * 16), ldsfrag(lds + ML_QS + t * 272 + ks * 64 + fq * 16), ae);
              hh[i] = ai + ae * git; }
          if (wave < 4 && fq == 0) { const float den = hh[2][0]; SC[SC_ISC + t] = 1.0f / fmaxf(fabsf(den), SC[SC_EN + t]); } }
        __syncthreads();
        { const int t = 16 * tb + fr; const float isc = SC[SC_ISC + t]; float p = 0.f;
          const size_t grow = (size_t)row0 + (size_t)c * CH + t;
#pragma unroll
          for (int i = 0; i < 2; ++i) { const f32x4 o = hh[i] * isc; p += (o[0] * o[0] + o[1] * o[1]) + (o[2] * o[2] + o[3] * o[3]);
              u32x2 w; w.x = cvtpk(o[0], o[1]); w.y = cvtpk(o[2], o[3]);
              if (t < L) *(GAS u32x2*)(HS + grow * 1024 + h * DV + DVS * sl + 16 * (2 * wh + i) + 4 * fq) = w; }
          p += __shfl_xor(p, 16); p += __shfl_xor(p, 32);
          if (fq == 0 && t < L) HSS[grow * 32 + h * 8 + sl * 2 + wh] = p; }
        { const float decay = SC[SC_MISC];
          bf16x8 kw[2];
#pragma unroll
          for (int ks = 0; ks < 2; ++ks) { const v4u kr = *(const LAS v4u*)(lds + ML_KT + (16 * wave + fr) * 144 + ks * 64 + fq * 16);
              const f32x4 w0 = *(const LAS f32x4*)(SC + SC_WS + 32 * ks + 8 * fq), w1 = *(const LAS f32x4*)(SC + SC_WS + 32 * ks + 8 * fq + 4);
              v4u o; o.x = cvtpk(bflo(kr.x) * w0[0], bfhi(kr.x) * w0[1]); o.y = cvtpk(bflo(kr.y) * w0[2], bfhi(kr.y) * w0[3]); o.z = cvtpk(bflo(kr.z) * w1[0], bfhi(kr.z) * w1[1]); o.w = cvtpk(bflo(kr.w) * w1[2], bfhi(kr.w) * w1[3]);
              kw[ks] = __builtin_bit_cast(bf16x8, o); }
#pragma unroll
          for (int vb = 0; vb < 5; ++vb) { Cst[vb] = Cst[vb] * decay;
#pragma unroll
              for (int ks = 0; ks < 2; ++ks) Cst[vb] = mfma16(kw[ks], ldsfrag(lds + ML_VT + (16 * vb + fr) * 144 + ks * 64 + fq * 16), Cst[vb]);
              u32x2 w; w.x = cvtpk_n(Cst[vb][0], Cst[vb][1]); w.y = cvtpk_n(Cst[vb][2], Cst[vb][3]); *(LAS u32x2*)(lds + ML_CB + (16 * vb + fr) * 272 + (16 * wave + 4 * fq) * 2) = w; } }
        __syncthreads();
        if (c + 1 < nch) ML_COMMIT();
        __syncthreads();
    }
    { float* co = A.out + (sample ? O_CS : O_CP) + ((size_t)(b * NH + h) * DV + DVS * sl) * DQK;
#pragma unroll
      for (int vb = 0; vb < 4; ++vb) *(f32x4*)(co + (size_t)(16 * vb + fr) * DQK + 16 * wave + 4 * fq) = Cst[vb];
      if (sl == 0 && fr == 0) *(f32x4*)(A.out + (sample ? O_NS : O_NP) + (size_t)(b * NH + h) * DQK + 16 * wave + 4 * fq) = Cst[4];
      if (sl == 0 && tid == 0) A.out[(sample ? O_MS : O_MP) + b * NH + h] = m0; }
    __syncthreads();
}

__device__ __forceinline__ float gelu_tanh(float y) { const float u = 0.7978845608028654f * (y + 0.044715f * y * y * y); const float th = 1.0f - 2.0f * __builtin_amdgcn_rcpf(__expf(2.0f * u) + 1.0f); return 0.5f * y * (1.0f + th); }
__device__ __forceinline__ void s5_item(const Args& A, LAS unsigned char* wlds  , int lane, int item) {
    unsigned char* ws = A.ws;
    const int fr = lane & 15, fq = lane >> 4;
    const bool sample = item >= NBATCH * NG; const int ii = sample ? item - NBATCH * NG : item;
    const int b = ii / NG, g = ii % NG;
    const int T = sample ? SLEN : SEQ, row0 = sample ? MP + b * SLEN : b * SEQ;
    const bf16* U = (const bf16*)(ws + WS_U); bf16* Z = (bf16*)(ws + WS_Z);
    const float* LAM = (const float*)(ws + WS_S5P + S5P_LAM); const bf16* BBT = (const bf16*)(ws + WS_S5P + S5P_BBT); const bf16* CC = (const bf16*)(ws + WS_S5P + S5P_CC);
    LAS float* BU = (LAS float*)wlds;
    LAS bf16* SB = (LAS bf16*)(wlds + 8448);
    bf16x8 bbA[8], ccA[4];
#pragma unroll
    for (int rb = 0; rb < 8; ++rb) bbA[rb] = (fq < 2) ? *(const bf16x8*)(BBT + ((size_t)g * 128 + 16 * rb + fr) * 16 + 8 * fq) : (bf16x8){0, 0, 0, 0, 0, 0, 0, 0};
#pragma unroll
    for (int ks = 0; ks < 4; ++ks) ccA[ks] = *(const bf16x8*)(CC + ((size_t)g * 16 + fr) * 128 + 32 * ks + 8 * fq);
    const float lr = LAM[(g * 64 + lane) * 2], li = LAM[(g * 64 + lane) * 2 + 1];
    float sr, si;
    if (sample) { sr = A.in[6][(size_t)(b * NG + g) * PST + lane]; si = A.in[7][(size_t)(b * NG + g) * PST + lane]; } else { sr = 0.f; si = 0.f; }
    const f32x4 dsk = *(const f32x4*)(A.in[22] + g * 16 + 4 * fq);
    const int nblk = T / 16;
    bf16x8 ub = (fq < 2) ? *(const bf16x8*)(U + (size_t)(row0 + fr) * 1024 + 16 * g + 8 * fq) : (bf16x8){0, 0, 0, 0, 0, 0, 0, 0};
    u32x2 u4 = *(const u32x2*)(U + (size_t)(row0 + fr) * 1024 + 16 * g + 4 * fq);
    for (int tbk = 0; tbk < nblk; ++tbk) {
        const bf16x8 ucur = ub; const u32x2 u4c = u4;
        if (tbk + 1 < nblk) { const size_t r = (size_t)row0 + 16 * (tbk + 1) + fr;
            if (fq < 2) ub = *(const bf16x8*)(U + r * 1024 + 16 * g + 8 * fq);
            u4 = *(const u32x2*)(U + r * 1024 + 16 * g + 4 * fq); }
#pragma unroll
        for (int rb = 0; rb < 8; ++rb) { const f32x4 d = mfma16(bbA[rb], ucur, (f32x4){0.f, 0.f, 0.f, 0.f}); *(LAS f32x4*)(BU + fr * 132 + 16 * rb + 4 * fq) = d; }
        WAVE_SYNC();
#pragma unroll
        for (int t = 0; t < 16; ++t) { const float bre = BU[t * 132 + lane], bim = BU[t * 132 + 64 + lane];
            const float nr = lr * sr - li * si + bre, ni = lr * si + li * sr + bim; sr = nr; si = ni;
            SB[t * 136 + lane] = (bf16)f2bf(sr); SB[t * 136 + 64 + lane] = (bf16)f2bf(si); }
        WAVE_SYNC();
        f32x4 y = (f32x4){0.f, 0.f, 0.f, 0.f};
#pragma unroll
        for (int ks = 0; ks < 4; ++ks) y = mfma16(ccA[ks], *(const LAS bf16x8*)(SB + fr * 136 + 32 * ks + 8 * fq), y);
        const float y0 = y[0] + dsk[0] * bflo(u4c.x), y1 = y[1] + dsk[1] * bfhi(u4c.x), y2 = y[2] + dsk[2] * bflo(u4c.y), y3 = y[3] + dsk[3] * bfhi(u4c.y);
        u32x2 w; w.x = cvtpk(gelu_tanh(y0), gelu_tanh(y1)); w.y = cvtpk(gelu_tanh(y2), gelu_tanh(y3));
        *(GAS u32x2*)(Z + ((size_t)row0 + 16 * tbk + fr) * 1024 + 16 * g + 4 * fq) = w;
        WAVE_SYNC();
    }
    float* so = A.out + (sample ? O_SRS : O_SRP) + (size_t)(b * NG + g) * PST; float* io = A.out + (sample ? O_SIS : O_SIP) + (size_t)(b * NG + g) * PST;
    so[lane] = sr; io[lane] = si;
}

__device__ __forceinline__ void outa_rows(const Args& A, int lane, int gw, int NGW) {
    unsigned char* ws = A.ws;
    const bf16* HS = (const bf16*)(ws + WS_HS); const bf16* OG = (const bf16*)(ws + WS_OG); const float* HSS = (const float*)(ws + WS_HSS); bf16* MIXIN = (bf16*)(ws + WS_MIXIN);
    f32x4 gm[2][2];
#pragma unroll
    for (int i = 0; i < 2; ++i) { gm[i][0] = *(const f32x4*)(A.in[14] + 512 * i + 8 * lane); gm[i][1] = *(const f32x4*)(A.in[14] + 512 * i + 8 * lane + 4); }
    for (int m = gw; m < MT; m += NGW) {
#pragma unroll
        for (int i = 0; i < 2; ++i) { const int col = 512 * i + 8 * lane, hh = col >> 8;
            const f32x4 p0 = *(const f32x4*)(HSS + (size_t)m * 32 + hh * 8), p1 = *(const f32x4*)(HSS + (size_t)m * 32 + hh * 8 + 4);
            const float ss = (p0[0] + p0[1]) + (p0[2] + p0[3]) + (p1[0] + p1[1]) + (p1[2] + p1[3]);
            const float rstd = 1.0f / sqrtf(ss * (1.0f / DV) + EPS);
            const v4u hv = *(const GAS v4u*)(HS + (size_t)m * 1024 + col), ov = *(const GAS v4u*)(OG + (size_t)m * 1024 + col);
            v4u o;
            o.x = cvtpk(bflo(hv.x) * rstd * gm[i][0][0] * sigmoidf_(bflo(ov.x)), bfhi(hv.x) * rstd * gm[i][0][1] * sigmoidf_(bfhi(ov.x)));
            o.y = cvtpk(bflo(hv.y) * rstd * gm[i][0][2] * sigmoidf_(bflo(ov.y)), bfhi(hv.y) * rstd * gm[i][0][3] * sigmoidf_(bfhi(ov.y)));
            o.z = cvtpk(bflo(hv.z) * rstd * gm[i][1][0] * sigmoidf_(bflo(ov.z)), bfhi(hv.z) * rstd * gm[i][1][1] * sigmoidf_(bfhi(ov.z)));
            o.w = cvtpk(bflo(hv.w) * rstd * gm[i][1][2] * sigmoidf_(bflo(ov.w)), bfhi(hv.w) * rstd * gm[i][1][3] * sigmoidf_(bfhi(ov.w)));
            *(GAS v4u*)(MIXIN + (size_t)m * 2048 + col) = o; }
    }
}
__device__ __forceinline__ float row_ss(const float* SSp, const float* SSs, int m, int lane) {
    float s;
    if (m < MP) s = (lane < 32) ? SSp[(size_t)m * 32 + lane] : 0.f; else s = SSs[(size_t)(m - MP) * 128 + lane] + SSs[(size_t)(m - MP) * 128 + 64 + lane];
    return wave_sum(s);
}
__device__ __forceinline__ void rowpass1(const Args& A, int lane, int gw, int NGW) {
    unsigned char* ws = A.ws;
    const bf16* MIX = (const bf16*)(ws + WS_MIX); bf16* XN = (bf16*)(ws + WS_XN);
    const float* SSp = (const float*)(ws + WS_SS1); const float* SSs = (const float*)(ws + WS_SSS + SSS_1);
    for (int m = gw; m < MT; m += NGW) {
        const float rstd1 = 1.0f / sqrtf(row_ss(SSp, SSs, m, lane) * (1.0f / DM) + EPS);
        const float* xrow = m < MP ? A.in[0] + (size_t)m * DM : A.in[1] + (size_t)(m - MP) * DM;
        float* orow = A.out + O_Y + (size_t)m * DM;
        f32x4 v[8]; float s = 0.f;
#pragma unroll
        for (int j = 0; j < 8; ++j) { const int k = 256 * j + 4 * lane;
            const f32x4 x = *(const GAS f32x4*)(xrow + k); const u32x2 mx = *(const GAS u32x2*)(MIX + (size_t)m * DM + k); const f32x4 gp = *(const f32x4*)(A.in[26] + k);
            f32x4 o; o[0] = x[0] + bflo(mx.x) * rstd1 * gp[0]; o[1] = x[1] + bfhi(mx.x) * rstd1 * gp[1]; o[2] = x[2] + bflo(mx.y) * rstd1 * gp[2]; o[3] = x[3] + bfhi(mx.y) * rstd1 * gp[3];
            v[j] = o; s += (o[0] * o[0] + o[1] * o[1]) + (o[2] * o[2] + o[3] * o[3]); *(GAS f32x4*)(orow + k) = o; }
        const float rstd2 = 1.0f / sqrtf(wave_sum(s) * (1.0f / DM) + EPS);
#pragma unroll
        for (int j = 0; j < 8; ++j) { const int k = 256 * j + 4 * lane; const f32x4 gf = *(const f32x4*)(A.in[27] + k);
            u32x2 o; o.x = cvtpk(v[j][0] * rstd2 * gf[0], v[j][1] * rstd2 * gf[1]); o.y = cvtpk(v[j][2] * rstd2 * gf[2], v[j][3] * rstd2 * gf[3]);
            *(GAS u32x2*)(XN + (size_t)m * DM + k) = o; }
    }
}
__device__ __forceinline__ void rowpass2(const Args& A, int lane, int gw, int NGW) {
    unsigned char* ws = A.ws;
    const bf16* FF = (const bf16*)(ws + WS_FF);
    const float* SSp = (const float*)(ws + WS_SS2); const float* SSs = (const float*)(ws + WS_SSS + SSS_2);
    for (int m = gw; m < MT; m += NGW) {
        const float rstd = 1.0f / sqrtf(row_ss(SSp, SSs, m, lane) * (1.0f / DM) + EPS);
        float* orow = A.out + O_Y + (size_t)m * DM;
#pragma unroll
        for (int j = 0; j < 8; ++j) { const int k = 256 * j + 4 * lane;
            const f32x4 x = *(const GAS f32x4*)(orow + k); const u32x2 f = *(const GAS u32x2*)(FF + (size_t)m * DM + k); const f32x4 gp = *(const f32x4*)(A.in[31] + k);
            f32x4 o; o[0] = x[0] + bflo(f.x) * rstd * gp[0]; o[1] = x[1] + bfhi(f.x) * rstd * gp[1]; o[2] = x[2] + bflo(f.y) * rstd * gp[2]; o[3] = x[3] + bfhi(f.y) * rstd * gp[3];
            *(GAS f32x4*)(orow + k) = o; }
    }
}
__global__ void __launch_bounds__(NWAVES * 64, 2) hymba_fwd(Args args) {
    extern __shared__ __attribute__((aligned(16))) unsigned char lds_raw[];
    LAS unsigned char* lds = (LAS unsigned char*)lds_raw;
    volatile LAS unsigned* MISC = (volatile LAS unsigned*)(lds + MISC_OFF);
    const int tid = threadIdx.x, lane = tid & 63, wave = __builtin_amdgcn_readfirstlane(tid >> 6);
    const int G = gridDim.x; const int bx = blockIdx.x; const int vcu = (G % 8 == 0) ? (bx % 8) * (G / 8) + bx / 8 : bx;
    unsigned char* ws = args.ws;
    gu32* ctl = (gu32*)(ws + WS_CTL);
    for (int u = tid; u < (LDS_BYTES - LDSCTL_OFF) / 4; u += NWAVES * 64) ((LAS unsigned*)(lds + LDSCTL_OFF))[u] = 0u;
    __syncthreads();
    XcdBarrier bar; bar.bar = (unsigned*)(ctl + CW_BAR); bar.x = 0; bar.st = nullptr;
    if (N_LAUNCHES == 1) bar = xcd_barrier_post((unsigned*)(ctl + CW_BAR), MISC + 8);
#define GRID_BAR() do { if (N_LAUNCHES == 1) xcd_barrier(bar); } while (0)
    const int lo = args.ph_lo, hi = args.ph_hi;
#define IN(k) (lo <= (k) && (k) < hi)
#define BOTH(k) (IN(k) && IN((k) + 1))
    const int gw = vcu * NWAVES + wave, NGW = G * NWAVES;

    if (IN(0)) { p0_prologue(args, lds, tid, lane, wave, vcu, G); if (BOTH(0)) GRID_BAR(); }

    if (IN(1)) {
        { pg8::Gemm g{(const bf16*)(ws + WS_XN), (const bf16*)(ws + WS_WIN), MP, 4096, DM}; pg8::StaticOrder S; S.init(MP, 4096, G, bx);
          pg8::EpiBf16<0> E{(bf16*)(ws + WS_QKRAW), 1024, nullptr, 1024, (size_t)WS_RSTRIDE / 2, 1.f};
          pg8::gemm_phase<pg8::EpiBf16<0>, pg8::StaticOrder, true, true>(lds + RING_OFF, g, S, E); }
        { bf16* O = (bf16*)(ws + WS_QKRAW);
          skinny_gemm<1>((const bf16*)(ws + WS_XN) + (size_t)MP * DM, (const bf16*)(ws + WS_WIN), DM, 4096 / 16, vcu, G, wave, lane,
              [](int it, int a, int fr) { return 16 * it + fr; },
              [O](int it, int row, int fq, const f32x4 (&acc)[1]) { const int col = 16 * it + 4 * fq, t = col >> 10;
                  u32x2 w; w.x = cvtpk_n(acc[0][0], acc[0][1]); w.y = cvtpk_n(acc[0][2], acc[0][3]);
                  *(GAS u32x2*)(O + (size_t)t * (WS_RSTRIDE / 2) + (size_t)(MP + row) * 1024 + (col & 1023)) = w; }); }
        if (BOTH(1)) GRID_BAR();
    }

    if (IN(2)) { p2_prep(args, lds, tid, vcu, G); if (BOTH(2)) GRID_BAR(); }

    if (IN(3)) {
        const int half = G / 2;
        if (vcu < half) { for (int it = vcu; it < 2 * NBATCH * NH * NSL; it += half) mlstm_item(args, lds, tid, lane, wave, it); }
        else { const int nb = G - half, bi = vcu - half;
               if (wave < 4) { for (int it = bi * 4 + wave; it < NBATCH * NG; it += nb * 4) s5_item(args, lds + wave * 12800, lane, it); }
               else { for (int it = bi * 4 + (wave - 4); it < SBATCH * NG; it += nb * 4) s5_item(args, lds + wave * 12800, lane, NBATCH * NG + it); } }
        if (BOTH(3)) GRID_BAR();
    }

    if (IN(4)) {
        { pg8::Gemm g{(const bf16*)(ws + WS_Z), (const bf16*)(ws + WS_WGLU), MP, 1024, 1024}; pg8::StaticOrder S; S.init(MP, 1024, G, bx);
          pg8::EpiGlu E{(const bf16*)(ws + WS_Z), (bf16*)(ws + WS_MIXIN), args.in[24]};
          pg8::gemm_phase<pg8::EpiGlu, pg8::StaticOrder, true, true>(lds + RING_OFF, g, S, E); }
        { const bf16* Zb = (const bf16*)(ws + WS_Z); bf16* O = (bf16*)(ws + WS_MIXIN); const float* bias = args.in[24];
          skinny_gemm<1>(Zb + (size_t)MP * 1024, (const bf16*)(ws + WS_WGLU), 1024, 1024 / 16, vcu, G, wave, lane,
              [](int it, int a, int fr) { return 16 * it + fr; },
              [Zb, O, bias](int it, int row, int fq, const f32x4 (&acc)[1]) { const int col = 16 * it + 4 * fq; const size_t m = (size_t)(MP + row);
                  const u32x2 z = *(const GAS u32x2*)(Zb + m * 1024 + col); const f32x4 bv = *(const f32x4*)(bias + col);
                  u32x2 w; w.x = cvtpk(bflo(z.x) * sigmoidf_(acc[0][0] + bv[0]), bfhi(z.x) * sigmoidf_(acc[0][1] + bv[1]));
                  w.y = cvtpk(bflo(z.y) * sigmoidf_(acc[0][2] + bv[2]), bfhi(z.y) * sigmoidf_(acc[0][3] + bv[3]));
                  *(GAS u32x2*)(O + m * 2048 + 1024 + col) = w; }); }
        outa_rows(args, lane, gw, NGW);
        if (BOTH(4)) GRID_BAR();
    }

    if (IN(5)) {
        { pg8::Gemm g{(const bf16*)(ws + WS_MIXIN), (const bf16*)(ws + WS_WOUT), MP, DM, DM}; pg8::StaticOrder S; S.init(MP, DM, G, bx);
          pg8::EpiSS E{(bf16*)(ws + WS_MIX), DM, (float*)(ws + WS_SS1)};
          pg8::gemm_phase<pg8::EpiSS, pg8::StaticOrder, true, true>(lds + RING_OFF, g, S, E); }
        { bf16* O = (bf16*)(ws + WS_MIX); float* SSs = (float*)(ws + WS_SSS + SSS_1);
          skinny_gemm<1>((const bf16*)(ws + WS_MIXIN) + (size_t)MP * DM, (const bf16*)(ws + WS_WOUT), DM, DM / 16, vcu, G, wave, lane,
              [](int it, int a, int fr) { return 16 * it + fr; },
              [O, SSs](int it, int row, int fq, const f32x4 (&acc)[1]) { const int col = 16 * it + 4 * fq;
                  u32x2 w; w.x = cvtpk_n(acc[0][0], acc[0][1]); w.y = cvtpk_n(acc[0][2], acc[0][3]);
                  *(GAS u32x2*)(O + (size_t)(MP + row) * DM + col) = w;
                  float s = (acc[0][0] * acc[0][0] + acc[0][1] * acc[0][1]) + (acc[0][2] * acc[0][2] + acc[0][3] * acc[0][3]);
                  s += __shfl_xor(s, 16); s += __shfl_xor(s, 32);
                  if (fq == 0) SSs[(size_t)row * 128 + it] = s; }); }
        if (BOTH(5)) GRID_BAR();
    }

    if (IN(6)) { rowpass1(args, lane, gw, NGW); if (BOTH(6)) GRID_BAR(); }

    if (IN(7)) {
        { pg8::Gemm g{(const bf16*)(ws + WS_XN), (const bf16*)(ws + WS_WGU), MP, 2 * DFF, DM}; pg8::StaticOrder S; S.init(MP, 2 * DFF, G, bx);
          pg8::EpiGU E{(bf16*)(ws + WS_ACT), DFF};
          pg8::gemm_phase<pg8::EpiGU, pg8::StaticOrder, true, true>(lds + RING_OFF, g, S, E); }
        { bf16* O = (bf16*)(ws + WS_ACT);
          skinny_gemm<2>((const bf16*)(ws + WS_XN) + (size_t)MP * DM, (const bf16*)(ws + WS_WGU), DM, DFF / 16, vcu, G, wave, lane,
              [](int it, int a, int fr) { const int j = 16 * it + fr; return 256 * (j >> 7) + 128 * a + (j & 127); },
              [O](int it, int row, int fq, const f32x4 (&acc)[2]) { const int col = 16 * it + 4 * fq;
                  u32x2 w; w.x = cvtpk(acc[0][0] * sigmoidf_(acc[0][0]) * acc[1][0], acc[0][1] * sigmoidf_(acc[0][1]) * acc[1][1]);
                  w.y = cvtpk(acc[0][2] * sigmoidf_(acc[0][2]) * acc[1][2], acc[0][3] * sigmoidf_(acc[0][3]) * acc[1][3]);
                  *(GAS u32x2*)(O + (size_t)(MP + row) * DFF + col) = w; }); }
        if (BOTH(7)) GRID_BAR();
    }

    if (IN(8)) {
        { pg8::Gemm g{(const bf16*)(ws + WS_ACT), (const bf16*)(ws + WS_WD), MP, DM, DFF}; pg8::StaticOrder S; S.init(MP, DM, G, bx);
          pg8::EpiSS E{(bf16*)(ws + WS_FF), DM, (float*)(ws + WS_SS2)};
          pg8::gemm_phase<pg8::EpiSS, pg8::StaticOrder, true, true>(lds + RING_OFF, g, S, E); }
        { bf16* O = (bf16*)(ws + WS_FF); float* SSs = (float*)(ws + WS_SSS + SSS_2);
          skinny_gemm<1>((const bf16*)(ws + WS_ACT) + (size_t)MP * DFF, (const bf16*)(ws + WS_WD), DFF, DM / 16, vcu, G, wave, lane,
              [](int it, int a, int fr) { return 16 * it + fr; },
              [O, SSs](int it, int row, int fq, const f32x4 (&acc)[1]) { const int col = 16 * it + 4 * fq;
                  u32x2 w; w.x = cvtpk_n(acc[0][0], acc[0][1]); w.y = cvtpk_n(acc[0][2], acc[0][3]);
                  *(GAS u32x2*)(O + (size_t)(MP + row) * DM + col) = w;
                  float s = (acc[0][0] * acc[0][0] + acc[0][1] * acc[0][1]) + (acc[0][2] * acc[0][2] + acc[0][3] * acc[0][3]);
                  s += __shfl_xor(s, 16); s += __shfl_xor(s, 32);
                  if (fq == 0) SSs[(size_t)row * 128 + it] = s; }); }
        if (BOTH(8)) GRID_BAR();
    }

    if (IN(9)) { rowpass2(args, lane, gw, NGW); }
#undef IN
#undef BOTH
}

#ifdef MK_DUMP_OFF
__global__ void dump_kernel(const unsigned short* src, float* dst, size_t n) {
    for (size_t i = (size_t)blockIdx.x * blockDim.x + threadIdx.x; i < n; i += (size_t)gridDim.x * blockDim.x) dst[i] = __uint_as_float((unsigned)src[i] << 16);
}
#endif
extern "C" void kernel_launch(void* const* d_in, const int* in_sizes, int n_in, void* d_out, int out_size, void* d_ws, size_t ws_size, hipStream_t stream) {
    static int grid = 0;
    if (grid == 0) {
        if (n_in != 32 || out_size != (int)O_END || ws_size < WS_END) { fprintf(stderr, "kernel_launch: unexpected problem: n_in %d out %d ws %zu\n", n_in, out_size, ws_size); grid = -1; return; }
        int dev = 0, cus = 0, per_cu = 0;
        if (hipGetDevice(&dev) != hipSuccess || hipDeviceGetAttribute(&cus, hipDeviceAttributeMultiprocessorCount, dev) != hipSuccess) { grid = -1; return; }
        if (hipFuncSetAttribute((const void*)hymba_fwd, hipFuncAttributeMaxDynamicSharedMemorySize, LDS_BYTES) != hipSuccess) { fprintf(stderr, "kernel_launch: hipFuncSetAttribute failed\n"); grid = -1; return; }
        if (hipOccupancyMaxActiveBlocksPerMultiprocessor(&per_cu, (const void*)hymba_fwd, NWAVES * 64, LDS_BYTES) != hipSuccess || per_cu < 1) { fprintf(stderr, "kernel_launch: occupancy query reports %d\n", per_cu); per_cu = 1; }
        (void)hipGetLastError();
        grid = cus;
    }
    if (grid < 0) return;
    if (hipMemsetAsync((char*)d_ws + WS_CTL, 0, CTL_ZERO_BYTES, stream) != hipSuccess) return;
    Args a{};
    for (int i = 0; i < 32; ++i) a.in[i] = (const float*)d_in[i];
    a.out = (float*)d_out; a.ws = (unsigned char*)d_ws;
#ifdef MK_LAST_PHASE
    const int n_l = (N_LAUNCHES == 1) ? 1 : (MK_LAST_PHASE + 1);
#else
    const int n_l = N_LAUNCHES;
#endif
    for (int li = 0; li < n_l; ++li) {
        a.ph_lo = (N_LAUNCHES == 1) ? 0 : li; a.ph_hi = (N_LAUNCHES == 1) ? N_PHASES : li + 1; a.li = li;
#ifdef MK_LAST_PHASE
        if (a.ph_hi > MK_LAST_PHASE + 1) a.ph_hi = MK_LAST_PHASE + 1;
#endif
        hipLaunchKernelGGL(hymba_fwd, dim3(grid), dim3(NWAVES * 64), LDS_BYTES, stream, a);
    }
#ifdef MK_DUMP_OFF
    hipLaunchKernelGGL(dump_kernel, dim3(2048), dim3(256), 0, stream, (const unsigned short*)((const unsigned char*)d_ws + (size_t)(MK_DUMP_OFF) * MiB), (float*)d_out, (size_t)(MK_DUMP_N));
#endif
}
```

```cpp
#define MK_N_LAUNCHES 1
#include <hip/hip_runtime.h>
#include <cstdio>
#include <cstdint>
#include <cmath>
namespace pg8 {
#define PG8_LAS __attribute__((address_space(3)))
typedef unsigned short bf16_t;
typedef short bf16x8 __attribute__((ext_vector_type(8)));
typedef float f32x4 __attribute__((ext_vector_type(4)));
typedef unsigned u32x4 __attribute__((ext_vector_type(4)));
constexpr int BM = 256, BK = 64, HALF = 128, HTB = HALF * BK * 2  , STAGE_BYTES = 8 * HTB, NXCD = 8, WGM = 4;

__host__ __device__ __forceinline__ int lds_byte(int r, int c) { const int st = (r >> 4) * 2 + (c >> 5), rr = r & 15, cc = c & 31, ob = rr * 64 + cc * 2; return st * 1024 + (ob ^ (((ob >> 9) & 1) << 5)); }
__host__ __device__ __forceinline__ void stage_rc(int b, int& R, int& C) { const int st = b / 1024, sb = b % 1024, swz = sb ^ (((sb >> 9) & 1) << 5); R = (st >> 1) * 16 + swz / 64; C = (st & 1) * 32 + (swz % 64) / 2; }
__host__ __device__ __forceinline__ int perm32(int rho) { const int n = rho >> 4, i = rho & 15; return 8 * (i >> 2) + 4 * n + (i & 3); }

struct Unit { int pm, pn; };
struct Gemm { const bf16_t* A; const bf16_t* Bt; int M, N, K; };

struct StaticOrder {
    int nM, nN, nwg, G, c, wgm;
    __host__ __device__ void init(int M, int N, int G_, int c_, int wgm_ = WGM) { nM = M / BM; nN = N / BM; nwg = nM * nN; G = G_; c = c_; wgm = wgm_; }
    __host__ __device__ bool next(int i, Unit& u) const {
        const long L = (long)i * G + c; if (L >= nwg) return false;
        int wgid = (int)L; { const int q = nwg / NXCD, r = nwg % NXCD, xcd = wgid % NXCD, off = wgid / NXCD; wgid = (xcd < r ? xcd * (q + 1) : r * (q + 1) + (xcd - r) * q) + off; }
        const int nig = wgm * nN, gid = wgid / nig, fm = gid * wgm, gsz = (nM - fm) < wgm ? (nM - fm) : wgm;
        u.pm = fm + ((wgid % nig) % gsz); u.pn = (wgid % nig) / gsz; return true;
    }
    __device__ __forceinline__ void a_ready(const Unit&) const {}
    __device__ __forceinline__ void done(const Unit&) const {}
};

__device__ __forceinline__ unsigned cvt_pk_bf16(float lo, float hi) { unsigned r; asm volatile("v_cvt_pk_bf16_f32 %0, %1, %2" : "=v"(r) : "v"(lo), "v"(hi)); return r; }
typedef float f32x2 __attribute__((ext_vector_type(2)));
__device__ __forceinline__ f32x2 gelu_pk(f32x2 v) {
    const f32x2 av = __builtin_elementwise_abs(v), d = av * 0.2316418882f + 1.0f;
    f32x2 t; t.x = __builtin_amdgcn_rcpf(d.x); t.y = __builtin_amdgcn_rcpf(d.y);
    f32x2 q = t * 0.5307027145f + (-0.7265760135f); q = q * t + 0.7107068705f; q = q * t + (-0.142248368f); q = q * t + 0.127414796f; q = q * t;
    const f32x2 s = (v * v) * (-0.72134752044f);
    f32x2 e; e.x = __builtin_amdgcn_exp2f(s.x); e.y = __builtin_amdgcn_exp2f(s.y);
    const f32x2 m = v * (q * e), r = v - m;
    f32x2 o; o.x = v.x < 0.f ? m.x : r.x; o.y = v.y < 0.f ? m.y : r.y; return o;
}

template <int ACT  > struct EpiBf16 {
    static constexpr bool PERM = true, AFTER_DRAIN = false; static_assert(ACT == 0 || ACT == 1, "EpiBf16: ACT is 0 (none) or 1 (gelu_pk)");
    bf16_t* O; int ldc; const float* bias; int split_cols; size_t split_stride; float scale0;
    __device__ __forceinline__ void operator()(const f32x4 (&acc)[2][2][4][2], const Unit& u, int wr, int wc, int fr, int fq) const {
        const int row0 = u.pm * BM + wr * 64 + fr; int colt = u.pn * BM; bf16_t* base = O;
        float sc = 1.f; if (split_cols) { const int t = colt / split_cols; base += (size_t)t * split_stride; colt -= t * split_cols; if (t == 0) sc = scale0; }
        const int col0 = colt + wc * 32 + 8 * fq, bcol0 = u.pn * BM + wc * 32 + 8 * fq;
        f32x4 bv[2][2];
#pragma unroll
        for (int bj = 0; bj < 2; ++bj)
#pragma unroll
            for (int n = 0; n < 2; ++n) bv[bj][n] = bias ? *(const f32x4*)(bias + bcol0 + bj * HALF + 4 * n) : (f32x4){0.f, 0.f, 0.f, 0.f};
#pragma unroll
        for (int ai = 0; ai < 2; ++ai)
#pragma unroll
            for (int m = 0; m < 4; ++m) { bf16_t* rowp = base + (size_t)(row0 + ai * HALF + m * 16) * ldc + col0;
#pragma unroll
                for (int bj = 0; bj < 2; ++bj) { f32x4 v0 = acc[ai][bj][m][0] + bv[bj][0], v1 = acc[ai][bj][m][1] + bv[bj][1];
                    if (ACT == 1) { f32x2 a = gelu_pk((f32x2){v0[0], v0[1]}), b = gelu_pk((f32x2){v0[2], v0[3]}), c = gelu_pk((f32x2){v1[0], v1[1]}), d = gelu_pk((f32x2){v1[2], v1[3]});
                        v0 = (f32x4){a.x, a.y, b.x, b.y}; v1 = (f32x4){c.x, c.y, d.x, d.y}; }
                    v0 = v0 * sc; v1 = v1 * sc; u32x4 w; w.x = cvt_pk_bf16(v0[0], v0[1]); w.y = cvt_pk_bf16(v0[2], v0[3]); w.z = cvt_pk_bf16(v1[0], v1[1]); w.w = cvt_pk_bf16(v1[2], v1[3]);
                    *(u32x4*)(rowp + bj * HALF) = w; } }
    }
};
__device__ __forceinline__ float fast_sigmoid(float v) { return __builtin_amdgcn_rcpf(1.0f + __expf(-v)); }
__device__ __forceinline__ float bf_lo(unsigned w) { return __uint_as_float(w << 16); }
__device__ __forceinline__ float bf_hi(unsigned w) { return __uint_as_float(w & 0xffff0000u); }
struct EpiGlu {
    static constexpr bool PERM = true, AFTER_DRAIN = false;
    const bf16_t* Z; bf16_t* O; const float* bias;
    __device__ __forceinline__ void operator()(const f32x4 (&acc)[2][2][4][2], const Unit& u, int wr, int wc, int fr, int fq) const {
        const int row0 = u.pm * BM + wr * 64 + fr, col0 = u.pn * BM + wc * 32 + 8 * fq;
        f32x4 bv[2][2];
#pragma unroll
        for (int bj = 0; bj < 2; ++bj)
#pragma unroll
            for (int n = 0; n < 2; ++n) bv[bj][n] = *(const f32x4*)(bias + col0 + bj * HALF + 4 * n);
#pragma unroll
        for (int ai = 0; ai < 2; ++ai) {
            u32x4 z[4][2];
#pragma unroll
            for (int m = 0; m < 4; ++m)
#pragma unroll
                for (int bj = 0; bj < 2; ++bj) z[m][bj] = *(const u32x4*)(Z + (size_t)(row0 + ai * HALF + m * 16) * 1024 + col0 + bj * HALF);
#pragma unroll
            for (int m = 0; m < 4; ++m) { const size_t row = (size_t)(row0 + ai * HALF + m * 16);
#pragma unroll
                for (int bj = 0; bj < 2; ++bj) { const int col = col0 + bj * HALF; const u32x4 zz = z[m][bj];
                    const f32x4 v0 = acc[ai][bj][m][0] + bv[bj][0], v1 = acc[ai][bj][m][1] + bv[bj][1];
                    u32x4 w;
                    w.x = cvt_pk_bf16(bf_lo(zz.x) * fast_sigmoid(v0[0]), bf_hi(zz.x) * fast_sigmoid(v0[1]));
                    w.y = cvt_pk_bf16(bf_lo(zz.y) * fast_sigmoid(v0[2]), bf_hi(zz.y) * fast_sigmoid(v0[3]));
                    w.z = cvt_pk_bf16(bf_lo(zz.z) * fast_sigmoid(v1[0]), bf_hi(zz.z) * fast_sigmoid(v1[1]));
                    w.w = cvt_pk_bf16(bf_lo(zz.w) * fast_sigmoid(v1[2]), bf_hi(zz.w) * fast_sigmoid(v1[3]));
                    *(u32x4*)(O + row * 2048 + 1024 + col) = w; } } }
    }
};
struct EpiSS {
    static constexpr bool PERM = true, AFTER_DRAIN = false;
    bf16_t* O; int ldc; float* SS;
    __device__ __forceinline__ void operator()(const f32x4 (&acc)[2][2][4][2], const Unit& u, int wr, int wc, int fr, int fq) const {
        const int row0 = u.pm * BM + wr * 64 + fr, col0 = u.pn * BM + wc * 32 + 8 * fq;
        float s[2][4];
#pragma unroll
        for (int ai = 0; ai < 2; ++ai)
#pragma unroll
            for (int m = 0; m < 4; ++m) { const size_t row = (size_t)(row0 + ai * HALF + m * 16); float t = 0.f;
#pragma unroll
                for (int bj = 0; bj < 2; ++bj) { const f32x4 v0 = acc[ai][bj][m][0], v1 = acc[ai][bj][m][1];
                    t += (v0[0] * v0[0] + v0[1] * v0[1]) + (v0[2] * v0[2] + v0[3] * v0[3]) + (v1[0] * v1[0] + v1[1] * v1[1]) + (v1[2] * v1[2] + v1[3] * v1[3]);
                    u32x4 w; w.x = cvt_pk_bf16(v0[0], v0[1]); w.y = cvt_pk_bf16(v0[2], v0[3]); w.z = cvt_pk_bf16(v1[0], v1[1]); w.w = cvt_pk_bf16(v1[2], v1[3]);
                    *(u32x4*)(O + row * ldc + col0 + bj * HALF) = w; }
                s[ai][m] = t; }
#pragma unroll
        for (int ai = 0; ai < 2; ++ai)
#pragma unroll
            for (int m = 0; m < 4; ++m) s[ai][m] += __shfl_xor(s[ai][m], 16);
#pragma unroll
        for (int ai = 0; ai < 2; ++ai)
#pragma unroll
            for (int m = 0; m < 4; ++m) s[ai][m] += __shfl_xor(s[ai][m], 32);
        if (fq == 0) {
#pragma unroll
            for (int ai = 0; ai < 2; ++ai)
#pragma unroll
                for (int m = 0; m < 4; ++m) SS[(size_t)(row0 + ai * HALF + m * 16) * 32 + u.pn * 4 + wc] = s[ai][m]; }
    }
};
struct EpiGU {
    static constexpr bool PERM = true, AFTER_DRAIN = false;
    bf16_t* O; int ldc;
    static __device__ __forceinline__ unsigned swiglu_pk(f32x2 g, f32x2 u) {
        const f32x2 t = g * -1.4426950408889634f; f32x2 e; e.x = __builtin_amdgcn_exp2f(t.x); e.y = __builtin_amdgcn_exp2f(t.y);
        const f32x2 d = e + 1.0f; f32x2 s; s.x = __builtin_amdgcn_rcpf(d.x); s.y = __builtin_amdgcn_rcpf(d.y);
        const f32x2 o = (g * u) * s; return cvt_pk_bf16(o.x, o.y);
    }
    __device__ __forceinline__ void operator()(const f32x4 (&acc)[2][2][4][2], const Unit& u, int wr, int wc, int fr, int fq) const {
        const int row0 = u.pm * BM + wr * 64 + fr, col0 = u.pn * HALF + wc * 32 + 8 * fq;
#pragma unroll
        for (int ai = 0; ai < 2; ++ai)
#pragma unroll
            for (int m = 0; m < 4; ++m) { const size_t row = (size_t)(row0 + ai * HALF + m * 16);
                const f32x4 g0 = acc[ai][0][m][0], g1 = acc[ai][0][m][1], u0 = acc[ai][1][m][0], u1 = acc[ai][1][m][1];
                u32x4 w;
                w.x = swiglu_pk((f32x2){g0[0], g0[1]}, (f32x2){u0[0], u0[1]});
                w.y = swiglu_pk((f32x2){g0[2], g0[3]}, (f32x2){u0[2], u0[3]});
                w.z = swiglu_pk((f32x2){g1[0], g1[1]}, (f32x2){u1[0], u1[1]});
                w.w = swiglu_pk((f32x2){g1[2], g1[3]}, (f32x2){u1[2], u1[3]});
                *(u32x4*)(O + row * ldc + col0) = w; }
    }
};
template <class Epi, class Sched, bool ALIGN_EPI = false, bool SP2 = false>
__device__ __forceinline__ void gemm_phase(PG8_LAS unsigned char* lds, const Gemm g, const Sched& S, const Epi& E) {
    const int tid = threadIdx.x, wid = __builtin_amdgcn_readfirstlane(tid >> 6), lane = tid & 63, wr = wid >> 2, wc = wid & 3, fr = lane & 15, fq = lane >> 4;
    const int K = g.K, nt = K / BK;
    unsigned voffA[2], voffB[2];
#pragma unroll
    for (int i = 0; i < 2; ++i) { int R, C; stage_rc(tid * 16 + i * 8192, R, C); const int Rb = Epi::PERM ? ((R & ~31) + perm32(R & 31)) : R;
        voffA[i] = (unsigned)(R * K + C) * 2u; voffB[i] = (unsigned)(Rb * K + C) * 2u; }
    const size_t kstep = (size_t)(BK * 2);
    const size_t hstep = (size_t)HALF * K * 2;
    const size_t tstep = 2 * hstep;
    const unsigned ldsw = (unsigned)wid * 1024u;
    const int aoff = lds_byte(wr * 64 + fr, fq * 8), boff = lds_byte(wc * 32 + fr, fq * 8);
#define PG8_SA(b, h) (((b) * 2 + (h)) * HTB)
#define PG8_SB(b, h) ((4 + (b) * 2 + (h)) * HTB)
#define PG8_STAGE(bufoff, gbase, voff) do { _Pragma("unroll") for (int _i = 0; _i < 2; ++_i) \
        __builtin_amdgcn_global_load_lds((const unsigned*)((const char*)(gbase) + (voff)[_i]), (PG8_LAS unsigned*)(lds + (bufoff) + ldsw + _i * 8192), 16, 0, 0); } while (0)
#define PG8_LDA(dst, b, h) do { _Pragma("unroll") for (int m = 0; m < 4; ++m) _Pragma("unroll") for (int k = 0; k < 2; ++k) dst[m][k] = *(const PG8_LAS bf16x8*)(lds + PG8_SA(b, h) + aoff + m * 2048 + k * 1024); } while (0)
#define PG8_LDB(dst, b, h) do { _Pragma("unroll") for (int n = 0; n < 2; ++n) _Pragma("unroll") for (int k = 0; k < 2; ++k) dst[n][k] = *(const PG8_LAS bf16x8*)(lds + PG8_SB(b, h) + boff + n * 2048 + k * 1024); } while (0)
#define PG8_MMA(ai, bj, At, Bt) do { __builtin_amdgcn_s_setprio(1); _Pragma("unroll") for (int m = 0; m < 4; ++m) _Pragma("unroll") for (int n = 0; n < 2; ++n) _Pragma("unroll") for (int k = 0; k < 2; ++k) \
        acc[ai][bj][m][n] = __builtin_amdgcn_mfma_f32_16x16x32_bf16(Bt[n][k], At[m][k], acc[ai][bj][m][n], 0, 0, 0); __builtin_amdgcn_s_setprio(0); } while (0)
#define PG8_WAIT_V(n) asm volatile("s_waitcnt vmcnt(" #n ")" ::: "memory")
#define PG8_WAIT_L(n) asm volatile("s_waitcnt lgkmcnt(" #n ")" ::: "memory")
#define PG8_BAR __builtin_amdgcn_s_barrier()
#define PG8_SCHED __builtin_amdgcn_sched_barrier(0)
    Unit cur, nxt; int ui = 0;
    if (!S.next(0, cur)) return;
    f32x4 acc[2][2][4][2];
#pragma unroll
    for (int a = 0; a < 2; ++a)
#pragma unroll
        for (int b = 0; b < 2; ++b)
#pragma unroll
            for (int m = 0; m < 4; ++m)
#pragma unroll
                for (int n = 0; n < 2; ++n) acc[a][b][m][n] = (f32x4){0.f, 0.f, 0.f, 0.f};
    bf16x8 At[4][2], B0[2][2], B1[2][2];
    const char* cA = (const char*)g.A + (size_t)cur.pm * tstep; const char* cB = (const char*)g.Bt + (size_t)cur.pn * tstep;
    S.a_ready(cur);
    if constexpr (SP2) {
        PG8_STAGE(PG8_SB(0, 0), cB, voffB); PG8_STAGE(PG8_SB(0, 1), cB + hstep, voffB); PG8_STAGE(PG8_SA(0, 0), cA, voffA); PG8_STAGE(PG8_SA(0, 1), cA + hstep, voffA);
        if (wr == 1) PG8_BAR;
        PG8_WAIT_V(2); PG8_BAR;
        PG8_STAGE(PG8_SB(1, 0), cB + kstep, voffB); PG8_STAGE(PG8_SA(1, 0), cA + kstep, voffA); PG8_STAGE(PG8_SB(1, 1), cB + hstep + kstep, voffB);
        PG8_WAIT_V(6); PG8_BAR;
    } else {
        PG8_STAGE(PG8_SB(0, 0), cB, voffB); PG8_STAGE(PG8_SA(0, 0), cA, voffA); PG8_STAGE(PG8_SB(0, 1), cB + hstep, voffB); PG8_STAGE(PG8_SA(0, 1), cA + hstep, voffA);
        if (wr == 1) PG8_BAR;
        PG8_WAIT_V(4); PG8_BAR;
        PG8_STAGE(PG8_SB(1, 0), cB + kstep, voffB); PG8_STAGE(PG8_SA(1, 0), cA + kstep, voffA); PG8_STAGE(PG8_SB(1, 1), cB + hstep + kstep, voffB);
        PG8_WAIT_V(6); PG8_BAR;
    }
    for (;;) {
        const bool has_next = S.next(ui + 1, nxt);
        const char* nA = has_next ? (const char*)g.A + (size_t)nxt.pm * tstep : cA; const char* nB = has_next ? (const char*)g.Bt + (size_t)nxt.pn * tstep : cB;
        for (int t = 0; t < nt; t += 2) {
            const bool last = (t == nt - 2);
            const char* a1 = cA + (size_t)(t + 1) * kstep;
            const char* a2 = last ? nA : cA + (size_t)(t + 2) * kstep; const char* b2 = last ? nB : cB + (size_t)(t + 2) * kstep;
            const char* a3 = a2 + kstep; const char* b3 = b2 + kstep;
            if (last && has_next) S.a_ready(nxt);
            if constexpr (SP2) {
            PG8_LDB(B0, 0, 0); PG8_LDB(B1, 0, 1); PG8_SCHED; PG8_LDA(At, 0, 0); PG8_STAGE(PG8_SA(1, 1), a1 + hstep, voffA);
            PG8_WAIT_V(8); PG8_WAIT_L(0); PG8_BAR; PG8_MMA(0, 0, At, B0); PG8_MMA(0, 1, At, B1); PG8_BAR; PG8_SCHED;
            PG8_LDA(At, 0, 1); PG8_STAGE(PG8_SB(0, 0), b2, voffB); PG8_STAGE(PG8_SB(0, 1), b2 + hstep, voffB); PG8_STAGE(PG8_SA(0, 0), a2, voffA);
            PG8_WAIT_V(8); PG8_WAIT_L(0); PG8_BAR; PG8_MMA(1, 0, At, B0); PG8_MMA(1, 1, At, B1); PG8_BAR; PG8_SCHED;
            PG8_LDB(B0, 1, 0); PG8_LDB(B1, 1, 1); PG8_SCHED; PG8_LDA(At, 1, 0); PG8_STAGE(PG8_SA(0, 1), a2 + hstep, voffA);
            PG8_WAIT_V(8); PG8_WAIT_L(0); PG8_BAR; PG8_MMA(0, 0, At, B0); PG8_MMA(0, 1, At, B1); PG8_BAR; PG8_SCHED;
            PG8_LDA(At, 1, 1); PG8_STAGE(PG8_SB(1, 0), b3, voffB); PG8_STAGE(PG8_SB(1, 1), b3 + hstep, voffB); PG8_STAGE(PG8_SA(1, 0), a3, voffA);
            PG8_WAIT_V(8); PG8_WAIT_L(0); PG8_BAR; PG8_MMA(1, 0, At, B0); PG8_MMA(1, 1, At, B1); PG8_BAR; PG8_SCHED;
            } else {
            PG8_LDB(B0, 0, 0); PG8_SCHED; PG8_LDA(At, 0, 0); PG8_STAGE(PG8_SA(1, 1), a1 + hstep, voffA);
            PG8_WAIT_L(8); PG8_BAR; PG8_WAIT_L(0); PG8_MMA(0, 0, At, B0); PG8_BAR; PG8_SCHED;
            PG8_LDB(B1, 0, 1); PG8_STAGE(PG8_SB(0, 0), b2, voffB);
            PG8_BAR; PG8_WAIT_L(0); PG8_MMA(0, 1, At, B1); PG8_BAR;
            PG8_LDA(At, 0, 1); PG8_STAGE(PG8_SA(0, 0), a2, voffA);
            PG8_BAR; PG8_WAIT_L(0); PG8_MMA(1, 0, At, B0); PG8_BAR; PG8_SCHED;
            PG8_STAGE(PG8_SB(0, 1), b2 + hstep, voffB);
            PG8_WAIT_V(6); PG8_BAR; PG8_MMA(1, 1, At, B1); PG8_BAR;
            PG8_LDB(B0, 1, 0); PG8_SCHED; PG8_LDA(At, 1, 0); PG8_STAGE(PG8_SA(0, 1), a2 + hstep, voffA);
            PG8_WAIT_L(8); PG8_BAR; PG8_WAIT_L(0); PG8_MMA(0, 0, At, B0); PG8_BAR; PG8_SCHED;
            PG8_LDB(B1, 1, 1); PG8_STAGE(PG8_SB(1, 0), b3, voffB);
            PG8_BAR; PG8_WAIT_L(0); PG8_MMA(0, 1, At, B1); PG8_BAR;
            PG8_LDA(At, 1, 1); PG8_STAGE(PG8_SA(1, 0), a3, voffA);
            PG8_BAR; PG8_WAIT_L(0); PG8_MMA(1, 0, At, B0); PG8_BAR; PG8_SCHED;
            PG8_STAGE(PG8_SB(1, 1), b3 + hstep, voffB);
            PG8_WAIT_V(6); PG8_BAR; PG8_MMA(1, 1, At, B1); PG8_BAR;
            }
        }
        if constexpr (ALIGN_EPI) { if (wr == 0) PG8_BAR; }
        if constexpr (!Epi::AFTER_DRAIN) { E(acc, cur, wr, wc, fr, fq); S.done(cur); }
        if (!has_next) break;
#pragma unroll
        for (int a = 0; a < 2; ++a)
#pragma unroll
            for (int b = 0; b < 2; ++b)
#pragma unroll
                for (int m = 0; m < 4; ++m)
#pragma unroll
                    for (int n = 0; n < 2; ++n) acc[a][b][m][n] = (f32x4){0.f, 0.f, 0.f, 0.f};
        cur = nxt; cA = nA; cB = nB; ++ui;
        if constexpr (ALIGN_EPI) { if (wr == 1) PG8_BAR; }
    }
    PG8_WAIT_V(0);
    if constexpr (!ALIGN_EPI) { if (wr == 0) PG8_BAR; }
    PG8_BAR;
    if constexpr (Epi::AFTER_DRAIN) { E.fused(acc, cur, wr, wc, fr, fq, lds, wid, lane); S.done(cur); }
#undef PG8_SA
#undef PG8_SB
#undef PG8_STAGE
#undef PG8_LDA
#undef PG8_LDB
#undef PG8_MMA
#undef PG8_WAIT_V
#undef PG8_WAIT_L
#undef PG8_BAR
#undef PG8_SCHED
}
}
#define GAS __attribute__((address_space(1)))
#define LAS __attribute__((address_space(3)))
typedef unsigned short bf16;
typedef unsigned v4u __attribute__((ext_vector_type(4)));
typedef float f32x4 __attribute__((ext_vector_type(4)));
typedef short bf16x8 __attribute__((ext_vector_type(8)));
typedef GAS unsigned gu32;
typedef GAS unsigned long long gu64;
#define RLX_AGENT __ATOMIC_RELAXED, __HIP_MEMORY_SCOPE_AGENT
#define LDS_WAIT() asm volatile("s_waitcnt lgkmcnt(0)" ::: "memory")
#define VM_WAIT() asm volatile("s_waitcnt vmcnt(0)" ::: "memory")
__device__ __forceinline__ unsigned long long rt() { return __builtin_amdgcn_s_memrealtime(); }
__device__ __forceinline__ unsigned f2bf(float f) { unsigned u = __builtin_bit_cast(unsigned, f); return (u + 0x7fffu + ((u >> 16) & 1u)) >> 16; }
__device__ __forceinline__ unsigned pk2(float lo, float hi) { return f2bf(lo) | (f2bf(hi) << 16); }
#define XB_TMO      128
#define XB_XCNT(j)  (256  + 64 * (j))
#define XB_XSUB(j)  (1280 + 64 * (j))
#define XB_XGEN(j)  (2304 + 64 * (j))
#define XB_TOP      3328
#define XB_TOPGEN   3392
#define XCD_BAR_WORDS 3456
#define XB_SPIN_CAP (1u << 18)

__device__ __forceinline__ unsigned xb_ld(unsigned* p)              { return __hip_atomic_load(p, __ATOMIC_RELAXED, __HIP_MEMORY_SCOPE_AGENT); }
__device__ __forceinline__ unsigned xb_add(unsigned* p, unsigned v) { return __hip_atomic_fetch_add(p, v, __ATOMIC_RELAXED, __HIP_MEMORY_SCOPE_AGENT); }
__device__ __forceinline__ unsigned xb_xcc_id() { return (unsigned)__builtin_amdgcn_s_getreg((3 << 11) | 20) & 0xFu; }
#define XB_SPIN(cond, bar) do { unsigned _sp = 0; while (cond) { __builtin_amdgcn_s_sleep(1); \
    if ((++_sp & 255u) == 0u) { if (xb_ld(&(bar)[XB_TMO])) break; if (_sp > XB_SPIN_CAP) { atomicAdd(&(bar)[XB_TMO], 1u); break; } } } } while (0)

struct XcdBarrier {
    unsigned* bar; unsigned x;
    volatile LAS unsigned* st;
};

__device__ __forceinline__ XcdBarrier xcd_barrier_post(unsigned* bar, volatile LAS unsigned* st) {
    XcdBarrier b; b.bar = bar; b.x = xb_xcc_id(); b.st = st;
    if (threadIdx.x == 0) (void)xb_add(&bar[XB_XCNT(b.x)], 1u);
    return b;
}
__device__ __forceinline__ void xcd_barrier_complete(unsigned* bar, unsigned x, unsigned& nloc, unsigned& nx) {
    const unsigned G = gridDim.x * gridDim.y * gridDim.z;
    unsigned sum, cnt, mine, sp = 0u;
    for (;;) {
        sum = 0u; cnt = 0u; mine = 0u;
#pragma unroll
        for (unsigned j = 0; j < 16; ++j) { const unsigned c = xb_ld(&bar[XB_XCNT(j)]); sum += c; cnt += (c > 0u) ? 1u : 0u; mine = (j == x) ? c : mine; }
        if (sum == G) break;
        __builtin_amdgcn_s_sleep(1);
        if ((++sp & 255u) == 0u) { if (xb_ld(&bar[XB_TMO])) break; if (sp > XB_SPIN_CAP) { atomicAdd(&bar[XB_TMO], 1u); break; } }
    }
    nloc = mine > 0u ? mine : 1u; nx = cnt > 0u ? cnt : 1u;
}

__device__ __forceinline__ void xcd_barrier(const XcdBarrier& b) {
    asm volatile("s_waitcnt vmcnt(0)" ::: "memory");
    __syncthreads();
    if (threadIdx.x == 0) {
        unsigned* bar = b.bar;
        __builtin_amdgcn_s_waitcnt(0);
        unsigned nloc = b.st[0], nx = b.st[1];
        if (nloc == 0u) { xcd_barrier_complete(bar, b.x, nloc, nx); b.st[0] = nloc; b.st[1] = nx; }
        const unsigned old = xb_add(&bar[XB_XSUB(b.x)], 1u);
        const unsigned gen = old / nloc;
        if (old + 1u == (gen + 1u) * nloc) {
            __builtin_amdgcn_fence(__ATOMIC_RELEASE, "agent");
            asm volatile("s_waitcnt vmcnt(0)" ::: "memory");
            const unsigned og = xb_add(&bar[XB_TOP], 1u);
            const unsigned tg = og / nx;
            if (og + 1u == (tg + 1u) * nx) xb_add(&bar[XB_TOPGEN], 1u);
            else XB_SPIN(xb_ld(&bar[XB_TOPGEN]) == tg, bar);
            __builtin_amdgcn_fence(__ATOMIC_ACQUIRE, "agent");
            xb_add(&bar[XB_XGEN(b.x)], 1u);
            asm volatile("s_waitcnt vmcnt(0)" ::: "memory");
        } else {
            XB_SPIN(xb_ld(&bar[XB_XGEN(b.x)]) == gen, bar);
            __builtin_amdgcn_fence(__ATOMIC_ACQUIRE, "agent");
            asm volatile("s_waitcnt vmcnt(0)" ::: "memory");
        }
    }
    __syncthreads();
}
constexpr int NWAVES = 8;
#ifndef MK_N_LAUNCHES
#define MK_N_LAUNCHES 1
#endif
constexpr int N_PHASES = 10;
constexpr int N_LAUNCHES = MK_N_LAUNCHES;

constexpr int DM = 2048, NBATCH = 8, SEQ = 2048, MP = NBATCH * SEQ, SBATCH = 8, SLEN = 16, MS = SBATCH * SLEN, MT = MP + MS;
constexpr int NH = 4, DV = 256, DQK = 128, QKW = 1024, NG = 64, GCH = 16, PST = 64, DFF = 5632, NIN = 4104;
constexpr int CH = 64, NCH = SEQ / CH;
constexpr int NSC = NBATCH * NCH + SBATCH;
constexpr float EPS = 1e-6f;
constexpr int DVS = 64, NSL = DV / DVS;

constexpr size_t O_Y = 0, O_CONVP = (size_t)MT * DM, O_CP = O_CONVP + 8 * 3 * 1024, O_NP = O_CP + 8 * 4 * 256 * 128, O_MP = O_NP + 8 * 4 * 128,
                 O_SRP = O_MP + 32, O_SIP = O_SRP + 8 * 64 * 64, O_CONVS = O_SIP + 8 * 64 * 64, O_CS = O_CONVS + 8 * 3 * 1024, O_NS = O_CS + 8 * 4 * 256 * 128,
                 O_MS = O_NS + 8 * 4 * 128, O_SRS = O_MS + 32, O_SIS = O_SRS + 8 * 64 * 64, O_END = O_SIS + 8 * 64 * 64;
static_assert(O_END == 36102208, "d_out map");

constexpr size_t MiB = 1u << 20;
constexpr size_t WS_CTL = 0, CTL_ZERO_BYTES = 1 * MiB;
constexpr size_t WS_WIN = 2 * MiB, WS_WGLU = 18 * MiB, WS_WOUT = 20 * MiB, WS_WGU = 28 * MiB, WS_WD = 72 * MiB;
constexpr size_t WS_XN = 96 * MiB;
constexpr size_t WS_R0 = 162 * MiB, WS_RSTRIDE = 33 * MiB;
constexpr size_t WS_QKRAW = WS_R0, WS_V = WS_R0 + WS_RSTRIDE, WS_OG = WS_R0 + 2 * WS_RSTRIDE, WS_U = WS_R0 + 3 * WS_RSTRIDE;
constexpr size_t WS_Q = 294 * MiB, WS_K = 311 * MiB;
constexpr size_t WS_Z = WS_QKRAW;
constexpr size_t WS_MIXIN = WS_Q;
constexpr size_t WS_MIX = WS_R0;
constexpr size_t WS_ACT = WS_R0;
constexpr size_t WS_X1B = WS_XN;
constexpr size_t WS_FF = 427 * MiB;
constexpr size_t WS_GATES = 378 * MiB, WS_HSS = 379 * MiB, WS_SS1 = 382 * MiB, WS_SS2 = 385 * MiB, WS_S5P = 388 * MiB, WS_SSS = 389 * MiB;
constexpr size_t WS_HS = 390 * MiB;
constexpr size_t WS_SCAL = 423 * MiB, WS_END = 492 * MiB;
static_assert(WS_XN + (size_t)MT * DM * 2 <= WS_R0 && WS_QKRAW + (size_t)MT * 1024 * 2 <= WS_V && WS_U + (size_t)MT * 1024 * 2 <= WS_Q && WS_Q + (size_t)MT * 512 * 2 <= WS_K &&
              WS_K + (size_t)MT * 512 * 2 <= WS_GATES && WS_MIXIN + (size_t)MT * DM * 2 <= WS_GATES && WS_MIX + (size_t)MT * DM * 2 <= WS_OG && WS_ACT + (size_t)MT * DFF * 2 <= WS_GATES &&
              WS_WD + (size_t)DM * DFF * 2 <= WS_XN && WS_WGU + (size_t)2 * DFF * DM * 2 <= WS_WD && WS_HSS + (size_t)MT * 32 * 4 <= WS_SS1 && WS_SS1 + (size_t)MT * 32 * 4 <= WS_SS2 &&
              WS_SS2 + (size_t)MT * 32 * 4 <= WS_S5P && WS_GATES + (size_t)MT * 8 * 4 <= WS_HSS && WS_HS + (size_t)MT * 1024 * 2 <= WS_SCAL && WS_SCAL + (size_t)NSC * 4 * 384 * 4 <= WS_FF && WS_FF + (size_t)MT * DM * 2 <= WS_END, "d_ws map");
constexpr size_t S5P_LAM = 0, S5P_BBT = 64 * 1024, S5P_CC = S5P_BBT + 64 * 128 * 16 * 2;
constexpr size_t SSS_1 = 0, SSS_2 = 128 * 128 * 4, SSS_RSTD2 = 256 * 1024, SSS_RSTD1 = 384 * 1024;
constexpr int CW_TMO = 0, CW_CODE = 1, CW_BAR = 4096;

constexpr int RING_OFF = 0, RING_BYTES = 131072;
constexpr int LDSCTL_OFF = 151552, MISC_OFF = LDSCTL_OFF + 320;
constexpr int LDS_BYTES = 155648;
typedef short s16x4 __attribute__((ext_vector_type(4)));
typedef unsigned u32x2 __attribute__((ext_vector_type(2)));
struct Frame {
    LAS unsigned char* lds;
    volatile LAS unsigned* MISC;
    gu32* ctl;
    int tid, lane, wave;
    int vcu, G;
    const float* const* in;
    float* out; unsigned char* ws;
};
__device__ __forceinline__ float wave_sum(float v) {
#pragma unroll
    for (int o = 1; o < 64; o <<= 1) v += __shfl_xor(v, o);
    return v;
}
__device__ __forceinline__ unsigned cvtpk(float lo, float hi) { unsigned r; asm volatile("v_cvt_pk_bf16_f32 %0, %1, %2" : "=v"(r) : "v"(lo), "v"(hi)); return r; }
typedef __bf16 bf16x2n_t __attribute__((ext_vector_type(2)));
__device__ __forceinline__ unsigned cvtpk_n(float lo, float hi) { const bf16x2n_t v = {(__bf16)lo, (__bf16)hi}; return __builtin_bit_cast(unsigned, v); }
__device__ __forceinline__ float bflo(unsigned w) { return __uint_as_float(w << 16); }
__device__ __forceinline__ float bfhi(unsigned w) { return __uint_as_float(w & 0xffff0000u); }
__device__ __forceinline__ float bf2f(bf16 h) { return __uint_as_float((unsigned)h << 16); }
__device__ __forceinline__ float sigmoidf_(float v) { return __builtin_amdgcn_rcpf(1.0f + __expf(-v)); }
__device__ __forceinline__ f32x4 mfma16(bf16x8 a, bf16x8 b, f32x4 c) { return __builtin_amdgcn_mfma_f32_16x16x32_bf16(a, b, c, 0, 0, 0); }
#define WAVE_SYNC() do { asm volatile("s_waitcnt lgkmcnt(0)" ::: "memory"); __builtin_amdgcn_wave_barrier(); } while (0)

#ifdef MK_STAMP
#ifndef MK_STAMP_SCALE
#define MK_STAMP_SCALE 0.002f
#endif
#define DBG_DECL unsigned long long dbg_acc_ = 0, dbg_t0_ = 0;
__device__ __forceinline__ unsigned long long dbg_rt() { unsigned long long t; __builtin_amdgcn_sched_barrier(0);
#ifdef MK_STAMP_CYC
    asm volatile("s_memtime %0\n\ts_waitcnt lgkmcnt(0)" : "=s"(t) :: "memory");
#else
    asm volatile("s_memrealtime %0\n\ts_waitcnt lgkmcnt(0)" : "=s"(t) :: "memory");
#endif
 __builtin_amdgcn_sched_barrier(0); return t; }
#define DBG_BEGIN(id) do { if ((id) == MK_STAMP) dbg_t0_ = dbg_rt(); } while (0)
#define DBG_END(id) do { if ((id) == MK_STAMP) dbg_acc_ += dbg_rt() - dbg_t0_; } while (0)
#define DBG_REPORT(cond) do { if ((cond) && (threadIdx.x & 63) == 0 && (threadIdx.x >> 6) == MK_STAMP_WAVE) ((unsigned*)(A.ws + WS_CTL))[16] = (unsigned)dbg_acc_; } while (0)
#define DBG_PERTURB(V, m_) do { if ((m_) == 0 && lane == 0) V[0][0] += (float)__hip_atomic_load((unsigned*)(A.ws + WS_CTL) + 16, __ATOMIC_RELAXED, __HIP_MEMORY_SCOPE_AGENT) * MK_STAMP_SCALE; } while (0)
#else
#define DBG_DECL
#define DBG_BEGIN(id)
#define DBG_END(id)
#define DBG_REPORT(cond)
#define DBG_PERTURB(V, m_)
#endif
struct Args { const float* in[32]; float* out; unsigned char* ws; int ph_lo, ph_hi, li, pad; };

__device__ __forceinline__ void p0_transpose_item(const float* W, int ldw, int src_col0, int k0, bf16* WT, int K, int out_row0, LAS float* scr, int lane, const float* kscale = nullptr) {
    if (kscale) {
#pragma unroll 8
        for (int i = 0; i < 32; ++i) { const int kk = 2 * i + (lane >> 5); scr[kk * 33 + (lane & 31)] = __builtin_nontemporal_load(W + (size_t)(k0 + kk) * ldw + src_col0 + (lane & 31)) * kscale[k0 + kk]; }
    } else {
#pragma unroll 8
    for (int i = 0; i < 32; ++i) { const int kk = 2 * i + (lane >> 5); scr[kk * 33 + (lane & 31)] = __builtin_nontemporal_load(W + (size_t)(k0 + kk) * ldw + src_col0 + (lane & 31)); }
    }
    LDS_WAIT(); asm volatile("" ::: "memory");
    const int c = lane & 7;
#pragma unroll
    for (int j = 0; j < 4; ++j) { const int n = (lane >> 3) + 8 * j; const LAS float* s = scr + (8 * c) * 33 + n;
        v4u o; o.x = pk2(s[0 * 33], s[1 * 33]); o.y = pk2(s[2 * 33], s[3 * 33]); o.z = pk2(s[4 * 33], s[5 * 33]); o.w = pk2(s[6 * 33], s[7 * 33]);
        *(GAS v4u*)(WT + (size_t)(out_row0 + n) * K + k0 + 8 * c) = o; }
    LDS_WAIT(); asm volatile("" ::: "memory");
}
__device__ __forceinline__ float log_sigmoid(float x) { return fminf(x, 0.f) - log1pf(__expf(-fabsf(x))); }

struct CvtItem { const float* W; int ldw, sc, k0; bf16* WT; int K, orow; const float* ks; };
constexpr int CV_I_IN = (DM / 64) * (4096 / 32), CV_I_GLU = (1024 / 64) * (1024 / 32), CV_I_OUT = (DM / 64) * (DM / 32), CV_I_GU = (DM / 64) * (2 * DFF / 32), CV_I_D = (DFF / 64) * (DM / 32);
__device__ __forceinline__ CvtItem cvt_item(const Args& A, int it) {
    unsigned char* ws = A.ws; int r = it; CvtItem c;
    if (r < CV_I_IN) { const int nnb = 4096 / 32, kb = r / nnb, nb = r % nnb, orow = 32 * nb; c = CvtItem{A.in[9], NIN, orow < 3072 ? orow : orow + 8, 64 * kb, (bf16*)(ws + WS_WIN), DM, orow, nullptr}; return c; } r -= CV_I_IN;
    if (r < CV_I_GLU) { const int nnb = 1024 / 32, kb = r / nnb, nb = r % nnb; c = CvtItem{A.in[23], 1024, 32 * nb, 64 * kb, (bf16*)(ws + WS_WGLU), 1024, 32 * nb, nullptr}; return c; } r -= CV_I_GLU;
    if (r < CV_I_OUT) { const int nnb = DM / 32, kb = r / nnb, nb = r % nnb; c = CvtItem{A.in[25], DM, 32 * nb, 64 * kb, (bf16*)(ws + WS_WOUT), DM, 32 * nb, nullptr}; return c; } r -= CV_I_OUT;
    if (r < CV_I_GU) { const int nnb = 2 * DFF / 32, kb = r / nnb, nb = r % nnb, orow = 32 * nb, pn = orow >> 8, cc = orow & 255;
        c = CvtItem{cc < 128 ? A.in[28] : A.in[29], DFF, 128 * pn + (cc & 127), 64 * kb, (bf16*)(ws + WS_WGU), DM, orow, A.in[27]}; return c; } r -= CV_I_GU;
    { const int nnb = DM / 32, kb = r / nnb, nb = r % nnb; c = CvtItem{A.in[30], DM, 32 * nb, 64 * kb, (bf16*)(ws + WS_WD), DFF, 32 * nb, nullptr}; return c; }
}
__device__ __forceinline__ void p0_prologue(const Args& A, LAS unsigned char* lds, int tid, int lane, int wave, int vcu, int G) {
    unsigned char* ws = A.ws;
    LAS float* WG = (LAS float*)lds;
    LAS float* scr = (LAS float*)(lds + wave * 8448);
    const int gw = vcu * NWAVES + wave, NGW = G * NWAVES;
    { constexpr int NIT = CV_I_IN + CV_I_GLU + CV_I_OUT + CV_I_GU + CV_I_D;
      float ra[32], rb[32]; CvtItem ia, ib;
#define CV_LOAD(R, I, it_) do { I = cvt_item(A, (it_)); \
        _Pragma("unroll") for (int i = 0; i < 32; ++i) { const int kk = 2 * i + (lane >> 5); R[i] = __builtin_nontemporal_load(I.W + (size_t)(I.k0 + kk) * I.ldw + I.sc + (lane & 31)); } } while (0)
#define CV_PROC(R, I) do { \
        if (I.ks) { _Pragma("unroll") for (int i = 0; i < 32; ++i) { const int kk = 2 * i + (lane >> 5); scr[kk * 33 + (lane & 31)] = R[i] * I.ks[I.k0 + kk]; } } \
        else { _Pragma("unroll") for (int i = 0; i < 32; ++i) { const int kk = 2 * i + (lane >> 5); scr[kk * 33 + (lane & 31)] = R[i]; } } \
        LDS_WAIT(); asm volatile("" ::: "memory"); \
        { const int c = lane & 7; \
          _Pragma("unroll") for (int j = 0; j < 4; ++j) { const int n = (lane >> 3) + 8 * j; const LAS float* s = scr + (8 * c) * 33 + n; \
              v4u o; o.x = pk2(s[0 * 33], s[1 * 33]); o.y = pk2(s[2 * 33], s[3 * 33]); o.z = pk2(s[4 * 33], s[5 * 33]); o.w = pk2(s[6 * 33], s[7 * 33]); \
              *(GAS v4u*)(I.WT + (size_t)(I.orow + n) * I.K + I.k0 + 8 * c) = o; } } \
        LDS_WAIT(); asm volatile("" ::: "memory"); } while (0)
      int it = gw;
      if (it < NIT) { CV_LOAD(ra, ia, it);
          for (;;) { const int it2 = it + NGW; if (it2 < NIT) CV_LOAD(rb, ib, it2); CV_PROC(ra, ia); if (it2 >= NIT) break;
                     it = it2 + NGW; if (it < NIT) CV_LOAD(ra, ia, it); CV_PROC(rb, ib); if (it >= NIT) break; } }
#undef CV_LOAD
#undef CV_PROC
    }
    { const int gt = vcu * (NWAVES * 64) + tid;
      if (gt < NG * PST) {
        const int g = gt >> 6, p = gt & 63;
        const double lr = (double)A.in[15][gt], li = (double)A.in[16][gt], dt = exp((double)A.in[17][g]);
        const double mag = exp(lr * dt), ang = li * dt, lbr = mag * cos(ang), lbi = mag * sin(ang);
        const double den = lr * lr + li * li, nr = lbr - 1.0, fre = (nr * lr + lbi * li) / den, fim = (lbi * lr - nr * li) / den;
        float* LAM = (float*)(ws + WS_S5P + S5P_LAM); LAM[gt * 2] = (float)lbr; LAM[gt * 2 + 1] = (float)lbi;
        bf16* BBT = (bf16*)(ws + WS_S5P + S5P_BBT); bf16* CC = (bf16*)(ws + WS_S5P + S5P_CC);
        const float* bre = A.in[18] + (size_t)gt * 16; const float* bim = A.in[19] + (size_t)gt * 16;
#pragma unroll
        for (int i = 0; i < 16; ++i) { const double br = bre[i], bi = bim[i];
            BBT[((size_t)g * 128 + 2 * p) * 16 + i] = (bf16)f2bf((float)(fre * br - fim * bi));
            BBT[((size_t)g * 128 + 2 * p + 1) * 16 + i] = (bf16)f2bf((float)(fre * bi + fim * br));
            CC[((size_t)g * 16 + i) * 128 + 2 * p] = (bf16)f2bf(A.in[20][((size_t)g * 16 + i) * 64 + p]);
            CC[((size_t)g * 16 + i) * 128 + 2 * p + 1] = (bf16)f2bf(-A.in[21][((size_t)g * 16 + i) * 64 + p]); }
      } }
    __syncthreads();
    { const float* win = A.in[9];
      for (int e = tid; e < 8 * 2048; e += NWAVES * 64) { const int k = e >> 3, c = e & 7; WG[c * 2048 + k] = win[(size_t)k * NIN + 3072 + c]; } }
    __syncthreads();
    { const GAS f32x4* gp = (const GAS f32x4*)A.in[8] + lane; f32x4 gv[8];
#pragma unroll
      for (int j = 0; j < 8; ++j) gv[j] = gp[64 * j];
      bf16* XN = (bf16*)(ws + WS_XN); float* GATES = (float*)(ws + WS_GATES);
      for (int m = gw; m < MT; m += NGW) {
        const float* xrow = m < MP ? A.in[0] + (size_t)m * DM : A.in[1] + (size_t)(m - MP) * DM;
        const GAS f32x4* xr = (const GAS f32x4*)xrow + lane;
        f32x4 v[8]; float s = 0.f;
#pragma unroll
        for (int j = 0; j < 8; ++j) { v[j] = __builtin_nontemporal_load(xr + 64 * j); s += (v[j].x * v[j].x + v[j].y * v[j].y) + (v[j].z * v[j].z + v[j].w * v[j].w); }
        const float ms = wave_sum(s) * (1.0f / DM) + EPS, rstd = 1.0f / sqrtf(ms);
        if (lane == 0) ((float*)(ws + WS_SSS + SSS_RSTD1))[m] = sqrtf(ms);
        GAS u32x2* o8 = (GAS u32x2*)(XN + (size_t)m * DM) + lane;
        float ga[8] = {0.f, 0.f, 0.f, 0.f, 0.f, 0.f, 0.f, 0.f};
#pragma unroll
        for (int j = 0; j < 8; ++j) { v[j] = v[j] * rstd * gv[j]; u32x2 o; o.x = cvtpk(v[j].x, v[j].y); o.y = cvtpk(v[j].z, v[j].w); o8[64 * j] = o;
#pragma unroll
            for (int c = 0; c < 8; ++c) { const f32x4 w = *(const LAS f32x4*)(WG + c * 2048 + 256 * j + 4 * lane); ga[c] += (v[j].x * w.x + v[j].y * w.y) + (v[j].z * w.z + v[j].w * w.w); } }
#pragma unroll
        for (int c = 0; c < 8; ++c) ga[c] = wave_sum(ga[c]);
        if (lane < 8) { float val = 0.f;
#pragma unroll
            for (int c = 0; c < 8; ++c) if (lane == c) val = ga[c];
            if (lane < 4) val += A.in[12][lane]; else val = log_sigmoid(val + A.in[13][lane - 4]);
            GATES[(size_t)m * 8 + lane] = val; }
      } }
}

template <int NACC, int K, class RowMap, class Epi>
__device__ __forceinline__ void skinny_gemm(const bf16* Arows, const bf16* Bt, LAS unsigned char* lds, int nitems, int first, int stride, int tid, int wave, int lane, RowMap rm, Epi epi) {
    const int fr = lane & 15, fq = lane >> 4;
    constexpr int KW = K / 8, NS = KW / 32;
    static_assert(KW % 32 == 0, "skinny_gemm: K must be a multiple of 256");
    const bf16* abase = Arows + (size_t)fr * K + wave * KW + 8 * fq;
    LAS f32x4* red = (LAS f32x4*)lds;
    for (int it = first; it < nitems; it += stride) {
        const bf16* brow[NACC]; f32x4 acc[NACC][8];
#pragma unroll
        for (int a = 0; a < NACC; ++a) { brow[a] = Bt + (size_t)rm(it, a, fr) * K + wave * KW + 8 * fq;
#pragma unroll
            for (int rb = 0; rb < 8; ++rb) acc[a][rb] = (f32x4){0.f, 0.f, 0.f, 0.f}; }
#pragma unroll 2
        for (int s = 0; s < NS; ++s) {
            bf16x8 av[8], bv[NACC];
#pragma unroll
            for (int a = 0; a < NACC; ++a) bv[a] = *(const bf16x8*)(brow[a] + 32 * s);
#pragma unroll
            for (int rb = 0; rb < 8; ++rb) av[rb] = *(const bf16x8*)(abase + (size_t)(16 * rb) * K + 32 * s);
#pragma unroll
            for (int rb = 0; rb < 8; ++rb)
#pragma unroll
                for (int a = 0; a < NACC; ++a) acc[a][rb] = mfma16(bv[a], av[rb], acc[a][rb]);
        }
#pragma unroll
        for (int a = 0; a < NACC; ++a)
#pragma unroll
            for (int rb = 0; rb < 8; ++rb) red[((a * 8 + wave) * 8 + rb) * 64 + lane] = acc[a][rb];
        __syncthreads();
        f32x4 fin[NACC];
#pragma unroll
        for (int a = 0; a < NACC; ++a) { f32x4 t = red[((a * 8 + 0) * 8 + wave) * 64 + lane];
#pragma unroll
            for (int w2 = 1; w2 < 8; ++w2) t += red[((a * 8 + w2) * 8 + wave) * 64 + lane];
            fin[a] = t; }
        __syncthreads();
        epi(it, 16 * wave + fr, fq, fin);
    }
}

__device__ __forceinline__ void p2_scalars(const Args& A, LAS unsigned char* lds, int lane, int wave, int item) {
    unsigned char* ws = A.ws;
    const float* GATES = (const float*)(ws + WS_GATES); float* SCAL = (float*)(ws + WS_SCAL);
    const int seq = item >> 2, h = item & 3; const bool sample = seq >= NBATCH; const int b = sample ? seq - NBATCH : seq;
    const int nch = sample ? 1 : NCH, L = sample ? SLEN : CH, row0 = sample ? MP + b * SLEN : b * SEQ, sc0 = sample ? NBATCH * NCH + b : b * NCH;
    LAS float* fl = (LAS float*)lds;
    float fc[4], a[4], pm[4];
#pragma unroll
    for (int i = 0; i < 4; ++i) { const int c = 4 * wave + i; float li = -INFINITY, lf = 0.f;
        if (c < nch && lane < L) { li = GATES[((size_t)row0 + c * CH + lane) * 8 + h]; lf = GATES[((size_t)row0 + c * CH + lane) * 8 + 4 + h]; }
        float f = lf;
#pragma unroll
        for (int d = 1; d < 64; d <<= 1) { const float o = __shfl_up(f, d); if (lane >= d) f += o; }
        const float aa = li - f; float p = aa;
#pragma unroll
        for (int d = 1; d < 64; d <<= 1) { const float o = __shfl_up(p, d); if (lane >= d) p = fmaxf(p, o); }
        fc[i] = f; a[i] = aa; pm[i] = p;
        if (lane == 63) { fl[c] = f; fl[32 + c] = p; } }
    __syncthreads();
    float m0c = 0.f, m0 = sample ? A.in[5][b * NH + h] : 0.f;
    for (int c = 0; c < nch; ++c) { if (lane == c) m0c = m0; m0 = fl[c] + fmaxf(fl[32 + c], m0); }
#pragma unroll
    for (int i = 0; i < 4; ++i) { const int c = 4 * wave + i;
        if (c < nch) { const float m0i = __shfl(m0c, c); const float mm = fmaxf(pm[i], m0i), mml = __shfl(mm, 63);
            float* o = SCAL + ((size_t)(sc0 + c) * 4 + h) * 384;
            o[lane] = a[i]; o[64 + lane] = mm; o[128 + lane] = __expf(m0i - mm); o[192 + lane] = __expf(-(fc[i] + mm)); o[256 + lane] = __expf(a[i] - mml);
            o[320 + lane] = (lane == 0) ? __expf(m0i - mml) : (__shfl(fc[i], 63) + mml); } }
    if (wave == 0 && lane == 0) A.out[(sample ? O_MS : O_MP) + b * NH + h] = m0;
    __syncthreads();
}
__device__ __forceinline__ void p2_conv(const Args& A, int tid, int vcu, int G) {
    unsigned char* ws = A.ws;
    const bf16* QKRAW = (const bf16*)(ws + WS_QKRAW); bf16* Q = (bf16*)(ws + WS_Q); bf16* Kb = (bf16*)(ws + WS_K);
    const int nthreads = G * NWAVES * 64;
    for (int it = vcu * (NWAVES * 64) + tid; it < (MT / 8) * 128; it += nthreads) {
        const int rb = it >> 7, ch = it & 127, rs = 8 * rb, col = 8 * ch;
        bool first, sample = rs >= MP; int b, tl, Lseq;
        if (!sample) { b = rs / SEQ; tl = rs % SEQ; Lseq = SEQ; } else { b = (rs - MP) / SLEN; tl = (rs - MP) % SLEN; Lseq = SLEN; }
        first = (tl == 0);
        float w[4][8], bc[8];
#pragma unroll
        for (int j = 0; j < 4; ++j) { const f32x4 a0 = *(const f32x4*)(A.in[10] + j * 1024 + col), a1 = *(const f32x4*)(A.in[10] + j * 1024 + col + 4);
            w[j][0] = a0[0]; w[j][1] = a0[1]; w[j][2] = a0[2]; w[j][3] = a0[3]; w[j][4] = a1[0]; w[j][5] = a1[1]; w[j][6] = a1[2]; w[j][7] = a1[3]; }
        { const f32x4 a0 = *(const f32x4*)(A.in[11] + col), a1 = *(const f32x4*)(A.in[11] + col + 4);
          bc[0] = a0[0]; bc[1] = a0[1]; bc[2] = a0[2]; bc[3] = a0[3]; bc[4] = a1[0]; bc[5] = a1[1]; bc[6] = a1[2]; bc[7] = a1[3]; }
        v4u raw[11];
#pragma unroll
        for (int r = 0; r < 11; ++r) { if (r >= 3 || !first) raw[r] = *(const GAS v4u*)(QKRAW + (size_t)(rs + r - 3) * 1024 + col); else raw[r] = (v4u){0u, 0u, 0u, 0u}; }
        float x0[8], x1[8], x2[8];
#define UNPK(dst, v) do { dst[0] = bflo(v.x); dst[1] = bfhi(v.x); dst[2] = bflo(v.y); dst[3] = bfhi(v.y); dst[4] = bflo(v.z); dst[5] = bfhi(v.z); dst[6] = bflo(v.w); dst[7] = bfhi(v.w); } while (0)
        if (first && sample) {
            const float* sp = A.in[2] + (size_t)b * 3 * 1024 + col;
#pragma unroll
            for (int i = 0; i < 8; ++i) { x0[i] = sp[i]; x1[i] = sp[1024 + i]; x2[i] = sp[2048 + i]; }
        } else { UNPK(x0, raw[0]); UNPK(x1, raw[1]); UNPK(x2, raw[2]); }
#pragma unroll
        for (int r = 0; r < 8; ++r) {
            float x3[8]; UNPK(x3, raw[r + 3]);
            float o[8];
#pragma unroll
            for (int i = 0; i < 8; ++i) { const float val = bc[i] + w[0][i] * x0[i] + w[1][i] * x1[i] + w[2][i] * x2[i] + w[3][i] * x3[i]; o[i] = val * sigmoidf_(val); }
            const size_t row = (size_t)rs + r;
            if (ch < 64) {
#pragma unroll
                for (int i = 0; i < 8; ++i) o[i] *= 0.08838834764831845f;
                v4u pk; pk.x = cvtpk(o[0], o[1]); pk.y = cvtpk(o[2], o[3]); pk.z = cvtpk(o[4], o[5]); pk.w = cvtpk(o[6], o[7]);
                *(GAS v4u*)(Q + row * 512 + col) = pk;
            } else {
                v4u pk; pk.x = cvtpk(o[0], o[1]); pk.y = cvtpk(o[2], o[3]); pk.z = cvtpk(o[4], o[5]); pk.w = cvtpk(o[6], o[7]);
                *(GAS v4u*)(Kb + row * 512 + (col - 512)) = pk;
            }
            const int tt = tl + r;
            if (tt >= Lseq - 3) { float* cv = A.out + (sample ? O_CONVS : O_CONVP) + ((size_t)b * 3 + (tt - (Lseq - 3))) * 1024 + col;
                *(f32x4*)cv = (f32x4){x3[0], x3[1], x3[2], x3[3]}; *(f32x4*)(cv + 4) = (f32x4){x3[4], x3[5], x3[6], x3[7]}; }
#pragma unroll
            for (int i = 0; i < 8; ++i) { x0[i] = x1[i]; x1[i] = x2[i]; x2[i] = x3[i]; }
        }
#undef UNPK
    }
}
constexpr int ML_QS = 0, ML_KS = 17408, ML_VS = 34816, ML_SC = 46080, ML_SET = 47616, ML_SS = 2 * ML_SET, ML_CB = ML_SS + 9216, ML_CBSZ = 21760;
static_assert(ML_CB + 2 * ML_CBSZ <= LDSCTL_OFF, "mLSTM LDS map");
constexpr int SC_A = 0, SC_MM = 64, SC_GI = 128, SC_EN = 192, SC_WS = 256, SC_MISC = 320;
__device__ __forceinline__ bf16x8 ldsfrag(const LAS unsigned char* p) { return *(const LAS bf16x8*)p; }
typedef __attribute__((address_space(3))) s16x4 lds_s16x4;
__device__ __forceinline__ bf16x8 trfrag(const LAS unsigned char* tile, int stride, int k0, int c0, int lane) {
    const int g = lane >> 4, q = (lane & 15) >> 2, p = lane & 3;
    const LAS unsigned char* a0 = tile + (k0 + 8 * g + q) * stride + (c0 + 4 * p) * 2;
    const s16x4 lo = __builtin_amdgcn_ds_read_tr16_b64_v4i16((lds_s16x4*)a0), hi = __builtin_amdgcn_ds_read_tr16_b64_v4i16((lds_s16x4*)(a0 + 4 * stride));
    return (bf16x8){lo[0], lo[1], lo[2], lo[3], hi[0], hi[1], hi[2], hi[3]};
}
#define LBAR() do { asm volatile("s_waitcnt lgkmcnt(0)" ::: "memory"); __builtin_amdgcn_s_barrier(); asm volatile("" ::: "memory"); } while (0)

__device__ __forceinline__ void mlstm_item(const Args& A, LAS unsigned char* lds, int tid, int lane, int wave, int item) {
    DBG_DECL
    unsigned char* ws = A.ws;
    const int fr = lane & 15, fq = lane >> 4;
    const bool sample = item >= NBATCH * NH * NSL; const int ii = sample ? item - NBATCH * NH * NSL : item;
    const int b = ii / (NH * NSL), h = (ii / NSL) % NH, sl = ii % NSL;
    const int nch = sample ? 1 : NCH, L = sample ? SLEN : CH;
    const int row0 = sample ? MP + b * SLEN : b * SEQ, sc0 = sample ? NBATCH * NCH + b : b * NCH;
    const bf16* Qg = (const bf16*)(ws + WS_Q); const bf16* Kg = (const bf16*)(ws + WS_K); const bf16* Vg = (const bf16*)(ws + WS_V);
    const float* SCAL = (const float*)(ws + WS_SCAL); bf16* HS = (bf16*)(ws + WS_HS); float* HSS = (float*)(ws + WS_HSS);
    if (tid < 256) { const int r = (tid >> 1) & 63, hf = tid & 1, st = tid >> 7; *(LAS v4u*)(lds + st * ML_SET + ML_VS + r * 176 + 128 + 16 * hf) = (v4u){hf == 0 ? 0x00003F80u : 0u, 0u, 0u, 0u}; }
    f32x4 Cst[5];
    if (sample) {
        const float* c0 = A.in[3] + ((size_t)(b * NH + h) * DV + DVS * sl) * DQK; const float* n0 = A.in[4] + (size_t)(b * NH + h) * DQK;
#pragma unroll
        for (int vb = 0; vb < 4; ++vb) Cst[vb] = *(const f32x4*)(c0 + (size_t)(16 * vb + fr) * DQK + 16 * wave + 4 * fq);
        Cst[4] = (fr == 0) ? *(const f32x4*)(n0 + 16 * wave + 4 * fq) : (f32x4){0.f, 0.f, 0.f, 0.f};
    } else {
#pragma unroll
        for (int vb = 0; vb < 5; ++vb) Cst[vb] = (f32x4){0.f, 0.f, 0.f, 0.f};
    }
#pragma unroll
    for (int vb = 0; vb < 5; ++vb) { u32x2 w; w.x = cvtpk_n(Cst[vb][0], Cst[vb][1]); w.y = cvtpk_n(Cst[vb][2], Cst[vb][3]); *(LAS u32x2*)(lds + ML_CB + (16 * vb + fr) * 272 + (16 * wave + 4 * fq) * 2) = w; }
    v4u pq[2], pk[2], pv; f32x4 psc = (f32x4){0.f, 0.f, 0.f, 0.f};
#define ML_ISSUE(c_) do { \
        const size_t r0_ = (size_t)row0 + (size_t)(c_) * CH; \
        _Pragma("unroll") for (int i = 0; i < 2; ++i) { const int e = tid + 512 * i, r = e >> 4, ch = e & 15; \
            if (r < L) { pq[i] = *(const GAS v4u*)(Qg + (r0_ + r) * 512 + 128 * h + 8 * ch); pk[i] = *(const GAS v4u*)(Kg + (r0_ + r) * 512 + 128 * h + 8 * ch); } \
            else { pq[i] = (v4u){0u, 0u, 0u, 0u}; pk[i] = (v4u){0u, 0u, 0u, 0u}; } } \
        { const int r = tid >> 3, ch = tid & 7; if (r < L) pv = *(const GAS v4u*)(Vg + (r0_ + r) * 1024 + DV * h + DVS * sl + 8 * ch); else pv = (v4u){0u, 0u, 0u, 0u}; } \
        if (tid < 96) psc = *(const GAS f32x4*)(SCAL + ((size_t)(sc0 + (c_)) * 4 + h) * 384 + 4 * tid); \
    } while (0)
#define ML_COMMIT(so_) do { LAS unsigned char* wl_ = lds + (so_); \
        _Pragma("unroll") for (int i = 0; i < 2; ++i) { const int e = tid + 512 * i, r = e >> 4, ch = e & 15; \
            *(LAS v4u*)(wl_ + ML_QS + r * 272 + ch * 16) = pq[i]; *(LAS v4u*)(wl_ + ML_KS + r * 272 + ch * 16) = pk[i]; } \
        { const int r = tid >> 3, ch = tid & 7; *(LAS v4u*)(wl_ + ML_VS + r * 176 + ch * 16) = pv; } \
        if (tid < 96) *(LAS f32x4*)((LAS float*)(wl_ + ML_SC) + 4 * tid) = psc; \
    } while (0)
    ML_ISSUE(0); ML_COMMIT(0);
    LBAR();
    const int tb = wave & 3, wh = wave >> 2, t = 16 * tb + fr;
    u32x2 hsw[2] = {(u32x2){0u, 0u}, (u32x2){0u, 0u}}; float hsp = 0.f;
#define ML_FLUSH(c_) do { const size_t grow = (size_t)row0 + (size_t)(c_) * CH + t; \
        if (t < L) { *(GAS u32x2*)(HS + grow * 1024 + h * DV + DVS * sl + 16 * (2 * wh) + 4 * fq) = hsw[0]; *(GAS u32x2*)(HS + grow * 1024 + h * DV + DVS * sl + 16 * (2 * wh + 1) + 4 * fq) = hsw[1]; \
                     if (fq == 0) HSS[grow * 32 + h * 8 + sl * 2 + wh] = hsp; } } while (0)
    DBG_BEGIN(8);
    for (int c = 0; c < nch; ++c) {
        if (c + 1 < nch) ML_ISSUE(c + 1);
        if (c > 0) ML_FLUSH(c - 1);
        const LAS unsigned char* cbr = lds + ML_CB + (c & 1) * ML_CBSZ; LAS unsigned char* cbw = lds + ML_CB + ((c + 1) & 1) * ML_CBSZ;
        const LAS unsigned char* tl = lds + (c & 1) * ML_SET; const LAS float* SC = (const LAS float*)(tl + ML_SC);
        DBG_BEGIN(4);
        bf16x8 qf[4];
#pragma unroll
        for (int ks = 0; ks < 4; ++ks) qf[ks] = ldsfrag(tl + ML_QS + t * 272 + ks * 64 + fq * 16);
        { bf16x8 kf[2][4];
#pragma unroll
          for (int i = 0; i < 2; ++i)
#pragma unroll
              for (int ks = 0; ks < 4; ++ks) kf[i][ks] = ldsfrag(tl + ML_KS + (16 * (2 * wh + i) + fr) * 272 + ks * 64 + fq * 16);
          const float mmt = SC[SC_MM + t]; f32x4 a4[2];
#pragma unroll
          for (int i = 0; i < 2; ++i) a4[i] = *(const LAS f32x4*)(SC + SC_A + 16 * (2 * wh + i) + 4 * fq);
          f32x4 g[2] = {(f32x4){0.f, 0.f, 0.f, 0.f}, (f32x4){0.f, 0.f, 0.f, 0.f}};
#pragma unroll
          for (int ks = 0; ks < 4; ++ks)
#pragma unroll
              for (int i = 0; i < 2; ++i) g[i] = mfma16(kf[i][ks], qf[ks], g[i]);
#pragma unroll
          for (int i = 0; i < 2; ++i) { const int s0 = 16 * (2 * wh + i) + 4 * fq; float v[4];
#pragma unroll
              for (int r = 0; r < 4; ++r) v[r] = (s0 + r <= t) ? g[i][r] * __expf(a4[i][r] - mmt) : 0.f;
              u32x2 w; w.x = cvtpk_n(v[0], v[1]); w.y = cvtpk_n(v[2], v[3]); *(LAS u32x2*)(lds + ML_SS + t * 144 + s0 * 2) = w; } }
        DBG_END(4);
        LBAR();
        DBG_BEGIN(5);
        { bf16x8 sf[2], vf[3][2], cf[3][4];
#pragma unroll
          for (int ks = 0; ks < 2; ++ks) sf[ks] = ldsfrag(lds + ML_SS + t * 144 + ks * 64 + fq * 16);
#pragma unroll
          for (int i = 0; i < 3; ++i) { const int vb = (i == 2) ? 4 : 2 * wh + i;
#pragma unroll
              for (int ks = 0; ks < 2; ++ks) vf[i][ks] = trfrag(tl + ML_VS, 176, 32 * ks, 16 * vb, lane);
#pragma unroll
              for (int ks = 0; ks < 4; ++ks) cf[i][ks] = ldsfrag(cbr + (16 * vb + fr) * 272 + ks * 64 + fq * 16); }
          const float git = SC[SC_GI + t], ent = SC[SC_EN + t];
          f32x4 ai[3], ae[3];
#pragma unroll
          for (int i = 0; i < 3; ++i) { ai[i] = (f32x4){0.f, 0.f, 0.f, 0.f}; ae[i] = (f32x4){0.f, 0.f, 0.f, 0.f}; }
#pragma unroll
          for (int ks = 0; ks < 4; ++ks)
#pragma unroll
              for (int i = 0; i < 3; ++i) { ae[i] = mfma16(cf[i][ks], qf[ks], ae[i]); if (ks < 2) ai[i] = mfma16(vf[i][ks], sf[ks], ai[i]); }
          f32x4 hh[3];
#pragma unroll
          for (int i = 0; i < 3; ++i) hh[i] = ai[i] + ae[i] * git;
          const float den = __shfl(hh[2][0], fr);
          const float isc = 1.0f / fmaxf(fabsf(den), ent); float p = 0.f;
#pragma unroll
          for (int i = 0; i < 2; ++i) { const f32x4 o = hh[i] * isc; p += (o[0] * o[0] + o[1] * o[1]) + (o[2] * o[2] + o[3] * o[3]);
              hsw[i].x = cvtpk_n(o[0], o[1]); hsw[i].y = cvtpk_n(o[2], o[3]); }
          p += __shfl_xor(p, 16); p += __shfl_xor(p, 32); hsp = p; }
        DBG_END(5); DBG_BEGIN(6);
        { const float decay = SC[SC_MISC];
          bf16x8 kw[2], vf[5][2];
#pragma unroll
          for (int vb = 0; vb < 5; ++vb)
#pragma unroll
              for (int ks = 0; ks < 2; ++ks) vf[vb][ks] = trfrag(tl + ML_VS, 176, 32 * ks, 16 * vb, lane);
#pragma unroll
          for (int ks = 0; ks < 2; ++ks) { const v4u kr = __builtin_bit_cast(v4u, trfrag(tl + ML_KS, 272, 32 * ks, 16 * wave, lane));
              const f32x4 w0 = *(const LAS f32x4*)(SC + SC_WS + 32 * ks + 8 * fq), w1 = *(const LAS f32x4*)(SC + SC_WS + 32 * ks + 8 * fq + 4);
              v4u o; o.x = cvtpk_n(bflo(kr.x) * w0[0], bfhi(kr.x) * w0[1]); o.y = cvtpk_n(bflo(kr.y) * w0[2], bfhi(kr.y) * w0[3]); o.z = cvtpk_n(bflo(kr.z) * w1[0], bfhi(kr.z) * w1[1]); o.w = cvtpk_n(bflo(kr.w) * w1[2], bfhi(kr.w) * w1[3]);
              kw[ks] = __builtin_bit_cast(bf16x8, o); }
#pragma unroll
          for (int vb = 0; vb < 5; ++vb) Cst[vb] = Cst[vb] * decay;
#pragma unroll
          for (int ks = 0; ks < 2; ++ks)
#pragma unroll
              for (int vb = 0; vb < 5; ++vb) Cst[vb] = mfma16(kw[ks], vf[vb][ks], Cst[vb]);
#pragma unroll
          for (int vb = 0; vb < 5; ++vb) { u32x2 w; w.x = cvtpk_n(Cst[vb][0], Cst[vb][1]); w.y = cvtpk_n(Cst[vb][2], Cst[vb][3]); *(LAS u32x2*)(cbw + (16 * vb + fr) * 272 + (16 * wave + 4 * fq) * 2) = w; } }
        DBG_END(6);
        DBG_BEGIN(7);
        if (c + 1 < nch) ML_COMMIT(((c + 1) & 1) * ML_SET);
        DBG_END(7);
        LBAR();
    }
    DBG_END(8); DBG_REPORT(item == 0);
    ML_FLUSH(nch - 1);
    { float* co = A.out + (sample ? O_CS : O_CP) + ((size_t)(b * NH + h) * DV + DVS * sl) * DQK;
#pragma unroll
      for (int vb = 0; vb < 4; ++vb) *(f32x4*)(co + (size_t)(16 * vb + fr) * DQK + 16 * wave + 4 * fq) = Cst[vb];
      if (sl == 0 && fr == 0) *(f32x4*)(A.out + (sample ? O_NS : O_NP) + (size_t)(b * NH + h) * DQK + 16 * wave + 4 * fq) = Cst[4]; }
    LBAR();
#undef ML_ISSUE
#undef ML_FLUSH
#undef ML_COMMIT
}

__device__ __forceinline__ float gelu_tanh(float y) { const float t = y * y, p = fmaf(t, 0.044715f, 1.0f);
    const float e = __builtin_amdgcn_exp2f(y * p * -2.302208198f); return y * __builtin_amdgcn_rcpf(1.0f + e); }
typedef float f32x2 __attribute__((ext_vector_type(2)));
__device__ __forceinline__ void s5_item(const Args& A, LAS unsigned char* slds, int lane, int role, int item) {
    DBG_DECL
    unsigned char* ws = A.ws;
    const int fr = lane & 15, fq = lane >> 4;
    const bool sample = item >= NBATCH * NG; const int ii = sample ? item - NBATCH * NG : item;
    const int b = ii / NG, g = ii % NG;
    const int T = sample ? SLEN : SEQ, row0 = sample ? MP + b * SLEN : b * SEQ;
    const bf16* U = (const bf16*)(ws + WS_U); bf16* Z = (bf16*)(ws + WS_Z);
    const float* LAM = (const float*)(ws + WS_S5P + S5P_LAM); const bf16* BBT = (const bf16*)(ws + WS_S5P + S5P_BBT); const bf16* CC = (const bf16*)(ws + WS_S5P + S5P_CC);
    const bf16x8 zf = (bf16x8){0, 0, 0, 0, 0, 0, 0, 0}; const f32x4 z4 = (f32x4){0.f, 0.f, 0.f, 0.f};
    const int nblk = T / 16;
    const bf16* ubase = U + (size_t)(row0 + fr) * 1024 + 16 * g + 8 * (fq & 1);
#define S5_LOADU(k_) (*(const bf16x8*)(ubase + (size_t)((k_) < nblk ? (k_) : nblk - 1) * 16 * 1024))
#define S5_BU(P_) ((LAS float*)(slds + (P_) * 8448))
#define S5_SB(P_) ((LAS bf16*)(slds + 16896 + (P_) * 4352))
    if (role == 0) {
        bf16x8 bbA[8];
#pragma unroll
        for (int rb = 0; rb < 8; ++rb) bbA[rb] = (fq < 2) ? *(const bf16x8*)(BBT + ((size_t)g * 128 + 16 * rb + fr) * 16 + 8 * fq) : zf;
        const float lr = LAM[(g * 64 + lane) * 2], li = LAM[(g * 64 + lane) * 2 + 1];
        float sr, si;
        if (sample) { sr = A.in[6][(size_t)(b * NG + g) * PST + lane]; si = A.in[7][(size_t)(b * NG + g) * PST + lane]; } else { sr = 0.f; si = 0.f; }
        bf16x8 ub = S5_LOADU(0), uc = S5_LOADU(1), ud = S5_LOADU(2);
#pragma unroll
        for (int rb = 0; rb < 8; ++rb) { const f32x4 d = mfma16(bbA[rb], ub, z4); *(LAS f32x4*)(S5_BU(0) + fr * 132 + 16 * rb + 4 * fq) = d; }
        LBAR();
#define S5_ITER_A(k_, P_) do { const int k = (k_); DBG_BEGIN(1); \
            f32x4 d[8]; \
            _Pragma("unroll") for (int rb = 0; rb < 8; ++rb) d[rb] = mfma16(bbA[rb], uc, z4);                                 \
            f32x2 bu[16]; { const LAS float* bc = S5_BU(P_); \
            _Pragma("unroll") for (int tt = 0; tt < 16; ++tt) bu[tt] = *(const LAS f32x2*)(bc + tt * 132 + 2 * lane); } \
            { LAS float* bn = S5_BU(1 - (P_)); \
            _Pragma("unroll") for (int rb = 0; rb < 8; ++rb) *(LAS f32x4*)(bn + fr * 132 + 16 * rb + 4 * fq) = d[rb]; } \
            { LAS bf16* sbc = S5_SB(P_); \
            f32x2 s2 = (f32x2){sr, si}; const f32x2 lr2 = (f32x2){lr, lr}, li2 = (f32x2){-li, li}; \
            _Pragma("unroll") for (int tt = 0; tt < 16; ++tt) { const f32x2 sw = __builtin_shufflevector(s2, s2, 1, 0); s2 = lr2 * s2 + (li2 * sw + bu[tt]);     \
                *(LAS unsigned*)(sbc + tt * 136 + 2 * lane) = cvtpk_n(s2[0], s2[1]); } sr = s2[0]; si = s2[1]; }                \
            uc = ud; ud = S5_LOADU(k + 3); DBG_END(1); \
            LBAR(); } while (0)
        DBG_BEGIN(2);
        for (int k2 = 0; k2 + 1 < nblk; k2 += 2) { S5_ITER_A(k2, 0); S5_ITER_A(k2 + 1, 1); }
        if (nblk & 1) S5_ITER_A(nblk - 1, 0);
        DBG_END(2); DBG_REPORT(!sample && item == 0);
#undef S5_ITER_A
        float* so = A.out + (sample ? O_SRS : O_SRP) + (size_t)(b * NG + g) * PST; float* io = A.out + (sample ? O_SIS : O_SIP) + (size_t)(b * NG + g) * PST;
        so[lane] = sr; io[lane] = si;
    } else {
        bf16x8 ccA[4], dA;
#pragma unroll
        for (int ks = 0; ks < 4; ++ks) ccA[ks] = *(const bf16x8*)(CC + ((size_t)g * 16 + fr) * 128 + 32 * ks + 8 * fq);
        { const short dv = (short)f2bf(A.in[22][g * 16 + fr]); dA = zf;
#pragma unroll
          for (int j = 0; j < 8; ++j) dA[j] = (fq < 2 && 8 * fq + j == fr) ? dv : (short)0; }
        bf16x8 ua = S5_LOADU(0), ub = S5_LOADU(0), uc = S5_LOADU(1);
        LBAR();
#define S5_Y(km1_, P_) do { const LAS bf16* sbp = S5_SB(P_); f32x4 y = z4; \
            _Pragma("unroll") for (int ks = 0; ks < 4; ++ks) y = mfma16(ccA[ks], *(const LAS bf16x8*)(sbp + fr * 136 + 32 * ks + 8 * fq), y); \
            y = mfma16(dA, ua, y); \
            u32x2 w; w.x = cvtpk_n(gelu_tanh(y[0]), gelu_tanh(y[1])); w.y = cvtpk_n(gelu_tanh(y[2]), gelu_tanh(y[3])); \
            *(GAS u32x2*)(Z + ((size_t)row0 + 16 * (km1_) + fr) * 1024 + 16 * g + 4 * fq) = w; } while (0)
#define S5_ITER_B(k_, P_) do { const int k = (k_); DBG_BEGIN(3); if (k >= 1) S5_Y(k - 1, 1 - (P_)); ua = ub; ub = uc; uc = S5_LOADU(k + 2); DBG_END(3); LBAR(); } while (0)
        for (int k2 = 0; k2 + 1 < nblk; k2 += 2) { S5_ITER_B(k2, 0); S5_ITER_B(k2 + 1, 1); }
        if (nblk & 1) S5_ITER_B(nblk - 1, 0);
        if ((nblk - 1) & 1) S5_Y(nblk - 1, 1); else S5_Y(nblk - 1, 0);
        DBG_REPORT(!sample && item == 0);
#undef S5_ITER_B
#undef S5_Y
    }
    LBAR();
#undef S5_BU
#undef S5_SB
#undef S5_LOADU
}

__device__ __forceinline__ void outa_rows(const Args& A, int lane, int gw, int NGW) {
    unsigned char* ws = A.ws;
    const bf16* HS = (const bf16*)(ws + WS_HS); const bf16* OG = (const bf16*)(ws + WS_OG); const float* HSS = (const float*)(ws + WS_HSS); bf16* MIXIN = (bf16*)(ws + WS_MIXIN);
    f32x4 gm[2][2];
#pragma unroll
    for (int i = 0; i < 2; ++i) { gm[i][0] = *(const f32x4*)(A.in[14] + 512 * i + 8 * lane); gm[i][1] = *(const f32x4*)(A.in[14] + 512 * i + 8 * lane + 4); }
    for (int m = gw; m < MT; m += NGW) {
        f32x4 p0[2], p1[2]; v4u hv[2], ov[2];
#pragma unroll
        for (int i = 0; i < 2; ++i) { const int col = 512 * i + 8 * lane, hh = col >> 8;
            p0[i] = *(const GAS f32x4*)(HSS + (size_t)m * 32 + hh * 8); p1[i] = *(const GAS f32x4*)(HSS + (size_t)m * 32 + hh * 8 + 4);
            hv[i] = *(const GAS v4u*)(HS + (size_t)m * 1024 + col); ov[i] = *(const GAS v4u*)(OG + (size_t)m * 1024 + col); }
        v4u o[2];
#pragma unroll
        for (int i = 0; i < 2; ++i) {
            const float ss = (p0[i][0] + p0[i][1]) + (p0[i][2] + p0[i][3]) + (p1[i][0] + p1[i][1]) + (p1[i][2] + p1[i][3]);
            const float rstd = 1.0f / sqrtf(ss * (1.0f / DV) + EPS);
            o[i].x = cvtpk(bflo(hv[i].x) * rstd * gm[i][0][0] * sigmoidf_(bflo(ov[i].x)), bfhi(hv[i].x) * rstd * gm[i][0][1] * sigmoidf_(bfhi(ov[i].x)));
            o[i].y = cvtpk(bflo(hv[i].y) * rstd * gm[i][0][2] * sigmoidf_(bflo(ov[i].y)), bfhi(hv[i].y) * rstd * gm[i][0][3] * sigmoidf_(bfhi(ov[i].y)));
            o[i].z = cvtpk(bflo(hv[i].z) * rstd * gm[i][1][0] * sigmoidf_(bflo(ov[i].z)), bfhi(hv[i].z) * rstd * gm[i][1][1] * sigmoidf_(bfhi(ov[i].z)));
            o[i].w = cvtpk(bflo(hv[i].w) * rstd * gm[i][1][2] * sigmoidf_(bflo(ov[i].w)), bfhi(hv[i].w) * rstd * gm[i][1][3] * sigmoidf_(bfhi(ov[i].w))); }
#pragma unroll
        for (int i = 0; i < 2; ++i) *(GAS v4u*)(MIXIN + (size_t)m * 2048 + 512 * i + 8 * lane) = o[i];
    }
}
__device__ __forceinline__ float row_ss_part(const float* SSp, const float* SSs, int m, int lane) {
    if (m < MP) return (lane < 32) ? SSp[(size_t)m * 32 + lane] : 0.f;
    return SSs[(size_t)(m - MP) * 128 + lane] + SSs[(size_t)(m - MP) * 128 + 64 + lane];
}
__device__ __forceinline__ void rowpass1(const Args& A, int lane, int gw, int NGW) {
    unsigned char* ws = A.ws;
    const bf16* MIX = (const bf16*)(ws + WS_MIX); bf16* X1B = (bf16*)(ws + WS_X1B); float* RSTD2 = (float*)(ws + WS_SSS + SSS_RSTD2);
    const float* SSp = (const float*)(ws + WS_SS1); const float* SSs = (const float*)(ws + WS_SSS + SSS_1);
    const float* RSTD1 = (const float*)(ws + WS_SSS + SSS_RSTD1);
    f32x4 g1[8], gi[8];
#pragma unroll
    for (int j = 0; j < 8; ++j) { g1[j] = *(const f32x4*)(A.in[26] + 256 * j + 4 * lane); const f32x4 g0 = *(const f32x4*)(A.in[8] + 256 * j + 4 * lane);
        gi[j] = (f32x4){1.0f / g0[0], 1.0f / g0[1], 1.0f / g0[2], 1.0f / g0[3]}; }
    u32x2 va[8], vb[8], ma[8], mb[8]; float sa = 0.f, sb = 0.f, ra = 0.f, rb = 0.f;
#define RP1_LOAD(V, M, S, R, m_) do { const int mm_ = (m_); \
        S = row_ss_part(SSp, SSs, mm_, lane); R = RSTD1[mm_]; \
        _Pragma("unroll") for (int j = 0; j < 8; ++j) { const int k = 256 * j + 4 * lane; V[j] = *(const GAS u32x2*)(X1B + (size_t)mm_ * DM + k); M[j] = *(const GAS u32x2*)(MIX + (size_t)mm_ * DM + k); } } while (0)
#define RP1_PROC(V, M, S, R, m_) do { const int mm_ = (m_); \
        const float rstd1 = 1.0f / sqrtf(wave_sum(S) * (1.0f / DM) + EPS); float s = 0.f; f32x4 O[8]; \
        _Pragma("unroll") for (int j = 0; j < 8; ++j) { f32x4 o; o[0] = bflo(V[j].x) * R * gi[j][0] + bflo(M[j].x) * rstd1 * g1[j][0]; o[1] = bfhi(V[j].x) * R * gi[j][1] + bfhi(M[j].x) * rstd1 * g1[j][1]; \
            o[2] = bflo(V[j].y) * R * gi[j][2] + bflo(M[j].y) * rstd1 * g1[j][2]; o[3] = bfhi(V[j].y) * R * gi[j][3] + bfhi(M[j].y) * rstd1 * g1[j][3]; \
            s += (o[0] * o[0] + o[1] * o[1]) + (o[2] * o[2] + o[3] * o[3]); O[j] = o; } \
        const float ms2 = wave_sum(s) * (1.0f / DM) + EPS, rstd2 = 1.0f / sqrtf(ms2); \
        _Pragma("unroll") for (int j = 0; j < 8; ++j) { u32x2 o; o.x = cvtpk(O[j][0] * rstd2, O[j][1] * rstd2); o.y = cvtpk(O[j][2] * rstd2, O[j][3] * rstd2); \
            *(GAS u32x2*)(X1B + (size_t)mm_ * DM + 256 * j + 4 * lane) = o; } \
        if (lane == 0) RSTD2[mm_] = sqrtf(ms2); } while (0)
    int m = gw;
    if (m < MT) { RP1_LOAD(va, ma, sa, ra, m);
        for (;;) { const int m2 = m + NGW; if (m2 < MT) RP1_LOAD(vb, mb, sb, rb, m2); RP1_PROC(va, ma, sa, ra, m); if (m2 >= MT) break;
                   m = m2 + NGW; if (m < MT) RP1_LOAD(va, ma, sa, ra, m); RP1_PROC(vb, mb, sb, rb, m2); if (m >= MT) break; } }
#undef RP1_LOAD
#undef RP1_PROC
}
__device__ __forceinline__ void rowpass2(const Args& A, int lane, int gw, int NGW) {
    unsigned char* ws = A.ws;
    const bf16* FF = (const bf16*)(ws + WS_FF); const bf16* X1B = (const bf16*)(ws + WS_X1B);
    const float* SSp = (const float*)(ws + WS_SS2); const float* SSs = (const float*)(ws + WS_SSS + SSS_2);
    f32x4 g3[8];
#pragma unroll
    for (int j = 0; j < 8; ++j) g3[j] = *(const f32x4*)(A.in[31] + 256 * j + 4 * lane);
    u32x2 xa[8], xb[8], fa[8], fb[8]; float sa = 0.f, sb = 0.f;
    const float* RSTD2 = (const float*)(ws + WS_SSS + SSS_RSTD2); float ra = 0.f, rb = 0.f;
#define RP2_LOAD(X, F, S, R, m_) do { const int mm_ = (m_); S = row_ss_part(SSp, SSs, mm_, lane); R = RSTD2[mm_]; \
        _Pragma("unroll") for (int j = 0; j < 8; ++j) { const int k = 256 * j + 4 * lane; X[j] = *(const GAS u32x2*)(X1B + (size_t)mm_ * DM + k); F[j] = *(const GAS u32x2*)(FF + (size_t)mm_ * DM + k); } } while (0)
#define RP2_PROC(X, F, S, R, m_) do { const int mm_ = (m_); float* orow = A.out + O_Y + (size_t)mm_ * DM; const float rstd = 1.0f / sqrtf(wave_sum(S) * (1.0f / DM) + EPS); f32x4 V[8]; \
        _Pragma("unroll") for (int j = 0; j < 8; ++j) { V[j][0] = bflo(X[j].x) * R + bflo(F[j].x) * rstd * g3[j][0]; V[j][1] = bfhi(X[j].x) * R + bfhi(F[j].x) * rstd * g3[j][1]; V[j][2] = bflo(X[j].y) * R + bflo(F[j].y) * rstd * g3[j][2]; V[j][3] = bfhi(X[j].y) * R + bfhi(F[j].y) * rstd * g3[j][3]; } \
        DBG_PERTURB(V, mm_); \
        _Pragma("unroll") for (int j = 0; j < 8; ++j) __builtin_nontemporal_store(V[j], (GAS f32x4*)(orow + 256 * j + 4 * lane)); } while (0)
    int m = gw;
    if (m < MT) { RP2_LOAD(xa, fa, sa, ra, m);
        for (;;) { const int m2 = m + NGW; if (m2 < MT) RP2_LOAD(xb, fb, sb, rb, m2); RP2_PROC(xa, fa, sa, ra, m); if (m2 >= MT) break;
                   m = m2 + NGW; if (m < MT) RP2_LOAD(xa, fa, sa, ra, m); RP2_PROC(xb, fb, sb, rb, m2); if (m >= MT) break; } }
#undef RP2_LOAD
#undef RP2_PROC
}
#ifndef MK_WGM_P5
#define MK_WGM_P5 4
#endif
#ifndef MK_WGM_P1
#define MK_WGM_P1 2
#endif
#ifndef MK_WGM_P7
#define MK_WGM_P7 4
#endif
#ifndef MK_WGM_P8
#define MK_WGM_P8 1
#endif
#ifndef MK_GU_ALIGN
#define MK_GU_ALIGN true
#endif
#ifndef MK_GU_SP2
#define MK_GU_SP2 true
#endif
__global__ void __launch_bounds__(NWAVES * 64, 2) hymba_fwd(Args args) {
    extern __shared__ __attribute__((aligned(16))) unsigned char lds_raw[];
    LAS unsigned char* lds = (LAS unsigned char*)lds_raw;
    volatile LAS unsigned* MISC = (volatile LAS unsigned*)(lds + MISC_OFF);
    const int tid = threadIdx.x, lane = tid & 63, wave = __builtin_amdgcn_readfirstlane(tid >> 6);
    const int G = gridDim.x; const int bx = blockIdx.x; const int vcu = (G % 8 == 0) ? (bx % 8) * (G / 8) + bx / 8 : bx;
    unsigned char* ws = args.ws;
    gu32* ctl = (gu32*)(ws + WS_CTL);
    for (int u = tid; u < (LDS_BYTES - LDSCTL_OFF) / 4; u += NWAVES * 64) ((LAS unsigned*)(lds + LDSCTL_OFF))[u] = 0u;
    __syncthreads();
    const XcdBarrier bar = xcd_barrier_post((unsigned*)(ctl + CW_BAR) + args.li * XCD_BAR_WORDS, MISC + 8);
#define GRID_BAR() xcd_barrier(bar)
    const int lo = args.ph_lo, hi = args.ph_hi;
#define IN(k) (lo <= (k) && (k) < hi)
#define BOTH(k) (IN(k) && IN((k) + 1))

    const int gw = vcu * NWAVES + wave, NGW = G * NWAVES;

    if (IN(0)) { p0_prologue(args, lds, tid, lane, wave, vcu, G); if (BOTH(0)) GRID_BAR(); }

    if (IN(1)) {
        { pg8::Gemm g{(const bf16*)(ws + WS_XN), (const bf16*)(ws + WS_WIN), MP, 4096, DM}; pg8::StaticOrder S; S.init(MP, 4096, G, bx, MK_WGM_P1);
          pg8::EpiBf16<0> E{(bf16*)(ws + WS_QKRAW), 1024, nullptr, 1024, (size_t)WS_RSTRIDE / 2, 1.f};
          pg8::gemm_phase<pg8::EpiBf16<0>, pg8::StaticOrder, true, true>(lds + RING_OFF, g, S, E); }
        { bf16* O = (bf16*)(ws + WS_QKRAW);
          skinny_gemm<1, DM>((const bf16*)(ws + WS_XN) + (size_t)MP * DM, (const bf16*)(ws + WS_WIN), lds, 4096 / 16, vcu, G, tid, wave, lane,
              [](int it, int a, int fr) { return 16 * it + fr; },
              [O](int it, int row, int fq, const f32x4 (&acc)[1]) { const int col = 16 * it + 4 * fq, t = col >> 10;
                  u32x2 w; w.x = cvtpk_n(acc[0][0], acc[0][1]); w.y = cvtpk_n(acc[0][2], acc[0][3]);
                  *(GAS u32x2*)(O + (size_t)t * (WS_RSTRIDE / 2) + (size_t)(MP + row) * 1024 + (col & 1023)) = w; }); }
        if (BOTH(1)) GRID_BAR();
    }

    if (IN(2)) { if (vcu < 64) p2_scalars(args, lds, lane, wave, vcu); p2_conv(args, tid, vcu, G); if (BOTH(2)) GRID_BAR(); }

    if (IN(3)) {
        const int half = G / 2;
#ifndef MK_REP_M
#define MK_REP_M 1
#endif
#ifndef MK_REP_S
#define MK_REP_S 1
#endif
        if (vcu < half) { for (int rp_ = 0; rp_ < MK_REP_M; ++rp_) for (int it = vcu; it < NBATCH * NH * NSL; it += half) mlstm_item(args, lds, tid, lane, wave, it); }
        else { const int nb = G - half, bi = vcu - half;
               for (int rp_ = 0; rp_ < MK_REP_S; ++rp_)
               for (int it = bi * 4 + (wave & 3); it < 2 * NBATCH * NG; it += nb * 4) s5_item(args, lds + (wave & 3) * 25600, lane, wave >> 2, it); }
        if (vcu >= half) { __syncthreads(); for (int it = NBATCH * NH * NSL + (vcu - half); it < 2 * NBATCH * NH * NSL; it += G - half) mlstm_item(args, lds, tid, lane, wave, it); }
        if (BOTH(3)) GRID_BAR();
    }

    if (IN(4)) {
        { pg8::Gemm g{(const bf16*)(ws + WS_Z), (const bf16*)(ws + WS_WGLU), MP, 1024, 1024}; pg8::StaticOrder S; S.init(MP, 1024, G, bx);
          pg8::EpiGlu E{(const bf16*)(ws + WS_Z), (bf16*)(ws + WS_MIXIN), args.in[24]};
          pg8::gemm_phase<pg8::EpiGlu, pg8::StaticOrder, true, true>(lds + RING_OFF, g, S, E); }
        { const bf16* Zb = (const bf16*)(ws + WS_Z); bf16* O = (bf16*)(ws + WS_MIXIN); const float* bias = args.in[24];
          skinny_gemm<1, 1024>(Zb + (size_t)MP * 1024, (const bf16*)(ws + WS_WGLU), lds, 1024 / 16, vcu, G, tid, wave, lane,
              [](int it, int a, int fr) { return 16 * it + fr; },
              [Zb, O, bias](int it, int row, int fq, const f32x4 (&acc)[1]) { const int col = 16 * it + 4 * fq; const size_t m = (size_t)(MP + row);
                  const u32x2 z = *(const GAS u32x2*)(Zb + m * 1024 + col); const f32x4 bv = *(const f32x4*)(bias + col);
                  u32x2 w; w.x = cvtpk(bflo(z.x) * sigmoidf_(acc[0][0] + bv[0]), bfhi(z.x) * sigmoidf_(acc[0][1] + bv[1]));
                  w.y = cvtpk(bflo(z.y) * sigmoidf_(acc[0][2] + bv[2]), bfhi(z.y) * sigmoidf_(acc[0][3] + bv[3]));
                  *(GAS u32x2*)(O + m * 2048 + 1024 + col) = w; }); }
        outa_rows(args, lane, gw, NGW);
        if (BOTH(4)) GRID_BAR();
    }

    if (IN(5)) {
        { pg8::Gemm g{(const bf16*)(ws + WS_MIXIN), (const bf16*)(ws + WS_WOUT), MP, DM, DM}; pg8::StaticOrder S; S.init(MP, DM, G, bx, MK_WGM_P5);
          pg8::EpiSS E{(bf16*)(ws + WS_MIX), DM, (float*)(ws + WS_SS1)};
          pg8::gemm_phase<pg8::EpiSS, pg8::StaticOrder, true, true>(lds + RING_OFF, g, S, E); }
        { bf16* O = (bf16*)(ws + WS_MIX); float* SSs = (float*)(ws + WS_SSS + SSS_1);
          skinny_gemm<1, DM>((const bf16*)(ws + WS_MIXIN) + (size_t)MP * DM, (const bf16*)(ws + WS_WOUT), lds, DM / 16, vcu, G, tid, wave, lane,
              [](int it, int a, int fr) { return 16 * it + fr; },
              [O, SSs](int it, int row, int fq, const f32x4 (&acc)[1]) { const int col = 16 * it + 4 * fq;
                  u32x2 w; w.x = cvtpk_n(acc[0][0], acc[0][1]); w.y = cvtpk_n(acc[0][2], acc[0][3]);
                  *(GAS u32x2*)(O + (size_t)(MP + row) * DM + col) = w;
                  float s = (acc[0][0] * acc[0][0] + acc[0][1] * acc[0][1]) + (acc[0][2] * acc[0][2] + acc[0][3] * acc[0][3]);
                  s += __shfl_xor(s, 16); s += __shfl_xor(s, 32);
                  if (fq == 0) SSs[(size_t)row * 128 + it] = s; }); }
        if (BOTH(5)) GRID_BAR();
    }

    if (IN(6)) { rowpass1(args, lane, gw, NGW); if (BOTH(6)) GRID_BAR(); }

    if (IN(7)) {
        { pg8::Gemm g{(const bf16*)(ws + WS_X1B), (const bf16*)(ws + WS_WGU), MP, 2 * DFF, DM}; pg8::StaticOrder S; S.init(MP, 2 * DFF, G, bx, MK_WGM_P7);
          pg8::EpiGU E{(bf16*)(ws + WS_ACT), DFF};
          pg8::gemm_phase<pg8::EpiGU, pg8::StaticOrder, MK_GU_ALIGN, MK_GU_SP2>(lds + RING_OFF, g, S, E); }
        { bf16* O = (bf16*)(ws + WS_ACT);
          skinny_gemm<2, DM>((const bf16*)(ws + WS_X1B) + (size_t)MP * DM, (const bf16*)(ws + WS_WGU), lds, DFF / 16, vcu, G, tid, wave, lane,
              [](int it, int a, int fr) { const int j = 16 * it + fr; return 256 * (j >> 7) + 128 * a + (j & 127); },
              [O](int it, int row, int fq, const f32x4 (&acc)[2]) { const int col = 16 * it + 4 * fq; const f32x4 g = acc[0], up = acc[1];
                  u32x2 w; w.x = cvtpk(g[0] * sigmoidf_(g[0]) * up[0], g[1] * sigmoidf_(g[1]) * up[1]);
                  w.y = cvtpk(g[2] * sigmoidf_(g[2]) * up[2], g[3] * sigmoidf_(g[3]) * up[3]);
                  *(GAS u32x2*)(O + (size_t)(MP + row) * DFF + col) = w; }); }
        if (BOTH(7)) GRID_BAR();
    }

    if (IN(8)) {
        { pg8::Gemm g{(const bf16*)(ws + WS_ACT), (const bf16*)(ws + WS_WD), MP, DM, DFF}; pg8::StaticOrder S; S.init(MP, DM, G, bx, MK_WGM_P8);
          pg8::EpiSS E{(bf16*)(ws + WS_FF), DM, (float*)(ws + WS_SS2)};
          pg8::gemm_phase<pg8::EpiSS, pg8::StaticOrder, true, true>(lds + RING_OFF, g, S, E); }
        { bf16* O = (bf16*)(ws + WS_FF); float* SSs = (float*)(ws + WS_SSS + SSS_2);
          skinny_gemm<1, DFF>((const bf16*)(ws + WS_ACT) + (size_t)MP * DFF, (const bf16*)(ws + WS_WD), lds, DM / 16, vcu, G, tid, wave, lane,
              [](int it, int a, int fr) { return 16 * it + fr; },
              [O, SSs](int it, int row, int fq, const f32x4 (&acc)[1]) { const int col = 16 * it + 4 * fq;
                  u32x2 w; w.x = cvtpk_n(acc[0][0], acc[0][1]); w.y = cvtpk_n(acc[0][2], acc[0][3]);
                  *(GAS u32x2*)(O + (size_t)(MP + row) * DM + col) = w;
                  float s = (acc[0][0] * acc[0][0] + acc[0][1] * acc[0][1]) + (acc[0][2] * acc[0][2] + acc[0][3] * acc[0][3]);
                  s += __shfl_xor(s, 16); s += __shfl_xor(s, 32);
                  if (fq == 0) SSs[(size_t)row * 128 + it] = s; }); }
        if (BOTH(8)) GRID_BAR();
    }

    if (IN(9)) { rowpass2(args, lane, gw, NGW); }
#undef IN
#undef BOTH
}

#ifdef MK_DUMP_OFF
__global__ void dump_kernel(const unsigned short* src, float* dst, size_t n) {
    for (size_t i = (size_t)blockIdx.x * blockDim.x + threadIdx.x; i < n; i += (size_t)gridDim.x * blockDim.x) dst[i] = __uint_as_float((unsigned)src[i] << 16);
}
#endif
extern "C" void kernel_launch(void* const* d_in, const int* in_sizes, int n_in, void* d_out, int out_size, void* d_ws, size_t ws_size, hipStream_t stream) {
    static int grid = 0;
    if (grid == 0) {
        if (n_in != 32 || out_size != (int)O_END || ws_size < WS_END) { fprintf(stderr, "kernel_launch: unexpected problem: n_in %d out %d ws %zu\n", n_in, out_size, ws_size); grid = -1; return; }
        int dev = 0, cus = 0, per_cu = 0;
        if (hipGetDevice(&dev) != hipSuccess || hipDeviceGetAttribute(&cus, hipDeviceAttributeMultiprocessorCount, dev) != hipSuccess) { grid = -1; return; }
        if (hipFuncSetAttribute((const void*)hymba_fwd, hipFuncAttributeMaxDynamicSharedMemorySize, LDS_BYTES) != hipSuccess) { fprintf(stderr, "kernel_launch: hipFuncSetAttribute failed\n"); grid = -1; return; }
        if (hipOccupancyMaxActiveBlocksPerMultiprocessor(&per_cu, (const void*)hymba_fwd, NWAVES * 64, LDS_BYTES) != hipSuccess || per_cu < 1) { fprintf(stderr, "kernel_launch: occupancy query reports %d\n", per_cu); per_cu = 1; }
        (void)hipGetLastError();
        grid = cus;
    }
    if (grid < 0) return;
    Args a{};
    for (int i = 0; i < 32; ++i) a.in[i] = (const float*)d_in[i];
    a.out = (float*)d_out; a.ws = (unsigned char*)d_ws;
    int lo[N_PHASES + 2], hi[N_PHASES + 2], nl = 0;
#if defined(MK_REPEAT)
    lo[0] = 0; hi[0] = MK_REPEAT + 1; lo[1] = MK_REPEAT; hi[1] = MK_REPEAT + 1; lo[2] = MK_REPEAT + 1; hi[2] = N_PHASES; nl = 3;
#else
    if (N_LAUNCHES == 1) { lo[0] = 0; hi[0] = N_PHASES; nl = 1; } else { for (int k = 0; k < N_PHASES; ++k) { lo[k] = k; hi[k] = k + 1; } nl = N_PHASES; }
#endif
    if (hipMemsetAsync((char*)d_ws + WS_CTL, 0, (size_t)(CW_BAR + nl * XCD_BAR_WORDS) * 4, stream) != hipSuccess) return;
    for (int li = 0; li < nl; ++li) {
        a.ph_lo = lo[li]; a.ph_hi = hi[li]; a.li = li;
        hipLaunchKernelGGL(hymba_fwd, dim3(grid), dim3(NWAVES * 64), LDS_BYTES, stream, a);
    }
#ifdef MK_DUMP_OFF
    hipLaunchKernelGGL(dump_kernel, dim3(2048), dim3(256), 0, stream, (const unsigned short*)((const unsigned char*)d_ws + (size_t)(MK_DUMP_OFF) * MiB), (float*)d_out, (size_t)(MK_DUMP_N));
#endif
}
```

```cpp
#define MK_N_LAUNCHES 1
#include <hip/hip_runtime.h>
#include <cstdio>
#include <cstdint>
#include <cmath>
namespace pg8 {
#define PG8_LAS __attribute__((address_space(3)))
typedef unsigned short bf16_t;
typedef short bf16x8 __attribute__((ext_vector_type(8)));
typedef float f32x4 __attribute__((ext_vector_type(4)));
typedef unsigned u32x4 __attribute__((ext_vector_type(4)));
constexpr int BM = 256, BK = 64, HALF = 128, HTB = HALF * BK * 2  , STAGE_BYTES = 8 * HTB, NXCD = 8, WGM = 4;

__host__ __device__ __forceinline__ int lds_byte(int r, int c) { const int st = (r >> 4) * 2 + (c >> 5), rr = r & 15, cc = c & 31, ob = rr * 64 + cc * 2; return st * 1024 + (ob ^ (((ob >> 9) & 1) << 5)); }
__host__ __device__ __forceinline__ void stage_rc(int b, int& R, int& C) { const int st = b / 1024, sb = b % 1024, swz = sb ^ (((sb >> 9) & 1) << 5); R = (st >> 1) * 16 + swz / 64; C = (st & 1) * 32 + (swz % 64) / 2; }
__host__ __device__ __forceinline__ int perm32(int rho) { const int n = rho >> 4, i = rho & 15; return 8 * (i >> 2) + 4 * n + (i & 3); }

struct Unit { int pm, pn; };
struct Gemm { const bf16_t* A; const bf16_t* Bt; int M, N, K; };

struct StaticOrder {
    int nM, nN, nwg, G, c, wgm;
    __host__ __device__ void init(int M, int N, int G_, int c_, int wgm_ = WGM) { nM = M / BM; nN = N / BM; nwg = nM * nN; G = G_; c = c_; wgm = wgm_; }
    __host__ __device__ bool next(int i, Unit& u) const {
        const long L = (long)i * G + c; if (L >= nwg) return false;
        int wgid = (int)L; { const int q = nwg / NXCD, r = nwg % NXCD, xcd = wgid % NXCD, off = wgid / NXCD; wgid = (xcd < r ? xcd * (q + 1) : r * (q + 1) + (xcd - r) * q) + off; }
        const int nig = wgm * nN, gid = wgid / nig, fm = gid * wgm, gsz = (nM - fm) < wgm ? (nM - fm) : wgm;
        u.pm = fm + ((wgid % nig) % gsz); u.pn = (wgid % nig) / gsz; return true;
    }
    __device__ __forceinline__ void a_ready(const Unit&) const {}
    __device__ __forceinline__ void done(const Unit&) const {}
};

__device__ __forceinline__ unsigned cvt_pk_bf16(float lo, float hi) { unsigned r; asm volatile("v_cvt_pk_bf16_f32 %0, %1, %2" : "=v"(r) : "v"(lo), "v"(hi)); return r; }
typedef float f32x2 __attribute__((ext_vector_type(2)));
__device__ __forceinline__ f32x2 gelu_pk(f32x2 v) {
    const f32x2 av = __builtin_elementwise_abs(v), d = av * 0.2316418882f + 1.0f;
    f32x2 t; t.x = __builtin_amdgcn_rcpf(d.x); t.y = __builtin_amdgcn_rcpf(d.y);
    f32x2 q = t * 0.5307027145f + (-0.7265760135f); q = q * t + 0.7107068705f; q = q * t + (-0.142248368f); q = q * t + 0.127414796f; q = q * t;
    const f32x2 s = (v * v) * (-0.72134752044f);
    f32x2 e; e.x = __builtin_amdgcn_exp2f(s.x); e.y = __builtin_amdgcn_exp2f(s.y);
    const f32x2 m = v * (q * e), r = v - m;
    f32x2 o; o.x = v.x < 0.f ? m.x : r.x; o.y = v.y < 0.f ? m.y : r.y; return o;
}

template <int ACT  > struct EpiBf16 {
    static constexpr bool PERM = true, AFTER_DRAIN = false; static_assert(ACT == 0 || ACT == 1, "EpiBf16: ACT is 0 (none) or 1 (gelu_pk)");
    bf16_t* O; int ldc; const float* bias; int split_cols; size_t split_stride; float scale0;
    __device__ __forceinline__ void operator()(const f32x4 (&acc)[2][2][4][2], const Unit& u, int wr, int wc, int fr, int fq) const {
        const int row0 = u.pm * BM + wr * 64 + fr; int colt = u.pn * BM; bf16_t* base = O;
        float sc = 1.f; if (split_cols) { const int t = colt / split_cols; base += (size_t)t * split_stride; colt -= t * split_cols; if (t == 0) sc = scale0; }
        const int col0 = colt + wc * 32 + 8 * fq, bcol0 = u.pn * BM + wc * 32 + 8 * fq;
        f32x4 bv[2][2];
#pragma unroll
        for (int bj = 0; bj < 2; ++bj)
#pragma unroll
            for (int n = 0; n < 2; ++n) bv[bj][n] = bias ? *(const f32x4*)(bias + bcol0 + bj * HALF + 4 * n) : (f32x4){0.f, 0.f, 0.f, 0.f};
#pragma unroll
        for (int ai = 0; ai < 2; ++ai)
#pragma unroll
            for (int m = 0; m < 4; ++m) { bf16_t* rowp = base + (size_t)(row0 + ai * HALF + m * 16) * ldc + col0;
#pragma unroll
                for (int bj = 0; bj < 2; ++bj) { f32x4 v0 = acc[ai][bj][m][0] + bv[bj][0], v1 = acc[ai][bj][m][1] + bv[bj][1];
                    if (ACT == 1) { f32x2 a = gelu_pk((f32x2){v0[0], v0[1]}), b = gelu_pk((f32x2){v0[2], v0[3]}), c = gelu_pk((f32x2){v1[0], v1[1]}), d = gelu_pk((f32x2){v1[2], v1[3]});
                        v0 = (f32x4){a.x, a.y, b.x, b.y}; v1 = (f32x4){c.x, c.y, d.x, d.y}; }
                    v0 = v0 * sc; v1 = v1 * sc; u32x4 w; w.x = cvt_pk_bf16(v0[0], v0[1]); w.y = cvt_pk_bf16(v0[2], v0[3]); w.z = cvt_pk_bf16(v1[0], v1[1]); w.w = cvt_pk_bf16(v1[2], v1[3]);
                    *(u32x4*)(rowp + bj * HALF) = w; } }
    }
};
__device__ __forceinline__ float fast_sigmoid(float v) { return __builtin_amdgcn_rcpf(1.0f + __expf(-v)); }
__device__ __forceinline__ float bf_lo(unsigned w) { return __uint_as_float(w << 16); }
__device__ __forceinline__ float bf_hi(unsigned w) { return __uint_as_float(w & 0xffff0000u); }
struct EpiGlu {
    static constexpr bool PERM = true, AFTER_DRAIN = false;
    const bf16_t* Z; bf16_t* O; const float* bias;
    __device__ __forceinline__ void operator()(const f32x4 (&acc)[2][2][4][2], const Unit& u, int wr, int wc, int fr, int fq) const {
        const int row0 = u.pm * BM + wr * 64 + fr, col0 = u.pn * BM + wc * 32 + 8 * fq;
        f32x4 bv[2][2];
#pragma unroll
        for (int bj = 0; bj < 2; ++bj)
#pragma unroll
            for (int n = 0; n < 2; ++n) bv[bj][n] = *(const f32x4*)(bias + col0 + bj * HALF + 4 * n);
#pragma unroll
        for (int ai = 0; ai < 2; ++ai) {
            u32x4 z[4][2];
#pragma unroll
            for (int m = 0; m < 4; ++m)
#pragma unroll
                for (int bj = 0; bj < 2; ++bj) z[m][bj] = *(const u32x4*)(Z + (size_t)(row0 + ai * HALF + m * 16) * 1024 + col0 + bj * HALF);
#pragma unroll
            for (int m = 0; m < 4; ++m) { const size_t row = (size_t)(row0 + ai * HALF + m * 16);
#pragma unroll
                for (int bj = 0; bj < 2; ++bj) { const int col = col0 + bj * HALF; const u32x4 zz = z[m][bj];
                    const f32x4 v0 = acc[ai][bj][m][0] + bv[bj][0], v1 = acc[ai][bj][m][1] + bv[bj][1];
                    u32x4 w;
                    w.x = cvt_pk_bf16(bf_lo(zz.x) * fast_sigmoid(v0[0]), bf_hi(zz.x) * fast_sigmoid(v0[1]));
                    w.y = cvt_pk_bf16(bf_lo(zz.y) * fast_sigmoid(v0[2]), bf_hi(zz.y) * fast_sigmoid(v0[3]));
                    w.z = cvt_pk_bf16(bf_lo(zz.z) * fast_sigmoid(v1[0]), bf_hi(zz.z) * fast_sigmoid(v1[1]));
                    w.w = cvt_pk_bf16(bf_lo(zz.w) * fast_sigmoid(v1[2]), bf_hi(zz.w) * fast_sigmoid(v1[3]));
                    *(u32x4*)(O + row * 2048 + 1024 + col) = w; } } }
    }
};
struct EpiSS {
    static constexpr bool PERM = true, AFTER_DRAIN = false;
    bf16_t* O; int ldc; float* SS;
    __device__ __forceinline__ void operator()(const f32x4 (&acc)[2][2][4][2], const Unit& u, int wr, int wc, int fr, int fq) const {
        const int row0 = u.pm * BM + wr * 64 + fr, col0 = u.pn * BM + wc * 32 + 8 * fq;
        float s[2][4];
#pragma unroll
        for (int ai = 0; ai < 2; ++ai)
#pragma unroll
            for (int m = 0; m < 4; ++m) { const size_t row = (size_t)(row0 + ai * HALF + m * 16); float t = 0.f;
#pragma unroll
                for (int bj = 0; bj < 2; ++bj) { const f32x4 v0 = acc[ai][bj][m][0], v1 = acc[ai][bj][m][1];
                    t += (v0[0] * v0[0] + v0[1] * v0[1]) + (v0[2] * v0[2] + v0[3] * v0[3]) + (v1[0] * v1[0] + v1[1] * v1[1]) + (v1[2] * v1[2] + v1[3] * v1[3]);
                    u32x4 w; w.x = cvt_pk_bf16(v0[0], v0[1]); w.y = cvt_pk_bf16(v0[2], v0[3]); w.z = cvt_pk_bf16(v1[0], v1[1]); w.w = cvt_pk_bf16(v1[2], v1[3]);
                    *(u32x4*)(O + row * ldc + col0 + bj * HALF) = w; }
                s[ai][m] = t; }
#pragma unroll
        for (int ai = 0; ai < 2; ++ai)
#pragma unroll
            for (int m = 0; m < 4; ++m) s[ai][m] += __shfl_xor(s[ai][m], 16);
#pragma unroll
        for (int ai = 0; ai < 2; ++ai)
#pragma unroll
            for (int m = 0; m < 4; ++m) s[ai][m] += __shfl_xor(s[ai][m], 32);
        if (fq == 0) {
#pragma unroll
            for (int ai = 0; ai < 2; ++ai)
#pragma unroll
                for (int m = 0; m < 4; ++m) SS[(size_t)(row0 + ai * HALF + m * 16) * 32 + u.pn * 4 + wc] = s[ai][m]; }
    }
};
struct EpiGU {
    static constexpr bool PERM = true, AFTER_DRAIN = false;
    bf16_t* O; int ldc;
    static __device__ __forceinline__ unsigned swiglu_pk(f32x2 g, f32x2 u) {
        const f32x2 t = g * -1.4426950408889634f; f32x2 e; e.x = __builtin_amdgcn_exp2f(t.x); e.y = __builtin_amdgcn_exp2f(t.y);
        const f32x2 d = e + 1.0f; f32x2 s; s.x = __builtin_amdgcn_rcpf(d.x); s.y = __builtin_amdgcn_rcpf(d.y);
        const f32x2 o = (g * u) * s; return cvt_pk_bf16(o.x, o.y);
    }
    __device__ __forceinline__ void operator()(const f32x4 (&acc)[2][2][4][2], const Unit& u, int wr, int wc, int fr, int fq) const {
        const int row0 = u.pm * BM + wr * 64 + fr, col0 = u.pn * HALF + wc * 32 + 8 * fq;
#pragma unroll
        for (int ai = 0; ai < 2; ++ai)
#pragma unroll
            for (int m = 0; m < 4; ++m) { const size_t row = (size_t)(row0 + ai * HALF + m * 16);
                const f32x4 g0 = acc[ai][0][m][0], g1 = acc[ai][0][m][1], u0 = acc[ai][1][m][0], u1 = acc[ai][1][m][1];
                u32x4 w;
                w.x = swiglu_pk((f32x2){g0[0], g0[1]}, (f32x2){u0[0], u0[1]});
                w.y = swiglu_pk((f32x2){g0[2], g0[3]}, (f32x2){u0[2], u0[3]});
                w.z = swiglu_pk((f32x2){g1[0], g1[1]}, (f32x2){u1[0], u1[1]});
                w.w = swiglu_pk((f32x2){g1[2], g1[3]}, (f32x2){u1[2], u1[3]});
                *(u32x4*)(O + row * ldc + col0) = w; }
    }
};
template <class Epi, class Sched, bool ALIGN_EPI = false, bool SP2 = false>
__device__ __forceinline__ void gemm_phase(PG8_LAS unsigned char* lds, const Gemm g, const Sched& S, const Epi& E) {
    const int tid = threadIdx.x, wid = __builtin_amdgcn_readfirstlane(tid >> 6), lane = tid & 63, wr = wid >> 2, wc = wid & 3, fr = lane & 15, fq = lane >> 4;
    const int K = g.K, nt = K / BK;
    unsigned voffA[2], voffB[2];
#pragma unroll
    for (int i = 0; i < 2; ++i) { int R, C; stage_rc(tid * 16 + i * 8192, R, C); const int Rb = Epi::PERM ? ((R & ~31) + perm32(R & 31)) : R;
        voffA[i] = (unsigned)(R * K + C) * 2u; voffB[i] = (unsigned)(Rb * K + C) * 2u; }
    const size_t kstep = (size_t)(BK * 2);
    const size_t hstep = (size_t)HALF * K * 2;
    const size_t tstep = 2 * hstep;
    const unsigned ldsw = (unsigned)wid * 1024u;
    const int aoff = lds_byte(wr * 64 + fr, fq * 8), boff = lds_byte(wc * 32 + fr, fq * 8);
#define PG8_SA(b, h) (((b) * 2 + (h)) * HTB)
#define PG8_SB(b, h) ((4 + (b) * 2 + (h)) * HTB)
#define PG8_STAGE(bufoff, gbase, voff) do { _Pragma("unroll") for (int _i = 0; _i < 2; ++_i) \
        __builtin_amdgcn_global_load_lds((const unsigned*)((const char*)(gbase) + (voff)[_i]), (PG8_LAS unsigned*)(lds + (bufoff) + ldsw + _i * 8192), 16, 0, 0); } while (0)
#define PG8_LDA(dst, b, h) do { _Pragma("unroll") for (int m = 0; m < 4; ++m) _Pragma("unroll") for (int k = 0; k < 2; ++k) dst[m][k] = *(const PG8_LAS bf16x8*)(lds + PG8_SA(b, h) + aoff + m * 2048 + k * 1024); } while (0)
#define PG8_LDB(dst, b, h) do { _Pragma("unroll") for (int n = 0; n < 2; ++n) _Pragma("unroll") for (int k = 0; k < 2; ++k) dst[n][k] = *(const PG8_LAS bf16x8*)(lds + PG8_SB(b, h) + boff + n * 2048 + k * 1024); } while (0)
#define PG8_MMA(ai, bj, At, Bt) do { __builtin_amdgcn_s_setprio(1); _Pragma("unroll") for (int m = 0; m < 4; ++m) _Pragma("unroll") for (int n = 0; n < 2; ++n) _Pragma("unroll") for (int k = 0; k < 2; ++k) \
        acc[ai][bj][m][n] = __builtin_amdgcn_mfma_f32_16x16x32_bf16(Bt[n][k], At[m][k], acc[ai][bj][m][n], 0, 0, 0); __builtin_amdgcn_s_setprio(0); } while (0)
#define PG8_WAIT_V(n) asm volatile("s_waitcnt vmcnt(" #n ")" ::: "memory")
#define PG8_WAIT_L(n) asm volatile("s_waitcnt lgkmcnt(" #n ")" ::: "memory")
#define PG8_BAR __builtin_amdgcn_s_barrier()
#define PG8_SCHED __builtin_amdgcn_sched_barrier(0)
    Unit cur, nxt; int ui = 0;
    if (!S.next(0, cur)) return;
    f32x4 acc[2][2][4][2];
#pragma unroll
    for (int a = 0; a < 2; ++a)
#pragma unroll
        for (int b = 0; b < 2; ++b)
#pragma unroll
            for (int m = 0; m < 4; ++m)
#pragma unroll
                for (int n = 0; n < 2; ++n) acc[a][b][m][n] = (f32x4){0.f, 0.f, 0.f, 0.f};
    bf16x8 At[4][2], B0[2][2], B1[2][2];
    const char* cA = (const char*)g.A + (size_t)cur.pm * tstep; const char* cB = (const char*)g.Bt + (size_t)cur.pn * tstep;
    S.a_ready(cur);
    if constexpr (SP2) {
        PG8_STAGE(PG8_SB(0, 0), cB, voffB); PG8_STAGE(PG8_SB(0, 1), cB + hstep, voffB); PG8_STAGE(PG8_SA(0, 0), cA, voffA); PG8_STAGE(PG8_SA(0, 1), cA + hstep, voffA);
        if (wr == 1) PG8_BAR;
        PG8_WAIT_V(2); PG8_BAR;
        PG8_STAGE(PG8_SB(1, 0), cB + kstep, voffB); PG8_STAGE(PG8_SA(1, 0), cA + kstep, voffA); PG8_STAGE(PG8_SB(1, 1), cB + hstep + kstep, voffB);
        PG8_WAIT_V(6); PG8_BAR;
    } else {
        PG8_STAGE(PG8_SB(0, 0), cB, voffB); PG8_STAGE(PG8_SA(0, 0), cA, voffA); PG8_STAGE(PG8_SB(0, 1), cB + hstep, voffB); PG8_STAGE(PG8_SA(0, 1), cA + hstep, voffA);
        if (wr == 1) PG8_BAR;
        PG8_WAIT_V(4); PG8_BAR;
        PG8_STAGE(PG8_SB(1, 0), cB + kstep, voffB); PG8_STAGE(PG8_SA(1, 0), cA + kstep, voffA); PG8_STAGE(PG8_SB(1, 1), cB + hstep + kstep, voffB);
        PG8_WAIT_V(6); PG8_BAR;
    }
    for (;;) {
        const bool has_next = S.next(ui + 1, nxt);
        const char* nA = has_next ? (const char*)g.A + (size_t)nxt.pm * tstep : cA; const char* nB = has_next ? (const char*)g.Bt + (size_t)nxt.pn * tstep : cB;
        for (int t = 0; t < nt; t += 2) {
            const bool last = (t == nt - 2);
            const char* a1 = cA + (size_t)(t + 1) * kstep;
            const char* a2 = last ? nA : cA + (size_t)(t + 2) * kstep; const char* b2 = last ? nB : cB + (size_t)(t + 2) * kstep;
            const char* a3 = a2 + kstep; const char* b3 = b2 + kstep;
            if (last && has_next) S.a_ready(nxt);
            if constexpr (SP2) {
            PG8_LDB(B0, 0, 0); PG8_LDB(B1, 0, 1); PG8_SCHED; PG8_LDA(At, 0, 0); PG8_STAGE(PG8_SA(1, 1), a1 + hstep, voffA);
            PG8_WAIT_V(8); PG8_WAIT_L(0); PG8_BAR; PG8_MMA(0, 0, At, B0); PG8_MMA(0, 1, At, B1); PG8_BAR; PG8_SCHED;
            PG8_LDA(At, 0, 1); PG8_STAGE(PG8_SB(0, 0), b2, voffB); PG8_STAGE(PG8_SB(0, 1), b2 + hstep, voffB); PG8_STAGE(PG8_SA(0, 0), a2, voffA);
            PG8_WAIT_V(8); PG8_WAIT_L(0); PG8_BAR; PG8_MMA(1, 0, At, B0); PG8_MMA(1, 1, At, B1); PG8_BAR; PG8_SCHED;
            PG8_LDB(B0, 1, 0); PG8_LDB(B1, 1, 1); PG8_SCHED; PG8_LDA(At, 1, 0); PG8_STAGE(PG8_SA(0, 1), a2 + hstep, voffA);
            PG8_WAIT_V(8); PG8_WAIT_L(0); PG8_BAR; PG8_MMA(0, 0, At, B0); PG8_MMA(0, 1, At, B1); PG8_BAR; PG8_SCHED;
            PG8_LDA(At, 1, 1); PG8_STAGE(PG8_SB(1, 0), b3, voffB); PG8_STAGE(PG8_SB(1, 1), b3 + hstep, voffB); PG8_STAGE(PG8_SA(1, 0), a3, voffA);
            PG8_WAIT_V(8); PG8_WAIT_L(0); PG8_BAR; PG8_MMA(1, 0, At, B0); PG8_MMA(1, 1, At, B1); PG8_BAR; PG8_SCHED;
            } else {
            PG8_LDB(B0, 0, 0); PG8_SCHED; PG8_LDA(At, 0, 0); PG8_STAGE(PG8_SA(1, 1), a1 + hstep, voffA);
            PG8_WAIT_L(8); PG8_BAR; PG8_WAIT_L(0); PG8_MMA(0, 0, At, B0); PG8_BAR; PG8_SCHED;
            PG8_LDB(B1, 0, 1); PG8_STAGE(PG8_SB(0, 0), b2, voffB);
            PG8_BAR; PG8_WAIT_L(0); PG8_MMA(0, 1, At, B1); PG8_BAR;
            PG8_LDA(At, 0, 1); PG8_STAGE(PG8_SA(0, 0), a2, voffA);
            PG8_BAR; PG8_WAIT_L(0); PG8_MMA(1, 0, At, B0); PG8_BAR; PG8_SCHED;
            PG8_STAGE(PG8_SB(0, 1), b2 + hstep, voffB);
            PG8_WAIT_V(6); PG8_BAR; PG8_MMA(1, 1, At, B1); PG8_BAR;
            PG8_LDB(B0, 1, 0); PG8_SCHED; PG8_LDA(At, 1, 0); PG8_STAGE(PG8_SA(0, 1), a2 + hstep, voffA);
            PG8_WAIT_L(8); PG8_BAR; PG8_WAIT_L(0); PG8_MMA(0, 0, At, B0); PG8_BAR; PG8_SCHED;
            PG8_LDB(B1, 1, 1); PG8_STAGE(PG8_SB(1, 0), b3, voffB);
            PG8_BAR; PG8_WAIT_L(0); PG8_MMA(0, 1, At, B1); PG8_BAR;
            PG8_LDA(At, 1, 1); PG8_STAGE(PG8_SA(1, 0), a3, voffA);
            PG8_BAR; PG8_WAIT_L(0); PG8_MMA(1, 0, At, B0); PG8_BAR; PG8_SCHED;
            PG8_STAGE(PG8_SB(1, 1), b3 + hstep, voffB);
            PG8_WAIT_V(6); PG8_BAR; PG8_MMA(1, 1, At, B1); PG8_BAR;
            }
        }
        if constexpr (ALIGN_EPI) { if (wr == 0) PG8_BAR; }
        if constexpr (!Epi::AFTER_DRAIN) { E(acc, cur, wr, wc, fr, fq); S.done(cur); }
        if (!has_next) break;
#pragma unroll
        for (int a = 0; a < 2; ++a)
#pragma unroll
            for (int b = 0; b < 2; ++b)
#pragma unroll
                for (int m = 0; m < 4; ++m)
#pragma unroll
                    for (int n = 0; n < 2; ++n) acc[a][b][m][n] = (f32x4){0.f, 0.f, 0.f, 0.f};
        cur = nxt; cA = nA; cB = nB; ++ui;
        if constexpr (ALIGN_EPI) { if (wr == 1) PG8_BAR; }
    }
    PG8_WAIT_V(0);
    if constexpr (!ALIGN_EPI) { if (wr == 0) PG8_BAR; }
    PG8_BAR;
    if constexpr (Epi::AFTER_DRAIN) { E.fused(acc, cur, wr, wc, fr, fq, lds, wid, lane); S.done(cur); }
#undef PG8_SA
#undef PG8_SB
#undef PG8_STAGE
#undef PG8_LDA
#undef PG8_LDB
#undef PG8_MMA
#undef PG8_WAIT_V
#undef PG8_WAIT_L
#undef PG8_BAR
#undef PG8_SCHED
}
}
#define GAS __attribute__((address_space(1)))
#define LAS __attribute__((address_space(3)))
typedef unsigned short bf16;
typedef unsigned v4u __attribute__((ext_vector_type(4)));
typedef float f32x4 __attribute__((ext_vector_type(4)));
typedef short bf16x8 __attribute__((ext_vector_type(8)));
typedef GAS unsigned gu32;
typedef GAS unsigned long long gu64;
#define RLX_AGENT __ATOMIC_RELAXED, __HIP_MEMORY_SCOPE_AGENT
#define LDS_WAIT() asm volatile("s_waitcnt lgkmcnt(0)" ::: "memory")
#define VM_WAIT() asm volatile("s_waitcnt vmcnt(0)" ::: "memory")
__device__ __forceinline__ unsigned long long rt() { return __builtin_amdgcn_s_memrealtime(); }
__device__ __forceinline__ unsigned f2bf(float f) { unsigned u = __builtin_bit_cast(unsigned, f); return (u + 0x7fffu + ((u >> 16) & 1u)) >> 16; }
__device__ __forceinline__ unsigned pk2(float lo, float hi) { return f2bf(lo) | (f2bf(hi) << 16); }
#define XB_TMO      128
#define XB_XCNT(j)  (256  + 64 * (j))
#define XB_XSUB(j)  (1280 + 64 * (j))
#define XB_XGEN(j)  (2304 + 64 * (j))
#define XB_TOP      3328
#define XB_TOPGEN   3392
#define XCD_BAR_WORDS 3456
#define XB_SPIN_CAP (1u << 18)

__device__ __forceinline__ unsigned xb_ld(unsigned* p)              { return __hip_atomic_load(p, __ATOMIC_RELAXED, __HIP_MEMORY_SCOPE_AGENT); }
__device__ __forceinline__ unsigned xb_add(unsigned* p, unsigned v) { return __hip_atomic_fetch_add(p, v, __ATOMIC_RELAXED, __HIP_MEMORY_SCOPE_AGENT); }
__device__ __forceinline__ unsigned xb_xcc_id() { return (unsigned)__builtin_amdgcn_s_getreg((3 << 11) | 20) & 0xFu; }
#define XB_SPIN(cond, bar) do { unsigned _sp = 0; while (cond) { __builtin_amdgcn_s_sleep(1); \
    if ((++_sp & 255u) == 0u) { if (xb_ld(&(bar)[XB_TMO])) break; if (_sp > XB_SPIN_CAP) { atomicAdd(&(bar)[XB_TMO], 1u); break; } } } } while (0)

struct XcdBarrier {
    unsigned* bar; unsigned x;
    volatile LAS unsigned* st;
};

__device__ __forceinline__ XcdBarrier xcd_barrier_post(unsigned* bar, volatile LAS unsigned* st) {
    XcdBarrier b; b.bar = bar; b.x = xb_xcc_id(); b.st = st;
    if (threadIdx.x == 0) (void)xb_add(&bar[XB_XCNT(b.x)], 1u);
    return b;
}
__device__ __forceinline__ void xcd_barrier_complete(unsigned* bar, unsigned x, unsigned& nloc, unsigned& nx) {
    const unsigned G = gridDim.x * gridDim.y * gridDim.z;
    unsigned sum, cnt, mine, sp = 0u;
    for (;;) {
        sum = 0u; cnt = 0u; mine = 0u;
#pragma unroll
        for (unsigned j = 0; j < 16; ++j) { const unsigned c = xb_ld(&bar[XB_XCNT(j)]); sum += c; cnt += (c > 0u) ? 1u : 0u; mine = (j == x) ? c : mine; }
        if (sum == G) break;
        __builtin_amdgcn_s_sleep(1);
        if ((++sp & 255u) == 0u) { if (xb_ld(&bar[XB_TMO])) break; if (sp > XB_SPIN_CAP) { atomicAdd(&bar[XB_TMO], 1u); break; } }
    }
    nloc = mine > 0u ? mine : 1u; nx = cnt > 0u ? cnt : 1u;
}

__device__ __forceinline__ void xcd_barrier(const XcdBarrier& b) {
    asm volatile("s_waitcnt vmcnt(0)" ::: "memory");
    __syncthreads();
    if (threadIdx.x == 0) {
        unsigned* bar = b.bar;
        __builtin_amdgcn_s_waitcnt(0);
        unsigned nloc = b.st[0], nx = b.st[1];
        if (nloc == 0u) { xcd_barrier_complete(bar, b.x, nloc, nx); b.st[0] = nloc; b.st[1] = nx; }
        const unsigned old = xb_add(&bar[XB_XSUB(b.x)], 1u);
        const unsigned gen = old / nloc;
        if (old + 1u == (gen + 1u) * nloc) {
            __builtin_amdgcn_fence(__ATOMIC_RELEASE, "agent");
            asm volatile("s_waitcnt vmcnt(0)" ::: "memory");
            const unsigned og = xb_add(&bar[XB_TOP], 1u);
            const unsigned tg = og / nx;
            if (og + 1u == (tg + 1u) * nx) xb_add(&bar[XB_TOPGEN], 1u);
            else XB_SPIN(xb_ld(&bar[XB_TOPGEN]) == tg, bar);
            __builtin_amdgcn_fence(__ATOMIC_ACQUIRE, "agent");
            xb_add(&bar[XB_XGEN(b.x)], 1u);
            asm volatile("s_waitcnt vmcnt(0)" ::: "memory");
        } else {
            XB_SPIN(xb_ld(&bar[XB_XGEN(b.x)]) == gen, bar);
            __builtin_amdgcn_fence(__ATOMIC_ACQUIRE, "agent");
            asm volatile("s_waitcnt vmcnt(0)" ::: "memory");
        }
    }
    __syncthreads();
}
constexpr int NWAVES = 8;
#ifndef MK_N_LAUNCHES
#define MK_N_LAUNCHES 1
#endif
constexpr int N_PHASES = 10;
constexpr int N_LAUNCHES = MK_N_LAUNCHES;

constexpr int DM = 2048, NBATCH = 8, SEQ = 2048, MP = NBATCH * SEQ, SBATCH = 8, SLEN = 16, MS = SBATCH * SLEN, MT = MP + MS;
constexpr int NH = 4, DV = 256, DQK = 128, QKW = 1024, NG = 64, GCH = 16, PST = 64, DFF = 5632, NIN = 4104;
constexpr int CH = 64, NCH = SEQ / CH;
constexpr int NSC = NBATCH * NCH + SBATCH;
constexpr float EPS = 1e-6f;
constexpr int DVS = 64, NSL = DV / DVS;

constexpr size_t O_Y = 0, O_CONVP = (size_t)MT * DM, O_CP = O_CONVP + 8 * 3 * 1024, O_NP = O_CP + 8 * 4 * 256 * 128, O_MP = O_NP + 8 * 4 * 128,
                 O_SRP = O_MP + 32, O_SIP = O_SRP + 8 * 64 * 64, O_CONVS = O_SIP + 8 * 64 * 64, O_CS = O_CONVS + 8 * 3 * 1024, O_NS = O_CS + 8 * 4 * 256 * 128,
                 O_MS = O_NS + 8 * 4 * 128, O_SRS = O_MS + 32, O_SIS = O_SRS + 8 * 64 * 64, O_END = O_SIS + 8 * 64 * 64;
static_assert(O_END == 36102208, "d_out map");

constexpr size_t MiB = 1u << 20;
constexpr size_t WS_CTL = 0, CTL_ZERO_BYTES = 1 * MiB;
constexpr size_t WS_WIN = 2 * MiB, WS_WGLU = 18 * MiB, WS_WOUT = 20 * MiB, WS_WGU = 28 * MiB, WS_WD = 72 * MiB;
constexpr size_t WS_XN = 96 * MiB;
constexpr size_t WS_R0 = 162 * MiB, WS_RSTRIDE = 33 * MiB;
constexpr size_t WS_QKRAW = WS_R0, WS_V = WS_R0 + WS_RSTRIDE, WS_OG = WS_R0 + 2 * WS_RSTRIDE, WS_U = WS_R0 + 3 * WS_RSTRIDE;
constexpr size_t WS_Q = 294 * MiB, WS_K = 311 * MiB;
constexpr size_t WS_Z = WS_QKRAW;
constexpr size_t WS_MIXIN = WS_Q;
constexpr size_t WS_MIX = WS_R0;
constexpr size_t WS_ACT = WS_R0;
constexpr size_t WS_X1B = WS_XN;
constexpr size_t WS_FF = 427 * MiB;
constexpr size_t WS_GATES = 378 * MiB, WS_HSS = 379 * MiB, WS_SS1 = 382 * MiB, WS_SS2 = 385 * MiB, WS_S5P = 388 * MiB, WS_SSS = 389 * MiB;
constexpr size_t WS_HS = 390 * MiB;
constexpr size_t WS_SCAL = 423 * MiB, WS_END = 492 * MiB;
static_assert(WS_XN + (size_t)MT * DM * 2 <= WS_R0 && WS_QKRAW + (size_t)MT * 1024 * 2 <= WS_V && WS_U + (size_t)MT * 1024 * 2 <= WS_Q && WS_Q + (size_t)MT * 512 * 2 <= WS_K &&
              WS_K + (size_t)MT * 512 * 2 <= WS_GATES && WS_MIXIN + (size_t)MT * DM * 2 <= WS_GATES && WS_MIX + (size_t)MT * DM * 2 <= WS_OG && WS_ACT + (size_t)MT * DFF * 2 <= WS_GATES &&
              WS_WD + (size_t)DM * DFF * 2 <= WS_XN && WS_WGU + (size_t)2 * DFF * DM * 2 <= WS_WD && WS_HSS + (size_t)MT * 32 * 4 <= WS_SS1 && WS_SS1 + (size_t)MT * 32 * 4 <= WS_SS2 &&
              WS_SS2 + (size_t)MT * 32 * 4 <= WS_S5P && WS_GATES + (size_t)MT * 8 * 4 <= WS_HSS && WS_HS + (size_t)MT * 1024 * 2 <= WS_SCAL && WS_SCAL + (size_t)NSC * 4 * 384 * 4 <= WS_FF && WS_FF + (size_t)MT * DM * 2 <= WS_END, "d_ws map");
constexpr size_t S5P_LAM = 0, S5P_BBT = 64 * 1024, S5P_CC = S5P_BBT + 64 * 128 * 16 * 2;
constexpr size_t SSS_1 = 0, SSS_2 = 128 * 128 * 4, SSS_RSTD2 = 256 * 1024, SSS_RSTD1 = 384 * 1024;
constexpr int CW_TMO = 0, CW_CODE = 1, CW_BAR = 4096;

constexpr int RING_OFF = 0, RING_BYTES = 131072;
constexpr int LDSCTL_OFF = 151552, MISC_OFF = LDSCTL_OFF + 320;
constexpr int LDS_BYTES = 155648;
typedef short s16x4 __attribute__((ext_vector_type(4)));
typedef unsigned u32x2 __attribute__((ext_vector_type(2)));
struct Frame {
    LAS unsigned char* lds;
    volatile LAS unsigned* MISC;
    gu32* ctl;
    int tid, lane, wave;
    int vcu, G;
    const float* const* in;
    float* out; unsigned char* ws;
};
__device__ __forceinline__ float wave_sum(float v) {
#pragma unroll
    for (int o = 1; o < 64; o <<= 1) v += __shfl_xor(v, o);
    return v;
}
__device__ __forceinline__ unsigned cvtpk(float lo, float hi) { unsigned r; asm volatile("v_cvt_pk_bf16_f32 %0, %1, %2" : "=v"(r) : "v"(lo), "v"(hi)); return r; }
typedef __bf16 bf16x2n_t __attribute__((ext_vector_type(2)));
__device__ __forceinline__ unsigned cvtpk_n(float lo, float hi) { const bf16x2n_t v = {(__bf16)lo, (__bf16)hi}; return __builtin_bit_cast(unsigned, v); }
__device__ __forceinline__ float bflo(unsigned w) { return __uint_as_float(w << 16); }
__device__ __forceinline__ float bfhi(unsigned w) { return __uint_as_float(w & 0xffff0000u); }
__device__ __forceinline__ float bf2f(bf16 h) { return __uint_as_float((unsigned)h << 16); }
__device__ __forceinline__ float sigmoidf_(float v) { return __builtin_amdgcn_rcpf(1.0f + __expf(-v)); }
__device__ __forceinline__ f32x4 mfma16(bf16x8 a, bf16x8 b, f32x4 c) { return __builtin_amdgcn_mfma_f32_16x16x32_bf16(a, b, c, 0, 0, 0); }
#define WAVE_SYNC() do { asm volatile("s_waitcnt lgkmcnt(0)" ::: "memory"); __builtin_amdgcn_wave_barrier(); } while (0)

#ifdef MK_STAMP
#ifndef MK_STAMP_SCALE
#define MK_STAMP_SCALE 0.002f
#endif
#define DBG_DECL unsigned long long dbg_acc_ = 0, dbg_t0_ = 0;
__device__ __forceinline__ unsigned long long dbg_rt() { unsigned long long t; __builtin_amdgcn_sched_barrier(0);
#ifdef MK_STAMP_CYC
    asm volatile("s_memtime %0\n\ts_waitcnt lgkmcnt(0)" : "=s"(t) :: "memory");
#else
    asm volatile("s_memrealtime %0\n\ts_waitcnt lgkmcnt(0)" : "=s"(t) :: "memory");
#endif
 __builtin_amdgcn_sched_barrier(0); return t; }
#define DBG_BEGIN(id) do { if ((id) == MK_STAMP) dbg_t0_ = dbg_rt(); } while (0)
#define DBG_END(id) do { if ((id) == MK_STAMP) dbg_acc_ += dbg_rt() - dbg_t0_; } while (0)
#define DBG_REPORT(cond) do { if ((cond) && (threadIdx.x & 63) == 0 && (threadIdx.x >> 6) == MK_STAMP_WAVE) ((unsigned*)(A.ws + WS_CTL))[16] = (unsigned)dbg_acc_; } while (0)
#define DBG_PERTURB(V, m_) do { if ((m_) == 0 && lane == 0) V[0][0] += (float)__hip_atomic_load((unsigned*)(A.ws + WS_CTL) + 16, __ATOMIC_RELAXED, __HIP_MEMORY_SCOPE_AGENT) * MK_STAMP_SCALE; } while (0)
#else
#define DBG_DECL
#define DBG_BEGIN(id)
#define DBG_END(id)
#define DBG_REPORT(cond)
#define DBG_PERTURB(V, m_)
#endif
struct Args { const float* in[32]; float* out; unsigned char* ws; int ph_lo, ph_hi, li, pad; };

__device__ __forceinline__ void p0_transpose_item(const float* W, int ldw, int src_col0, int k0, bf16* WT, int K, int out_row0, LAS float* scr, int lane, const float* kscale = nullptr) {
    if (kscale) {
#pragma unroll 8
        for (int i = 0; i < 32; ++i) { const int kk = 2 * i + (lane >> 5); scr[kk * 33 + (lane & 31)] = __builtin_nontemporal_load(W + (size_t)(k0 + kk) * ldw + src_col0 + (lane & 31)) * kscale[k0 + kk]; }
    } else {
#pragma unroll 8
    for (int i = 0; i < 32; ++i) { const int kk = 2 * i + (lane >> 5); scr[kk * 33 + (lane & 31)] = __builtin_nontemporal_load(W + (size_t)(k0 + kk) * ldw + src_col0 + (lane & 31)); }
    }
    LDS_WAIT(); asm volatile("" ::: "memory");
    const int c = lane & 7;
#pragma unroll
    for (int j = 0; j < 4; ++j) { const int n = (lane >> 3) + 8 * j; const LAS float* s = scr + (8 * c) * 33 + n;
        v4u o; o.x = pk2(s[0 * 33], s[1 * 33]); o.y = pk2(s[2 * 33], s[3 * 33]); o.z = pk2(s[4 * 33], s[5 * 33]); o.w = pk2(s[6 * 33], s[7 * 33]);
        *(GAS v4u*)(WT + (size_t)(out_row0 + n) * K + k0 + 8 * c) = o; }
    LDS_WAIT(); asm volatile("" ::: "memory");
}
__device__ __forceinline__ float log_sigmoid(float x) { return fminf(x, 0.f) - log1pf(__expf(-fabsf(x))); }

struct CvtItem { const float* W; int ldw, sc, k0; bf16* WT; int K, orow; const float* ks; };
constexpr int CV_I_IN = (DM / 64) * (4096 / 32), CV_I_GLU = (1024 / 64) * (1024 / 32), CV_I_OUT = (DM / 64) * (DM / 32), CV_I_GU = (DM / 64) * (2 * DFF / 32), CV_I_D = (DFF / 64) * (DM / 32);
__device__ __forceinline__ CvtItem cvt_item(const Args& A, int it) {
    unsigned char* ws = A.ws; int r = it; CvtItem c;
    if (r < CV_I_IN) { const int nnb = 4096 / 32, kb = r / nnb, nb = r % nnb, orow = 32 * nb; c = CvtItem{A.in[9], NIN, orow < 3072 ? orow : orow + 8, 64 * kb, (bf16*)(ws + WS_WIN), DM, orow, nullptr}; return c; } r -= CV_I_IN;
    if (r < CV_I_GLU) { const int nnb = 1024 / 32, kb = r / nnb, nb = r % nnb; c = CvtItem{A.in[23], 1024, 32 * nb, 64 * kb, (bf16*)(ws + WS_WGLU), 1024, 32 * nb, nullptr}; return c; } r -= CV_I_GLU;
    if (r < CV_I_OUT) { const int nnb = DM / 32, kb = r / nnb, nb = r % nnb; c = CvtItem{A.in[25], DM, 32 * nb, 64 * kb, (bf16*)(ws + WS_WOUT), DM, 32 * nb, nullptr}; return c; } r -= CV_I_OUT;
    if (r < CV_I_GU) { const int nnb = 2 * DFF / 32, kb = r / nnb, nb = r % nnb, orow = 32 * nb, pn = orow >> 8, cc = orow & 255;
        c = CvtItem{cc < 128 ? A.in[28] : A.in[29], DFF, 128 * pn + (cc & 127), 64 * kb, (bf16*)(ws + WS_WGU), DM, orow, A.in[27]}; return c; } r -= CV_I_GU;
    { const int nnb = DM / 32, kb = r / nnb, nb = r % nnb; c = CvtItem{A.in[30], DM, 32 * nb, 64 * kb, (bf16*)(ws + WS_WD), DFF, 32 * nb, nullptr}; return c; }
}
__device__ __forceinline__ void p0_prologue(const Args& A, LAS unsigned char* lds, int tid, int lane, int wave, int vcu, int G) {
    unsigned char* ws = A.ws;
    LAS float* WG = (LAS float*)lds;
    LAS float* scr = (LAS float*)(lds + wave * 8448);
    const int gw = vcu * NWAVES + wave, NGW = G * NWAVES;
    { constexpr int NIT = CV_I_IN + CV_I_GLU + CV_I_OUT + CV_I_GU + CV_I_D;
      float ra[32], rb[32]; CvtItem ia, ib;
#define CV_LOAD(R, I, it_) do { I = cvt_item(A, (it_)); \
        _Pragma("unroll") for (int i = 0; i < 32; ++i) { const int kk = 2 * i + (lane >> 5); R[i] = __builtin_nontemporal_load(I.W + (size_t)(I.k0 + kk) * I.ldw + I.sc + (lane & 31)); } } while (0)
#define CV_PROC(R, I) do { \
        if (I.ks) { _Pragma("unroll") for (int i = 0; i < 32; ++i) { const int kk = 2 * i + (lane >> 5); scr[kk * 33 + (lane & 31)] = R[i] * I.ks[I.k0 + kk]; } } \
        else { _Pragma("unroll") for (int i = 0; i < 32; ++i) { const int kk = 2 * i + (lane >> 5); scr[kk * 33 + (lane & 31)] = R[i]; } } \
        LDS_WAIT(); asm volatile("" ::: "memory"); \
        { const int c = lane & 7; \
          _Pragma("unroll") for (int j = 0; j < 4; ++j) { const int n = (lane >> 3) + 8 * j; const LAS float* s = scr + (8 * c) * 33 + n; \
              v4u o; o.x = pk2(s[0 * 33], s[1 * 33]); o.y = pk2(s[2 * 33], s[3 * 33]); o.z = pk2(s[4 * 33], s[5 * 33]); o.w = pk2(s[6 * 33], s[7 * 33]); \
              *(GAS v4u*)(I.WT + (size_t)(I.orow + n) * I.K + I.k0 + 8 * c) = o; } } \
        LDS_WAIT(); asm volatile("" ::: "memory"); } while (0)
      int it = gw;
      if (it < NIT) { CV_LOAD(ra, ia, it);
          for (;;) { const int it2 = it + NGW; if (it2 < NIT) CV_LOAD(rb, ib, it2); CV_PROC(ra, ia); if (it2 >= NIT) break;
                     it = it2 + NGW; if (it < NIT) CV_LOAD(ra, ia, it); CV_PROC(rb, ib); if (it >= NIT) break; } }
#undef CV_LOAD
#undef CV_PROC
    }
    { const int gt = vcu * (NWAVES * 64) + tid;
      if (gt < NG * PST) {
        const int g = gt >> 6, p = gt & 63;
        const double lr = (double)A.in[15][gt], li = (double)A.in[16][gt], dt = exp((double)A.in[17][g]);
        const double mag = exp(lr * dt), ang = li * dt, lbr = mag * cos(ang), lbi = mag * sin(ang);
        const double den = lr * lr + li * li, nr = lbr - 1.0, fre = (nr * lr + lbi * li) / den, fim = (lbi * lr - nr * li) / den;
        float* LAM = (float*)(ws + WS_S5P + S5P_LAM); LAM[gt * 2] = (float)lbr; LAM[gt * 2 + 1] = (float)lbi;
        bf16* BBT = (bf16*)(ws + WS_S5P + S5P_BBT); bf16* CC = (bf16*)(ws + WS_S5P + S5P_CC);
        const float* bre = A.in[18] + (size_t)gt * 16; const float* bim = A.in[19] + (size_t)gt * 16;
#pragma unroll
        for (int i = 0; i < 16; ++i) { const double br = bre[i], bi = bim[i];
            BBT[((size_t)g * 128 + 2 * p) * 16 + i] = (bf16)f2bf((float)(fre * br - fim * bi));
            BBT[((size_t)g * 128 + 2 * p + 1) * 16 + i] = (bf16)f2bf((float)(fre * bi + fim * br));
            CC[((size_t)g * 16 + i) * 128 + 2 * p] = (bf16)f2bf(A.in[20][((size_t)g * 16 + i) * 64 + p]);
            CC[((size_t)g * 16 + i) * 128 + 2 * p + 1] = (bf16)f2bf(-A.in[21][((size_t)g * 16 + i) * 64 + p]); }
      } }
    __syncthreads();
    { const float* win = A.in[9];
      for (int e = tid; e < 8 * 2048; e += NWAVES * 64) { const int k = e >> 3, c = e & 7; WG[c * 2048 + k] = win[(size_t)k * NIN + 3072 + c]; } }
    __syncthreads();
    { const GAS f32x4* gp = (const GAS f32x4*)A.in[8] + lane; f32x4 gv[8];
#pragma unroll
      for (int j = 0; j < 8; ++j) gv[j] = gp[64 * j];
      bf16* XN = (bf16*)(ws + WS_XN); float* GATES = (float*)(ws + WS_GATES);
      for (int m = gw; m < MT; m += NGW) {
        const float* xrow = m < MP ? A.in[0] + (size_t)m * DM : A.in[1] + (size_t)(m - MP) * DM;
        const GAS f32x4* xr = (const GAS f32x4*)xrow + lane;
        f32x4 v[8]; float s = 0.f;
#pragma unroll
        for (int j = 0; j < 8; ++j) { v[j] = __builtin_nontemporal_load(xr + 64 * j); s += (v[j].x * v[j].x + v[j].y * v[j].y) + (v[j].z * v[j].z + v[j].w * v[j].w); }
        const float ms = wave_sum(s) * (1.0f / DM) + EPS, rstd = 1.0f / sqrtf(ms);
        if (lane == 0) ((float*)(ws + WS_SSS + SSS_RSTD1))[m] = sqrtf(ms);
        GAS u32x2* o8 = (GAS u32x2*)(XN + (size_t)m * DM) + lane;
        float ga[8] = {0.f, 0.f, 0.f, 0.f, 0.f, 0.f, 0.f, 0.f};
#pragma unroll
        for (int j = 0; j < 8; ++j) { v[j] = v[j] * rstd * gv[j]; u32x2 o; o.x = cvtpk(v[j].x, v[j].y); o.y = cvtpk(v[j].z, v[j].w); o8[64 * j] = o;
#pragma unroll
            for (int c = 0; c < 8; ++c) { const f32x4 w = *(const LAS f32x4*)(WG + c * 2048 + 256 * j + 4 * lane); ga[c] += (v[j].x * w.x + v[j].y * w.y) + (v[j].z * w.z + v[j].w * w.w); } }
#pragma unroll
        for (int c = 0; c < 8; ++c) ga[c] = wave_sum(ga[c]);
        if (lane < 8) { float val = 0.f;
#pragma unroll
            for (int c = 0; c < 8; ++c) if (lane == c) val = ga[c];
            if (lane < 4) val += A.in[12][lane]; else val = log_sigmoid(val + A.in[13][lane - 4]);
            GATES[(size_t)m * 8 + lane] = val; }
      } }
}

template <int NACC, int K, class RowMap, class Epi>
__device__ __forceinline__ void skinny_gemm(const bf16* Arows, const bf16* Bt, LAS unsigned char* lds, int nitems, int first, int stride, int tid, int wave, int lane, RowMap rm, Epi epi) {
    const int fr = lane & 15, fq = lane >> 4;
    constexpr int KW = K / 8, NS = KW / 32;
    static_assert(KW % 32 == 0, "skinny_gemm: K must be a multiple of 256");
    const bf16* abase = Arows + (size_t)fr * K + wave * KW + 8 * fq;
    LAS f32x4* red = (LAS f32x4*)lds;
    for (int it = first; it < nitems; it += stride) {
        const bf16* brow[NACC]; f32x4 acc[NACC][8];
#pragma unroll
        for (int a = 0; a < NACC; ++a) { brow[a] = Bt + (size_t)rm(it, a, fr) * K + wave * KW + 8 * fq;
#pragma unroll
            for (int rb = 0; rb < 8; ++rb) acc[a][rb] = (f32x4){0.f, 0.f, 0.f, 0.f}; }
#pragma unroll 2
        for (int s = 0; s < NS; ++s) {
            bf16x8 av[8], bv[NACC];
#pragma unroll
            for (int a = 0; a < NACC; ++a) bv[a] = *(const bf16x8*)(brow[a] + 32 * s);
#pragma unroll
            for (int rb = 0; rb < 8; ++rb) av[rb] = *(const bf16x8*)(abase + (size_t)(16 * rb) * K + 32 * s);
#pragma unroll
            for (int rb = 0; rb < 8; ++rb)
#pragma unroll
                for (int a = 0; a < NACC; ++a) acc[a][rb] = mfma16(bv[a], av[rb], acc[a][rb]);
        }
#pragma unroll
        for (int a = 0; a < NACC; ++a)
#pragma unroll
            for (int rb = 0; rb < 8; ++rb) red[((a * 8 + wave) * 8 + rb) * 64 + lane] = acc[a][rb];
        __syncthreads();
        f32x4 fin[NACC];
#pragma unroll
        for (int a = 0; a < NACC; ++a) { f32x4 t = red[((a * 8 + 0) * 8 + wave) * 64 + lane];
#pragma unroll
            for (int w2 = 1; w2 < 8; ++w2) t += red[((a * 8 + w2) * 8 + wave) * 64 + lane];
            fin[a] = t; }
        __syncthreads();
        epi(it, 16 * wave + fr, fq, fin);
    }
}

__device__ __forceinline__ void p2_scalars(const Args& A, LAS unsigned char* lds, int lane, int wave, int item) {
    unsigned char* ws = A.ws;
    const float* GATES = (const float*)(ws + WS_GATES); float* SCAL = (float*)(ws + WS_SCAL);
    const int seq = item >> 2, h = item & 3; const bool sample = seq >= NBATCH; const int b = sample ? seq - NBATCH : seq;
    const int nch = sample ? 1 : NCH, L = sample ? SLEN : CH, row0 = sample ? MP + b * SLEN : b * SEQ, sc0 = sample ? NBATCH * NCH + b : b * NCH;
    LAS float* fl = (LAS float*)lds;
    float fc[4], a[4], pm[4];
#pragma unroll
    for (int i = 0; i < 4; ++i) { const int c = 4 * wave + i; float li = -INFINITY, lf = 0.f;
        if (c < nch && lane < L) { li = GATES[((size_t)row0 + c * CH + lane) * 8 + h]; lf = GATES[((size_t)row0 + c * CH + lane) * 8 + 4 + h]; }
        float f = lf;
#pragma unroll
        for (int d = 1; d < 64; d <<= 1) { const float o = __shfl_up(f, d); if (lane >= d) f += o; }
        const float aa = li - f; float p = aa;
#pragma unroll
        for (int d = 1; d < 64; d <<= 1) { const float o = __shfl_up(p, d); if (lane >= d) p = fmaxf(p, o); }
        fc[i] = f; a[i] = aa; pm[i] = p;
        if (lane == 63) { fl[c] = f; fl[32 + c] = p; } }
    __syncthreads();
    float m0c = 0.f, m0 = sample ? A.in[5][b * NH + h] : 0.f;
    for (int c = 0; c < nch; ++c) { if (lane == c) m0c = m0; m0 = fl[c] + fmaxf(fl[32 + c], m0); }
#pragma unroll
    for (int i = 0; i < 4; ++i) { const int c = 4 * wave + i;
        if (c < nch) { const float m0i = __shfl(m0c, c); const float mm = fmaxf(pm[i], m0i), mml = __shfl(mm, 63);
            float* o = SCAL + ((size_t)(sc0 + c) * 4 + h) * 384;
            o[lane] = a[i]; o[64 + lane] = mm; o[128 + lane] = __expf(m0i - mm); o[192 + lane] = __expf(-(fc[i] + mm)); o[256 + lane] = __expf(a[i] - mml);
            o[320 + lane] = (lane == 0) ? __expf(m0i - mml) : (__shfl(fc[i], 63) + mml); } }
    if (wave == 0 && lane == 0) A.out[(sample ? O_MS : O_MP) + b * NH + h] = m0;
    __syncthreads();
}
__device__ __forceinline__ void p2_conv(const Args& A, int tid, int vcu, int G) {
    unsigned char* ws = A.ws;
    const bf16* QKRAW = (const bf16*)(ws + WS_QKRAW); bf16* Q = (bf16*)(ws + WS_Q); bf16* Kb = (bf16*)(ws + WS_K);
    const int nthreads = G * NWAVES * 64;
    for (int it = vcu * (NWAVES * 64) + tid; it < (MT / 8) * 128; it += nthreads) {
        const int rb = it >> 7, ch = it & 127, rs = 8 * rb, col = 8 * ch;
        bool first, sample = rs >= MP; int b, tl, Lseq;
        if (!sample) { b = rs / SEQ; tl = rs % SEQ; Lseq = SEQ; } else { b = (rs - MP) / SLEN; tl = (rs - MP) % SLEN; Lseq = SLEN; }
        first = (tl == 0);
        float w[4][8], bc[8];
#pragma unroll
        for (int j = 0; j < 4; ++j) { const f32x4 a0 = *(const f32x4*)(A.in[10] + j * 1024 + col), a1 = *(const f32x4*)(A.in[10] + j * 1024 + col + 4);
            w[j][0] = a0[0]; w[j][1] = a0[1]; w[j][2] = a0[2]; w[j][3] = a0[3]; w[j][4] = a1[0]; w[j][5] = a1[1]; w[j][6] = a1[2]; w[j][7] = a1[3]; }
        { const f32x4 a0 = *(const f32x4*)(A.in[11] + col), a1 = *(const f32x4*)(A.in[11] + col + 4);
          bc[0] = a0[0]; bc[1] = a0[1]; bc[2] = a0[2]; bc[3] = a0[3]; bc[4] = a1[0]; bc[5] = a1[1]; bc[6] = a1[2]; bc[7] = a1[3]; }
        v4u raw[11];
#pragma unroll
        for (int r = 0; r < 11; ++r) { if (r >= 3 || !first) raw[r] = *(const GAS v4u*)(QKRAW + (size_t)(rs + r - 3) * 1024 + col); else raw[r] = (v4u){0u, 0u, 0u, 0u}; }
        float x0[8], x1[8], x2[8];
#define UNPK(dst, v) do { dst[0] = bflo(v.x); dst[1] = bfhi(v.x); dst[2] = bflo(v.y); dst[3] = bfhi(v.y); dst[4] = bflo(v.z); dst[5] = bfhi(v.z); dst[6] = bflo(v.w); dst[7] = bfhi(v.w); } while (0)
        if (first && sample) {
            const float* sp = A.in[2] + (size_t)b * 3 * 1024 + col;
#pragma unroll
            for (int i = 0; i < 8; ++i) { x0[i] = sp[i]; x1[i] = sp[1024 + i]; x2[i] = sp[2048 + i]; }
        } else { UNPK(x0, raw[0]); UNPK(x1, raw[1]); UNPK(x2, raw[2]); }
#pragma unroll
        for (int r = 0; r < 8; ++r) {
            float x3[8]; UNPK(x3, raw[r + 3]);
            float o[8];
#pragma unroll
            for (int i = 0; i < 8; ++i) { const float val = bc[i] + w[0][i] * x0[i] + w[1][i] * x1[i] + w[2][i] * x2[i] + w[3][i] * x3[i]; o[i] = val * sigmoidf_(val); }
            const size_t row = (size_t)rs + r;
            if (ch < 64) {
#pragma unroll
                for (int i = 0; i < 8; ++i) o[i] *= 0.08838834764831845f;
                v4u pk; pk.x = cvtpk(o[0], o[1]); pk.y = cvtpk(o[2], o[3]); pk.z = cvtpk(o[4], o[5]); pk.w = cvtpk(o[6], o[7]);
                *(GAS v4u*)(Q + row * 512 + col) = pk;
            } else {
                v4u pk; pk.x = cvtpk(o[0], o[1]); pk.y = cvtpk(o[2], o[3]); pk.z = cvtpk(o[4], o[5]); pk.w = cvtpk(o[6], o[7]);
                *(GAS v4u*)(Kb + row * 512 + (col - 512)) = pk;
            }
            const int tt = tl + r;
            if (tt >= Lseq - 3) { float* cv = A.out + (sample ? O_CONVS : O_CONVP) + ((size_t)b * 3 + (tt - (Lseq - 3))) * 1024 + col;
                *(f32x4*)cv = (f32x4){x3[0], x3[1], x3[2], x3[3]}; *(f32x4*)(cv + 4) = (f32x4){x3[4], x3[5], x3[6], x3[7]}; }
#pragma unroll
            for (int i = 0; i < 8; ++i) { x0[i] = x1[i]; x1[i] = x2[i]; x2[i] = x3[i]; }
        }
#undef UNPK
    }
}
constexpr int ML_QS = 0, ML_KS = 17408, ML_VS = 34816, ML_SC = 46080, ML_SET = 47616, ML_SS = 2 * ML_SET, ML_CB = ML_SS + 9216, ML_CBSZ = 21760;
static_assert(ML_CB + 2 * ML_CBSZ <= LDSCTL_OFF, "mLSTM LDS map");
constexpr int SC_A = 0, SC_MM = 64, SC_GI = 128, SC_EN = 192, SC_WS = 256, SC_MISC = 320;
__device__ __forceinline__ bf16x8 ldsfrag(const LAS unsigned char* p) { return *(const LAS bf16x8*)p; }
typedef __attribute__((address_space(3))) s16x4 lds_s16x4;
__device__ __forceinline__ bf16x8 trfrag(const LAS unsigned char* tile, int stride, int k0, int c0, int lane) {
    const int g = lane >> 4, q = (lane & 15) >> 2, p = lane & 3;
    const LAS unsigned char* a0 = tile + (k0 + 8 * g + q) * stride + (c0 + 4 * p) * 2;
    const s16x4 lo = __builtin_amdgcn_ds_read_tr16_b64_v4i16((lds_s16x4*)a0), hi = __builtin_amdgcn_ds_read_tr16_b64_v4i16((lds_s16x4*)(a0 + 4 * stride));
    return (bf16x8){lo[0], lo[1], lo[2], lo[3], hi[0], hi[1], hi[2], hi[3]};
}
#define LBAR() do { asm volatile("s_waitcnt lgkmcnt(0)" ::: "memory"); __builtin_amdgcn_s_barrier(); asm volatile("" ::: "memory"); } while (0)

__device__ __forceinline__ void mlstm_item(const Args& A, LAS unsigned char* lds, int tid, int lane, int wave, int item) {
    DBG_DECL
    unsigned char* ws = A.ws;
    const int fr = lane & 15, fq = lane >> 4;
    const bool sample = item >= NBATCH * NH * NSL; const int ii = sample ? item - NBATCH * NH * NSL : item;
    const int b = ii / (NH * NSL), h = (ii / NSL) % NH, sl = ii % NSL;
    const int nch = sample ? 1 : NCH, L = sample ? SLEN : CH;
    const int row0 = sample ? MP + b * SLEN : b * SEQ, sc0 = sample ? NBATCH * NCH + b : b * NCH;
    const bf16* Qg = (const bf16*)(ws + WS_Q); const bf16* Kg = (const bf16*)(ws + WS_K); const bf16* Vg = (const bf16*)(ws + WS_V);
    const float* SCAL = (const float*)(ws + WS_SCAL); bf16* HS = (bf16*)(ws + WS_HS); float* HSS = (float*)(ws + WS_HSS);
    if (tid < 256) { const int r = (tid >> 1) & 63, hf = tid & 1, st = tid >> 7; *(LAS v4u*)(lds + st * ML_SET + ML_VS + r * 176 + 128 + 16 * hf) = (v4u){hf == 0 ? 0x00003F80u : 0u, 0u, 0u, 0u}; }
    f32x4 Cst[5];
    if (sample) {
        const float* c0 = A.in[3] + ((size_t)(b * NH + h) * DV + DVS * sl) * DQK; const float* n0 = A.in[4] + (size_t)(b * NH + h) * DQK;
#pragma unroll
        for (int vb = 0; vb < 4; ++vb) Cst[vb] = *(const f32x4*)(c0 + (size_t)(16 * vb + fr) * DQK + 16 * wave + 4 * fq);
        Cst[4] = (fr == 0) ? *(const f32x4*)(n0 + 16 * wave + 4 * fq) : (f32x4){0.f, 0.f, 0.f, 0.f};
    } else {
#pragma unroll
        for (int vb = 0; vb < 5; ++vb) Cst[vb] = (f32x4){0.f, 0.f, 0.f, 0.f};
    }
#pragma unroll
    for (int vb = 0; vb < 5; ++vb) { u32x2 w; w.x = cvtpk_n(Cst[vb][0], Cst[vb][1]); w.y = cvtpk_n(Cst[vb][2], Cst[vb][3]); *(LAS u32x2*)(lds + ML_CB + (16 * vb + fr) * 272 + (16 * wave + 4 * fq) * 2) = w; }
    v4u pq[2], pk[2], pv; f32x4 psc = (f32x4){0.f, 0.f, 0.f, 0.f};
#define ML_ISSUE(c_) do { \
        const size_t r0_ = (size_t)row0 + (size_t)(c_) * CH; \
        _Pragma("unroll") for (int i = 0; i < 2; ++i) { const int e = tid + 512 * i, r = e >> 4, ch = e & 15; \
            if (r < L) { pq[i] = *(const GAS v4u*)(Qg + (r0_ + r) * 512 + 128 * h + 8 * ch); pk[i] = *(const GAS v4u*)(Kg + (r0_ + r) * 512 + 128 * h + 8 * ch); } \
            else { pq[i] = (v4u){0u, 0u, 0u, 0u}; pk[i] = (v4u){0u, 0u, 0u, 0u}; } } \
        { const int r = tid >> 3, ch = tid & 7; if (r < L) pv = *(const GAS v4u*)(Vg + (r0_ + r) * 1024 + DV * h + DVS * sl + 8 * ch); else pv = (v4u){0u, 0u, 0u, 0u}; } \
        if (tid < 96) psc = *(const GAS f32x4*)(SCAL + ((size_t)(sc0 + (c_)) * 4 + h) * 384 + 4 * tid); \
    } while (0)
#define ML_COMMIT(so_) do { LAS unsigned char* wl_ = lds + (so_); \
        _Pragma("unroll") for (int i = 0; i < 2; ++i) { const int e = tid + 512 * i, r = e >> 4, ch = e & 15; \
            *(LAS v4u*)(wl_ + ML_QS + r * 272 + ch * 16) = pq[i]; *(LAS v4u*)(wl_ + ML_KS + r * 272 + ch * 16) = pk[i]; } \
        { const int r = tid >> 3, ch = tid & 7; *(LAS v4u*)(wl_ + ML_VS + r * 176 + ch * 16) = pv; } \
        if (tid < 96) *(LAS f32x4*)((LAS float*)(wl_ + ML_SC) + 4 * tid) = psc; \
    } while (0)
    ML_ISSUE(0); ML_COMMIT(0);
    LBAR();
    const int tb = wave & 3, wh = wave >> 2, t = 16 * tb + fr;
    u32x2 hsw[2] = {(u32x2){0u, 0u}, (u32x2){0u, 0u}}; float hsp = 0.f;
#define ML_FLUSH(c_) do { const size_t grow = (size_t)row0 + (size_t)(c_) * CH + t; \
        if (t < L) { *(GAS u32x2*)(HS + grow * 1024 + h * DV + DVS * sl + 16 * (2 * wh) + 4 * fq) = hsw[0]; *(GAS u32x2*)(HS + grow * 1024 + h * DV + DVS * sl + 16 * (2 * wh + 1) + 4 * fq) = hsw[1]; \
                     if (fq == 0) HSS[grow * 32 + h * 8 + sl * 2 + wh] = hsp; } } while (0)
    DBG_BEGIN(8);
    for (int c = 0; c < nch; ++c) {
        if (c + 1 < nch) ML_ISSUE(c + 1);
        if (c > 0) ML_FLUSH(c - 1);
        const LAS unsigned char* cbr = lds + ML_CB + (c & 1) * ML_CBSZ; LAS unsigned char* cbw = lds + ML_CB + ((c + 1) & 1) * ML_CBSZ;
        const LAS unsigned char* tl = lds + (c & 1) * ML_SET; const LAS float* SC = (const LAS float*)(tl + ML_SC);
        DBG_BEGIN(4);
        bf16x8 qf[4];
#pragma unroll
        for (int ks = 0; ks < 4; ++ks) qf[ks] = ldsfrag(tl + ML_QS + t * 272 + ks * 64 + fq * 16);
        { bf16x8 kf[2][4];
#pragma unroll
          for (int i = 0; i < 2; ++i)
#pragma unroll
              for (int ks = 0; ks < 4; ++ks) kf[i][ks] = ldsfrag(tl + ML_KS + (16 * (2 * wh + i) + fr) * 272 + ks * 64 + fq * 16);
          const float mmt = SC[SC_MM + t]; f32x4 a4[2];
#pragma unroll
          for (int i = 0; i < 2; ++i) a4[i] = *(const LAS f32x4*)(SC + SC_A + 16 * (2 * wh + i) + 4 * fq);
          f32x4 g[2] = {(f32x4){0.f, 0.f, 0.f, 0.f}, (f32x4){0.f, 0.f, 0.f, 0.f}};
#pragma unroll
          for (int ks = 0; ks < 4; ++ks)
#pragma unroll
              for (int i = 0; i < 2; ++i) g[i] = mfma16(kf[i][ks], qf[ks], g[i]);
#pragma unroll
          for (int i = 0; i < 2; ++i) { const int s0 = 16 * (2 * wh + i) + 4 * fq; float v[4];
#pragma unroll
              for (int r = 0; r < 4; ++r) v[r] = (s0 + r <= t) ? g[i][r] * __expf(a4[i][r] - mmt) : 0.f;
              u32x2 w; w.x = cvtpk_n(v[0], v[1]); w.y = cvtpk_n(v[2], v[3]); *(LAS u32x2*)(lds + ML_SS + t * 144 + s0 * 2) = w; } }
        DBG_END(4);
        LBAR();
        DBG_BEGIN(5);
        { bf16x8 sf[2], vf[3][2], cf[3][4];
#pragma unroll
          for (int ks = 0; ks < 2; ++ks) sf[ks] = ldsfrag(lds + ML_SS + t * 144 + ks * 64 + fq * 16);
#pragma unroll
          for (int i = 0; i < 3; ++i) { const int vb = (i == 2) ? 4 : 2 * wh + i;
#pragma unroll
              for (int ks = 0; ks < 2; ++ks) vf[i][ks] = trfrag(tl + ML_VS, 176, 32 * ks, 16 * vb, lane);
#pragma unroll
              for (int ks = 0; ks < 4; ++ks) cf[i][ks] = ldsfrag(cbr + (16 * vb + fr) * 272 + ks * 64 + fq * 16); }
          const float git = SC[SC_GI + t], ent = SC[SC_EN + t];
          f32x4 ai[3], ae[3];
#pragma unroll
          for (int i = 0; i < 3; ++i) { ai[i] = (f32x4){0.f, 0.f, 0.f, 0.f}; ae[i] = (f32x4){0.f, 0.f, 0.f, 0.f}; }
#pragma unroll
          for (int ks = 0; ks < 4; ++ks)
#pragma unroll
              for (int i = 0; i < 3; ++i) { ae[i] = mfma16(cf[i][ks], qf[ks], ae[i]); if (ks < 2) ai[i] = mfma16(vf[i][ks], sf[ks], ai[i]); }
          f32x4 hh[3];
#pragma unroll
          for (int i = 0; i < 3; ++i) hh[i] = ai[i] + ae[i] * git;
          const float den = __shfl(hh[2][0], fr);
          const float isc = 1.0f / fmaxf(fabsf(den), ent); float p = 0.f;
#pragma unroll
          for (int i = 0; i < 2; ++i) { const f32x4 o = hh[i] * isc; p += (o[0] * o[0] + o[1] * o[1]) + (o[2] * o[2] + o[3] * o[3]);
              hsw[i].x = cvtpk_n(o[0], o[1]); hsw[i].y = cvtpk_n(o[2], o[3]); }
          p += __shfl_xor(p, 16); p += __shfl_xor(p, 32); hsp = p; }
        DBG_END(5); DBG_BEGIN(6);
        { const float decay = SC[SC_MISC];
          bf16x8 kw[2], vf[5][2];
#pragma unroll
          for (int vb = 0; vb < 5; ++vb)
#pragma unroll
              for (int ks = 0; ks < 2; ++ks) vf[vb][ks] = trfrag(tl + ML_VS, 176, 32 * ks, 16 * vb, lane);
#pragma unroll
          for (int ks = 0; ks < 2; ++ks) { const v4u kr = __builtin_bit_cast(v4u, trfrag(tl + ML_KS, 272, 32 * ks, 16 * wave, lane));
              const f32x4 w0 = *(const LAS f32x4*)(SC + SC_WS + 32 * ks + 8 * fq), w1 = *(const LAS f32x4*)(SC + SC_WS + 32 * ks + 8 * fq + 4);
              v4u o; o.x = cvtpk_n(bflo(kr.x) * w0[0], bfhi(kr.x) * w0[1]); o.y = cvtpk_n(bflo(kr.y) * w0[2], bfhi(kr.y) * w0[3]); o.z = cvtpk_n(bflo(kr.z) * w1[0], bfhi(kr.z) * w1[1]); o.w = cvtpk_n(bflo(kr.w) * w1[2], bfhi(kr.w) * w1[3]);
              kw[ks] = __builtin_bit_cast(bf16x8, o); }
#pragma unroll
          for (int vb = 0; vb < 5; ++vb) Cst[vb] = Cst[vb] * decay;
#pragma unroll
          for (int ks = 0; ks < 2; ++ks)
#pragma unroll
              for (int vb = 0; vb < 5; ++vb) Cst[vb] = mfma16(kw[ks], vf[vb][ks], Cst[vb]);
#pragma unroll
          for (int vb = 0; vb < 5; ++vb) { u32x2 w; w.x = cvtpk_n(Cst[vb][0], Cst[vb][1]); w.y = cvtpk_n(Cst[vb][2], Cst[vb][3]); *(LAS u32x2*)(cbw + (16 * vb + fr) * 272 + (16 * wave + 4 * fq) * 2) = w; } }
        DBG_END(6);
        DBG_BEGIN(7);
        if (c + 1 < nch) ML_COMMIT(((c + 1) & 1) * ML_SET);
        DBG_END(7);
        LBAR();
    }
    DBG_END(8); DBG_REPORT(item == 0);
    ML_FLUSH(nch - 1);
    { float* co = A.out + (sample ? O_CS : O_CP) + ((size_t)(b * NH + h) * DV + DVS * sl) * DQK;
#pragma unroll
      for (int vb = 0; vb < 4; ++vb) *(f32x4*)(co + (size_t)(16 * vb + fr) * DQK + 16 * wave + 4 * fq) = Cst[vb];
      if (sl == 0 && fr == 0) *(f32x4*)(A.out + (sample ? O_NS : O_NP) + (size_t)(b * NH + h) * DQK + 16 * wave + 4 * fq) = Cst[4]; }
    LBAR();
#undef ML_ISSUE
#undef ML_FLUSH
#undef ML_COMMIT
}

__device__ __forceinline__ float gelu_tanh(float y) { const float t = y * y, p = fmaf(t, 0.044715f, 1.0f);
    const float e = __builtin_amdgcn_exp2f(y * p * -2.302208198f); return y * __builtin_amdgcn_rcpf(1.0f + e); }
typedef float f32x2 __attribute__((ext_vector_type(2)));
__device__ __forceinline__ void s5_item(const Args& A, LAS unsigned char* slds, int lane, int role, int item) {
    DBG_DECL
    unsigned char* ws = A.ws;
    const int fr = lane & 15, fq = lane >> 4;
    const bool sample = item >= NBATCH * NG; const int ii = sample ? item - NBATCH * NG : item;
    const int b = ii / NG, g = ii % NG;
    const int T = sample ? SLEN : SEQ, row0 = sample ? MP + b * SLEN : b * SEQ;
    const bf16* U = (const bf16*)(ws + WS_U); bf16* Z = (bf16*)(ws + WS_Z);
    const float* LAM = (const float*)(ws + WS_S5P + S5P_LAM); const bf16* BBT = (const bf16*)(ws + WS_S5P + S5P_BBT); const bf16* CC = (const bf16*)(ws + WS_S5P + S5P_CC);
    const bf16x8 zf = (bf16x8){0, 0, 0, 0, 0, 0, 0, 0}; const f32x4 z4 = (f32x4){0.f, 0.f, 0.f, 0.f};
    const int nblk = T / 16;
    const bf16* ubase = U + (size_t)(row0 + fr) * 1024 + 16 * g + 8 * (fq & 1);
#define S5_LOADU(k_) (*(const bf16x8*)(ubase + (size_t)((k_) < nblk ? (k_) : nblk - 1) * 16 * 1024))
#define S5_BU(P_) ((LAS float*)(slds + (P_) * 8448))
#define S5_SB(P_) ((LAS bf16*)(slds + 16896 + (P_) * 4352))
    if (role == 0) {
        bf16x8 bbA[8];
#pragma unroll
        for (int rb = 0; rb < 8; ++rb) bbA[rb] = (fq < 2) ? *(const bf16x8*)(BBT + ((size_t)g * 128 + 16 * rb + fr) * 16 + 8 * fq) : zf;
        const float lr = LAM[(g * 64 + lane) * 2], li = LAM[(g * 64 + lane) * 2 + 1];
        float sr, si;
        if (sample) { sr = A.in[6][(size_t)(b * NG + g) * PST + lane]; si = A.in[7][(size_t)(b * NG + g) * PST + lane]; } else { sr = 0.f; si = 0.f; }
        bf16x8 ub = S5_LOADU(0), uc = S5_LOADU(1), ud = S5_LOADU(2);
#pragma unroll
        for (int rb = 0; rb < 8; ++rb) { const f32x4 d = mfma16(bbA[rb], ub, z4); *(LAS f32x4*)(S5_BU(0) + fr * 132 + 16 * rb + 4 * fq) = d; }
        LBAR();
#define S5_ITER_A(k_, P_) do { const int k = (k_); DBG_BEGIN(1); \
            f32x4 d[8]; \
            _Pragma("unroll") for (int rb = 0; rb < 8; ++rb) d[rb] = mfma16(bbA[rb], uc, z4);                                 \
            f32x2 bu[16]; { const LAS float* bc = S5_BU(P_); \
            _Pragma("unroll") for (int tt = 0; tt < 16; ++tt) bu[tt] = *(const LAS f32x2*)(bc + tt * 132 + 2 * lane); } \
            { LAS float* bn = S5_BU(1 - (P_)); \
            _Pragma("unroll") for (int rb = 0; rb < 8; ++rb) *(LAS f32x4*)(bn + fr * 132 + 16 * rb + 4 * fq) = d[rb]; } \
            { LAS bf16* sbc = S5_SB(P_); \
            f32x2 s2 = (f32x2){sr, si}; const f32x2 lr2 = (f32x2){lr, lr}, li2 = (f32x2){-li, li}; \
            _Pragma("unroll") for (int tt = 0; tt < 16; ++tt) { const f32x2 sw = __builtin_shufflevector(s2, s2, 1, 0); s2 = lr2 * s2 + (li2 * sw + bu[tt]);     \
                *(LAS unsigned*)(sbc + tt * 136 + 2 * lane) = cvtpk_n(s2[0], s2[1]); } sr = s2[0]; si = s2[1]; }                \
            uc = ud; ud = S5_LOADU(k + 3); DBG_END(1); \
            LBAR(); } while (0)
        DBG_BEGIN(2);
        for (int k2 = 0; k2 + 1 < nblk; k2 += 2) { S5_ITER_A(k2, 0); S5_ITER_A(k2 + 1, 1); }
        if (nblk & 1) S5_ITER_A(nblk - 1, 0);
        DBG_END(2); DBG_REPORT(!sample && item == 0);
#undef S5_ITER_A
        float* so = A.out + (sample ? O_SRS : O_SRP) + (size_t)(b * NG + g) * PST; float* io = A.out + (sample ? O_SIS : O_SIP) + (size_t)(b * NG + g) * PST;
        so[lane] = sr; io[lane] = si;
    } else {
        bf16x8 ccA[4], dA;
#pragma unroll
        for (int ks = 0; ks < 4; ++ks) ccA[ks] = *(const bf16x8*)(CC + ((size_t)g * 16 + fr) * 128 + 32 * ks + 8 * fq);
        { const short dv = (short)f2bf(A.in[22][g * 16 + fr]); dA = zf;
#pragma unroll
          for (int j = 0; j < 8; ++j) dA[j] = (fq < 2 && 8 * fq + j == fr) ? dv : (short)0; }
        bf16x8 ua = S5_LOADU(0), ub = S5_LOADU(0), uc = S5_LOADU(1);
        LBAR();
#define S5_Y(km1_, P_) do { const LAS bf16* sbp = S5_SB(P_); f32x4 y = z4; \
            _Pragma("unroll") for (int ks = 0; ks < 4; ++ks) y = mfma16(ccA[ks], *(const LAS bf16x8*)(sbp + fr * 136 + 32 * ks + 8 * fq), y); \
            y = mfma16(dA, ua, y); \
            u32x2 w; w.x = cvtpk_n(gelu_tanh(y[0]), gelu_tanh(y[1])); w.y = cvtpk_n(gelu_tanh(y[2]), gelu_tanh(y[3])); \
            *(GAS u32x2*)(Z + ((size_t)row0 + 16 * (km1_) + fr) * 1024 + 16 * g + 4 * fq) = w; } while (0)
#define S5_ITER_B(k_, P_) do { const int k = (k_); DBG_BEGIN(3); if (k >= 1) S5_Y(k - 1, 1 - (P_)); ua = ub; ub = uc; uc = S5_LOADU(k + 2); DBG_END(3); LBAR(); } while (0)
        for (int k2 = 0; k2 + 1 < nblk; k2 += 2) { S5_ITER_B(k2, 0); S5_ITER_B(k2 + 1, 1); }
        if (nblk & 1) S5_ITER_B(nblk - 1, 0);
        if ((nblk - 1) & 1) S5_Y(nblk - 1, 1); else S5_Y(nblk - 1, 0);
        DBG_REPORT(!sample && item == 0);
#undef S5_ITER_B
#undef S5_Y
    }
    LBAR();
#undef S5_BU
#undef S5_SB
#undef S5_LOADU
}

__device__ __forceinline__ void outa_rows(const Args& A, int lane, int gw, int NGW) {
    unsigned char* ws = A.ws;
    const bf16* HS = (const bf16*)(ws + WS_HS); const bf16* OG = (const bf16*)(ws + WS_OG); const float* HSS = (const float*)(ws + WS_HSS); bf16* MIXIN = (bf16*)(ws + WS_MIXIN);
    f32x4 gm[2][2];
#pragma unroll
    for (int i = 0; i < 2; ++i) { gm[i][0] = *(const f32x4*)(A.in[14] + 512 * i + 8 * lane); gm[i][1] = *(const f32x4*)(A.in[14] + 512 * i + 8 * lane + 4); }
    for (int m = gw; m < MT; m += NGW) {
        f32x4 p0[2], p1[2]; v4u hv[2], ov[2];
#pragma unroll
        for (int i = 0; i < 2; ++i) { const int col = 512 * i + 8 * lane, hh = col >> 8;
            p0[i] = *(const GAS f32x4*)(HSS + (size_t)m * 32 + hh * 8); p1[i] = *(const GAS f32x4*)(HSS + (size_t)m * 32 + hh * 8 + 4);
            hv[i] = *(const GAS v4u*)(HS + (size_t)m * 1024 + col); ov[i] = *(const GAS v4u*)(OG + (size_t)m * 1024 + col); }
        v4u o[2];
#pragma unroll
        for (int i = 0; i < 2; ++i) {
            const float ss = (p0[i][0] + p0[i][1]) + (p0[i][2] + p0[i][3]) + (p1[i][0] + p1[i][1]) + (p1[i][2] + p1[i][3]);
            const float rstd = 1.0f / sqrtf(ss * (1.0f / DV) + EPS);
            o[i].x = cvtpk(bflo(hv[i].x) * rstd * gm[i][0][0] * sigmoidf_(bflo(ov[i].x)), bfhi(hv[i].x) * rstd * gm[i][0][1] * sigmoidf_(bfhi(ov[i].x)));
            o[i].y = cvtpk(bflo(hv[i].y) * rstd * gm[i][0][2] * sigmoidf_(bflo(ov[i].y)), bfhi(hv[i].y) * rstd * gm[i][0][3] * sigmoidf_(bfhi(ov[i].y)));
            o[i].z = cvtpk(bflo(hv[i].z) * rstd * gm[i][1][0] * sigmoidf_(bflo(ov[i].z)), bfhi(hv[i].z) * rstd * gm[i][1][1] * sigmoidf_(bfhi(ov[i].z)));
            o[i].w = cvtpk(bflo(hv[i].w) * rstd * gm[i][1][2] * sigmoidf_(bflo(ov[i].w)), bfhi(hv[i].w) * rstd * gm[i][1][3] * sigmoidf_(bfhi(ov[i].w))); }
#pragma unroll
        for (int i = 0; i < 2; ++i) *(GAS v4u*)(MIXIN + (size_t)m * 2048 + 512 * i + 8 * lane) = o[i];
    }
}
__device__ __forceinline__ float row_ss_part(const float* SSp, const float* SSs, int m, int lane) {
    if (m < MP) return (lane < 32) ? SSp[(size_t)m * 32 + lane] : 0.f;
    return SSs[(size_t)(m - MP) * 128 + lane] + SSs[(size_t)(m - MP) * 128 + 64 + lane];
}
__device__ __forceinline__ void rowpass1(const Args& A, int lane, int gw, int NGW) {
    unsigned char* ws = A.ws;
    const bf16* MIX = (const bf16*)(ws + WS_MIX); bf16* X1B = (bf16*)(ws + WS_X1B); float* RSTD2 = (float*)(ws + WS_SSS + SSS_RSTD2);
    const float* SSp = (const float*)(ws + WS_SS1); const float* SSs = (const float*)(ws + WS_SSS + SSS_1);
    const float* RSTD1 = (const float*)(ws + WS_SSS + SSS_RSTD1);
    f32x4 g1[8], gi[8];
#pragma unroll
    for (int j = 0; j < 8; ++j) { g1[j] = *(const f32x4*)(A.in[26] + 256 * j + 4 * lane); const f32x4 g0 = *(const f32x4*)(A.in[8] + 256 * j + 4 * lane);
        gi[j] = (f32x4){1.0f / g0[0], 1.0f / g0[1], 1.0f / g0[2], 1.0f / g0[3]}; }
    u32x2 va[8], vb[8], ma[8], mb[8]; float sa = 0.f, sb = 0.f, ra = 0.f, rb = 0.f;
#define RP1_LOAD(V, M, S, R, m_) do { const int mm_ = (m_); \
        S = row_ss_part(SSp, SSs, mm_, lane); R = RSTD1[mm_]; \
        _Pragma("unroll") for (int j = 0; j < 8; ++j) { const int k = 256 * j + 4 * lane; V[j] = *(const GAS u32x2*)(X1B + (size_t)mm_ * DM + k); M[j] = *(const GAS u32x2*)(MIX + (size_t)mm_ * DM + k); } } while (0)
#define RP1_PROC(V, M, S, R, m_) do { const int mm_ = (m_); \
        const float rstd1 = 1.0f / sqrtf(wave_sum(S) * (1.0f / DM) + EPS); float s = 0.f; f32x4 O[8]; \
        _Pragma("unroll") for (int j = 0; j < 8; ++j) { f32x4 o; o[0] = bflo(V[j].x) * R * gi[j][0] + bflo(M[j].x) * rstd1 * g1[j][0]; o[1] = bfhi(V[j].x) * R * gi[j][1] + bfhi(M[j].x) * rstd1 * g1[j][1]; \
            o[2] = bflo(V[j].y) * R * gi[j][2] + bflo(M[j].y) * rstd1 * g1[j][2]; o[3] = bfhi(V[j].y) * R * gi[j][3] + bfhi(M[j].y) * rstd1 * g1[j][3]; \
            s += (o[0] * o[0] + o[1] * o[1]) + (o[2] * o[2] + o[3] * o[3]); O[j] = o; } \
        const float ms2 = wave_sum(s) * (1.0f / DM) + EPS, rstd2 = 1.0f / sqrtf(ms2); \
        _Pragma("unroll") for (int j = 0; j < 8; ++j) { u32x2 o; o.x = cvtpk(O[j][0] * rstd2, O[j][1] * rstd2); o.y = cvtpk(O[j][2] * rstd2, O[j][3] * rstd2); \
            *(GAS u32x2*)(X1B + (size_t)mm_ * DM + 256 * j + 4 * lane) = o; } \
        if (lane == 0) RSTD2[mm_] = sqrtf(ms2); } while (0)
    int m = gw;
    if (m < MT) { RP1_LOAD(va, ma, sa, ra, m);
        for (;;) { const int m2 = m + NGW; if (m2 < MT) RP1_LOAD(vb, mb, sb, rb, m2); RP1_PROC(va, ma, sa, ra, m); if (m2 >= MT) break;
                   m = m2 + NGW; if (m < MT) RP1_LOAD(va, ma, sa, ra, m); RP1_PROC(vb, mb, sb, rb, m2); if (m >= MT) break; } }
#undef RP1_LOAD
#undef RP1_PROC
}
__device__ __forceinline__ void rowpass2(const Args& A, int lane, int gw, int NGW) {
    unsigned char* ws = A.ws;
    const bf16* FF = (const bf16*)(ws + WS_FF); const bf16* X1B = (const bf16*)(ws + WS_X1B);
    const float* SSp = (const float*)(ws + WS_SS2); const float* SSs = (const float*)(ws + WS_SSS + SSS_2);
    f32x4 g3[8];
#pragma unroll
    for (int j = 0; j < 8; ++j) g3[j] = *(const f32x4*)(A.in[31] + 256 * j + 4 * lane);
    u32x2 xa[8], xb[8], fa[8], fb[8]; float sa = 0.f, sb = 0.f;
    const float* RSTD2 = (const float*)(ws + WS_SSS + SSS_RSTD2); float ra = 0.f, rb = 0.f;
#define RP2_LOAD(X, F, S, R, m_) do { const int mm_ = (m_); S = row_ss_part(SSp, SSs, mm_, lane); R = RSTD2[mm_]; \
        _Pragma("unroll") for (int j = 0; j < 8; ++j) { const int k = 256 * j + 4 * lane; X[j] = *(const GAS u32x2*)(X1B + (size_t)mm_ * DM + k); F[j] = *(const GAS u32x2*)(FF + (size_t)mm_ * DM + k); } } while (0)
#define RP2_PROC(X, F, S, R, m_) do { const int mm_ = (m_); float* orow = A.out + O_Y + (size_t)mm_ * DM; const float rstd = 1.0f / sqrtf(wave_sum(S) * (1.0f / DM) + EPS); f32x4 V[8]; \
        _Pragma("unroll") for (int j = 0; j < 8; ++j) { V[j][0] = bflo(X[j].x) * R + bflo(F[j].x) * rstd * g3[j][0]; V[j][1] = bfhi(X[j].x) * R + bfhi(F[j].x) * rstd * g3[j][1]; V[j][2] = bflo(X[j].y) * R + bflo(F[j].y) * rstd * g3[j][2]; V[j][3] = bfhi(X[j].y) * R + bfhi(F[j].y) * rstd * g3[j][3]; } \
        DBG_PERTURB(V, mm_); \
        _Pragma("unroll") for (int j = 0; j < 8; ++j) __builtin_nontemporal_store(V[j], (GAS f32x4*)(orow + 256 * j + 4 * lane)); } while (0)
    int m = gw;
    if (m < MT) { RP2_LOAD(xa, fa, sa, ra, m);
        for (;;) { const int m2 = m + NGW; if (m2 < MT) RP2_LOAD(xb, fb, sb, rb, m2); RP2_PROC(xa, fa, sa, ra, m); if (m2 >= MT) break;
                   m = m2 + NGW; if (m < MT) RP2_LOAD(xa, fa, sa, ra, m); RP2_PROC(xb, fb, sb, rb, m2); if (m >= MT) break; } }
#undef RP2_LOAD
#undef RP2_PROC
}
#ifndef MK_AL_P4
#define MK_AL_P4 true
#endif
#ifndef MK_AL_SS
#define MK_AL_SS true
#endif
#ifndef MK_WGM_P5
#define MK_WGM_P5 4
#endif
#ifndef MK_WGM_P1
#define MK_WGM_P1 2
#endif
#ifndef MK_WGM_P7
#define MK_WGM_P7 4
#endif
#ifndef MK_WGM_P8
#define MK_WGM_P8 1
#endif
#ifndef MK_GU_ALIGN
#define MK_GU_ALIGN true
#endif
#ifndef MK_GU_SP2
#define MK_GU_SP2 true
#endif
__global__ void __launch_bounds__(NWAVES * 64, 2) hymba_fwd(Args args) {
    extern __shared__ __attribute__((aligned(16))) unsigned char lds_raw[];
    LAS unsigned char* lds = (LAS unsigned char*)lds_raw;
    volatile LAS unsigned* MISC = (volatile LAS unsigned*)(lds + MISC_OFF);
    const int tid = threadIdx.x, lane = tid & 63, wave = __builtin_amdgcn_readfirstlane(tid >> 6);
    const int G = gridDim.x; const int bx = blockIdx.x; const int vcu = (G % 8 == 0) ? (bx % 8) * (G / 8) + bx / 8 : bx;
    unsigned char* ws = args.ws;
    gu32* ctl = (gu32*)(ws + WS_CTL);
    for (int u = tid; u < (LDS_BYTES - LDSCTL_OFF) / 4; u += NWAVES * 64) ((LAS unsigned*)(lds + LDSCTL_OFF))[u] = 0u;
    __syncthreads();
    const XcdBarrier bar = xcd_barrier_post((unsigned*)(ctl + CW_BAR) + args.li * XCD_BAR_WORDS, MISC + 8);
#define GRID_BAR() xcd_barrier(bar)
    const int lo = args.ph_lo, hi = args.ph_hi;
#define IN(k) (lo <= (k) && (k) < hi)
#define BOTH(k) (IN(k) && IN((k) + 1))

    const int gw = vcu * NWAVES + wave, NGW = G * NWAVES;

    if (IN(0)) { p0_prologue(args, lds, tid, lane, wave, vcu, G); if (BOTH(0)) GRID_BAR(); }

    if (IN(1)) {
        { pg8::Gemm g{(const bf16*)(ws + WS_XN), (const bf16*)(ws + WS_WIN), MP, 4096, DM}; pg8::StaticOrder S; S.init(MP, 4096, G, bx, MK_WGM_P1);
          pg8::EpiBf16<0> E{(bf16*)(ws + WS_QKRAW), 1024, nullptr, 1024, (size_t)WS_RSTRIDE / 2, 1.f};
          pg8::gemm_phase<pg8::EpiBf16<0>, pg8::StaticOrder, true, true>(lds + RING_OFF, g, S, E); }
        { bf16* O = (bf16*)(ws + WS_QKRAW);
          skinny_gemm<1, DM>((const bf16*)(ws + WS_XN) + (size_t)MP * DM, (const bf16*)(ws + WS_WIN), lds, 4096 / 16, vcu, G, tid, wave, lane,
              [](int it, int a, int fr) { return 16 * it + fr; },
              [O](int it, int row, int fq, const f32x4 (&acc)[1]) { const int col = 16 * it + 4 * fq, t = col >> 10;
                  u32x2 w; w.x = cvtpk_n(acc[0][0], acc[0][1]); w.y = cvtpk_n(acc[0][2], acc[0][3]);
                  *(GAS u32x2*)(O + (size_t)t * (WS_RSTRIDE / 2) + (size_t)(MP + row) * 1024 + (col & 1023)) = w; }); }
        if (BOTH(1)) GRID_BAR();
    }

    if (IN(2)) { if (vcu < 64) p2_scalars(args, lds, lane, wave, vcu); p2_conv(args, tid, vcu, G); if (BOTH(2)) GRID_BAR(); }

    if (IN(3)) {
        const int half = G / 2;
#ifndef MK_REP_M
#define MK_REP_M 1
#endif
#ifndef MK_REP_S
#define MK_REP_S 1
#endif
        if (vcu < half) { for (int rp_ = 0; rp_ < MK_REP_M; ++rp_) for (int it = vcu; it < NBATCH * NH * NSL; it += half) mlstm_item(args, lds, tid, lane, wave, it); }
        else { const int nb = G - half, bi = vcu - half;
               for (int rp_ = 0; rp_ < MK_REP_S; ++rp_)
               for (int it = bi * 4 + (wave & 3); it < 2 * NBATCH * NG; it += nb * 4) s5_item(args, lds + (wave & 3) * 25600, lane, wave >> 2, it); }
        if (vcu >= half) { __syncthreads(); for (int it = NBATCH * NH * NSL + (vcu - half); it < 2 * NBATCH * NH * NSL; it += G - half) mlstm_item(args, lds, tid, lane, wave, it); }
        if (BOTH(3)) GRID_BAR();
    }

    if (IN(4)) {
        { pg8::Gemm g{(const bf16*)(ws + WS_Z), (const bf16*)(ws + WS_WGLU), MP, 1024, 1024}; pg8::StaticOrder S; S.init(MP, 1024, G, bx);
          pg8::EpiGlu E{(const bf16*)(ws + WS_Z), (bf16*)(ws + WS_MIXIN), args.in[24]};
          pg8::gemm_phase<pg8::EpiGlu, pg8::StaticOrder, MK_AL_P4, true>(lds + RING_OFF, g, S, E); }
        { const bf16* Zb = (const bf16*)(ws + WS_Z); bf16* O = (bf16*)(ws + WS_MIXIN); const float* bias = args.in[24];
          skinny_gemm<1, 1024>(Zb + (size_t)MP * 1024, (const bf16*)(ws + WS_WGLU), lds, 1024 / 16, vcu, G, tid, wave, lane,
              [](int it, int a, int fr) { return 16 * it + fr; },
              [Zb, O, bias](int it, int row, int fq, const f32x4 (&acc)[1]) { const int col = 16 * it + 4 * fq; const size_t m = (size_t)(MP + row);
                  const u32x2 z = *(const GAS u32x2*)(Zb + m * 1024 + col); const f32x4 bv = *(const f32x4*)(bias + col);
                  u32x2 w; w.x = cvtpk(bflo(z.x) * sigmoidf_(acc[0][0] + bv[0]), bfhi(z.x) * sigmoidf_(acc[0][1] + bv[1]));
                  w.y = cvtpk(bflo(z.y) * sigmoidf_(acc[0][2] + bv[2]), bfhi(z.y) * sigmoidf_(acc[0][3] + bv[3]));
                  *(GAS u32x2*)(O + m * 2048 + 1024 + col) = w; }); }
        outa_rows(args, lane, gw, NGW);
        if (BOTH(4)) GRID_BAR();
    }

    if (IN(5)) {
        { pg8::Gemm g{(const bf16*)(ws + WS_MIXIN), (const bf16*)(ws + WS_WOUT), MP, DM, DM}; pg8::StaticOrder S; S.init(MP, DM, G, bx, MK_WGM_P5);
          pg8::EpiSS E{(bf16*)(ws + WS_MIX), DM, (float*)(ws + WS_SS1)};
          pg8::gemm_phase<pg8::EpiSS, pg8::StaticOrder, MK_AL_SS, true>(lds + RING_OFF, g, S, E); }
        { bf16* O = (bf16*)(ws + WS_MIX); float* SSs = (float*)(ws + WS_SSS + SSS_1);
          skinny_gemm<1, DM>((const bf16*)(ws + WS_MIXIN) + (size_t)MP * DM, (const bf16*)(ws + WS_WOUT), lds, DM / 16, vcu, G, tid, wave, lane,
              [](int it, int a, int fr) { return 16 * it + fr; },
              [O, SSs](int it, int row, int fq, const f32x4 (&acc)[1]) { const int col = 16 * it + 4 * fq;
                  u32x2 w; w.x = cvtpk_n(acc[0][0], acc[0][1]); w.y = cvtpk_n(acc[0][2], acc[0][3]);
                  *(GAS u32x2*)(O + (size_t)(MP + row) * DM + col) = w;
                  float s = (acc[0][0] * acc[0][0] + acc[0][1] * acc[0][1]) + (acc[0][2] * acc[0][2] + acc[0][3] * acc[0][3]);
                  s += __shfl_xor(s, 16); s += __shfl_xor(s, 32);
                  if (fq == 0) SSs[(size_t)row * 128 + it] = s; }); }
        if (BOTH(5)) GRID_BAR();
    }

    if (IN(6)) { rowpass1(args, lane, gw, NGW); if (BOTH(6)) GRID_BAR(); }

    if (IN(7)) {
        { pg8::Gemm g{(const bf16*)(ws + WS_X1B), (const bf16*)(ws + WS_WGU), MP, 2 * DFF, DM}; pg8::StaticOrder S; S.init(MP, 2 * DFF, G, bx, MK_WGM_P7);
          pg8::EpiGU E{(bf16*)(ws + WS_ACT), DFF};
          pg8::gemm_phase<pg8::EpiGU, pg8::StaticOrder, MK_GU_ALIGN, MK_GU_SP2>(lds + RING_OFF, g, S, E); }
        { bf16* O = (bf16*)(ws + WS_ACT);
          skinny_gemm<2, DM>((const bf16*)(ws + WS_X1B) + (size_t)MP * DM, (const bf16*)(ws + WS_WGU), lds, DFF / 16, vcu, G, tid, wave, lane,
              [](int it, int a, int fr) { const int j = 16 * it + fr; return 256 * (j >> 7) + 128 * a + (j & 127); },
              [O](int it, int row, int fq, const f32x4 (&acc)[2]) { const int col = 16 * it + 4 * fq; const f32x4 g = acc[0], up = acc[1];
                  u32x2 w; w.x = cvtpk(g[0] * sigmoidf_(g[0]) * up[0], g[1] * sigmoidf_(g[1]) * up[1]);
                  w.y = cvtpk(g[2] * sigmoidf_(g[2]) * up[2], g[3] * sigmoidf_(g[3]) * up[3]);
                  *(GAS u32x2*)(O + (size_t)(MP + row) * DFF + col) = w; }); }
        if (BOTH(7)) GRID_BAR();
    }

    if (IN(8)) {
        { pg8::Gemm g{(const bf16*)(ws + WS_ACT), (const bf16*)(ws + WS_WD), MP, DM, DFF}; pg8::StaticOrder S; S.init(MP, DM, G, bx, MK_WGM_P8);
          pg8::EpiSS E{(bf16*)(ws + WS_FF), DM, (float*)(ws + WS_SS2)};
          pg8::gemm_phase<pg8::EpiSS, pg8::StaticOrder, MK_AL_SS, true>(lds + RING_OFF, g, S, E); }
        { bf16* O = (bf16*)(ws + WS_FF); float* SSs = (float*)(ws + WS_SSS + SSS_2);
          skinny_gemm<1, DFF>((const bf16*)(ws + WS_ACT) + (size_t)MP * DFF, (const bf16*)(ws + WS_WD), lds, DM / 16, vcu, G, tid, wave, lane,
              [](int it, int a, int fr) { return 16 * it + fr; },
              [O, SSs](int it, int row, int fq, const f32x4 (&acc)[1]) { const int col = 16 * it + 4 * fq;
                  u32x2 w; w.x = cvtpk_n(acc[0][0], acc[0][1]); w.y = cvtpk_n(acc[0][2], acc[0][3]);
                  *(GAS u32x2*)(O + (size_t)(MP + row) * DM + col) = w;
                  float s = (acc[0][0] * acc[0][0] + acc[0][1] * acc[0][1]) + (acc[0][2] * acc[0][2] + acc[0][3] * acc[0][3]);
                  s += __shfl_xor(s, 16); s += __shfl_xor(s, 32);
                  if (fq == 0) SSs[(size_t)row * 128 + it] = s; }); }
        if (BOTH(8)) GRID_BAR();
    }

    if (IN(9)) { rowpass2(args, lane, gw, NGW); }
#undef IN
#undef BOTH
}

#ifdef MK_DUMP_OFF
__global__ void dump_kernel(const unsigned short* src, float* dst, size_t n) {
    for (size_t i = (size_t)blockIdx.x * blockDim.x + threadIdx.x; i < n; i += (size_t)gridDim.x * blockDim.x) dst[i] = __uint_as_float((unsigned)src[i] << 16);
}
#endif
extern "C" void kernel_launch(void* const* d_in, const int* in_sizes, int n_in, void* d_out, int out_size, void* d_ws, size_t ws_size, hipStream_t stream) {
    static int grid = 0;
    if (grid == 0) {
        if (n_in != 32 || out_size != (int)O_END || ws_size < WS_END) { fprintf(stderr, "kernel_launch: unexpected problem: n_in %d out %d ws %zu\n", n_in, out_size, ws_size); grid = -1; return; }
        int dev = 0, cus = 0, per_cu = 0;
        if (hipGetDevice(&dev) != hipSuccess || hipDeviceGetAttribute(&cus, hipDeviceAttributeMultiprocessorCount, dev) != hipSuccess) { grid = -1; return; }
        if (hipFuncSetAttribute((const void*)hymba_fwd, hipFuncAttributeMaxDynamicSharedMemorySize, LDS_BYTES) != hipSuccess) { fprintf(stderr, "kernel_launch: hipFuncSetAttribute failed\n"); grid = -1; return; }
        if (hipOccupancyMaxActiveBlocksPerMultiprocessor(&per_cu, (const void*)hymba_fwd, NWAVES * 64, LDS_BYTES) != hipSuccess || per_cu < 1) { fprintf(stderr, "kernel_launch: occupancy query reports %d\n", per_cu); per_cu = 1; }
        (void)hipGetLastError();
        grid = cus;
    }
    if (grid < 0) return;
    Args a{};
    for (int i = 0; i < 32; ++i) a.in[i] = (const float*)d_in[i];
    a.out = (float*)d_out; a.ws = (unsigned char*)d_ws;
    int lo[N_PHASES + 2], hi[N_PHASES + 2], nl = 0;
#if defined(MK_REPEAT)
    lo[0] = 0; hi[0] = MK_REPEAT + 1; lo[1] = MK_REPEAT; hi[1] = MK_REPEAT + 1; lo[2] = MK_REPEAT + 1; hi[2] = N_PHASES; nl = 3;
#else
    if (N_LAUNCHES == 1) { lo[0] = 0; hi[0] = N_PHASES; nl = 1; } else { for (int k = 0; k < N_PHASES; ++k) { lo[k] = k; hi[k] = k + 1; } nl = N_PHASES; }
#endif
    if (hipMemsetAsync((char*)d_ws + WS_CTL, 0, (size_t)(CW_BAR + nl * XCD_BAR_WORDS) * 4, stream) != hipSuccess) return;
    for (int li = 0; li < nl; ++li) {
        a.ph_lo = lo[li]; a.ph_hi = hi[li]; a.li = li;
        hipLaunchKernelGGL(hymba_fwd, dim3(grid), dim3(NWAVES * 64), LDS_BYTES, stream, a);
    }
#ifdef MK_DUMP_OFF
    hipLaunchKernelGGL(dump_kernel, dim3(2048), dim3(256), 0, stream, (const unsigned short*)((const unsigned char*)d_ws + (size_t)(MK_DUMP_OFF) * MiB), (float*)d_out, (size_t)(MK_DUMP_N));
#endif
}
```

```cpp
#define MK_N_LAUNCHES 1
#include <hip/hip_runtime.h>
#include <cstdio>
#include <cstdint>
#include <cmath>
namespace pg8 {
#define PG8_LAS __attribute__((address_space(3)))
typedef unsigned short bf16_t;
typedef short bf16x8 __attribute__((ext_vector_type(8)));
typedef float f32x4 __attribute__((ext_vector_type(4)));
typedef unsigned u32x4 __attribute__((ext_vector_type(4)));
constexpr int BM = 256, BK = 64, HALF = 128, HTB = HALF * BK * 2  , STAGE_BYTES = 8 * HTB, NXCD = 8, WGM = 4;

__host__ __device__ __forceinline__ int lds_byte(int r, int c) { const int st = (r >> 4) * 2 + (c >> 5), rr = r & 15, cc = c & 31, ob = rr * 64 + cc * 2; return st * 1024 + (ob ^ (((ob >> 9) & 1) << 5)); }
__host__ __device__ __forceinline__ void stage_rc(int b, int& R, int& C) { const int st = b / 1024, sb = b % 1024, swz = sb ^ (((sb >> 9) & 1) << 5); R = (st >> 1) * 16 + swz / 64; C = (st & 1) * 32 + (swz % 64) / 2; }
__host__ __device__ __forceinline__ int perm32(int rho) { const int n = rho >> 4, i = rho & 15; return 8 * (i >> 2) + 4 * n + (i & 3); }

struct Unit { int pm, pn; };
struct Gemm { const bf16_t* A; const bf16_t* Bt; int M, N, K; };

struct StaticOrder {
    int nM, nN, nwg, G, c, wgm;
    __host__ __device__ void init(int M, int N, int G_, int c_, int wgm_ = WGM) { nM = M / BM; nN = N / BM; nwg = nM * nN; G = G_; c = c_; wgm = wgm_; }
    __host__ __device__ bool next(int i, Unit& u) const {
        const long L = (long)i * G + c; if (L >= nwg) return false;
        int wgid = (int)L; { const int q = nwg / NXCD, r = nwg % NXCD, xcd = wgid % NXCD, off = wgid / NXCD; wgid = (xcd < r ? xcd * (q + 1) : r * (q + 1) + (xcd - r) * q) + off; }
        const int nig = wgm * nN, gid = wgid / nig, fm = gid * wgm, gsz = (nM - fm) < wgm ? (nM - fm) : wgm;
        u.pm = fm + ((wgid % nig) % gsz); u.pn = (wgid % nig) / gsz; return true;
    }
    __device__ __forceinline__ void a_ready(const Unit&) const {}
    __device__ __forceinline__ void done(const Unit&) const {}
};

__device__ __forceinline__ unsigned cvt_pk_bf16(float lo, float hi) { unsigned r; asm volatile("v_cvt_pk_bf16_f32 %0, %1, %2" : "=v"(r) : "v"(lo), "v"(hi)); return r; }
typedef float f32x2 __attribute__((ext_vector_type(2)));
__device__ __forceinline__ f32x2 gelu_pk(f32x2 v) {
    const f32x2 av = __builtin_elementwise_abs(v), d = av * 0.2316418882f + 1.0f;
    f32x2 t; t.x = __builtin_amdgcn_rcpf(d.x); t.y = __builtin_amdgcn_rcpf(d.y);
    f32x2 q = t * 0.5307027145f + (-0.7265760135f); q = q * t + 0.7107068705f; q = q * t + (-0.142248368f); q = q * t + 0.127414796f; q = q * t;
    const f32x2 s = (v * v) * (-0.72134752044f);
    f32x2 e; e.x = __builtin_amdgcn_exp2f(s.x); e.y = __builtin_amdgcn_exp2f(s.y);
    const f32x2 m = v * (q * e), r = v - m;
    f32x2 o; o.x = v.x < 0.f ? m.x : r.x; o.y = v.y < 0.f ? m.y : r.y; return o;
}

template <int ACT  > struct EpiBf16 {
    static constexpr bool PERM = true, AFTER_DRAIN = false; static_assert(ACT == 0 || ACT == 1, "EpiBf16: ACT is 0 (none) or 1 (gelu_pk)");
    bf16_t* O; int ldc; const float* bias; int split_cols; size_t split_stride; float scale0;
    __device__ __forceinline__ void operator()(const f32x4 (&acc)[2][2][4][2], const Unit& u, int wr, int wc, int fr, int fq) const {
        const int row0 = u.pm * BM + wr * 64 + fr; int colt = u.pn * BM; bf16_t* base = O;
        float sc = 1.f; if (split_cols) { const int t = colt / split_cols; base += (size_t)t * split_stride; colt -= t * split_cols; if (t == 0) sc = scale0; }
        const int col0 = colt + wc * 32 + 8 * fq, bcol0 = u.pn * BM + wc * 32 + 8 * fq;
        f32x4 bv[2][2];
#pragma unroll
        for (int bj = 0; bj < 2; ++bj)
#pragma unroll
            for (int n = 0; n < 2; ++n) bv[bj][n] = bias ? *(const f32x4*)(bias + bcol0 + bj * HALF + 4 * n) : (f32x4){0.f, 0.f, 0.f, 0.f};
#pragma unroll
        for (int ai = 0; ai < 2; ++ai)
#pragma unroll
            for (int m = 0; m < 4; ++m) { bf16_t* rowp = base + (size_t)(row0 + ai * HALF + m * 16) * ldc + col0;
#pragma unroll
                for (int bj = 0; bj < 2; ++bj) { f32x4 v0 = acc[ai][bj][m][0] + bv[bj][0], v1 = acc[ai][bj][m][1] + bv[bj][1];
                    if (ACT == 1) { f32x2 a = gelu_pk((f32x2){v0[0], v0[1]}), b = gelu_pk((f32x2){v0[2], v0[3]}), c = gelu_pk((f32x2){v1[0], v1[1]}), d = gelu_pk((f32x2){v1[2], v1[3]});
                        v0 = (f32x4){a.x, a.y, b.x, b.y}; v1 = (f32x4){c.x, c.y, d.x, d.y}; }
                    v0 = v0 * sc; v1 = v1 * sc; u32x4 w; w.x = cvt_pk_bf16(v0[0], v0[1]); w.y = cvt_pk_bf16(v0[2], v0[3]); w.z = cvt_pk_bf16(v1[0], v1[1]); w.w = cvt_pk_bf16(v1[2], v1[3]);
                    *(u32x4*)(rowp + bj * HALF) = w; } }
    }
};
__device__ __forceinline__ float fast_sigmoid(float v) { return __builtin_amdgcn_rcpf(1.0f + __expf(-v)); }
__device__ __forceinline__ float bf_lo(unsigned w) { return __uint_as_float(w << 16); }
__device__ __forceinline__ float bf_hi(unsigned w) { return __uint_as_float(w & 0xffff0000u); }
struct EpiGlu {
    static constexpr bool PERM = true, AFTER_DRAIN = false;
    const bf16_t* Z; bf16_t* O; const float* bias;
    __device__ __forceinline__ void operator()(const f32x4 (&acc)[2][2][4][2], const Unit& u, int wr, int wc, int fr, int fq) const {
        const int row0 = u.pm * BM + wr * 64 + fr, col0 = u.pn * BM + wc * 32 + 8 * fq;
        f32x4 bv[2][2];
#pragma unroll
        for (int bj = 0; bj < 2; ++bj)
#pragma unroll
            for (int n = 0; n < 2; ++n) bv[bj][n] = *(const f32x4*)(bias + col0 + bj * HALF + 4 * n);
#pragma unroll
        for (int ai = 0; ai < 2; ++ai) {
            u32x4 z[4][2];
#pragma unroll
            for (int m = 0; m < 4; ++m)
#pragma unroll
                for (int bj = 0; bj < 2; ++bj) z[m][bj] = *(const u32x4*)(Z + (size_t)(row0 + ai * HALF + m * 16) * 1024 + col0 + bj * HALF);
#pragma unroll
            for (int m = 0; m < 4; ++m) { const size_t row = (size_t)(row0 + ai * HALF + m * 16);
#pragma unroll
                for (int bj = 0; bj < 2; ++bj) { const int col = col0 + bj * HALF; const u32x4 zz = z[m][bj];
                    const f32x4 v0 = acc[ai][bj][m][0] + bv[bj][0], v1 = acc[ai][bj][m][1] + bv[bj][1];
                    u32x4 w;
                    w.x = cvt_pk_bf16(bf_lo(zz.x) * fast_sigmoid(v0[0]), bf_hi(zz.x) * fast_sigmoid(v0[1]));
                    w.y = cvt_pk_bf16(bf_lo(zz.y) * fast_sigmoid(v0[2]), bf_hi(zz.y) * fast_sigmoid(v0[3]));
                    w.z = cvt_pk_bf16(bf_lo(zz.z) * fast_sigmoid(v1[0]), bf_hi(zz.z) * fast_sigmoid(v1[1]));
                    w.w = cvt_pk_bf16(bf_lo(zz.w) * fast_sigmoid(v1[2]), bf_hi(zz.w) * fast_sigmoid(v1[3]));
                    *(u32x4*)(O + row * 2048 + 1024 + col) = w; } } }
    }
};
struct EpiSS {
    static constexpr bool PERM = true, AFTER_DRAIN = false;
    bf16_t* O; int ldc; float* SS;
    __device__ __forceinline__ void operator()(const f32x4 (&acc)[2][2][4][2], const Unit& u, int wr, int wc, int fr, int fq) const {
        const int row0 = u.pm * BM + wr * 64 + fr, col0 = u.pn * BM + wc * 32 + 8 * fq;
        float s[2][4];
#pragma unroll
        for (int ai = 0; ai < 2; ++ai)
#pragma unroll
            for (int m = 0; m < 4; ++m) { const size_t row = (size_t)(row0 + ai * HALF + m * 16); float t = 0.f;
#pragma unroll
                for (int bj = 0; bj < 2; ++bj) { const f32x4 v0 = acc[ai][bj][m][0], v1 = acc[ai][bj][m][1];
                    t += (v0[0] * v0[0] + v0[1] * v0[1]) + (v0[2] * v0[2] + v0[3] * v0[3]) + (v1[0] * v1[0] + v1[1] * v1[1]) + (v1[2] * v1[2] + v1[3] * v1[3]);
                    u32x4 w; w.x = cvt_pk_bf16(v0[0], v0[1]); w.y = cvt_pk_bf16(v0[2], v0[3]); w.z = cvt_pk_bf16(v1[0], v1[1]); w.w = cvt_pk_bf16(v1[2], v1[3]);
                    *(u32x4*)(O + row * ldc + col0 + bj * HALF) = w; }
                s[ai][m] = t; }
#pragma unroll
        for (int ai = 0; ai < 2; ++ai)
#pragma unroll
            for (int m = 0; m < 4; ++m) s[ai][m] += __shfl_xor(s[ai][m], 16);
#pragma unroll
        for (int ai = 0; ai < 2; ++ai)
#pragma unroll
            for (int m = 0; m < 4; ++m) s[ai][m] += __shfl_xor(s[ai][m], 32);
        if (fq == 0) {
#pragma unroll
            for (int ai = 0; ai < 2; ++ai)
#pragma unroll
                for (int m = 0; m < 4; ++m) SS[(size_t)(row0 + ai * HALF + m * 16) * 32 + u.pn * 4 + wc] = s[ai][m]; }
    }
};
struct EpiGU {
    static constexpr bool PERM = true, AFTER_DRAIN = false;
    bf16_t* O; int ldc;
    static __device__ __forceinline__ unsigned swiglu_pk(f32x2 g, f32x2 u) {
        const f32x2 t = g * -1.4426950408889634f; f32x2 e; e.x = __builtin_amdgcn_exp2f(t.x); e.y = __builtin_amdgcn_exp2f(t.y);
        const f32x2 d = e + 1.0f; f32x2 s; s.x = __builtin_amdgcn_rcpf(d.x); s.y = __builtin_amdgcn_rcpf(d.y);
        const f32x2 o = (g * u) * s; return cvt_pk_bf16(o.x, o.y);
    }
    __device__ __forceinline__ void operator()(const f32x4 (&acc)[2][2][4][2], const Unit& u, int wr, int wc, int fr, int fq) const {
        const int row0 = u.pm * BM + wr * 64 + fr, col0 = u.pn * HALF + wc * 32 + 8 * fq;
#pragma unroll
        for (int ai = 0; ai < 2; ++ai)
#pragma unroll
            for (int m = 0; m < 4; ++m) { const size_t row = (size_t)(row0 + ai * HALF + m * 16);
                const f32x4 g0 = acc[ai][0][m][0], g1 = acc[ai][0][m][1], u0 = acc[ai][1][m][0], u1 = acc[ai][1][m][1];
                u32x4 w;
                w.x = swiglu_pk((f32x2){g0[0], g0[1]}, (f32x2){u0[0], u0[1]});
                w.y = swiglu_pk((f32x2){g0[2], g0[3]}, (f32x2){u0[2], u0[3]});
                w.z = swiglu_pk((f32x2){g1[0], g1[1]}, (f32x2){u1[0], u1[1]});
                w.w = swiglu_pk((f32x2){g1[2], g1[3]}, (f32x2){u1[2], u1[3]});
                *(u32x4*)(O + row * ldc + col0) = w; }
    }
};
template <class Epi, class Sched, bool ALIGN_EPI = false, bool SP2 = false>
__device__ __forceinline__ void gemm_phase(PG8_LAS unsigned char* lds, const Gemm g, const Sched& S, const Epi& E) {
    const int tid = threadIdx.x, wid = __builtin_amdgcn_readfirstlane(tid >> 6), lane = tid & 63, wr = wid >> 2, wc = wid & 3, fr = lane & 15, fq = lane >> 4;
    const int K = g.K, nt = K / BK;
    unsigned voffA[2], voffB[2];
#pragma unroll
    for (int i = 0; i < 2; ++i) { int R, C; stage_rc(tid * 16 + i * 8192, R, C); const int Rb = Epi::PERM ? ((R & ~31) + perm32(R & 31)) : R;
        voffA[i] = (unsigned)(R * K + C) * 2u; voffB[i] = (unsigned)(Rb * K + C) * 2u; }
    const size_t kstep = (size_t)(BK * 2);
    const size_t hstep = (size_t)HALF * K * 2;
    const size_t tstep = 2 * hstep;
    const unsigned ldsw = (unsigned)wid * 1024u;
    const int aoff = lds_byte(wr * 64 + fr, fq * 8), boff = lds_byte(wc * 32 + fr, fq * 8);
#define PG8_SA(b, h) (((b) * 2 + (h)) * HTB)
#define PG8_SB(b, h) ((4 + (b) * 2 + (h)) * HTB)
#define PG8_STAGE(bufoff, gbase, voff) do { _Pragma("unroll") for (int _i = 0; _i < 2; ++_i) \
        __builtin_amdgcn_global_load_lds((const unsigned*)((const char*)(gbase) + (voff)[_i]), (PG8_LAS unsigned*)(lds + (bufoff) + ldsw + _i * 8192), 16, 0, 0); } while (0)
#define PG8_LDA(dst, b, h) do { _Pragma("unroll") for (int m = 0; m < 4; ++m) _Pragma("unroll") for (int k = 0; k < 2; ++k) dst[m][k] = *(const PG8_LAS bf16x8*)(lds + PG8_SA(b, h) + aoff + m * 2048 + k * 1024); } while (0)
#define PG8_LDB(dst, b, h) do { _Pragma("unroll") for (int n = 0; n < 2; ++n) _Pragma("unroll") for (int k = 0; k < 2; ++k) dst[n][k] = *(const PG8_LAS bf16x8*)(lds + PG8_SB(b, h) + boff + n * 2048 + k * 1024); } while (0)
#define PG8_MMA(ai, bj, At, Bt) do { __builtin_amdgcn_s_setprio(1); _Pragma("unroll") for (int m = 0; m < 4; ++m) _Pragma("unroll") for (int n = 0; n < 2; ++n) _Pragma("unroll") for (int k = 0; k < 2; ++k) \
        acc[ai][bj][m][n] = __builtin_amdgcn_mfma_f32_16x16x32_bf16(Bt[n][k], At[m][k], acc[ai][bj][m][n], 0, 0, 0); __builtin_amdgcn_s_setprio(0); } while (0)
#define PG8_WAIT_V(n) asm volatile("s_waitcnt vmcnt(" #n ")" ::: "memory")
#define PG8_WAIT_L(n) asm volatile("s_waitcnt lgkmcnt(" #n ")" ::: "memory")
#define PG8_BAR __builtin_amdgcn_s_barrier()
#define PG8_SCHED __builtin_amdgcn_sched_barrier(0)
    Unit cur, nxt; int ui = 0;
    if (!S.next(0, cur)) return;
    f32x4 acc[2][2][4][2];
#pragma unroll
    for (int a = 0; a < 2; ++a)
#pragma unroll
        for (int b = 0; b < 2; ++b)
#pragma unroll
            for (int m = 0; m < 4; ++m)
#pragma unroll
                for (int n = 0; n < 2; ++n) acc[a][b][m][n] = (f32x4){0.f, 0.f, 0.f, 0.f};
    bf16x8 At[4][2], B0[2][2], B1[2][2];
    const char* cA = (const char*)g.A + (size_t)cur.pm * tstep; const char* cB = (const char*)g.Bt + (size_t)cur.pn * tstep;
    S.a_ready(cur);
    if constexpr (SP2) {
        PG8_STAGE(PG8_SB(0, 0), cB, voffB); PG8_STAGE(PG8_SB(0, 1), cB + hstep, voffB); PG8_STAGE(PG8_SA(0, 0), cA, voffA); PG8_STAGE(PG8_SA(0, 1), cA + hstep, voffA);
        if (wr == 1) PG8_BAR;
        PG8_WAIT_V(2); PG8_BAR;
        PG8_STAGE(PG8_SB(1, 0), cB + kstep, voffB); PG8_STAGE(PG8_SA(1, 0), cA + kstep, voffA); PG8_STAGE(PG8_SB(1, 1), cB + hstep + kstep, voffB);
        PG8_WAIT_V(6); PG8_BAR;
    } else {
        PG8_STAGE(PG8_SB(0, 0), cB, voffB); PG8_STAGE(PG8_SA(0, 0), cA, voffA); PG8_STAGE(PG8_SB(0, 1), cB + hstep, voffB); PG8_STAGE(PG8_SA(0, 1), cA + hstep, voffA);
        if (wr == 1) PG8_BAR;
        PG8_WAIT_V(4); PG8_BAR;
        PG8_STAGE(PG8_SB(1, 0), cB + kstep, voffB); PG8_STAGE(PG8_SA(1, 0), cA + kstep, voffA); PG8_STAGE(PG8_SB(1, 1), cB + hstep + kstep, voffB);
        PG8_WAIT_V(6); PG8_BAR;
    }
    for (;;) {
        const bool has_next = S.next(ui + 1, nxt);
        const char* nA = has_next ? (const char*)g.A + (size_t)nxt.pm * tstep : cA; const char* nB = has_next ? (const char*)g.Bt + (size_t)nxt.pn * tstep : cB;
        for (int t = 0; t < nt; t += 2) {
            const bool last = (t == nt - 2);
            const char* a1 = cA + (size_t)(t + 1) * kstep;
            const char* a2 = last ? nA : cA + (size_t)(t + 2) * kstep; const char* b2 = last ? nB : cB + (size_t)(t + 2) * kstep;
            const char* a3 = a2 + kstep; const char* b3 = b2 + kstep;
            if (last && has_next) S.a_ready(nxt);
            if constexpr (SP2) {
            PG8_LDB(B0, 0, 0); PG8_LDB(B1, 0, 1); PG8_SCHED; PG8_LDA(At, 0, 0); PG8_STAGE(PG8_SA(1, 1), a1 + hstep, voffA);
            PG8_WAIT_V(8); PG8_WAIT_L(0); PG8_BAR; PG8_MMA(0, 0, At, B0); PG8_MMA(0, 1, At, B1); PG8_BAR; PG8_SCHED;
            PG8_LDA(At, 0, 1); PG8_STAGE(PG8_SB(0, 0), b2, voffB); PG8_STAGE(PG8_SB(0, 1), b2 + hstep, voffB); PG8_STAGE(PG8_SA(0, 0), a2, voffA);
            PG8_WAIT_V(8); PG8_WAIT_L(0); PG8_BAR; PG8_MMA(1, 0, At, B0); PG8_MMA(1, 1, At, B1); PG8_BAR; PG8_SCHED;
            PG8_LDB(B0, 1, 0); PG8_LDB(B1, 1, 1); PG8_SCHED; PG8_LDA(At, 1, 0); PG8_STAGE(PG8_SA(0, 1), a2 + hstep, voffA);
            PG8_WAIT_V(8); PG8_WAIT_L(0); PG8_BAR; PG8_MMA(0, 0, At, B0); PG8_MMA(0, 1, At, B1); PG8_BAR; PG8_SCHED;
            PG8_LDA(At, 1, 1); PG8_STAGE(PG8_SB(1, 0), b3, voffB); PG8_STAGE(PG8_SB(1, 1), b3 + hstep, voffB); PG8_STAGE(PG8_SA(1, 0), a3, voffA);
            PG8_WAIT_V(8); PG8_WAIT_L(0); PG8_BAR; PG8_MMA(1, 0, At, B0); PG8_MMA(1, 1, At, B1); PG8_BAR; PG8_SCHED;
            } else {
            PG8_LDB(B0, 0, 0); PG8_SCHED; PG8_LDA(At, 0, 0); PG8_STAGE(PG8_SA(1, 1), a1 + hstep, voffA);
            PG8_WAIT_L(8); PG8_BAR; PG8_WAIT_L(0); PG8_MMA(0, 0, At, B0); PG8_BAR; PG8_SCHED;
            PG8_LDB(B1, 0, 1); PG8_STAGE(PG8_SB(0, 0), b2, voffB);
            PG8_BAR; PG8_WAIT_L(0); PG8_MMA(0, 1, At, B1); PG8_BAR;
            PG8_LDA(At, 0, 1); PG8_STAGE(PG8_SA(0, 0), a2, voffA);
            PG8_BAR; PG8_WAIT_L(0); PG8_MMA(1, 0, At, B0); PG8_BAR; PG8_SCHED;
            PG8_STAGE(PG8_SB(0, 1), b2 + hstep, voffB);
            PG8_WAIT_V(6); PG8_BAR; PG8_MMA(1, 1, At, B1); PG8_BAR;
            PG8_LDB(B0, 1, 0); PG8_SCHED; PG8_LDA(At, 1, 0); PG8_STAGE(PG8_SA(0, 1), a2 + hstep, voffA);
            PG8_WAIT_L(8); PG8_BAR; PG8_WAIT_L(0); PG8_MMA(0, 0, At, B0); PG8_BAR; PG8_SCHED;
            PG8_LDB(B1, 1, 1); PG8_STAGE(PG8_SB(1, 0), b3, voffB);
            PG8_BAR; PG8_WAIT_L(0); PG8_MMA(0, 1, At, B1); PG8_BAR;
            PG8_LDA(At, 1, 1); PG8_STAGE(PG8_SA(1, 0), a3, voffA);
            PG8_BAR; PG8_WAIT_L(0); PG8_MMA(1, 0, At, B0); PG8_BAR; PG8_SCHED;
            PG8_STAGE(PG8_SB(1, 1), b3 + hstep, voffB);
            PG8_WAIT_V(6); PG8_BAR; PG8_MMA(1, 1, At, B1); PG8_BAR;
            }
        }
        if constexpr (ALIGN_EPI) { if (wr == 0) PG8_BAR; }
        if constexpr (!Epi::AFTER_DRAIN) { E(acc, cur, wr, wc, fr, fq); S.done(cur); }
        if (!has_next) break;
#pragma unroll
        for (int a = 0; a < 2; ++a)
#pragma unroll
            for (int b = 0; b < 2; ++b)
#pragma unroll
                for (int m = 0; m < 4; ++m)
#pragma unroll
                    for (int n = 0; n < 2; ++n) acc[a][b][m][n] = (f32x4){0.f, 0.f, 0.f, 0.f};
        cur = nxt; cA = nA; cB = nB; ++ui;
        if constexpr (ALIGN_EPI) { if (wr == 1) PG8_BAR; }
    }
    PG8_WAIT_V(0);
    if constexpr (!ALIGN_EPI) { if (wr == 0) PG8_BAR; }
    PG8_BAR;
    if constexpr (Epi::AFTER_DRAIN) { E.fused(acc, cur, wr, wc, fr, fq, lds, wid, lane); S.done(cur); }
#undef PG8_SA
#undef PG8_SB
#undef PG8_STAGE
#undef PG8_LDA
#undef PG8_LDB
#undef PG8_MMA
#undef PG8_WAIT_V
#undef PG8_WAIT_L
#undef PG8_BAR
#undef PG8_SCHED
}
}
#define GAS __attribute__((address_space(1)))
#define LAS __attribute__((address_space(3)))
typedef unsigned short bf16;
typedef unsigned v4u __attribute__((ext_vector_type(4)));
typedef float f32x4 __attribute__((ext_vector_type(4)));
typedef short bf16x8 __attribute__((ext_vector_type(8)));
typedef GAS unsigned gu32;
typedef GAS unsigned long long gu64;
#define RLX_AGENT __ATOMIC_RELAXED, __HIP_MEMORY_SCOPE_AGENT
#define LDS_WAIT() asm volatile("s_waitcnt lgkmcnt(0)" ::: "memory")
#define VM_WAIT() asm volatile("s_waitcnt vmcnt(0)" ::: "memory")
__device__ __forceinline__ unsigned long long rt() { return __builtin_amdgcn_s_memrealtime(); }
__device__ __forceinline__ unsigned f2bf(float f) { unsigned u = __builtin_bit_cast(unsigned, f); return (u + 0x7fffu + ((u >> 16) & 1u)) >> 16; }
__device__ __forceinline__ unsigned pk2(float lo, float hi) { return f2bf(lo) | (f2bf(hi) << 16); }
#define XB_TMO      128
#define XB_XCNT(j)  (256  + 64 * (j))
#define XB_XSUB(j)  (1280 + 64 * (j))
#define XB_XGEN(j)  (2304 + 64 * (j))
#define XB_TOP      3328
#define XB_TOPGEN   3392
#define XCD_BAR_WORDS 3456
#define XB_SPIN_CAP (1u << 18)

__device__ __forceinline__ unsigned xb_ld(unsigned* p)              { return __hip_atomic_load(p, __ATOMIC_RELAXED, __HIP_MEMORY_SCOPE_AGENT); }
__device__ __forceinline__ unsigned xb_add(unsigned* p, unsigned v) { return __hip_atomic_fetch_add(p, v, __ATOMIC_RELAXED, __HIP_MEMORY_SCOPE_AGENT); }
__device__ __forceinline__ unsigned xb_xcc_id() { return (unsigned)__builtin_amdgcn_s_getreg((3 << 11) | 20) & 0xFu; }
#define XB_SPIN(cond, bar) do { unsigned _sp = 0; while (cond) { __builtin_amdgcn_s_sleep(1); \
    if ((++_sp & 255u) == 0u) { if (xb_ld(&(bar)[XB_TMO])) break; if (_sp > XB_SPIN_CAP) { atomicAdd(&(bar)[XB_TMO], 1u); break; } } } } while (0)

struct XcdBarrier {
    unsigned* bar; unsigned x;
    volatile LAS unsigned* st;
};

__device__ __forceinline__ XcdBarrier xcd_barrier_post(unsigned* bar, volatile LAS unsigned* st) {
    XcdBarrier b; b.bar = bar; b.x = xb_xcc_id(); b.st = st;
    if (threadIdx.x == 0) (void)xb_add(&bar[XB_XCNT(b.x)], 1u);
    return b;
}
__device__ __forceinline__ void xcd_barrier_complete(unsigned* bar, unsigned x, unsigned& nloc, unsigned& nx) {
    const unsigned G = gridDim.x * gridDim.y * gridDim.z;
    unsigned sum, cnt, mine, sp = 0u;
    for (;;) {
        sum = 0u; cnt = 0u; mine = 0u;
#pragma unroll
        for (unsigned j = 0; j < 16; ++j) { const unsigned c = xb_ld(&bar[XB_XCNT(j)]); sum += c; cnt += (c > 0u) ? 1u : 0u; mine = (j == x) ? c : mine; }
        if (sum == G) break;
        __builtin_amdgcn_s_sleep(1);
        if ((++sp & 255u) == 0u) { if (xb_ld(&bar[XB_TMO])) break; if (sp > XB_SPIN_CAP) { atomicAdd(&bar[XB_TMO], 1u); break; } }
    }
    nloc = mine > 0u ? mine : 1u; nx = cnt > 0u ? cnt : 1u;
}

__device__ __forceinline__ void xcd_barrier(const XcdBarrier& b) {
    asm volatile("s_waitcnt vmcnt(0)" ::: "memory");
    __syncthreads();
    if (threadIdx.x == 0) {
        unsigned* bar = b.bar;
        __builtin_amdgcn_s_waitcnt(0);
        unsigned nloc = b.st[0], nx = b.st[1];
        if (nloc == 0u) { xcd_barrier_complete(bar, b.x, nloc, nx); b.st[0] = nloc; b.st[1] = nx; }
        const unsigned old = xb_add(&bar[XB_XSUB(b.x)], 1u);
        const unsigned gen = old / nloc;
        if (old + 1u == (gen + 1u) * nloc) {
            __builtin_amdgcn_fence(__ATOMIC_RELEASE, "agent");
            asm volatile("s_waitcnt vmcnt(0)" ::: "memory");
            const unsigned og = xb_add(&bar[XB_TOP], 1u);
            const unsigned tg = og / nx;
            if (og + 1u == (tg + 1u) * nx) xb_add(&bar[XB_TOPGEN], 1u);
            else XB_SPIN(xb_ld(&bar[XB_TOPGEN]) == tg, bar);
            __builtin_amdgcn_fence(__ATOMIC_ACQUIRE, "agent");
            xb_add(&bar[XB_XGEN(b.x)], 1u);
            asm volatile("s_waitcnt vmcnt(0)" ::: "memory");
        } else {
            XB_SPIN(xb_ld(&bar[XB_XGEN(b.x)]) == gen, bar);
            __builtin_amdgcn_fence(__ATOMIC_ACQUIRE, "agent");
            asm volatile("s_waitcnt vmcnt(0)" ::: "memory");
        }
    }
    __syncthreads();
}
constexpr int NWAVES = 8;
#ifndef MK_N_LAUNCHES
#define MK_N_LAUNCHES 1
#endif
constexpr int N_PHASES = 10;
constexpr int N_LAUNCHES = MK_N_LAUNCHES;

constexpr int DM = 2048, NBATCH = 8, SEQ = 2048, MP = NBATCH * SEQ, SBATCH = 8, SLEN = 16, MS = SBATCH * SLEN, MT = MP + MS;
constexpr int NH = 4, DV = 256, DQK = 128, QKW = 1024, NG = 64, GCH = 16, PST = 64, DFF = 5632, NIN = 4104;
constexpr int CH = 64, NCH = SEQ / CH;
constexpr int NSC = NBATCH * NCH + SBATCH;
constexpr float EPS = 1e-6f;
constexpr int DVS = 64, NSL = DV / DVS;

constexpr size_t O_Y = 0, O_CONVP = (size_t)MT * DM, O_CP = O_CONVP + 8 * 3 * 1024, O_NP = O_CP + 8 * 4 * 256 * 128, O_MP = O_NP + 8 * 4 * 128,
                 O_SRP = O_MP + 32, O_SIP = O_SRP + 8 * 64 * 64, O_CONVS = O_SIP + 8 * 64 * 64, O_CS = O_CONVS + 8 * 3 * 1024, O_NS = O_CS + 8 * 4 * 256 * 128,
                 O_MS = O_NS + 8 * 4 * 128, O_SRS = O_MS + 32, O_SIS = O_SRS + 8 * 64 * 64, O_END = O_SIS + 8 * 64 * 64;
static_assert(O_END == 36102208, "d_out map");

constexpr size_t MiB = 1u << 20;
constexpr size_t WS_CTL = 0, CTL_ZERO_BYTES = 1 * MiB;
constexpr size_t WS_WIN = 2 * MiB, WS_WGLU = 18 * MiB, WS_WOUT = 20 * MiB, WS_WGU = 28 * MiB, WS_WD = 72 * MiB;
constexpr size_t WS_XN = 96 * MiB;
constexpr size_t WS_R0 = 162 * MiB, WS_RSTRIDE = 33 * MiB;
constexpr size_t WS_QKRAW = WS_R0, WS_V = WS_R0 + WS_RSTRIDE, WS_OG = WS_R0 + 2 * WS_RSTRIDE, WS_U = WS_R0 + 3 * WS_RSTRIDE;
constexpr size_t WS_Q = 294 * MiB, WS_K = 311 * MiB;
constexpr size_t WS_Z = WS_QKRAW;
constexpr size_t WS_MIXIN = WS_Q;
constexpr size_t WS_MIX = WS_R0;
constexpr size_t WS_ACT = WS_R0;
constexpr size_t WS_X1B = WS_XN;
constexpr size_t WS_FF = 427 * MiB;
constexpr size_t WS_GATES = 378 * MiB, WS_HSS = 379 * MiB, WS_SS1 = 382 * MiB, WS_SS2 = 385 * MiB, WS_S5P = 388 * MiB, WS_SSS = 389 * MiB;
constexpr size_t WS_HS = 390 * MiB;
constexpr size_t WS_SCAL = 423 * MiB, WS_END = 492 * MiB;
static_assert(WS_XN + (size_t)MT * DM * 2 <= WS_R0 && WS_QKRAW + (size_t)MT * 1024 * 2 <= WS_V && WS_U + (size_t)MT * 1024 * 2 <= WS_Q && WS_Q + (size_t)MT * 512 * 2 <= WS_K &&
              WS_K + (size_t)MT * 512 * 2 <= WS_GATES && WS_MIXIN + (size_t)MT * DM * 2 <= WS_GATES && WS_MIX + (size_t)MT * DM * 2 <= WS_OG && WS_ACT + (size_t)MT * DFF * 2 <= WS_GATES &&
              WS_WD + (size_t)DM * DFF * 2 <= WS_XN && WS_WGU + (size_t)2 * DFF * DM * 2 <= WS_WD && WS_HSS + (size_t)MT * 32 * 4 <= WS_SS1 && WS_SS1 + (size_t)MT * 32 * 4 <= WS_SS2 &&
              WS_SS2 + (size_t)MT * 32 * 4 <= WS_S5P && WS_GATES + (size_t)MT * 8 * 4 <= WS_HSS && WS_HS + (size_t)MT * 1024 * 2 <= WS_SCAL && WS_SCAL + (size_t)NSC * 4 * 384 * 4 <= WS_FF && WS_FF + (size_t)MT * DM * 2 <= WS_END, "d_ws map");
constexpr size_t S5P_LAM = 0, S5P_BBT = 64 * 1024, S5P_CC = S5P_BBT + 64 * 128 * 16 * 2;
constexpr size_t SSS_1 = 0, SSS_2 = 128 * 128 * 4, SSS_RSTD2 = 256 * 1024, SSS_RSTD1 = 384 * 1024;
constexpr int CW_TMO = 0, CW_CODE = 1, CW_BAR = 4096;

constexpr int RING_OFF = 0, RING_BYTES = 131072;
constexpr int LDSCTL_OFF = 151552, MISC_OFF = LDSCTL_OFF + 320;
constexpr int LDS_BYTES = 155648;
typedef short s16x4 __attribute__((ext_vector_type(4)));
typedef unsigned u32x2 __attribute__((ext_vector_type(2)));
struct Frame {
    LAS unsigned char* lds;
    volatile LAS unsigned* MISC;
    gu32* ctl;
    int tid, lane, wave;
    int vcu, G;
    const float* const* in;
    float* out; unsigned char* ws;
};
__device__ __forceinline__ float wave_sum(float v) {
#pragma unroll
    for (int o = 1; o < 64; o <<= 1) v += __shfl_xor(v, o);
    return v;
}
__device__ __forceinline__ unsigned cvtpk(float lo, float hi) { unsigned r; asm volatile("v_cvt_pk_bf16_f32 %0, %1, %2" : "=v"(r) : "v"(lo), "v"(hi)); return r; }
typedef __bf16 bf16x2n_t __attribute__((ext_vector_type(2)));
__device__ __forceinline__ unsigned cvtpk_n(float lo, float hi) { const bf16x2n_t v = {(__bf16)lo, (__bf16)hi}; return __builtin_bit_cast(unsigned, v); }
__device__ __forceinline__ float bflo(unsigned w) { return __uint_as_float(w << 16); }
__device__ __forceinline__ float bfhi(unsigned w) { return __uint_as_float(w & 0xffff0000u); }
__device__ __forceinline__ float bf2f(bf16 h) { return __uint_as_float((unsigned)h << 16); }
__device__ __forceinline__ float sigmoidf_(float v) { return __builtin_amdgcn_rcpf(1.0f + __expf(-v)); }
__device__ __forceinline__ f32x4 mfma16(bf16x8 a, bf16x8 b, f32x4 c) { return __builtin_amdgcn_mfma_f32_16x16x32_bf16(a, b, c, 0, 0, 0); }
#define WAVE_SYNC() do { asm volatile("s_waitcnt lgkmcnt(0)" ::: "memory"); __builtin_amdgcn_wave_barrier(); } while (0)

#ifdef MK_STAMP
#ifndef MK_STAMP_SCALE
#define MK_STAMP_SCALE 0.002f
#endif
#define DBG_DECL unsigned long long dbg_acc_ = 0, dbg_t0_ = 0;
__device__ __forceinline__ unsigned long long dbg_rt() { unsigned long long t; __builtin_amdgcn_sched_barrier(0);
#ifdef MK_STAMP_CYC
    asm volatile("s_memtime %0\n\ts_waitcnt lgkmcnt(0)" : "=s"(t) :: "memory");
#else
    asm volatile("s_memrealtime %0\n\ts_waitcnt lgkmcnt(0)" : "=s"(t) :: "memory");
#endif
 __builtin_amdgcn_sched_barrier(0); return t; }
#define DBG_BEGIN(id) do { if ((id) == MK_STAMP) dbg_t0_ = dbg_rt(); } while (0)
#define DBG_END(id) do { if ((id) == MK_STAMP) dbg_acc_ += dbg_rt() - dbg_t0_; } while (0)
#define DBG_REPORT(cond) do { if ((cond) && (threadIdx.x & 63) == 0 && (threadIdx.x >> 6) == MK_STAMP_WAVE) ((unsigned*)(A.ws + WS_CTL))[16] = (unsigned)dbg_acc_; } while (0)
#define DBG_PERTURB(V, m_) do { if ((m_) == 0 && lane == 0) V[0][0] += (float)__hip_atomic_load((unsigned*)(A.ws + WS_CTL) + 16, __ATOMIC_RELAXED, __HIP_MEMORY_SCOPE_AGENT) * MK_STAMP_SCALE; } while (0)
#else
#define DBG_DECL
#define DBG_BEGIN(id)
#define DBG_END(id)
#define DBG_REPORT(cond)
#define DBG_PERTURB(V, m_)
#endif
struct Args { const float* in[32]; float* out; unsigned char* ws; int ph_lo, ph_hi, li, pad; };

__device__ __forceinline__ void p0_transpose_item(const float* W, int ldw, int src_col0, int k0, bf16* WT, int K, int out_row0, LAS float* scr, int lane, const float* kscale = nullptr) {
    if (kscale) {
#pragma unroll 8
        for (int i = 0; i < 32; ++i) { const int kk = 2 * i + (lane >> 5); scr[kk * 33 + (lane & 31)] = __builtin_nontemporal_load(W + (size_t)(k0 + kk) * ldw + src_col0 + (lane & 31)) * kscale[k0 + kk]; }
    } else {
#pragma unroll 8
    for (int i = 0; i < 32; ++i) { const int kk = 2 * i + (lane >> 5); scr[kk * 33 + (lane & 31)] = __builtin_nontemporal_load(W + (size_t)(k0 + kk) * ldw + src_col0 + (lane & 31)); }
    }
    LDS_WAIT(); asm volatile("" ::: "memory");
    const int c = lane & 7;
#pragma unroll
    for (int j = 0; j < 4; ++j) { const int n = (lane >> 3) + 8 * j; const LAS float* s = scr + (8 * c) * 33 + n;
        v4u o; o.x = pk2(s[0 * 33], s[1 * 33]); o.y = pk2(s[2 * 33], s[3 * 33]); o.z = pk2(s[4 * 33], s[5 * 33]); o.w = pk2(s[6 * 33], s[7 * 33]);
        *(GAS v4u*)(WT + (size_t)(out_row0 + n) * K + k0 + 8 * c) = o; }
    LDS_WAIT(); asm volatile("" ::: "memory");
}
__device__ __forceinline__ float log_sigmoid(float x) { return fminf(x, 0.f) - log1pf(__expf(-fabsf(x))); }

struct CvtItem { const float* W; int ldw, sc, k0; bf16* WT; int K, orow; const float* ks; };
constexpr int CV_I_IN = (DM / 64) * (4096 / 32), CV_I_GLU = (1024 / 64) * (1024 / 32), CV_I_OUT = (DM / 64) * (DM / 32), CV_I_GU = (DM / 64) * (2 * DFF / 32), CV_I_D = (DFF / 64) * (DM / 32);
__device__ __forceinline__ CvtItem cvt_item(const Args& A, int it) {
    unsigned char* ws = A.ws; int r = it; CvtItem c;
    if (r < CV_I_IN) { const int nnb = 4096 / 32, kb = r / nnb, nb = r % nnb, orow = 32 * nb; c = CvtItem{A.in[9], NIN, orow < 3072 ? orow : orow + 8, 64 * kb, (bf16*)(ws + WS_WIN), DM, orow, nullptr}; return c; } r -= CV_I_IN;
    if (r < CV_I_GLU) { const int nnb = 1024 / 32, kb = r / nnb, nb = r % nnb; c = CvtItem{A.in[23], 1024, 32 * nb, 64 * kb, (bf16*)(ws + WS_WGLU), 1024, 32 * nb, nullptr}; return c; } r -= CV_I_GLU;
    if (r < CV_I_OUT) { const int nnb = DM / 32, kb = r / nnb, nb = r % nnb; c = CvtItem{A.in[25], DM, 32 * nb, 64 * kb, (bf16*)(ws + WS_WOUT), DM, 32 * nb, nullptr}; return c; } r -= CV_I_OUT;
    if (r < CV_I_GU) { const int nnb = 2 * DFF / 32, kb = r / nnb, nb = r % nnb, orow = 32 * nb, pn = orow >> 8, cc = orow & 255;
        c = CvtItem{cc < 128 ? A.in[28] : A.in[29], DFF, 128 * pn + (cc & 127), 64 * kb, (bf16*)(ws + WS_WGU), DM, orow, A.in[27]}; return c; } r -= CV_I_GU;
    { const int nnb = DM / 32, kb = r / nnb, nb = r % nnb; c = CvtItem{A.in[30], DM, 32 * nb, 64 * kb, (bf16*)(ws + WS_WD), DFF, 32 * nb, nullptr}; return c; }
}
__device__ __forceinline__ void p0_prologue(const Args& A, LAS unsigned char* lds, int tid, int lane, int wave, int vcu, int G) {
    unsigned char* ws = A.ws;
    LAS float* WG = (LAS float*)lds;
    LAS float* scr = (LAS float*)(lds + wave * 8448);
    const int gw = vcu * NWAVES + wave, NGW = G * NWAVES;
    { constexpr int NIT = CV_I_IN + CV_I_GLU + CV_I_OUT + CV_I_GU + CV_I_D;
      float ra[32], rb[32]; CvtItem ia, ib;
#define CV_LOAD(R, I, it_) do { I = cvt_item(A, (it_)); \
        _Pragma("unroll") for (int i = 0; i < 32; ++i) { const int kk = 2 * i + (lane >> 5); R[i] = __builtin_nontemporal_load(I.W + (size_t)(I.k0 + kk) * I.ldw + I.sc + (lane & 31)); } } while (0)
#define CV_PROC(R, I) do { \
        if (I.ks) { _Pragma("unroll") for (int i = 0; i < 32; ++i) { const int kk = 2 * i + (lane >> 5); scr[kk * 33 + (lane & 31)] = R[i] * I.ks[I.k0 + kk]; } } \
        else { _Pragma("unroll") for (int i = 0; i < 32; ++i) { const int kk = 2 * i + (lane >> 5); scr[kk * 33 + (lane & 31)] = R[i]; } } \
        LDS_WAIT(); asm volatile("" ::: "memory"); \
        { const int c = lane & 7; \
          _Pragma("unroll") for (int j = 0; j < 4; ++j) { const int n = (lane >> 3) + 8 * j; const LAS float* s = scr + (8 * c) * 33 + n; \
              v4u o; o.x = pk2(s[0 * 33], s[1 * 33]); o.y = pk2(s[2 * 33], s[3 * 33]); o.z = pk2(s[4 * 33], s[5 * 33]); o.w = pk2(s[6 * 33], s[7 * 33]); \
              *(GAS v4u*)(I.WT + (size_t)(I.orow + n) * I.K + I.k0 + 8 * c) = o; } } \
        LDS_WAIT(); asm volatile("" ::: "memory"); } while (0)
      int it = gw;
      if (it < NIT) { CV_LOAD(ra, ia, it);
          for (;;) { const int it2 = it + NGW; if (it2 < NIT) CV_LOAD(rb, ib, it2); CV_PROC(ra, ia); if (it2 >= NIT) break;
                     it = it2 + NGW; if (it < NIT) CV_LOAD(ra, ia, it); CV_PROC(rb, ib); if (it >= NIT) break; } }
#undef CV_LOAD
#undef CV_PROC
    }
    { const int gt = vcu * (NWAVES * 64) + tid;
      if (gt < NG * PST) {
        const int g = gt >> 6, p = gt & 63;
        const double lr = (double)A.in[15][gt], li = (double)A.in[16][gt], dt = exp((double)A.in[17][g]);
        const double mag = exp(lr * dt), ang = li * dt, lbr = mag * cos(ang), lbi = mag * sin(ang);
        const double den = lr * lr + li * li, nr = lbr - 1.0, fre = (nr * lr + lbi * li) / den, fim = (lbi * lr - nr * li) / den;
        float* LAM = (float*)(ws + WS_S5P + S5P_LAM); LAM[gt * 2] = (float)lbr; LAM[gt * 2 + 1] = (float)lbi;
        bf16* BBT = (bf16*)(ws + WS_S5P + S5P_BBT); bf16* CC = (bf16*)(ws + WS_S5P + S5P_CC);
        const float* bre = A.in[18] + (size_t)gt * 16; const float* bim = A.in[19] + (size_t)gt * 16;
#pragma unroll
        for (int i = 0; i < 16; ++i) { const double br = bre[i], bi = bim[i];
            BBT[((size_t)g * 128 + 2 * p) * 16 + i] = (bf16)f2bf((float)(fre * br - fim * bi));
            BBT[((size_t)g * 128 + 2 * p + 1) * 16 + i] = (bf16)f2bf((float)(fre * bi + fim * br));
            CC[((size_t)g * 16 + i) * 128 + 2 * p] = (bf16)f2bf(A.in[20][((size_t)g * 16 + i) * 64 + p]);
            CC[((size_t)g * 16 + i) * 128 + 2 * p + 1] = (bf16)f2bf(-A.in[21][((size_t)g * 16 + i) * 64 + p]); }
      } }
    __syncthreads();
    { const float* win = A.in[9];
      for (int e = tid; e < 8 * 2048; e += NWAVES * 64) { const int k = e >> 3, c = e & 7; WG[c * 2048 + k] = win[(size_t)k * NIN + 3072 + c]; } }
    __syncthreads();
    { const GAS f32x4* gp = (const GAS f32x4*)A.in[8] + lane; f32x4 gv[8];
#pragma unroll
      for (int j = 0; j < 8; ++j) gv[j] = gp[64 * j];
      bf16* XN = (bf16*)(ws + WS_XN); float* GATES = (float*)(ws + WS_GATES);
      f32x4 va[8], vb[8];
#define P0R_LOAD(V, m_) do { const int mm_ = (m_); const float* xrow = mm_ < MP ? A.in[0] + (size_t)mm_ * DM : A.in[1] + (size_t)(mm_ - MP) * DM; const GAS f32x4* xr = (const GAS f32x4*)xrow + lane; \
        _Pragma("unroll") for (int j = 0; j < 8; ++j) V[j] = __builtin_nontemporal_load(xr + 64 * j); } while (0)
#define P0R_PROC(V, m_) do { const int mm_ = (m_); float s = 0.f; \
        _Pragma("unroll") for (int j = 0; j < 8; ++j) s += (V[j].x * V[j].x + V[j].y * V[j].y) + (V[j].z * V[j].z + V[j].w * V[j].w); \
        const float ms = wave_sum(s) * (1.0f / DM) + EPS, rstd = 1.0f / sqrtf(ms); \
        if (lane == 0) ((float*)(ws + WS_SSS + SSS_RSTD1))[mm_] = sqrtf(ms); \
        GAS u32x2* o8 = (GAS u32x2*)(XN + (size_t)mm_ * DM) + lane; \
        float ga[8] = {0.f, 0.f, 0.f, 0.f, 0.f, 0.f, 0.f, 0.f}; \
        _Pragma("unroll") for (int j = 0; j < 8; ++j) { V[j] = V[j] * rstd * gv[j]; u32x2 o; o.x = cvtpk(V[j].x, V[j].y); o.y = cvtpk(V[j].z, V[j].w); o8[64 * j] = o; \
            _Pragma("unroll") for (int c = 0; c < 8; ++c) { const f32x4 w = *(const LAS f32x4*)(WG + c * 2048 + 256 * j + 4 * lane); ga[c] += (V[j].x * w.x + V[j].y * w.y) + (V[j].z * w.z + V[j].w * w.w); } } \
        _Pragma("unroll") for (int c = 0; c < 8; ++c) ga[c] = wave_sum(ga[c]); \
        if (lane < 8) { float val = 0.f; \
            _Pragma("unroll") for (int c = 0; c < 8; ++c) if (lane == c) val = ga[c]; \
            if (lane < 4) val += A.in[12][lane]; else val = log_sigmoid(val + A.in[13][lane - 4]); \
            GATES[(size_t)mm_ * 8 + lane] = val; } } while (0)
      int m = gw;
      if (m < MT) { P0R_LOAD(va, m);
          for (;;) { const int m2 = m + NGW; if (m2 < MT) P0R_LOAD(vb, m2); P0R_PROC(va, m); if (m2 >= MT) break;
                     m = m2 + NGW; if (m < MT) P0R_LOAD(va, m); P0R_PROC(vb, m2); if (m >= MT) break; } }
#undef P0R_LOAD
#undef P0R_PROC
    }
}

template <int NACC, int K, class RowMap, class Epi>
__device__ __forceinline__ void skinny_gemm(const bf16* Arows, const bf16* Bt, LAS unsigned char* lds, int nitems, int first, int stride, int tid, int wave, int lane, RowMap rm, Epi epi) {
    const int fr = lane & 15, fq = lane >> 4;
    constexpr int KW = K / 8, NS = KW / 32;
    static_assert(KW % 32 == 0, "skinny_gemm: K must be a multiple of 256");
    const bf16* abase = Arows + (size_t)fr * K + wave * KW + 8 * fq;
    LAS f32x4* red = (LAS f32x4*)lds;
    for (int it = first; it < nitems; it += stride) {
        const bf16* brow[NACC]; f32x4 acc[NACC][8];
#pragma unroll
        for (int a = 0; a < NACC; ++a) { brow[a] = Bt + (size_t)rm(it, a, fr) * K + wave * KW + 8 * fq;
#pragma unroll
            for (int rb = 0; rb < 8; ++rb) acc[a][rb] = (f32x4){0.f, 0.f, 0.f, 0.f}; }
#pragma unroll 2
        for (int s = 0; s < NS; ++s) {
            bf16x8 av[8], bv[NACC];
#pragma unroll
            for (int a = 0; a < NACC; ++a) bv[a] = *(const bf16x8*)(brow[a] + 32 * s);
#pragma unroll
            for (int rb = 0; rb < 8; ++rb) av[rb] = *(const bf16x8*)(abase + (size_t)(16 * rb) * K + 32 * s);
#pragma unroll
            for (int rb = 0; rb < 8; ++rb)
#pragma unroll
                for (int a = 0; a < NACC; ++a) acc[a][rb] = mfma16(bv[a], av[rb], acc[a][rb]);
        }
#pragma unroll
        for (int a = 0; a < NACC; ++a)
#pragma unroll
            for (int rb = 0; rb < 8; ++rb) red[((a * 8 + wave) * 8 + rb) * 64 + lane] = acc[a][rb];
        __syncthreads();
        f32x4 fin[NACC];
#pragma unroll
        for (int a = 0; a < NACC; ++a) { f32x4 t = red[((a * 8 + 0) * 8 + wave) * 64 + lane];
#pragma unroll
            for (int w2 = 1; w2 < 8; ++w2) t += red[((a * 8 + w2) * 8 + wave) * 64 + lane];
            fin[a] = t; }
        __syncthreads();
        epi(it, 16 * wave + fr, fq, fin);
    }
}

__device__ __forceinline__ void p2_scalars(const Args& A, LAS unsigned char* lds, int lane, int wave, int item) {
    unsigned char* ws = A.ws;
    const float* GATES = (const float*)(ws + WS_GATES); float* SCAL = (float*)(ws + WS_SCAL);
    const int seq = item >> 2, h = item & 3; const bool sample = seq >= NBATCH; const int b = sample ? seq - NBATCH : seq;
    const int nch = sample ? 1 : NCH, L = sample ? SLEN : CH, row0 = sample ? MP + b * SLEN : b * SEQ, sc0 = sample ? NBATCH * NCH + b : b * NCH;
    LAS float* fl = (LAS float*)lds;
    float fc[4], a[4], pm[4];
#pragma unroll
    for (int i = 0; i < 4; ++i) { const int c = 4 * wave + i; float li = -INFINITY, lf = 0.f;
        if (c < nch && lane < L) { li = GATES[((size_t)row0 + c * CH + lane) * 8 + h]; lf = GATES[((size_t)row0 + c * CH + lane) * 8 + 4 + h]; }
        float f = lf;
#pragma unroll
        for (int d = 1; d < 64; d <<= 1) { const float o = __shfl_up(f, d); if (lane >= d) f += o; }
        const float aa = li - f; float p = aa;
#pragma unroll
        for (int d = 1; d < 64; d <<= 1) { const float o = __shfl_up(p, d); if (lane >= d) p = fmaxf(p, o); }
        fc[i] = f; a[i] = aa; pm[i] = p;
        if (lane == 63) { fl[c] = f; fl[32 + c] = p; } }
    __syncthreads();
    float m0c = 0.f, m0 = sample ? A.in[5][b * NH + h] : 0.f;
    for (int c = 0; c < nch; ++c) { if (lane == c) m0c = m0; m0 = fl[c] + fmaxf(fl[32 + c], m0); }
#pragma unroll
    for (int i = 0; i < 4; ++i) { const int c = 4 * wave + i;
        if (c < nch) { const float m0i = __shfl(m0c, c); const float mm = fmaxf(pm[i], m0i), mml = __shfl(mm, 63);
            float* o = SCAL + ((size_t)(sc0 + c) * 4 + h) * 384;
            o[lane] = a[i]; o[64 + lane] = mm; o[128 + lane] = __expf(m0i - mm); o[192 + lane] = __expf(-(fc[i] + mm)); o[256 + lane] = __expf(a[i] - mml);
            o[320 + lane] = (lane == 0) ? __expf(m0i - mml) : (__shfl(fc[i], 63) + mml); } }
    if (wave == 0 && lane == 0) A.out[(sample ? O_MS : O_MP) + b * NH + h] = m0;
    __syncthreads();
}
__device__ __forceinline__ void p2_conv(const Args& A, int tid, int vcu, int G) {
    unsigned char* ws = A.ws;
    const bf16* QKRAW = (const bf16*)(ws + WS_QKRAW); bf16* Q = (bf16*)(ws + WS_Q); bf16* Kb = (bf16*)(ws + WS_K);
    const int nthreads = G * NWAVES * 64;
    for (int it = vcu * (NWAVES * 64) + tid; it < (MT / 8) * 128; it += nthreads) {
        const int rb = it >> 7, ch = it & 127, rs = 8 * rb, col = 8 * ch;
        bool first, sample = rs >= MP; int b, tl, Lseq;
        if (!sample) { b = rs / SEQ; tl = rs % SEQ; Lseq = SEQ; } else { b = (rs - MP) / SLEN; tl = (rs - MP) % SLEN; Lseq = SLEN; }
        first = (tl == 0);
        float w[4][8], bc[8];
#pragma unroll
        for (int j = 0; j < 4; ++j) { const f32x4 a0 = *(const f32x4*)(A.in[10] + j * 1024 + col), a1 = *(const f32x4*)(A.in[10] + j * 1024 + col + 4);
            w[j][0] = a0[0]; w[j][1] = a0[1]; w[j][2] = a0[2]; w[j][3] = a0[3]; w[j][4] = a1[0]; w[j][5] = a1[1]; w[j][6] = a1[2]; w[j][7] = a1[3]; }
        { const f32x4 a0 = *(const f32x4*)(A.in[11] + col), a1 = *(const f32x4*)(A.in[11] + col + 4);
          bc[0] = a0[0]; bc[1] = a0[1]; bc[2] = a0[2]; bc[3] = a0[3]; bc[4] = a1[0]; bc[5] = a1[1]; bc[6] = a1[2]; bc[7] = a1[3]; }
        v4u raw[11];
#pragma unroll
        for (int r = 0; r < 11; ++r) { if (r >= 3 || !first) raw[r] = *(const GAS v4u*)(QKRAW + (size_t)(rs + r - 3) * 1024 + col); else raw[r] = (v4u){0u, 0u, 0u, 0u}; }
        float x0[8], x1[8], x2[8];
#define UNPK(dst, v) do { dst[0] = bflo(v.x); dst[1] = bfhi(v.x); dst[2] = bflo(v.y); dst[3] = bfhi(v.y); dst[4] = bflo(v.z); dst[5] = bfhi(v.z); dst[6] = bflo(v.w); dst[7] = bfhi(v.w); } while (0)
        if (first && sample) {
            const float* sp = A.in[2] + (size_t)b * 3 * 1024 + col;
#pragma unroll
            for (int i = 0; i < 8; ++i) { x0[i] = sp[i]; x1[i] = sp[1024 + i]; x2[i] = sp[2048 + i]; }
        } else { UNPK(x0, raw[0]); UNPK(x1, raw[1]); UNPK(x2, raw[2]); }
#pragma unroll
        for (int r = 0; r < 8; ++r) {
            float x3[8]; UNPK(x3, raw[r + 3]);
            float o[8];
#pragma unroll
            for (int i = 0; i < 8; ++i) { const float val = bc[i] + w[0][i] * x0[i] + w[1][i] * x1[i] + w[2][i] * x2[i] + w[3][i] * x3[i]; o[i] = val * sigmoidf_(val); }
            const size_t row = (size_t)rs + r;
            if (ch < 64) {
#pragma unroll
                for (int i = 0; i < 8; ++i) o[i] *= 0.08838834764831845f;
                v4u pk; pk.x = cvtpk(o[0], o[1]); pk.y = cvtpk(o[2], o[3]); pk.z = cvtpk(o[4], o[5]); pk.w = cvtpk(o[6], o[7]);
                *(GAS v4u*)(Q + row * 512 + col) = pk;
            } else {
                v4u pk; pk.x = cvtpk(o[0], o[1]); pk.y = cvtpk(o[2], o[3]); pk.z = cvtpk(o[4], o[5]); pk.w = cvtpk(o[6], o[7]);
                *(GAS v4u*)(Kb + row * 512 + (col - 512)) = pk;
            }
            const int tt = tl + r;
            if (tt >= Lseq - 3) { float* cv = A.out + (sample ? O_CONVS : O_CONVP) + ((size_t)b * 3 + (tt - (Lseq - 3))) * 1024 + col;
                *(f32x4*)cv = (f32x4){x3[0], x3[1], x3[2], x3[3]}; *(f32x4*)(cv + 4) = (f32x4){x3[4], x3[5], x3[6], x3[7]}; }
#pragma unroll
            for (int i = 0; i < 8; ++i) { x0[i] = x1[i]; x1[i] = x2[i]; x2[i] = x3[i]; }
        }
#undef UNPK
    }
}
constexpr int ML_QS = 0, ML_KS = 17408, ML_VS = 34816, ML_SC = 46080, ML_SET = 47616, ML_SS = 2 * ML_SET, ML_CB = ML_SS + 9216, ML_CBSZ = 21760;
static_assert(ML_CB + 2 * ML_CBSZ <= LDSCTL_OFF, "mLSTM LDS map");
constexpr int SC_A = 0, SC_MM = 64, SC_GI = 128, SC_EN = 192, SC_WS = 256, SC_MISC = 320;
__device__ __forceinline__ bf16x8 ldsfrag(const LAS unsigned char* p) { return *(const LAS bf16x8*)p; }
typedef __attribute__((address_space(3))) s16x4 lds_s16x4;
__device__ __forceinline__ bf16x8 trfrag(const LAS unsigned char* tile, int stride, int k0, int c0, int lane) {
    const int g = lane >> 4, q = (lane & 15) >> 2, p = lane & 3;
    const LAS unsigned char* a0 = tile + (k0 + 8 * g + q) * stride + (c0 + 4 * p) * 2;
    const s16x4 lo = __builtin_amdgcn_ds_read_tr16_b64_v4i16((lds_s16x4*)a0), hi = __builtin_amdgcn_ds_read_tr16_b64_v4i16((lds_s16x4*)(a0 + 4 * stride));
    return (bf16x8){lo[0], lo[1], lo[2], lo[3], hi[0], hi[1], hi[2], hi[3]};
}
#define LBAR() do { asm volatile("s_waitcnt lgkmcnt(0)" ::: "memory"); __builtin_amdgcn_s_barrier(); asm volatile("" ::: "memory"); } while (0)

__device__ __forceinline__ void mlstm_item(const Args& A, LAS unsigned char* lds, int tid, int lane, int wave, int item) {
    DBG_DECL
    unsigned char* ws = A.ws;
    const int fr = lane & 15, fq = lane >> 4;
    const bool sample = item >= NBATCH * NH * NSL; const int ii = sample ? item - NBATCH * NH * NSL : item;
    const int b = ii / (NH * NSL), h = (ii / NSL) % NH, sl = ii % NSL;
    const int nch = sample ? 1 : NCH, L = sample ? SLEN : CH;
    const int row0 = sample ? MP + b * SLEN : b * SEQ, sc0 = sample ? NBATCH * NCH + b : b * NCH;
    const bf16* Qg = (const bf16*)(ws + WS_Q); const bf16* Kg = (const bf16*)(ws + WS_K); const bf16* Vg = (const bf16*)(ws + WS_V);
    const float* SCAL = (const float*)(ws + WS_SCAL); bf16* HS = (bf16*)(ws + WS_HS); float* HSS = (float*)(ws + WS_HSS);
    if (tid < 256) { const int r = (tid >> 1) & 63, hf = tid & 1, st = tid >> 7; *(LAS v4u*)(lds + st * ML_SET + ML_VS + r * 176 + 128 + 16 * hf) = (v4u){hf == 0 ? 0x00003F80u : 0u, 0u, 0u, 0u}; }
    f32x4 Cst[5];
    if (sample) {
        const float* c0 = A.in[3] + ((size_t)(b * NH + h) * DV + DVS * sl) * DQK; const float* n0 = A.in[4] + (size_t)(b * NH + h) * DQK;
#pragma unroll
        for (int vb = 0; vb < 4; ++vb) Cst[vb] = *(const f32x4*)(c0 + (size_t)(16 * vb + fr) * DQK + 16 * wave + 4 * fq);
        Cst[4] = (fr == 0) ? *(const f32x4*)(n0 + 16 * wave + 4 * fq) : (f32x4){0.f, 0.f, 0.f, 0.f};
    } else {
#pragma unroll
        for (int vb = 0; vb < 5; ++vb) Cst[vb] = (f32x4){0.f, 0.f, 0.f, 0.f};
    }
#pragma unroll
    for (int vb = 0; vb < 5; ++vb) { u32x2 w; w.x = cvtpk_n(Cst[vb][0], Cst[vb][1]); w.y = cvtpk_n(Cst[vb][2], Cst[vb][3]); *(LAS u32x2*)(lds + ML_CB + (16 * vb + fr) * 272 + (16 * wave + 4 * fq) * 2) = w; }
    v4u pq[2], pk[2], pv; f32x4 psc = (f32x4){0.f, 0.f, 0.f, 0.f};
#define ML_ISSUE(c_) do { \
        const size_t r0_ = (size_t)row0 + (size_t)(c_) * CH; \
        _Pragma("unroll") for (int i = 0; i < 2; ++i) { const int e = tid + 512 * i, r = e >> 4, ch = e & 15; \
            if (r < L) { pq[i] = *(const GAS v4u*)(Qg + (r0_ + r) * 512 + 128 * h + 8 * ch); pk[i] = *(const GAS v4u*)(Kg + (r0_ + r) * 512 + 128 * h + 8 * ch); } \
            else { pq[i] = (v4u){0u, 0u, 0u, 0u}; pk[i] = (v4u){0u, 0u, 0u, 0u}; } } \
        { const int r = tid >> 3, ch = tid & 7; if (r < L) pv = *(const GAS v4u*)(Vg + (r0_ + r) * 1024 + DV * h + DVS * sl + 8 * ch); else pv = (v4u){0u, 0u, 0u, 0u}; } \
        if (tid < 96) psc = *(const GAS f32x4*)(SCAL + ((size_t)(sc0 + (c_)) * 4 + h) * 384 + 4 * tid); \
    } while (0)
#define ML_COMMIT(so_) do { LAS unsigned char* wl_ = lds + (so_); \
        _Pragma("unroll") for (int i = 0; i < 2; ++i) { const int e = tid + 512 * i, r = e >> 4, ch = e & 15; \
            *(LAS v4u*)(wl_ + ML_QS + r * 272 + ch * 16) = pq[i]; *(LAS v4u*)(wl_ + ML_KS + r * 272 + ch * 16) = pk[i]; } \
        { const int r = tid >> 3, ch = tid & 7; *(LAS v4u*)(wl_ + ML_VS + r * 176 + ch * 16) = pv; } \
        if (tid < 96) *(LAS f32x4*)((LAS float*)(wl_ + ML_SC) + 4 * tid) = psc; \
    } while (0)
    ML_ISSUE(0); ML_COMMIT(0);
    LBAR();
    const int tb = wave & 3, wh = wave >> 2, t = 16 * tb + fr;
    u32x2 hsw[2] = {(u32x2){0u, 0u}, (u32x2){0u, 0u}}; float hsp = 0.f;
#define ML_FLUSH(c_) do { const size_t grow = (size_t)row0 + (size_t)(c_) * CH + t; \
        if (t < L) { *(GAS u32x2*)(HS + grow * 1024 + h * DV + DVS * sl + 16 * (2 * wh) + 4 * fq) = hsw[0]; *(GAS u32x2*)(HS + grow * 1024 + h * DV + DVS * sl + 16 * (2 * wh + 1) + 4 * fq) = hsw[1]; \
                     if (fq == 0) HSS[grow * 32 + h * 8 + sl * 2 + wh] = hsp; } } while (0)
    DBG_BEGIN(8);
    for (int c = 0; c < nch; ++c) {
        if (c + 1 < nch) ML_ISSUE(c + 1);
        if (c > 0) ML_FLUSH(c - 1);
        const LAS unsigned char* cbr = lds + ML_CB + (c & 1) * ML_CBSZ; LAS unsigned char* cbw = lds + ML_CB + ((c + 1) & 1) * ML_CBSZ;
        const LAS unsigned char* tl = lds + (c & 1) * ML_SET; const LAS float* SC = (const LAS float*)(tl + ML_SC);
        DBG_BEGIN(4);
        bf16x8 qf[4];
#pragma unroll
        for (int ks = 0; ks < 4; ++ks) qf[ks] = ldsfrag(tl + ML_QS + t * 272 + ks * 64 + fq * 16);
        { bf16x8 kf[2][4];
#pragma unroll
          for (int i = 0; i < 2; ++i)
#pragma unroll
              for (int ks = 0; ks < 4; ++ks) kf[i][ks] = ldsfrag(tl + ML_KS + (16 * (2 * wh + i) + fr) * 272 + ks * 64 + fq * 16);
          const float mmt = SC[SC_MM + t]; f32x4 a4[2];
#pragma unroll
          for (int i = 0; i < 2; ++i) a4[i] = *(const LAS f32x4*)(SC + SC_A + 16 * (2 * wh + i) + 4 * fq);
          f32x4 g[2] = {(f32x4){0.f, 0.f, 0.f, 0.f}, (f32x4){0.f, 0.f, 0.f, 0.f}};
#pragma unroll
          for (int ks = 0; ks < 4; ++ks)
#pragma unroll
              for (int i = 0; i < 2; ++i) g[i] = mfma16(kf[i][ks], qf[ks], g[i]);
#pragma unroll
          for (int i = 0; i < 2; ++i) { const int s0 = 16 * (2 * wh + i) + 4 * fq; float v[4];
#pragma unroll
              for (int r = 0; r < 4; ++r) v[r] = (s0 + r <= t) ? g[i][r] * __expf(a4[i][r] - mmt) : 0.f;
              u32x2 w; w.x = cvtpk_n(v[0], v[1]); w.y = cvtpk_n(v[2], v[3]); *(LAS u32x2*)(lds + ML_SS + t * 144 + s0 * 2) = w; } }
        DBG_END(4);
        LBAR();
        DBG_BEGIN(5);
        { bf16x8 sf[2], vf[3][2], cf[3][4];
#pragma unroll
          for (int ks = 0; ks < 2; ++ks) sf[ks] = ldsfrag(lds + ML_SS + t * 144 + ks * 64 + fq * 16);
#pragma unroll
          for (int i = 0; i < 3; ++i) { const int vb = (i == 2) ? 4 : 2 * wh + i;
#pragma unroll
              for (int ks = 0; ks < 2; ++ks) vf[i][ks] = trfrag(tl + ML_VS, 176, 32 * ks, 16 * vb, lane);
#pragma unroll
              for (int ks = 0; ks < 4; ++ks) cf[i][ks] = ldsfrag(cbr + (16 * vb + fr) * 272 + ks * 64 + fq * 16); }
          const float git = SC[SC_GI + t], ent = SC[SC_EN + t];
          f32x4 ai[3], ae[3];
#pragma unroll
          for (int i = 0; i < 3; ++i) { ai[i] = (f32x4){0.f, 0.f, 0.f, 0.f}; ae[i] = (f32x4){0.f, 0.f, 0.f, 0.f}; }
#pragma unroll
          for (int ks = 0; ks < 4; ++ks)
#pragma unroll
              for (int i = 0; i < 3; ++i) { ae[i] = mfma16(cf[i][ks], qf[ks], ae[i]); if (ks < 2) ai[i] = mfma16(vf[i][ks], sf[ks], ai[i]); }
          f32x4 hh[3];
#pragma unroll
          for (int i = 0; i < 3; ++i) hh[i] = ai[i] + ae[i] * git;
          const float den = __shfl(hh[2][0], fr);
          const float isc = 1.0f / fmaxf(fabsf(den), ent); float p = 0.f;
#pragma unroll
          for (int i = 0; i < 2; ++i) { const f32x4 o = hh[i] * isc; p += (o[0] * o[0] + o[1] * o[1]) + (o[2] * o[2] + o[3] * o[3]);
              hsw[i].x = cvtpk_n(o[0], o[1]); hsw[i].y = cvtpk_n(o[2], o[3]); }
          p += __shfl_xor(p, 16); p += __shfl_xor(p, 32); hsp = p; }
        DBG_END(5); DBG_BEGIN(6);
        { const float decay = SC[SC_MISC];
          bf16x8 kw[2], vf[5][2];
#pragma unroll
          for (int vb = 0; vb < 5; ++vb)
#pragma unroll
              for (int ks = 0; ks < 2; ++ks) vf[vb][ks] = trfrag(tl + ML_VS, 176, 32 * ks, 16 * vb, lane);
#pragma unroll
          for (int ks = 0; ks < 2; ++ks) { const v4u kr = __builtin_bit_cast(v4u, trfrag(tl + ML_KS, 272, 32 * ks, 16 * wave, lane));
              const f32x4 w0 = *(const LAS f32x4*)(SC + SC_WS + 32 * ks + 8 * fq), w1 = *(const LAS f32x4*)(SC + SC_WS + 32 * ks + 8 * fq + 4);
              v4u o; o.x = cvtpk_n(bflo(kr.x) * w0[0], bfhi(kr.x) * w0[1]); o.y = cvtpk_n(bflo(kr.y) * w0[2], bfhi(kr.y) * w0[3]); o.z = cvtpk_n(bflo(kr.z) * w1[0], bfhi(kr.z) * w1[1]); o.w = cvtpk_n(bflo(kr.w) * w1[2], bfhi(kr.w) * w1[3]);
              kw[ks] = __builtin_bit_cast(bf16x8, o); }
#pragma unroll
          for (int vb = 0; vb < 5; ++vb) Cst[vb] = Cst[vb] * decay;
#pragma unroll
          for (int ks = 0; ks < 2; ++ks)
#pragma unroll
              for (int vb = 0; vb < 5; ++vb) Cst[vb] = mfma16(kw[ks], vf[vb][ks], Cst[vb]);
#pragma unroll
          for (int vb = 0; vb < 5; ++vb) { u32x2 w; w.x = cvtpk_n(Cst[vb][0], Cst[vb][1]); w.y = cvtpk_n(Cst[vb][2], Cst[vb][3]); *(LAS u32x2*)(cbw + (16 * vb + fr) * 272 + (16 * wave + 4 * fq) * 2) = w; } }
        DBG_END(6);
        DBG_BEGIN(7);
        if (c + 1 < nch) ML_COMMIT(((c + 1) & 1) * ML_SET);
        DBG_END(7);
        LBAR();
    }
    DBG_END(8); DBG_REPORT(item == 0);
    ML_FLUSH(nch - 1);
    { float* co = A.out + (sample ? O_CS : O_CP) + ((size_t)(b * NH + h) * DV + DVS * sl) * DQK;
#pragma unroll
      for (int vb = 0; vb < 4; ++vb) *(f32x4*)(co + (size_t)(16 * vb + fr) * DQK + 16 * wave + 4 * fq) = Cst[vb];
      if (sl == 0 && fr == 0) *(f32x4*)(A.out + (sample ? O_NS : O_NP) + (size_t)(b * NH + h) * DQK + 16 * wave + 4 * fq) = Cst[4]; }
    LBAR();
#undef ML_ISSUE
#undef ML_FLUSH
#undef ML_COMMIT
}

__device__ __forceinline__ float gelu_tanh(float y) { const float t = y * y, p = fmaf(t, 0.044715f, 1.0f);
    const float e = __builtin_amdgcn_exp2f(y * p * -2.302208198f); return y * __builtin_amdgcn_rcpf(1.0f + e); }
typedef float f32x2 __attribute__((ext_vector_type(2)));
__device__ __forceinline__ void s5_item(const Args& A, LAS unsigned char* slds, int lane, int role, int item) {
    DBG_DECL
    unsigned char* ws = A.ws;
    const int fr = lane & 15, fq = lane >> 4;
    const bool sample = item >= NBATCH * NG; const int ii = sample ? item - NBATCH * NG : item;
    const int b = ii / NG, g = ii % NG;
    const int T = sample ? SLEN : SEQ, row0 = sample ? MP + b * SLEN : b * SEQ;
    const bf16* U = (const bf16*)(ws + WS_U); bf16* Z = (bf16*)(ws + WS_Z);
    const float* LAM = (const float*)(ws + WS_S5P + S5P_LAM); const bf16* BBT = (const bf16*)(ws + WS_S5P + S5P_BBT); const bf16* CC = (const bf16*)(ws + WS_S5P + S5P_CC);
    const bf16x8 zf = (bf16x8){0, 0, 0, 0, 0, 0, 0, 0}; const f32x4 z4 = (f32x4){0.f, 0.f, 0.f, 0.f};
    const int nblk = T / 16;
    const bf16* ubase = U + (size_t)(row0 + fr) * 1024 + 16 * g + 8 * (fq & 1);
#define S5_LOADU(k_) (*(const bf16x8*)(ubase + (size_t)((k_) < nblk ? (k_) : nblk - 1) * 16 * 1024))
#define S5_BU(P_) ((LAS float*)(slds + (P_) * 8448))
#define S5_SB(P_) ((LAS bf16*)(slds + 16896 + (P_) * 4352))
    if (role == 0) {
        bf16x8 bbA[8];
#pragma unroll
        for (int rb = 0; rb < 8; ++rb) bbA[rb] = (fq < 2) ? *(const bf16x8*)(BBT + ((size_t)g * 128 + 16 * rb + fr) * 16 + 8 * fq) : zf;
        const float lr = LAM[(g * 64 + lane) * 2], li = LAM[(g * 64 + lane) * 2 + 1];
        float sr, si;
        if (sample) { sr = A.in[6][(size_t)(b * NG + g) * PST + lane]; si = A.in[7][(size_t)(b * NG + g) * PST + lane]; } else { sr = 0.f; si = 0.f; }
        bf16x8 ub = S5_LOADU(0), uc = S5_LOADU(1), ud = S5_LOADU(2);
#pragma unroll
        for (int rb = 0; rb < 8; ++rb) { const f32x4 d = mfma16(bbA[rb], ub, z4); *(LAS f32x4*)(S5_BU(0) + fr * 132 + 16 * rb + 4 * fq) = d; }
        LBAR();
#define S5_ITER_A(k_, P_) do { const int k = (k_); DBG_BEGIN(1); \
            f32x4 d[8]; \
            _Pragma("unroll") for (int rb = 0; rb < 8; ++rb) d[rb] = mfma16(bbA[rb], uc, z4);                                 \
            f32x2 bu[16]; { const LAS float* bc = S5_BU(P_); \
            _Pragma("unroll") for (int tt = 0; tt < 16; ++tt) bu[tt] = *(const LAS f32x2*)(bc + tt * 132 + 2 * lane); } \
            { LAS float* bn = S5_BU(1 - (P_)); \
            _Pragma("unroll") for (int rb = 0; rb < 8; ++rb) *(LAS f32x4*)(bn + fr * 132 + 16 * rb + 4 * fq) = d[rb]; } \
            { LAS bf16* sbc = S5_SB(P_); \
            f32x2 s2 = (f32x2){sr, si}; const f32x2 lr2 = (f32x2){lr, lr}, li2 = (f32x2){-li, li}; \
            _Pragma("unroll") for (int tt = 0; tt < 16; ++tt) { const f32x2 sw = __builtin_shufflevector(s2, s2, 1, 0); s2 = lr2 * s2 + (li2 * sw + bu[tt]);     \
                *(LAS unsigned*)(sbc + tt * 136 + 2 * lane) = cvtpk_n(s2[0], s2[1]); } sr = s2[0]; si = s2[1]; }                \
            uc = ud; ud = S5_LOADU(k + 3); DBG_END(1); \
            LBAR(); } while (0)
        DBG_BEGIN(2);
        for (int k2 = 0; k2 + 1 < nblk; k2 += 2) { S5_ITER_A(k2, 0); S5_ITER_A(k2 + 1, 1); }
        if (nblk & 1) S5_ITER_A(nblk - 1, 0);
        DBG_END(2); DBG_REPORT(!sample && item == 0);
#undef S5_ITER_A
        float* so = A.out + (sample ? O_SRS : O_SRP) + (size_t)(b * NG + g) * PST; float* io = A.out + (sample ? O_SIS : O_SIP) + (size_t)(b * NG + g) * PST;
        so[lane] = sr; io[lane] = si;
    } else {
        bf16x8 ccA[4], dA;
#pragma unroll
        for (int ks = 0; ks < 4; ++ks) ccA[ks] = *(const bf16x8*)(CC + ((size_t)g * 16 + fr) * 128 + 32 * ks + 8 * fq);
        { const short dv = (short)f2bf(A.in[22][g * 16 + fr]); dA = zf;
#pragma unroll
          for (int j = 0; j < 8; ++j) dA[j] = (fq < 2 && 8 * fq + j == fr) ? dv : (short)0; }
        bf16x8 ua = S5_LOADU(0), ub = S5_LOADU(0), uc = S5_LOADU(1);
        LBAR();
#define S5_Y(km1_, P_) do { const LAS bf16* sbp = S5_SB(P_); f32x4 y = z4; \
            _Pragma("unroll") for (int ks = 0; ks < 4; ++ks) y = mfma16(ccA[ks], *(const LAS bf16x8*)(sbp + fr * 136 + 32 * ks + 8 * fq), y); \
            y = mfma16(dA, ua, y); \
            u32x2 w; w.x = cvtpk_n(gelu_tanh(y[0]), gelu_tanh(y[1])); w.y = cvtpk_n(gelu_tanh(y[2]), gelu_tanh(y[3])); \
            *(GAS u32x2*)(Z + ((size_t)row0 + 16 * (km1_) + fr) * 1024 + 16 * g + 4 * fq) = w; } while (0)
#define S5_ITER_B(k_, P_) do { const int k = (k_); DBG_BEGIN(3); if (k >= 1) S5_Y(k - 1, 1 - (P_)); ua = ub; ub = uc; uc = S5_LOADU(k + 2); DBG_END(3); LBAR(); } while (0)
        for (int k2 = 0; k2 + 1 < nblk; k2 += 2) { S5_ITER_B(k2, 0); S5_ITER_B(k2 + 1, 1); }
        if (nblk & 1) S5_ITER_B(nblk - 1, 0);
        if ((nblk - 1) & 1) S5_Y(nblk - 1, 1); else S5_Y(nblk - 1, 0);
        DBG_REPORT(!sample && item == 0);
#undef S5_ITER_B
#undef S5_Y
    }
    LBAR();
#undef S5_BU
#undef S5_SB
#undef S5_LOADU
}

__device__ __forceinline__ void outa_rows(const Args& A, int lane, int gw, int NGW) {
    unsigned char* ws = A.ws;
    const bf16* HS = (const bf16*)(ws + WS_HS); const bf16* OG = (const bf16*)(ws + WS_OG); const float* HSS = (const float*)(ws + WS_HSS); bf16* MIXIN = (bf16*)(ws + WS_MIXIN);
    f32x4 gm[2][2];
#pragma unroll
    for (int i = 0; i < 2; ++i) { gm[i][0] = *(const f32x4*)(A.in[14] + 512 * i + 8 * lane); gm[i][1] = *(const f32x4*)(A.in[14] + 512 * i + 8 * lane + 4); }
    for (int m = gw; m < MT; m += NGW) {
        f32x4 p0[2], p1[2]; v4u hv[2], ov[2];
#pragma unroll
        for (int i = 0; i < 2; ++i) { const int col = 512 * i + 8 * lane, hh = col >> 8;
            p0[i] = *(const GAS f32x4*)(HSS + (size_t)m * 32 + hh * 8); p1[i] = *(const GAS f32x4*)(HSS + (size_t)m * 32 + hh * 8 + 4);
            hv[i] = *(const GAS v4u*)(HS + (size_t)m * 1024 + col); ov[i] = *(const GAS v4u*)(OG + (size_t)m * 1024 + col); }
        v4u o[2];
#pragma unroll
        for (int i = 0; i < 2; ++i) {
            const float ss = (p0[i][0] + p0[i][1]) + (p0[i][2] + p0[i][3]) + (p1[i][0] + p1[i][1]) + (p1[i][2] + p1[i][3]);
            const float rstd = 1.0f / sqrtf(ss * (1.0f / DV) + EPS);
            o[i].x = cvtpk(bflo(hv[i].x) * rstd * gm[i][0][0] * sigmoidf_(bflo(ov[i].x)), bfhi(hv[i].x) * rstd * gm[i][0][1] * sigmoidf_(bfhi(ov[i].x)));
            o[i].y = cvtpk(bflo(hv[i].y) * rstd * gm[i][0][2] * sigmoidf_(bflo(ov[i].y)), bfhi(hv[i].y) * rstd * gm[i][0][3] * sigmoidf_(bfhi(ov[i].y)));
            o[i].z = cvtpk(bflo(hv[i].z) * rstd * gm[i][1][0] * sigmoidf_(bflo(ov[i].z)), bfhi(hv[i].z) * rstd * gm[i][1][1] * sigmoidf_(bfhi(ov[i].z)));
            o[i].w = cvtpk(bflo(hv[i].w) * rstd * gm[i][1][2] * sigmoidf_(bflo(ov[i].w)), bfhi(hv[i].w) * rstd * gm[i][1][3] * sigmoidf_(bfhi(ov[i].w))); }
#pragma unroll
        for (int i = 0; i < 2; ++i) *(GAS v4u*)(MIXIN + (size_t)m * 2048 + 512 * i + 8 * lane) = o[i];
    }
}
__device__ __forceinline__ float row_ss_part(const float* SSp, const float* SSs, int m, int lane) {
    if (m < MP) return (lane < 32) ? SSp[(size_t)m * 32 + lane] : 0.f;
    return SSs[(size_t)(m - MP) * 128 + lane] + SSs[(size_t)(m - MP) * 128 + 64 + lane];
}
__device__ __forceinline__ void rowpass1(const Args& A, int lane, int gw, int NGW) {
    unsigned char* ws = A.ws;
    const bf16* MIX = (const bf16*)(ws + WS_MIX); bf16* X1B = (bf16*)(ws + WS_X1B); float* RSTD2 = (float*)(ws + WS_SSS + SSS_RSTD2);
    const float* SSp = (const float*)(ws + WS_SS1); const float* SSs = (const float*)(ws + WS_SSS + SSS_1);
    const float* RSTD1 = (const float*)(ws + WS_SSS + SSS_RSTD1);
    f32x4 g1[8], gi[8];
#pragma unroll
    for (int j = 0; j < 8; ++j) { g1[j] = *(const f32x4*)(A.in[26] + 256 * j + 4 * lane); const f32x4 g0 = *(const f32x4*)(A.in[8] + 256 * j + 4 * lane);
        gi[j] = (f32x4){1.0f / g0[0], 1.0f / g0[1], 1.0f / g0[2], 1.0f / g0[3]}; }
    u32x2 va[8], vb[8], ma[8], mb[8]; float sa = 0.f, sb = 0.f, ra = 0.f, rb = 0.f;
#define RP1_LOAD(V, M, S, R, m_) do { const int mm_ = (m_); \
        S = row_ss_part(SSp, SSs, mm_, lane); R = RSTD1[mm_]; \
        _Pragma("unroll") for (int j = 0; j < 8; ++j) { const int k = 256 * j + 4 * lane; V[j] = *(const GAS u32x2*)(X1B + (size_t)mm_ * DM + k); M[j] = *(const GAS u32x2*)(MIX + (size_t)mm_ * DM + k); } } while (0)
#define RP1_PROC(V, M, S, R, m_) do { const int mm_ = (m_); \
        const float rstd1 = 1.0f / sqrtf(wave_sum(S) * (1.0f / DM) + EPS); float s = 0.f; f32x4 O[8]; \
        _Pragma("unroll") for (int j = 0; j < 8; ++j) { f32x4 o; o[0] = bflo(V[j].x) * R * gi[j][0] + bflo(M[j].x) * rstd1 * g1[j][0]; o[1] = bfhi(V[j].x) * R * gi[j][1] + bfhi(M[j].x) * rstd1 * g1[j][1]; \
            o[2] = bflo(V[j].y) * R * gi[j][2] + bflo(M[j].y) * rstd1 * g1[j][2]; o[3] = bfhi(V[j].y) * R * gi[j][3] + bfhi(M[j].y) * rstd1 * g1[j][3]; \
            s += (o[0] * o[0] + o[1] * o[1]) + (o[2] * o[2] + o[3] * o[3]); O[j] = o; } \
        const float ms2 = wave_sum(s) * (1.0f / DM) + EPS, rstd2 = 1.0f / sqrtf(ms2); \
        _Pragma("unroll") for (int j = 0; j < 8; ++j) { u32x2 o; o.x = cvtpk(O[j][0] * rstd2, O[j][1] * rstd2); o.y = cvtpk(O[j][2] * rstd2, O[j][3] * rstd2); \
            *(GAS u32x2*)(X1B + (size_t)mm_ * DM + 256 * j + 4 * lane) = o; } \
        if (lane == 0) RSTD2[mm_] = sqrtf(ms2); } while (0)
    int m = gw;
    if (m < MT) { RP1_LOAD(va, ma, sa, ra, m);
        for (;;) { const int m2 = m + NGW; if (m2 < MT) RP1_LOAD(vb, mb, sb, rb, m2); RP1_PROC(va, ma, sa, ra, m); if (m2 >= MT) break;
                   m = m2 + NGW; if (m < MT) RP1_LOAD(va, ma, sa, ra, m); RP1_PROC(vb, mb, sb, rb, m2); if (m >= MT) break; } }
#undef RP1_LOAD
#undef RP1_PROC
}
__device__ __forceinline__ void rowpass2(const Args& A, int lane, int gw, int NGW) {
    unsigned char* ws = A.ws;
    const bf16* FF = (const bf16*)(ws + WS_FF); const bf16* X1B = (const bf16*)(ws + WS_X1B);
    const float* SSp = (const float*)(ws + WS_SS2); const float* SSs = (const float*)(ws + WS_SSS + SSS_2);
    f32x4 g3[8];
#pragma unroll
    for (int j = 0; j < 8; ++j) g3[j] = *(const f32x4*)(A.in[31] + 256 * j + 4 * lane);
    u32x2 xa[8], xb[8], fa[8], fb[8]; float sa = 0.f, sb = 0.f;
    const float* RSTD2 = (const float*)(ws + WS_SSS + SSS_RSTD2); float ra = 0.f, rb = 0.f;
#define RP2_LOAD(X, F, S, R, m_) do { const int mm_ = (m_); S = row_ss_part(SSp, SSs, mm_, lane); R = RSTD2[mm_]; \
        _Pragma("unroll") for (int j = 0; j < 8; ++j) { const int k = 256 * j + 4 * lane; X[j] = *(const GAS u32x2*)(X1B + (size_t)mm_ * DM + k); F[j] = *(const GAS u32x2*)(FF + (size_t)mm_ * DM + k); } } while (0)
#define RP2_PROC(X, F, S, R, m_) do { const int mm_ = (m_); float* orow = A.out + O_Y + (size_t)mm_ * DM; const float rstd = 1.0f / sqrtf(wave_sum(S) * (1.0f / DM) + EPS); f32x4 V[8]; \
        _Pragma("unroll") for (int j = 0; j < 8; ++j) { V[j][0] = bflo(X[j].x) * R + bflo(F[j].x) * rstd * g3[j][0]; V[j][1] = bfhi(X[j].x) * R + bfhi(F[j].x) * rstd * g3[j][1]; V[j][2] = bflo(X[j].y) * R + bflo(F[j].y) * rstd * g3[j][2]; V[j][3] = bfhi(X[j].y) * R + bfhi(F[j].y) * rstd * g3[j][3]; } \
        DBG_PERTURB(V, mm_); \
        _Pragma("unroll") for (int j = 0; j < 8; ++j) __builtin_nontemporal_store(V[j], (GAS f32x4*)(orow + 256 * j + 4 * lane)); } while (0)
    int m = gw;
    if (m < MT) { RP2_LOAD(xa, fa, sa, ra, m);
        for (;;) { const int m2 = m + NGW; if (m2 < MT) RP2_LOAD(xb, fb, sb, rb, m2); RP2_PROC(xa, fa, sa, ra, m); if (m2 >= MT) break;
                   m = m2 + NGW; if (m < MT) RP2_LOAD(xa, fa, sa, ra, m); RP2_PROC(xb, fb, sb, rb, m2); if (m >= MT) break; } }
#undef RP2_LOAD
#undef RP2_PROC
}
#ifndef MK_AL_P4
#define MK_AL_P4 true
#endif
#ifndef MK_AL_SS
#define MK_AL_SS true
#endif
#ifndef MK_WGM_P5
#define MK_WGM_P5 4
#endif
#ifndef MK_WGM_P1
#define MK_WGM_P1 2
#endif
#ifndef MK_WGM_P7
#define MK_WGM_P7 4
#endif
#ifndef MK_WGM_P8
#define MK_WGM_P8 1
#endif
#ifndef MK_GU_ALIGN
#define MK_GU_ALIGN true
#endif
#ifndef MK_GU_SP2
#define MK_GU_SP2 true
#endif
__global__ void __launch_bounds__(NWAVES * 64, 2) hymba_fwd(Args args) {
    extern __shared__ __attribute__((aligned(16))) unsigned char lds_raw[];
    LAS unsigned char* lds = (LAS unsigned char*)lds_raw;
    volatile LAS unsigned* MISC = (volatile LAS unsigned*)(lds + MISC_OFF);
    const int tid = threadIdx.x, lane = tid & 63, wave = __builtin_amdgcn_readfirstlane(tid >> 6);
    const int G = gridDim.x; const int bx = blockIdx.x; const int vcu = (G % 8 == 0) ? (bx % 8) * (G / 8) + bx / 8 : bx;
    unsigned char* ws = args.ws;
    gu32* ctl = (gu32*)(ws + WS_CTL);
    for (int u = tid; u < (LDS_BYTES - LDSCTL_OFF) / 4; u += NWAVES * 64) ((LAS unsigned*)(lds + LDSCTL_OFF))[u] = 0u;
    __syncthreads();
    const XcdBarrier bar = xcd_barrier_post((unsigned*)(ctl + CW_BAR) + args.li * XCD_BAR_WORDS, MISC + 8);
#define GRID_BAR() xcd_barrier(bar)
    const int lo = args.ph_lo, hi = args.ph_hi;
#define IN(k) (lo <= (k) && (k) < hi)
#define BOTH(k) (IN(k) && IN((k) + 1))

    const int gw = vcu * NWAVES + wave, NGW = G * NWAVES;

    if (IN(0)) { p0_prologue(args, lds, tid, lane, wave, vcu, G); if (BOTH(0)) GRID_BAR(); }

    if (IN(1)) {
        { pg8::Gemm g{(const bf16*)(ws + WS_XN), (const bf16*)(ws + WS_WIN), MP, 4096, DM}; pg8::StaticOrder S; S.init(MP, 4096, G, bx, MK_WGM_P1);
          pg8::EpiBf16<0> E{(bf16*)(ws + WS_QKRAW), 1024, nullptr, 1024, (size_t)WS_RSTRIDE / 2, 1.f};
          pg8::gemm_phase<pg8::EpiBf16<0>, pg8::StaticOrder, true, true>(lds + RING_OFF, g, S, E); }
        { bf16* O = (bf16*)(ws + WS_QKRAW);
          skinny_gemm<1, DM>((const bf16*)(ws + WS_XN) + (size_t)MP * DM, (const bf16*)(ws + WS_WIN), lds, 4096 / 16, vcu, G, tid, wave, lane,
              [](int it, int a, int fr) { return 16 * it + fr; },
              [O](int it, int row, int fq, const f32x4 (&acc)[1]) { const int col = 16 * it + 4 * fq, t = col >> 10;
                  u32x2 w; w.x = cvtpk_n(acc[0][0], acc[0][1]); w.y = cvtpk_n(acc[0][2], acc[0][3]);
                  *(GAS u32x2*)(O + (size_t)t * (WS_RSTRIDE / 2) + (size_t)(MP + row) * 1024 + (col & 1023)) = w; }); }
        if (BOTH(1)) GRID_BAR();
    }

    if (IN(2)) { if (vcu < 64) p2_scalars(args, lds, lane, wave, vcu); p2_conv(args, tid, vcu, G); if (BOTH(2)) GRID_BAR(); }

    if (IN(3)) {
        const int half = G / 2;
#ifndef MK_REP_M
#define MK_REP_M 1
#endif
#ifndef MK_REP_S
#define MK_REP_S 1
#endif
        if (vcu < half) { for (int rp_ = 0; rp_ < MK_REP_M; ++rp_) for (int it = vcu; it < NBATCH * NH * NSL; it += half) mlstm_item(args, lds, tid, lane, wave, it); }
        else { const int nb = G - half, bi = vcu - half;
               for (int rp_ = 0; rp_ < MK_REP_S; ++rp_)
               for (int it = bi * 4 + (wave & 3); it < 2 * NBATCH * NG; it += nb * 4) s5_item(args, lds + (wave & 3) * 25600, lane, wave >> 2, it); }
        if (vcu >= half) { __syncthreads(); for (int it = NBATCH * NH * NSL + (vcu - half); it < 2 * NBATCH * NH * NSL; it += G - half) mlstm_item(args, lds, tid, lane, wave, it); }
        if (BOTH(3)) GRID_BAR();
    }

    if (IN(4)) {
        { pg8::Gemm g{(const bf16*)(ws + WS_Z), (const bf16*)(ws + WS_WGLU), MP, 1024, 1024}; pg8::StaticOrder S; S.init(MP, 1024, G, bx);
          pg8::EpiGlu E{(const bf16*)(ws + WS_Z), (bf16*)(ws + WS_MIXIN), args.in[24]};
          pg8::gemm_phase<pg8::EpiGlu, pg8::StaticOrder, MK_AL_P4, true>(lds + RING_OFF, g, S, E); }
        { const bf16* Zb = (const bf16*)(ws + WS_Z); bf16* O = (bf16*)(ws + WS_MIXIN); const float* bias = args.in[24];
          skinny_gemm<1, 1024>(Zb + (size_t)MP * 1024, (const bf16*)(ws + WS_WGLU), lds, 1024 / 16, vcu, G, tid, wave, lane,
              [](int it, int a, int fr) { return 16 * it + fr; },
              [Zb, O, bias](int it, int row, int fq, const f32x4 (&acc)[1]) { const int col = 16 * it + 4 * fq; const size_t m = (size_t)(MP + row);
                  const u32x2 z = *(const GAS u32x2*)(Zb + m * 1024 + col); const f32x4 bv = *(const f32x4*)(bias + col);
                  u32x2 w; w.x = cvtpk(bflo(z.x) * sigmoidf_(acc[0][0] + bv[0]), bfhi(z.x) * sigmoidf_(acc[0][1] + bv[1]));
                  w.y = cvtpk(bflo(z.y) * sigmoidf_(acc[0][2] + bv[2]), bfhi(z.y) * sigmoidf_(acc[0][3] + bv[3]));
                  *(GAS u32x2*)(O + m * 2048 + 1024 + col) = w; }); }
        outa_rows(args, lane, gw, NGW);
        if (BOTH(4)) GRID_BAR();
    }

    if (IN(5)) {
        { pg8::Gemm g{(const bf16*)(ws + WS_MIXIN), (const bf16*)(ws + WS_WOUT), MP, DM, DM}; pg8::StaticOrder S; S.init(MP, DM, G, bx, MK_WGM_P5);
          pg8::EpiSS E{(bf16*)(ws + WS_MIX), DM, (float*)(ws + WS_SS1)};
          pg8::gemm_phase<pg8::EpiSS, pg8::StaticOrder, MK_AL_SS, true>(lds + RING_OFF, g, S, E); }
        { bf16* O = (bf16*)(ws + WS_MIX); float* SSs = (float*)(ws + WS_SSS + SSS_1);
          skinny_gemm<1, DM>((const bf16*)(ws + WS_MIXIN) + (size_t)MP * DM, (const bf16*)(ws + WS_WOUT), lds, DM / 16, vcu, G, tid, wave, lane,
              [](int it, int a, int fr) { return 16 * it + fr; },
              [O, SSs](int it, int row, int fq, const f32x4 (&acc)[1]) { const int col = 16 * it + 4 * fq;
                  u32x2 w; w.x = cvtpk_n(acc[0][0], acc[0][1]); w.y = cvtpk_n(acc[0][2], acc[0][3]);
                  *(GAS u32x2*)(O + (size_t)(MP + row) * DM + col) = w;
                  float s = (acc[0][0] * acc[0][0] + acc[0][1] * acc[0][1]) + (acc[0][2] * acc[0][2] + acc[0][3] * acc[0][3]);
                  s += __shfl_xor(s, 16); s += __shfl_xor(s, 32);
                  if (fq == 0) SSs[(size_t)row * 128 + it] = s; }); }
        if (BOTH(5)) GRID_BAR();
    }

    if (IN(6)) { rowpass1(args, lane, gw, NGW); if (BOTH(6)) GRID_BAR(); }

    if (IN(7)) {
        { pg8::Gemm g{(const bf16*)(ws + WS_X1B), (const bf16*)(ws + WS_WGU), MP, 2 * DFF, DM}; pg8::StaticOrder S; S.init(MP, 2 * DFF, G, bx, MK_WGM_P7);
          pg8::EpiGU E{(bf16*)(ws + WS_ACT), DFF};
          pg8::gemm_phase<pg8::EpiGU, pg8::StaticOrder, MK_GU_ALIGN, MK_GU_SP2>(lds + RING_OFF, g, S, E); }
        { bf16* O = (bf16*)(ws + WS_ACT);
          skinny_gemm<2, DM>((const bf16*)(ws + WS_X1B) + (size_t)MP * DM, (const bf16*)(ws + WS_WGU), lds, DFF / 16, vcu, G, tid, wave, lane,
              [](int it, int a, int fr) { const int j = 16 * it + fr; return 256 * (j >> 7) + 128 * a + (j & 127); },
              [O](int it, int row, int fq, const f32x4 (&acc)[2]) { const int col = 16 * it + 4 * fq; const f32x4 g = acc[0], up = acc[1];
                  u32x2 w; w.x = cvtpk(g[0] * sigmoidf_(g[0]) * up[0], g[1] * sigmoidf_(g[1]) * up[1]);
                  w.y = cvtpk(g[2] * sigmoidf_(g[2]) * up[2], g[3] * sigmoidf_(g[3]) * up[3]);
                  *(GAS u32x2*)(O + (size_t)(MP + row) * DFF + col) = w; }); }
        if (BOTH(7)) GRID_BAR();
    }

    if (IN(8)) {
        { pg8::Gemm g{(const bf16*)(ws + WS_ACT), (const bf16*)(ws + WS_WD), MP, DM, DFF}; pg8::StaticOrder S; S.init(MP, DM, G, bx, MK_WGM_P8);
          pg8::EpiSS E{(bf16*)(ws + WS_FF), DM, (float*)(ws + WS_SS2)};
          pg8::gemm_phase<pg8::EpiSS, pg8::StaticOrder, MK_AL_SS, true>(lds + RING_OFF, g, S, E); }
        { bf16* O = (bf16*)(ws + WS_FF); float* SSs = (float*)(ws + WS_SSS + SSS_2);
          skinny_gemm<1, DFF>((const bf16*)(ws + WS_ACT) + (size_t)MP * DFF, (const bf16*)(ws + WS_WD), lds, DM / 16, vcu, G, tid, wave, lane,
              [](int it, int a, int fr) { return 16 * it + fr; },
              [O, SSs](int it, int row, int fq, const f32x4 (&acc)[1]) { const int col = 16 * it + 4 * fq;
                  u32x2 w; w.x = cvtpk_n(acc[0][0], acc[0][1]); w.y = cvtpk_n(acc[0][2], acc[0][3]);
                  *(GAS u32x2*)(O + (size_t)(MP + row) * DM + col) = w;
                  float s = (acc[0][0] * acc[0][0] + acc[0][1] * acc[0][1]) + (acc[0][2] * acc[0][2] + acc[0][3] * acc[0][3]);
                  s += __shfl_xor(s, 16); s += __shfl_xor(s, 32);
                  if (fq == 0) SSs[(size_t)row * 128 + it] = s; }); }
        if (BOTH(8)) GRID_BAR();
    }

    if (IN(9)) { rowpass2(args, lane, gw, NGW); }
#undef IN
#undef BOTH
}

#ifdef MK_DUMP_OFF
__global__ void dump_kernel(const unsigned short* src, float* dst, size_t n) {
    for (size_t i = (size_t)blockIdx.x * blockDim.x + threadIdx.x; i < n; i += (size_t)gridDim.x * blockDim.x) dst[i] = __uint_as_float((unsigned)src[i] << 16);
}
#endif
extern "C" void kernel_launch(void* const* d_in, const int* in_sizes, int n_in, void* d_out, int out_size, void* d_ws, size_t ws_size, hipStream_t stream) {
    static int grid = 0;
    if (grid == 0) {
        if (n_in != 32 || out_size != (int)O_END || ws_size < WS_END) { fprintf(stderr, "kernel_launch: unexpected problem: n_in %d out %d ws %zu\n", n_in, out_size, ws_size); grid = -1; return; }
        int dev = 0, cus = 0, per_cu = 0;
        if (hipGetDevice(&dev) != hipSuccess || hipDeviceGetAttribute(&cus, hipDeviceAttributeMultiprocessorCount, dev) != hipSuccess) { grid = -1; return; }
        if (hipFuncSetAttribute((const void*)hymba_fwd, hipFuncAttributeMaxDynamicSharedMemorySize, LDS_BYTES) != hipSuccess) { fprintf(stderr, "kernel_launch: hipFuncSetAttribute failed\n"); grid = -1; return; }
        if (hipOccupancyMaxActiveBlocksPerMultiprocessor(&per_cu, (const void*)hymba_fwd, NWAVES * 64, LDS_BYTES) != hipSuccess || per_cu < 1) { fprintf(stderr, "kernel_launch: occupancy query reports %d\n", per_cu); per_cu = 1; }
        (void)hipGetLastError();
        grid = cus;
    }
    if (grid < 0) return;
    Args a{};
    for (int i = 0; i < 32; ++i) a.in[i] = (const float*)d_in[i];
    a.out = (float*)d_out; a.ws = (unsigned char*)d_ws;
    int lo[N_PHASES + 2], hi[N_PHASES + 2], nl = 0;
#if defined(MK_REPEAT)
    lo[0] = 0; hi[0] = MK_REPEAT + 1; lo[1] = MK_REPEAT; hi[1] = MK_REPEAT + 1; lo[2] = MK_REPEAT + 1; hi[2] = N_PHASES; nl = 3;
#else
    if (N_LAUNCHES == 1) { lo[0] = 0; hi[0] = N_PHASES; nl = 1; } else { for (int k = 0; k < N_PHASES; ++k) { lo[k] = k; hi[k] = k + 1; } nl = N_PHASES; }
#endif
    if (hipMemsetAsync((char*)d_ws + WS_CTL, 0, (size_t)(CW_BAR + nl * XCD_BAR_WORDS) * 4, stream) != hipSuccess) return;
    for (int li = 0; li < nl; ++li) {
        a.ph_lo = lo[li]; a.ph_hi = hi[li]; a.li = li;
        hipLaunchKernelGGL(hymba_fwd, dim3(grid), dim3(NWAVES * 64), LDS_BYTES, stream, a);
    }
#ifdef MK_DUMP_OFF
    hipLaunchKernelGGL(dump_kernel, dim3(2048), dim3(256), 0, stream, (const unsigned short*)((const unsigned char*)d_ws + (size_t)(MK_DUMP_OFF) * MiB), (float*)d_out, (size_t)(MK_DUMP_N));
#endif
}
```

```cpp
#define MK_N_LAUNCHES 1
#include <hip/hip_runtime.h>
#include <cstdio>
#include <cstdint>
#include <cmath>
namespace pg8 {
#define PG8_LAS __attribute__((address_space(3)))
typedef unsigned short bf16_t;
typedef short bf16x8 __attribute__((ext_vector_type(8)));
typedef float f32x4 __attribute__((ext_vector_type(4)));
typedef unsigned u32x4 __attribute__((ext_vector_type(4)));
typedef int i32x4 __attribute__((ext_vector_type(4)));
typedef int i32x8 __attribute__((ext_vector_type(8)));
__device__ __forceinline__ i32x8 cat8(bf16x8 lo, bf16x8 hi) { return __builtin_shufflevector(__builtin_bit_cast(i32x4, lo), __builtin_bit_cast(i32x4, hi), 0, 1, 2, 3, 4, 5, 6, 7); }
constexpr int BM = 256, BK = 64, HALF = 128, HTB = HALF * BK * 2  , STAGE_BYTES = 8 * HTB, NXCD = 8, WGM = 4;

__host__ __device__ __forceinline__ int lds_byte(int r, int c) { const int st = (r >> 4) * 2 + (c >> 5), rr = r & 15, cc = c & 31, ob = rr * 64 + cc * 2; return st * 1024 + (ob ^ (((ob >> 9) & 1) << 5)); }
__host__ __device__ __forceinline__ void stage_rc(int b, int& R, int& C) { const int st = b / 1024, sb = b % 1024, swz = sb ^ (((sb >> 9) & 1) << 5); R = (st >> 1) * 16 + swz / 64; C = (st & 1) * 32 + (swz % 64) / 2; }
__host__ __device__ __forceinline__ int perm32(int rho) { const int n = rho >> 4, i = rho & 15; return 8 * (i >> 2) + 4 * n + (i & 3); }

struct Unit { int pm, pn; };
struct Gemm { const bf16_t* A; const bf16_t* Bt; int M, N, K; };

struct StaticOrder {
    int nM, nN, nwg, G, c, wgm;
    __host__ __device__ void init(int M, int N, int G_, int c_, int wgm_ = WGM) { nM = M / BM; nN = N / BM; nwg = nM * nN; G = G_; c = c_; wgm = wgm_; }
    __host__ __device__ bool next(int i, Unit& u) const {
        const long L = (long)i * G + c; if (L >= nwg) return false;
        int wgid = (int)L; { const int q = nwg / NXCD, r = nwg % NXCD, xcd = wgid % NXCD, off = wgid / NXCD; wgid = (xcd < r ? xcd * (q + 1) : r * (q + 1) + (xcd - r) * q) + off; }
        const int nig = wgm * nN, gid = wgid / nig, fm = gid * wgm, gsz = (nM - fm) < wgm ? (nM - fm) : wgm;
        u.pm = fm + ((wgid % nig) % gsz); u.pn = (wgid % nig) / gsz; return true;
    }
    __device__ __forceinline__ void a_ready(const Unit&) const {}
    __device__ __forceinline__ void done(const Unit&) const {}
};

__device__ __forceinline__ unsigned cvt_pk_bf16(float lo, float hi) { unsigned r; asm volatile("v_cvt_pk_bf16_f32 %0, %1, %2" : "=v"(r) : "v"(lo), "v"(hi)); return r; }
typedef float f32x2 __attribute__((ext_vector_type(2)));
__device__ __forceinline__ f32x2 gelu_pk(f32x2 v) {
    const f32x2 av = __builtin_elementwise_abs(v), d = av * 0.2316418882f + 1.0f;
    f32x2 t; t.x = __builtin_amdgcn_rcpf(d.x); t.y = __builtin_amdgcn_rcpf(d.y);
    f32x2 q = t * 0.5307027145f + (-0.7265760135f); q = q * t + 0.7107068705f; q = q * t + (-0.142248368f); q = q * t + 0.127414796f; q = q * t;
    const f32x2 s = (v * v) * (-0.72134752044f);
    f32x2 e; e.x = __builtin_amdgcn_exp2f(s.x); e.y = __builtin_amdgcn_exp2f(s.y);
    const f32x2 m = v * (q * e), r = v - m;
    f32x2 o; o.x = v.x < 0.f ? m.x : r.x; o.y = v.y < 0.f ? m.y : r.y; return o;
}

template <int ACT  > struct EpiBf16 {
    static constexpr bool PERM = true, AFTER_DRAIN = false; static_assert(ACT == 0 || ACT == 1, "EpiBf16: ACT is 0 (none) or 1 (gelu_pk)");
    bf16_t* O; int ldc; const float* bias; int split_cols; size_t split_stride; float scale0;
    __device__ __forceinline__ void operator()(const f32x4 (&acc)[2][2][4][2], const Unit& u, int wr, int wc, int fr, int fq) const {
        const int row0 = u.pm * BM + wr * 64 + fr; int colt = u.pn * BM; bf16_t* base = O;
        float sc = 1.f; if (split_cols) { const int t = colt / split_cols; base += (size_t)t * split_stride; colt -= t * split_cols; if (t == 0) sc = scale0; }
        const int col0 = colt + wc * 32 + 8 * fq, bcol0 = u.pn * BM + wc * 32 + 8 * fq;
        f32x4 bv[2][2];
#pragma unroll
        for (int bj = 0; bj < 2; ++bj)
#pragma unroll
            for (int n = 0; n < 2; ++n) bv[bj][n] = bias ? *(const f32x4*)(bias + bcol0 + bj * HALF + 4 * n) : (f32x4){0.f, 0.f, 0.f, 0.f};
#pragma unroll
        for (int ai = 0; ai < 2; ++ai)
#pragma unroll
            for (int m = 0; m < 4; ++m) { bf16_t* rowp = base + (size_t)(row0 + ai * HALF + m * 16) * ldc + col0;
#pragma unroll
                for (int bj = 0; bj < 2; ++bj) { f32x4 v0 = acc[ai][bj][m][0] + bv[bj][0], v1 = acc[ai][bj][m][1] + bv[bj][1];
                    if (ACT == 1) { f32x2 a = gelu_pk((f32x2){v0[0], v0[1]}), b = gelu_pk((f32x2){v0[2], v0[3]}), c = gelu_pk((f32x2){v1[0], v1[1]}), d = gelu_pk((f32x2){v1[2], v1[3]});
                        v0 = (f32x4){a.x, a.y, b.x, b.y}; v1 = (f32x4){c.x, c.y, d.x, d.y}; }
                    v0 = v0 * sc; v1 = v1 * sc; u32x4 w; w.x = cvt_pk_bf16(v0[0], v0[1]); w.y = cvt_pk_bf16(v0[2], v0[3]); w.z = cvt_pk_bf16(v1[0], v1[1]); w.w = cvt_pk_bf16(v1[2], v1[3]);
                    *(u32x4*)(rowp + bj * HALF) = w; } }
    }
};
__device__ __forceinline__ float fast_sigmoid(float v) { return __builtin_amdgcn_rcpf(1.0f + __expf(-v)); }
__device__ __forceinline__ float bf_lo(unsigned w) { return __uint_as_float(w << 16); }
__device__ __forceinline__ float bf_hi(unsigned w) { return __uint_as_float(w & 0xffff0000u); }
struct EpiGlu {
    static constexpr bool PERM = true, AFTER_DRAIN = false;
    const bf16_t* Z; bf16_t* O; const float* bias;
    __device__ __forceinline__ void operator()(const f32x4 (&acc)[2][2][4][2], const Unit& u, int wr, int wc, int fr, int fq) const {
        const int row0 = u.pm * BM + wr * 64 + fr, col0 = u.pn * BM + wc * 32 + 8 * fq;
        f32x4 bv[2][2];
#pragma unroll
        for (int bj = 0; bj < 2; ++bj)
#pragma unroll
            for (int n = 0; n < 2; ++n) bv[bj][n] = *(const f32x4*)(bias + col0 + bj * HALF + 4 * n);
#pragma unroll
        for (int ai = 0; ai < 2; ++ai) {
            u32x4 z[4][2];
#pragma unroll
            for (int m = 0; m < 4; ++m)
#pragma unroll
                for (int bj = 0; bj < 2; ++bj) z[m][bj] = *(const u32x4*)(Z + (size_t)(row0 + ai * HALF + m * 16) * 1024 + col0 + bj * HALF);
#pragma unroll
            for (int m = 0; m < 4; ++m) { const size_t row = (size_t)(row0 + ai * HALF + m * 16);
#pragma unroll
                for (int bj = 0; bj < 2; ++bj) { const int col = col0 + bj * HALF; const u32x4 zz = z[m][bj];
                    const f32x4 v0 = acc[ai][bj][m][0] + bv[bj][0], v1 = acc[ai][bj][m][1] + bv[bj][1];
                    u32x4 w;
                    w.x = cvt_pk_bf16(bf_lo(zz.x) * fast_sigmoid(v0[0]), bf_hi(zz.x) * fast_sigmoid(v0[1]));
                    w.y = cvt_pk_bf16(bf_lo(zz.y) * fast_sigmoid(v0[2]), bf_hi(zz.y) * fast_sigmoid(v0[3]));
                    w.z = cvt_pk_bf16(bf_lo(zz.z) * fast_sigmoid(v1[0]), bf_hi(zz.z) * fast_sigmoid(v1[1]));
                    w.w = cvt_pk_bf16(bf_lo(zz.w) * fast_sigmoid(v1[2]), bf_hi(zz.w) * fast_sigmoid(v1[3]));
                    *(u32x4*)(O + row * 2048 + 1024 + col) = w; } } }
    }
};
template <bool SCALED> struct EpiSS {
    static constexpr bool PERM = true, AFTER_DRAIN = false;
    bf16_t* O; int ldc; float* SS; float scale;
    __device__ __forceinline__ void operator()(const f32x4 (&acc)[2][2][4][2], const Unit& u, int wr, int wc, int fr, int fq) const {
        const int row0 = u.pm * BM + wr * 64 + fr, col0 = u.pn * BM + wc * 32 + 8 * fq;
        float s[2][4];
#pragma unroll
        for (int ai = 0; ai < 2; ++ai)
#pragma unroll
            for (int m = 0; m < 4; ++m) { const size_t row = (size_t)(row0 + ai * HALF + m * 16); float t = 0.f;
#pragma unroll
                for (int bj = 0; bj < 2; ++bj) { f32x4 v0 = acc[ai][bj][m][0], v1 = acc[ai][bj][m][1]; if (SCALED) { v0 = v0 * scale; v1 = v1 * scale; }
                    t += (v0[0] * v0[0] + v0[1] * v0[1]) + (v0[2] * v0[2] + v0[3] * v0[3]) + (v1[0] * v1[0] + v1[1] * v1[1]) + (v1[2] * v1[2] + v1[3] * v1[3]);
                    u32x4 w; w.x = cvt_pk_bf16(v0[0], v0[1]); w.y = cvt_pk_bf16(v0[2], v0[3]); w.z = cvt_pk_bf16(v1[0], v1[1]); w.w = cvt_pk_bf16(v1[2], v1[3]);
                    *(u32x4*)(O + row * ldc + col0 + bj * HALF) = w; }
                s[ai][m] = t; }
#pragma unroll
        for (int ai = 0; ai < 2; ++ai)
#pragma unroll
            for (int m = 0; m < 4; ++m) s[ai][m] += __shfl_xor(s[ai][m], 16);
#pragma unroll
        for (int ai = 0; ai < 2; ++ai)
#pragma unroll
            for (int m = 0; m < 4; ++m) s[ai][m] += __shfl_xor(s[ai][m], 32);
        if (fq == 0) {
#pragma unroll
            for (int ai = 0; ai < 2; ++ai)
#pragma unroll
                for (int m = 0; m < 4; ++m) SS[(size_t)(row0 + ai * HALF + m * 16) * 32 + u.pn * 4 + wc] = s[ai][m]; }
    }
};
struct EpiGU {
    static constexpr bool PERM = true, AFTER_DRAIN = false;
    bf16_t* O; int ldc;
    static __device__ __forceinline__ unsigned swiglu_pk(f32x2 g, f32x2 u) {
        const f32x2 t = g * -1.4426950408889634f; f32x2 e; e.x = __builtin_amdgcn_exp2f(t.x); e.y = __builtin_amdgcn_exp2f(t.y);
        const f32x2 d = e + 1.0f; f32x2 s; s.x = __builtin_amdgcn_rcpf(d.x); s.y = __builtin_amdgcn_rcpf(d.y);
        const f32x2 o = (g * u) * s; return cvt_pk_bf16(o.x, o.y);
    }
    __device__ __forceinline__ void operator()(const f32x4 (&acc)[2][2][4][2], const Unit& u, int wr, int wc, int fr, int fq) const {
        const int row0 = u.pm * BM + wr * 64 + fr, col0 = u.pn * HALF + wc * 32 + 8 * fq;
#pragma unroll
        for (int ai = 0; ai < 2; ++ai)
#pragma unroll
            for (int m = 0; m < 4; ++m) { const size_t row = (size_t)(row0 + ai * HALF + m * 16);
                const f32x4 g0 = acc[ai][0][m][0], g1 = acc[ai][0][m][1], u0 = acc[ai][1][m][0], u1 = acc[ai][1][m][1];
                u32x4 w;
                w.x = swiglu_pk((f32x2){g0[0], g0[1]}, (f32x2){u0[0], u0[1]});
                w.y = swiglu_pk((f32x2){g0[2], g0[3]}, (f32x2){u0[2], u0[3]});
                w.z = swiglu_pk((f32x2){g1[0], g1[1]}, (f32x2){u1[0], u1[1]});
                w.w = swiglu_pk((f32x2){g1[2], g1[3]}, (f32x2){u1[2], u1[3]});
                *(u32x4*)(O + row * ldc + col0) = w; }
    }
};
struct EpiGU8 {
    static constexpr bool PERM = true, AFTER_DRAIN = false;
    unsigned char* O; int ldc;
    static __device__ __forceinline__ f32x2 swiglu2(f32x2 g, f32x2 u) {
        const f32x2 t = g * -1.4426950408889634f; f32x2 e; e.x = __builtin_amdgcn_exp2f(t.x); e.y = __builtin_amdgcn_exp2f(t.y);
        const f32x2 d = e + 1.0f; f32x2 s; s.x = __builtin_amdgcn_rcpf(d.x); s.y = __builtin_amdgcn_rcpf(d.y);
        f32x2 o = (g * u) * s; o.x = __builtin_amdgcn_fmed3f(o.x, -448.f, 448.f); o.y = __builtin_amdgcn_fmed3f(o.y, -448.f, 448.f); return o;
    }
    __device__ __forceinline__ void operator()(const f32x4 (&acc)[2][2][4][2], const Unit& u, int wr, int wc, int fr, int fq) const {
        const int row0 = u.pm * BM + wr * 64 + fr, col0 = u.pn * HALF + wc * 32 + 8 * fq;
#pragma unroll
        for (int ai = 0; ai < 2; ++ai)
#pragma unroll
            for (int m = 0; m < 4; ++m) { const size_t row = (size_t)(row0 + ai * HALF + m * 16);
                const f32x4 g0 = acc[ai][0][m][0], g1 = acc[ai][0][m][1], u0 = acc[ai][1][m][0], u1 = acc[ai][1][m][1];
                const f32x2 a = swiglu2((f32x2){g0[0], g0[1]}, (f32x2){u0[0], u0[1]}), b = swiglu2((f32x2){g0[2], g0[3]}, (f32x2){u0[2], u0[3]});
                const f32x2 c = swiglu2((f32x2){g1[0], g1[1]}, (f32x2){u1[0], u1[1]}), d = swiglu2((f32x2){g1[2], g1[3]}, (f32x2){u1[2], u1[3]});
                int w0 = 0, w1 = 0;
                w0 = __builtin_amdgcn_cvt_pk_fp8_f32(a.x, a.y, w0, false); w0 = __builtin_amdgcn_cvt_pk_fp8_f32(b.x, b.y, w0, true);
                w1 = __builtin_amdgcn_cvt_pk_fp8_f32(c.x, c.y, w1, false); w1 = __builtin_amdgcn_cvt_pk_fp8_f32(d.x, d.y, w1, true);
                typedef unsigned u32x2_t __attribute__((ext_vector_type(2)));
                *(u32x2_t*)(O + row * ldc + col0) = (u32x2_t){(unsigned)w0, (unsigned)w1}; }
    }
};
template <class Epi, class Sched, bool ALIGN_EPI = false, bool SP2 = false, bool F8 = false>
__device__ __forceinline__ void gemm_phase(PG8_LAS unsigned char* lds, const Gemm g, const Sched& S, const Epi& E) {
    int tid = threadIdx.x; asm volatile("" : "+v"(tid));
    const int wid = __builtin_amdgcn_readfirstlane(tid >> 6), lane = tid & 63, wr = wid >> 2, wc = wid & 3, fr = lane & 15, fq = lane >> 4;
    const int K = g.K, nt = K / BK;
    unsigned voffA[2], voffB[2];
#pragma unroll
    for (int i = 0; i < 2; ++i) { int R, C; stage_rc(tid * 16 + i * 8192, R, C); const int Rb = Epi::PERM ? ((R & ~31) + perm32(R & 31)) : R;
        voffA[i] = (unsigned)(R * K + C) * 2u; voffB[i] = (unsigned)(Rb * K + C) * 2u; }
    const size_t kstep = (size_t)(BK * 2);
    const size_t hstep = (size_t)HALF * K * 2;
    const size_t tstep = 2 * hstep;
    const unsigned ldsw = (unsigned)wid * 1024u;
    const int aoff = lds_byte(wr * 64 + fr, fq * 8), boff = lds_byte(wc * 32 + fr, fq * 8);
#define PG8_SA(b, h) (((b) * 2 + (h)) * HTB)
#define PG8_SB(b, h) ((4 + (b) * 2 + (h)) * HTB)
#define PG8_STAGE(bufoff, gbase, voff) do { _Pragma("unroll") for (int _i = 0; _i < 2; ++_i) { unsigned _vo = (voff)[_i]; asm volatile("" : "+v"(_vo));     \
        __builtin_amdgcn_global_load_lds((const unsigned*)((const char*)(gbase) + _vo), (PG8_LAS unsigned*)(lds + (bufoff) + ldsw + _i * 8192), 16, 0, 0); } } while (0)
#define PG8_LDA(dst, b, h) do { _Pragma("unroll") for (int m = 0; m < 4; ++m) _Pragma("unroll") for (int k = 0; k < 2; ++k) dst[m][k] = *(const PG8_LAS bf16x8*)(lds + PG8_SA(b, h) + aoff + m * 2048 + k * 1024); } while (0)
#define PG8_LDB(dst, b, h) do { _Pragma("unroll") for (int n = 0; n < 2; ++n) _Pragma("unroll") for (int k = 0; k < 2; ++k) dst[n][k] = *(const PG8_LAS bf16x8*)(lds + PG8_SB(b, h) + boff + n * 2048 + k * 1024); } while (0)
#define PG8_MMA(ai, bj, At, Bt) do { __builtin_amdgcn_s_setprio(1); \
        if constexpr (F8) { _Pragma("unroll") for (int m = 0; m < 4; ++m) _Pragma("unroll") for (int n = 0; n < 2; ++n) \
            acc[ai][bj][m][n] = __builtin_amdgcn_mfma_scale_f32_16x16x128_f8f6f4(cat8(Bt[n][0], Bt[n][1]), cat8(At[m][0], At[m][1]), acc[ai][bj][m][n], 0, 0, 0, 0, 0, 0); } \
        else { _Pragma("unroll") for (int m = 0; m < 4; ++m) _Pragma("unroll") for (int n = 0; n < 2; ++n) _Pragma("unroll") for (int k = 0; k < 2; ++k) \
            acc[ai][bj][m][n] = __builtin_amdgcn_mfma_f32_16x16x32_bf16(Bt[n][k], At[m][k], acc[ai][bj][m][n], 0, 0, 0); } \
        __builtin_amdgcn_s_setprio(0); } while (0)
#define PG8_WAIT_V(n) asm volatile("s_waitcnt vmcnt(" #n ")" ::: "memory")
#define PG8_WAIT_L(n) asm volatile("s_waitcnt lgkmcnt(" #n ")" ::: "memory")
#define PG8_BAR __builtin_amdgcn_s_barrier()
#define PG8_SCHED __builtin_amdgcn_sched_barrier(0)
    Unit cur, nxt; int ui = 0;
    if (!S.next(0, cur)) return;
    f32x4 acc[2][2][4][2];
#pragma unroll
    for (int a = 0; a < 2; ++a)
#pragma unroll
        for (int b = 0; b < 2; ++b)
#pragma unroll
            for (int m = 0; m < 4; ++m)
#pragma unroll
                for (int n = 0; n < 2; ++n) acc[a][b][m][n] = (f32x4){0.f, 0.f, 0.f, 0.f};
    bf16x8 At[4][2], B0[2][2], B1[2][2];
    const char* cA = (const char*)g.A + (size_t)cur.pm * tstep; const char* cB = (const char*)g.Bt + (size_t)cur.pn * tstep;
    S.a_ready(cur);
    if constexpr (SP2) {
        PG8_STAGE(PG8_SB(0, 0), cB, voffB); PG8_STAGE(PG8_SB(0, 1), cB + hstep, voffB); PG8_STAGE(PG8_SA(0, 0), cA, voffA); PG8_STAGE(PG8_SA(0, 1), cA + hstep, voffA);
        if (wr == 1) PG8_BAR;
        PG8_WAIT_V(2); PG8_BAR;
        PG8_STAGE(PG8_SB(1, 0), cB + kstep, voffB); PG8_STAGE(PG8_SA(1, 0), cA + kstep, voffA); PG8_STAGE(PG8_SB(1, 1), cB + hstep + kstep, voffB);
        PG8_WAIT_V(6); PG8_BAR;
    } else {
        PG8_STAGE(PG8_SB(0, 0), cB, voffB); PG8_STAGE(PG8_SA(0, 0), cA, voffA); PG8_STAGE(PG8_SB(0, 1), cB + hstep, voffB); PG8_STAGE(PG8_SA(0, 1), cA + hstep, voffA);
        if (wr == 1) PG8_BAR;
        PG8_WAIT_V(4); PG8_BAR;
        PG8_STAGE(PG8_SB(1, 0), cB + kstep, voffB); PG8_STAGE(PG8_SA(1, 0), cA + kstep, voffA); PG8_STAGE(PG8_SB(1, 1), cB + hstep + kstep, voffB);
        PG8_WAIT_V(6); PG8_BAR;
    }
    for (;;) {
        const bool has_next = S.next(ui + 1, nxt);
        const char* nA = has_next ? (const char*)g.A + (size_t)nxt.pm * tstep : cA; const char* nB = has_next ? (const char*)g.Bt + (size_t)nxt.pn * tstep : cB;
        for (int t = 0; t < nt; t += 2) {
            const bool last = (t == nt - 2);
            const char* a1 = cA + (size_t)(t + 1) * kstep;
            const char* a2 = last ? nA : cA + (size_t)(t + 2) * kstep; const char* b2 = last ? nB : cB + (size_t)(t + 2) * kstep;
            const char* a3 = a2 + kstep; const char* b3 = b2 + kstep;
            if (last && has_next) S.a_ready(nxt);
            if constexpr (SP2) {
            PG8_LDB(B0, 0, 0); PG8_LDB(B1, 0, 1); PG8_SCHED; PG8_LDA(At, 0, 0); PG8_STAGE(PG8_SA(1, 1), a1 + hstep, voffA);
            PG8_WAIT_V(8); PG8_WAIT_L(0); PG8_BAR; PG8_MMA(0, 0, At, B0); PG8_MMA(0, 1, At, B1); PG8_BAR; PG8_SCHED;
            PG8_LDA(At, 0, 1); PG8_STAGE(PG8_SB(0, 0), b2, voffB); PG8_STAGE(PG8_SB(0, 1), b2 + hstep, voffB); PG8_STAGE(PG8_SA(0, 0), a2, voffA);
            PG8_WAIT_V(8); PG8_WAIT_L(0); PG8_BAR; PG8_MMA(1, 0, At, B0); PG8_MMA(1, 1, At, B1); PG8_BAR; PG8_SCHED;
            PG8_LDB(B0, 1, 0); PG8_LDB(B1, 1, 1); PG8_SCHED; PG8_LDA(At, 1, 0); PG8_STAGE(PG8_SA(0, 1), a2 + hstep, voffA);
            PG8_WAIT_V(8); PG8_WAIT_L(0); PG8_BAR; PG8_MMA(0, 0, At, B0); PG8_MMA(0, 1, At, B1); PG8_BAR; PG8_SCHED;
            PG8_LDA(At, 1, 1); PG8_STAGE(PG8_SB(1, 0), b3, voffB); PG8_STAGE(PG8_SB(1, 1), b3 + hstep, voffB); PG8_STAGE(PG8_SA(1, 0), a3, voffA);
            PG8_WAIT_V(8); PG8_WAIT_L(0); PG8_BAR; PG8_MMA(1, 0, At, B0); PG8_MMA(1, 1, At, B1); PG8_BAR; PG8_SCHED;
            } else {
            PG8_LDB(B0, 0, 0); PG8_SCHED; PG8_LDA(At, 0, 0); PG8_STAGE(PG8_SA(1, 1), a1 + hstep, voffA);
            PG8_WAIT_L(8); PG8_BAR; PG8_WAIT_L(0); PG8_MMA(0, 0, At, B0); PG8_BAR; PG8_SCHED;
            PG8_LDB(B1, 0, 1); PG8_STAGE(PG8_SB(0, 0), b2, voffB);
            PG8_BAR; PG8_WAIT_L(0); PG8_MMA(0, 1, At, B1); PG8_BAR;
            PG8_LDA(At, 0, 1); PG8_STAGE(PG8_SA(0, 0), a2, voffA);
            PG8_BAR; PG8_WAIT_L(0); PG8_MMA(1, 0, At, B0); PG8_BAR; PG8_SCHED;
            PG8_STAGE(PG8_SB(0, 1), b2 + hstep, voffB);
            PG8_WAIT_V(6); PG8_BAR; PG8_MMA(1, 1, At, B1); PG8_BAR;
            PG8_LDB(B0, 1, 0); PG8_SCHED; PG8_LDA(At, 1, 0); PG8_STAGE(PG8_SA(0, 1), a2 + hstep, voffA);
            PG8_WAIT_L(8); PG8_BAR; PG8_WAIT_L(0); PG8_MMA(0, 0, At, B0); PG8_BAR; PG8_SCHED;
            PG8_LDB(B1, 1, 1); PG8_STAGE(PG8_SB(1, 0), b3, voffB);
            PG8_BAR; PG8_WAIT_L(0); PG8_MMA(0, 1, At, B1); PG8_BAR;
            PG8_LDA(At, 1, 1); PG8_STAGE(PG8_SA(1, 0), a3, voffA);
            PG8_BAR; PG8_WAIT_L(0); PG8_MMA(1, 0, At, B0); PG8_BAR; PG8_SCHED;
            PG8_STAGE(PG8_SB(1, 1), b3 + hstep, voffB);
            PG8_WAIT_V(6); PG8_BAR; PG8_MMA(1, 1, At, B1); PG8_BAR;
            }
        }
        if constexpr (ALIGN_EPI) { if (wr == 0) PG8_BAR; }
        if constexpr (!Epi::AFTER_DRAIN) { int t2 = threadIdx.x; asm volatile("" : "+v"(t2)); E(acc, cur, wr, wc, t2 & 15, (t2 >> 4) & 3); S.done(cur); }
        if (!has_next) break;
#pragma unroll
        for (int a = 0; a < 2; ++a)
#pragma unroll
            for (int b = 0; b < 2; ++b)
#pragma unroll
                for (int m = 0; m < 4; ++m)
#pragma unroll
                    for (int n = 0; n < 2; ++n) acc[a][b][m][n] = (f32x4){0.f, 0.f, 0.f, 0.f};
        cur = nxt; cA = nA; cB = nB; ++ui;
        if constexpr (ALIGN_EPI) { if (wr == 1) PG8_BAR; }
    }
    PG8_WAIT_V(0);
    if constexpr (!ALIGN_EPI) { if (wr == 0) PG8_BAR; }
    PG8_BAR;
    if constexpr (Epi::AFTER_DRAIN) { E.fused(acc, cur, wr, wc, fr, fq, lds, wid, lane); S.done(cur); }
#undef PG8_SA
#undef PG8_SB
#undef PG8_STAGE
#undef PG8_LDA
#undef PG8_LDB
#undef PG8_MMA
#undef PG8_WAIT_V
#undef PG8_WAIT_L
#undef PG8_BAR
#undef PG8_SCHED
}
}
#define GAS __attribute__((address_space(1)))
#define LAS __attribute__((address_space(3)))
typedef unsigned short bf16;
typedef unsigned v4u __attribute__((ext_vector_type(4)));
typedef float f32x4 __attribute__((ext_vector_type(4)));
typedef short bf16x8 __attribute__((ext_vector_type(8)));
typedef GAS unsigned gu32;
typedef GAS unsigned long long gu64;
#define RLX_AGENT __ATOMIC_RELAXED, __HIP_MEMORY_SCOPE_AGENT
#define LDS_WAIT() asm volatile("s_waitcnt lgkmcnt(0)" ::: "memory")
#define VM_WAIT() asm volatile("s_waitcnt vmcnt(0)" ::: "memory")
__device__ __forceinline__ unsigned long long rt() { return __builtin_amdgcn_s_memrealtime(); }
__device__ __forceinline__ unsigned f2bf(float f) { unsigned u = __builtin_bit_cast(unsigned, f); return (u + 0x7fffu + ((u >> 16) & 1u)) >> 16; }
__device__ __forceinline__ unsigned pk2(float lo, float hi) { return f2bf(lo) | (f2bf(hi) << 16); }
#define XB_TMO      128
#define XB_XCNT(j)  (256  + 64 * (j))
#define XB_XSUB(j)  (1280 + 64 * (j))
#define XB_XGEN(j)  (2304 + 64 * (j))
#define XB_TOP      3328
#define XB_TOPGEN   3392
#define XCD_BAR_WORDS 3456
#define XB_SPIN_CAP (1u << 18)

__device__ __forceinline__ unsigned xb_ld(unsigned* p)              { return __hip_atomic_load(p, __ATOMIC_RELAXED, __HIP_MEMORY_SCOPE_AGENT); }
__device__ __forceinline__ unsigned xb_add(unsigned* p, unsigned v) { return __hip_atomic_fetch_add(p, v, __ATOMIC_RELAXED, __HIP_MEMORY_SCOPE_AGENT); }
__device__ __forceinline__ unsigned xb_xcc_id() { return (unsigned)__builtin_amdgcn_s_getreg((3 << 11) | 20) & 0xFu; }
#define XB_SPIN(cond, bar) do { unsigned _sp = 0; while (cond) { __builtin_amdgcn_s_sleep(1); \
    if ((++_sp & 255u) == 0u) { if (xb_ld(&(bar)[XB_TMO])) break; if (_sp > XB_SPIN_CAP) { atomicAdd(&(bar)[XB_TMO], 1u); break; } } } } while (0)

struct XcdBarrier {
    unsigned* bar; unsigned x;
    volatile LAS unsigned* st;
};

__device__ __forceinline__ XcdBarrier xcd_barrier_post(unsigned* bar, volatile LAS unsigned* st) {
    XcdBarrier b; b.bar = bar; b.x = xb_xcc_id(); b.st = st;
    if (threadIdx.x == 0) (void)xb_add(&bar[XB_XCNT(b.x)], 1u);
    return b;
}
__device__ __forceinline__ void xcd_barrier_complete(unsigned* bar, unsigned x, unsigned& nloc, unsigned& nx) {
    const unsigned G = gridDim.x * gridDim.y * gridDim.z;
    unsigned sum, cnt, mine, sp = 0u;
    for (;;) {
        sum = 0u; cnt = 0u; mine = 0u;
#pragma unroll
        for (unsigned j = 0; j < 16; ++j) { const unsigned c = xb_ld(&bar[XB_XCNT(j)]); sum += c; cnt += (c > 0u) ? 1u : 0u; mine = (j == x) ? c : mine; }
        if (sum == G) break;
        __builtin_amdgcn_s_sleep(1);
        if ((++sp & 255u) == 0u) { if (xb_ld(&bar[XB_TMO])) break; if (sp > XB_SPIN_CAP) { atomicAdd(&bar[XB_TMO], 1u); break; } }
    }
    nloc = mine > 0u ? mine : 1u; nx = cnt > 0u ? cnt : 1u;
}

__device__ __forceinline__ void xcd_barrier(const XcdBarrier& b) {
    asm volatile("s_waitcnt vmcnt(0)" ::: "memory");
    __syncthreads();
    if (threadIdx.x == 0) {
        unsigned* bar = b.bar;
        __builtin_amdgcn_s_waitcnt(0);
        unsigned nloc = b.st[0], nx = b.st[1];
        if (nloc == 0u) { xcd_barrier_complete(bar, b.x, nloc, nx); b.st[0] = nloc; b.st[1] = nx; }
        const unsigned old = xb_add(&bar[XB_XSUB(b.x)], 1u);
        const unsigned gen = old / nloc;
        if (old + 1u == (gen + 1u) * nloc) {
            __builtin_amdgcn_fence(__ATOMIC_RELEASE, "agent");
            asm volatile("s_waitcnt vmcnt(0)" ::: "memory");
            const unsigned og = xb_add(&bar[XB_TOP], 1u);
            const unsigned tg = og / nx;
            if (og + 1u == (tg + 1u) * nx) xb_add(&bar[XB_TOPGEN], 1u);
            else XB_SPIN(xb_ld(&bar[XB_TOPGEN]) == tg, bar);
            __builtin_amdgcn_fence(__ATOMIC_ACQUIRE, "agent");
            xb_add(&bar[XB_XGEN(b.x)], 1u);
            asm volatile("s_waitcnt vmcnt(0)" ::: "memory");
        } else {
            XB_SPIN(xb_ld(&bar[XB_XGEN(b.x)]) == gen, bar);
            __builtin_amdgcn_fence(__ATOMIC_ACQUIRE, "agent");
            asm volatile("s_waitcnt vmcnt(0)" ::: "memory");
        }
    }
    __syncthreads();
}
constexpr int NWAVES = 8;
#ifndef MK_N_LAUNCHES
#define MK_N_LAUNCHES 1
#endif
constexpr int N_PHASES = 10;
constexpr int N_LAUNCHES = MK_N_LAUNCHES;

constexpr int DM = 2048, NBATCH = 8, SEQ = 2048, MP = NBATCH * SEQ, SBATCH = 8, SLEN = 16, MS = SBATCH * SLEN, MT = MP + MS;
constexpr int NH = 4, DV = 256, DQK = 128, QKW = 1024, NG = 64, GCH = 16, PST = 64, DFF = 5632, NIN = 4104;
constexpr int CH = 64, NCH = SEQ / CH;
constexpr int NSC = NBATCH * NCH + SBATCH;
constexpr float EPS = 1e-6f;
constexpr int DVS = 64, NSL = DV / DVS;

constexpr size_t O_Y = 0, O_CONVP = (size_t)MT * DM, O_CP = O_CONVP + 8 * 3 * 1024, O_NP = O_CP + 8 * 4 * 256 * 128, O_MP = O_NP + 8 * 4 * 128,
                 O_SRP = O_MP + 32, O_SIP = O_SRP + 8 * 64 * 64, O_CONVS = O_SIP + 8 * 64 * 64, O_CS = O_CONVS + 8 * 3 * 1024, O_NS = O_CS + 8 * 4 * 256 * 128,
                 O_MS = O_NS + 8 * 4 * 128, O_SRS = O_MS + 32, O_SIS = O_SRS + 8 * 64 * 64, O_END = O_SIS + 8 * 64 * 64;
static_assert(O_END == 36102208, "d_out map");

constexpr size_t MiB = 1u << 20;
constexpr size_t WS_CTL = 0, CTL_ZERO_BYTES = 1 * MiB;
constexpr size_t WS_WIN = 2 * MiB, WS_WGLU = 18 * MiB, WS_WOUT = 20 * MiB, WS_WGU = 28 * MiB, WS_WD = 72 * MiB;
constexpr size_t WS_XN = 96 * MiB;
constexpr size_t WS_R0 = 162 * MiB, WS_RSTRIDE = 33 * MiB;
constexpr size_t WS_QKRAW = WS_R0, WS_V = WS_R0 + WS_RSTRIDE, WS_OG = WS_R0 + 2 * WS_RSTRIDE, WS_U = WS_R0 + 3 * WS_RSTRIDE;
constexpr size_t WS_Q = 294 * MiB, WS_K = 311 * MiB;
constexpr size_t WS_Z = WS_QKRAW;
constexpr size_t WS_MIXIN = WS_Q;
constexpr size_t WS_MIX = WS_R0;
constexpr size_t WS_ACT8 = WS_R0;
constexpr size_t WS_ACTS = WS_R0 + 90 * MiB;
constexpr size_t WS_X1B = WS_XN;
constexpr size_t WS_FF = 427 * MiB;
constexpr size_t WS_GATES = 378 * MiB, WS_HSS = 379 * MiB, WS_SS1 = 382 * MiB, WS_SS2 = 385 * MiB, WS_S5P = 388 * MiB, WS_SSS = 389 * MiB;
constexpr size_t WS_HS = 390 * MiB;
constexpr size_t WS_SCAL = 423 * MiB, WS_WD8 = 492 * MiB, WS_END = 504 * MiB;
static_assert(WS_XN + (size_t)MT * DM * 2 <= WS_R0 && WS_QKRAW + (size_t)MT * 1024 * 2 <= WS_V && WS_U + (size_t)MT * 1024 * 2 <= WS_Q && WS_Q + (size_t)MT * 512 * 2 <= WS_K &&
              WS_K + (size_t)MT * 512 * 2 <= WS_GATES && WS_MIXIN + (size_t)MT * DM * 2 <= WS_GATES && WS_MIX + (size_t)MT * DM * 2 <= WS_OG && WS_ACT8 + (size_t)MP * DFF <= WS_ACTS && WS_ACTS + (size_t)MS * DFF * 2 <= WS_GATES && WS_FF + (size_t)MT * DM * 2 <= WS_WD8 && WS_WD8 + (size_t)DM * DFF <= WS_END &&
              WS_WD + (size_t)DM * DFF * 2 <= WS_XN && WS_WGU + (size_t)2 * DFF * DM * 2 <= WS_WD && WS_HSS + (size_t)MT * 32 * 4 <= WS_SS1 && WS_SS1 + (size_t)MT * 32 * 4 <= WS_SS2 &&
              WS_SS2 + (size_t)MT * 32 * 4 <= WS_S5P && WS_GATES + (size_t)MT * 8 * 4 <= WS_HSS && WS_HS + (size_t)MT * 1024 * 2 <= WS_SCAL && WS_SCAL + (size_t)NSC * 4 * 384 * 4 <= WS_FF && WS_FF + (size_t)MT * DM * 2 <= WS_END, "d_ws map");
constexpr size_t S5P_LAM = 0, S5P_BBT = 64 * 1024, S5P_CC = S5P_BBT + 64 * 128 * 16 * 2;
constexpr size_t SSS_1 = 0, SSS_2 = 128 * 128 * 4, SSS_RSTD2 = 256 * 1024, SSS_RSTD1 = 384 * 1024;
constexpr int CW_TMO = 0, CW_CODE = 1, CW_BAR = 4096;

constexpr int RING_OFF = 0, RING_BYTES = 131072;
constexpr int LDSCTL_OFF = 151552, MISC_OFF = LDSCTL_OFF + 320;
constexpr int LDS_BYTES = 155648;
typedef short s16x4 __attribute__((ext_vector_type(4)));
typedef unsigned u32x2 __attribute__((ext_vector_type(2)));
struct Frame {
    LAS unsigned char* lds;
    volatile LAS unsigned* MISC;
    gu32* ctl;
    int tid, lane, wave;
    int vcu, G;
    const float* const* in;
    float* out; unsigned char* ws;
};
__device__ __forceinline__ float wave_sum(float v) {
#pragma unroll
    for (int o = 1; o < 64; o <<= 1) v += __shfl_xor(v, o);
    return v;
}
__device__ __forceinline__ unsigned cvtpk(float lo, float hi) { unsigned r; asm volatile("v_cvt_pk_bf16_f32 %0, %1, %2" : "=v"(r) : "v"(lo), "v"(hi)); return r; }
typedef __bf16 bf16x2n_t __attribute__((ext_vector_type(2)));
__device__ __forceinline__ unsigned cvtpk_n(float lo, float hi) { const bf16x2n_t v = {(__bf16)lo, (__bf16)hi}; return __builtin_bit_cast(unsigned, v); }
__device__ __forceinline__ float bflo(unsigned w) { return __uint_as_float(w << 16); }
__device__ __forceinline__ float bfhi(unsigned w) { return __uint_as_float(w & 0xffff0000u); }
__device__ __forceinline__ float bf2f(bf16 h) { return __uint_as_float((unsigned)h << 16); }
__device__ __forceinline__ float sigmoidf_(float v) { return __builtin_amdgcn_rcpf(1.0f + __expf(-v)); }
__device__ __forceinline__ f32x4 mfma16(bf16x8 a, bf16x8 b, f32x4 c) { return __builtin_amdgcn_mfma_f32_16x16x32_bf16(a, b, c, 0, 0, 0); }
#define WAVE_SYNC() do { asm volatile("s_waitcnt lgkmcnt(0)" ::: "memory"); __builtin_amdgcn_wave_barrier(); } while (0)

#ifdef MK_STAMP
#ifndef MK_STAMP_SCALE
#define MK_STAMP_SCALE 0.002f
#endif
#define DBG_DECL unsigned long long dbg_acc_ = 0, dbg_t0_ = 0;
__device__ __forceinline__ unsigned long long dbg_rt() { unsigned long long t; __builtin_amdgcn_sched_barrier(0);
#ifdef MK_STAMP_CYC
    asm volatile("s_memtime %0\n\ts_waitcnt lgkmcnt(0)" : "=s"(t) :: "memory");
#else
    asm volatile("s_memrealtime %0\n\ts_waitcnt lgkmcnt(0)" : "=s"(t) :: "memory");
#endif
 __builtin_amdgcn_sched_barrier(0); return t; }
#define DBG_BEGIN(id) do { if ((id) == MK_STAMP) dbg_t0_ = dbg_rt(); } while (0)
#define DBG_END(id) do { if ((id) == MK_STAMP) dbg_acc_ += dbg_rt() - dbg_t0_; } while (0)
#define DBG_REPORT(cond) do { if ((cond) && (threadIdx.x & 63) == 0 && (threadIdx.x >> 6) == MK_STAMP_WAVE) ((unsigned*)(A.ws + WS_CTL))[16] = (unsigned)dbg_acc_; } while (0)
#define DBG_PERTURB(V, m_) do { if ((m_) == 0 && lane == 0) V[0][0] += (float)__hip_atomic_load((unsigned*)(A.ws + WS_CTL) + 16, __ATOMIC_RELAXED, __HIP_MEMORY_SCOPE_AGENT) * MK_STAMP_SCALE; } while (0)
#else
#define DBG_DECL
#define DBG_BEGIN(id)
#define DBG_END(id)
#define DBG_REPORT(cond)
#define DBG_PERTURB(V, m_)
#endif
struct Args { const float* in[32]; float* out; unsigned char* ws; int ph_lo, ph_hi, li, pad; };
__device__ __forceinline__ int fresh_tid() { int t = threadIdx.x; asm volatile("" : "+v"(t)); return t; }
#define PHASE_IDS const int tid = fresh_tid(), lane = tid & 63; (void)tid; (void)lane;

__device__ __forceinline__ void p0_transpose_item(const float* W, int ldw, int src_col0, int k0, bf16* WT, int K, int out_row0, LAS float* scr, int lane, const float* kscale = nullptr) {
    if (kscale) {
#pragma unroll 8
        for (int i = 0; i < 32; ++i) { const int kk = 2 * i + (lane >> 5); scr[kk * 33 + (lane & 31)] = __builtin_nontemporal_load(W + (size_t)(k0 + kk) * ldw + src_col0 + (lane & 31)) * kscale[k0 + kk]; }
    } else {
#pragma unroll 8
    for (int i = 0; i < 32; ++i) { const int kk = 2 * i + (lane >> 5); scr[kk * 33 + (lane & 31)] = __builtin_nontemporal_load(W + (size_t)(k0 + kk) * ldw + src_col0 + (lane & 31)); }
    }
    LDS_WAIT(); asm volatile("" ::: "memory");
    const int c = lane & 7;
#pragma unroll
    for (int j = 0; j < 4; ++j) { const int n = (lane >> 3) + 8 * j; const LAS float* s = scr + (8 * c) * 33 + n;
        v4u o; o.x = pk2(s[0 * 33], s[1 * 33]); o.y = pk2(s[2 * 33], s[3 * 33]); o.z = pk2(s[4 * 33], s[5 * 33]); o.w = pk2(s[6 * 33], s[7 * 33]);
        *(GAS v4u*)(WT + (size_t)(out_row0 + n) * K + k0 + 8 * c) = o; }
    LDS_WAIT(); asm volatile("" ::: "memory");
}
__device__ __forceinline__ float log_sigmoid(float x) { return fminf(x, 0.f) - log1pf(__expf(-fabsf(x))); }

struct CvtItem { const float* W; int ldw, sc, k0; bf16* WT; int K, orow; const float* ks; unsigned char* W8; };
constexpr int CV_I_IN = (DM / 64) * (4096 / 32), CV_I_GLU = (1024 / 64) * (1024 / 32), CV_I_OUT = (DM / 64) * (DM / 32), CV_I_GU = (DM / 64) * (2 * DFF / 32), CV_I_D = (DFF / 64) * (DM / 32);
__device__ __forceinline__ CvtItem cvt_item(const Args& A, int it) {
    unsigned char* ws = A.ws; int r = it; CvtItem c;
    if (r < CV_I_IN) { const int nnb = 4096 / 32, kb = r / nnb, nb = r % nnb, orow = 32 * nb; c = CvtItem{A.in[9], NIN, orow < 3072 ? orow : orow + 8, 64 * kb, (bf16*)(ws + WS_WIN), DM, orow, nullptr, nullptr}; return c; } r -= CV_I_IN;
    if (r < CV_I_GLU) { const int nnb = 1024 / 32, kb = r / nnb, nb = r % nnb; c = CvtItem{A.in[23], 1024, 32 * nb, 64 * kb, (bf16*)(ws + WS_WGLU), 1024, 32 * nb, nullptr, nullptr}; return c; } r -= CV_I_GLU;
    if (r < CV_I_OUT) { const int nnb = DM / 32, kb = r / nnb, nb = r % nnb; c = CvtItem{A.in[25], DM, 32 * nb, 64 * kb, (bf16*)(ws + WS_WOUT), DM, 32 * nb, nullptr, nullptr}; return c; } r -= CV_I_OUT;
    if (r < CV_I_GU) { const int nnb = 2 * DFF / 32, kb = r / nnb, nb = r % nnb, orow = 32 * nb, pn = orow >> 8, cc = orow & 255;
        c = CvtItem{cc < 128 ? A.in[28] : A.in[29], DFF, 128 * pn + (cc & 127), 64 * kb, (bf16*)(ws + WS_WGU), DM, orow, A.in[27], nullptr}; return c; } r -= CV_I_GU;
    { const int nnb = DM / 32, kb = r / nnb, nb = r % nnb; c = CvtItem{A.in[30], DM, 32 * nb, 64 * kb, (bf16*)(ws + WS_WD), DFF, 32 * nb, nullptr, ws + WS_WD8}; return c; }
}
__device__ __forceinline__ void p0_prologue(const Args& A, LAS unsigned char* lds, int tid, int lane, int wave, int vcu, int G) {
    unsigned char* ws = A.ws;
    LAS float* WG = (LAS float*)lds;
    LAS float* scr = (LAS float*)(lds + wave * 8448);
    const int gw = vcu * NWAVES + wave, NGW = G * NWAVES;
    { constexpr int NIT = CV_I_IN + CV_I_GLU + CV_I_OUT + CV_I_GU + CV_I_D;
      float ra[32], rb[32]; CvtItem ia, ib;
#define CV_LOAD(R, I, it_) do { I = cvt_item(A, (it_)); \
        _Pragma("unroll") for (int i = 0; i < 32; ++i) { const int kk = 2 * i + (lane >> 5); R[i] = __builtin_nontemporal_load(I.W + (size_t)(I.k0 + kk) * I.ldw + I.sc + (lane & 31)); } } while (0)
#define F8C(v_) __builtin_amdgcn_fmed3f((v_) * 1024.0f, -448.f, 448.f)
#define CV_PROC(R, I) do { \
        if (I.ks) { _Pragma("unroll") for (int i = 0; i < 32; ++i) { const int kk = 2 * i + (lane >> 5); scr[kk * 33 + (lane & 31)] = R[i] * I.ks[I.k0 + kk]; } } \
        else { _Pragma("unroll") for (int i = 0; i < 32; ++i) { const int kk = 2 * i + (lane >> 5); scr[kk * 33 + (lane & 31)] = R[i]; } } \
        LDS_WAIT(); asm volatile("" ::: "memory"); \
        { const int c = lane & 7; \
          _Pragma("unroll") for (int j = 0; j < 4; ++j) { const int n = (lane >> 3) + 8 * j; const LAS float* s = scr + (8 * c) * 33 + n; \
              v4u o; o.x = pk2(s[0 * 33], s[1 * 33]); o.y = pk2(s[2 * 33], s[3 * 33]); o.z = pk2(s[4 * 33], s[5 * 33]); o.w = pk2(s[6 * 33], s[7 * 33]); \
              *(GAS v4u*)(I.WT + (size_t)(I.orow + n) * I.K + I.k0 + 8 * c) = o; \
              if (I.W8) { int w0 = 0, w1 = 0; \
                  w0 = __builtin_amdgcn_cvt_pk_fp8_f32(F8C(s[0 * 33]), F8C(s[1 * 33]), w0, false); w0 = __builtin_amdgcn_cvt_pk_fp8_f32(F8C(s[2 * 33]), F8C(s[3 * 33]), w0, true); \
                  w1 = __builtin_amdgcn_cvt_pk_fp8_f32(F8C(s[4 * 33]), F8C(s[5 * 33]), w1, false); w1 = __builtin_amdgcn_cvt_pk_fp8_f32(F8C(s[6 * 33]), F8C(s[7 * 33]), w1, true); \
                  *(GAS u32x2*)(I.W8 + (size_t)(I.orow + n) * I.K + I.k0 + 8 * c) = (u32x2){(unsigned)w0, (unsigned)w1}; } } } \
        LDS_WAIT(); asm volatile("" ::: "memory"); } while (0)
      int it = gw;
      if (it < NIT) { CV_LOAD(ra, ia, it);
          for (;;) { const int it2 = it + NGW; if (it2 < NIT) CV_LOAD(rb, ib, it2); CV_PROC(ra, ia); if (it2 >= NIT) break;
                     it = it2 + NGW; if (it < NIT) CV_LOAD(ra, ia, it); CV_PROC(rb, ib); if (it >= NIT) break; } }
#undef CV_LOAD
#undef CV_PROC
#undef F8C
    }
    { const int gt = vcu * (NWAVES * 64) + tid;
      if (gt < NG * PST) {
        const int g = gt >> 6, p = gt & 63;
        const double lr = (double)A.in[15][gt], li = (double)A.in[16][gt], dt = exp((double)A.in[17][g]);
        const double mag = exp(lr * dt), ang = li * dt, lbr = mag * cos(ang), lbi = mag * sin(ang);
        const double den = lr * lr + li * li, nr = lbr - 1.0, fre = (nr * lr + lbi * li) / den, fim = (lbi * lr - nr * li) / den;
        float* LAM = (float*)(ws + WS_S5P + S5P_LAM); LAM[gt * 2] = (float)lbr; LAM[gt * 2 + 1] = (float)lbi;
        bf16* BBT = (bf16*)(ws + WS_S5P + S5P_BBT); bf16* CC = (bf16*)(ws + WS_S5P + S5P_CC);
        const float* bre = A.in[18] + (size_t)gt * 16; const float* bim = A.in[19] + (size_t)gt * 16;
#pragma unroll
        for (int i = 0; i < 16; ++i) { const double br = bre[i], bi = bim[i];
            BBT[((size_t)g * 128 + 2 * p) * 16 + i] = (bf16)f2bf((float)(fre * br - fim * bi));
            BBT[((size_t)g * 128 + 2 * p + 1) * 16 + i] = (bf16)f2bf((float)(fre * bi + fim * br));
            CC[((size_t)g * 16 + i) * 128 + 2 * p] = (bf16)f2bf(A.in[20][((size_t)g * 16 + i) * 64 + p]);
            CC[((size_t)g * 16 + i) * 128 + 2 * p + 1] = (bf16)f2bf(-A.in[21][((size_t)g * 16 + i) * 64 + p]); }
      } }
    __syncthreads();
    { const float* win = A.in[9];
      for (int e = tid; e < 8 * 2048; e += NWAVES * 64) { const int k = e >> 3, c = e & 7; WG[c * 2048 + k] = win[(size_t)k * NIN + 3072 + c]; } }
    __syncthreads();
    { const GAS f32x4* gp = (const GAS f32x4*)A.in[8] + lane; f32x4 gv[8];
#pragma unroll
      for (int j = 0; j < 8; ++j) gv[j] = gp[64 * j];
      bf16* XN = (bf16*)(ws + WS_XN); float* GATES = (float*)(ws + WS_GATES);
      f32x4 va[8], vb[8];
#define P0R_LOAD(V, m_) do { const int mm_ = (m_); const float* xrow = mm_ < MP ? A.in[0] + (size_t)mm_ * DM : A.in[1] + (size_t)(mm_ - MP) * DM; const GAS f32x4* xr = (const GAS f32x4*)xrow + lane; \
        _Pragma("unroll") for (int j = 0; j < 8; ++j) V[j] = __builtin_nontemporal_load(xr + 64 * j); } while (0)
#define P0R_PROC(V, m_) do { const int mm_ = (m_); float s = 0.f; \
        _Pragma("unroll") for (int j = 0; j < 8; ++j) s += (V[j].x * V[j].x + V[j].y * V[j].y) + (V[j].z * V[j].z + V[j].w * V[j].w); \
        const float ms = wave_sum(s) * (1.0f / DM) + EPS, rstd = 1.0f / sqrtf(ms); \
        if (lane == 0) ((float*)(ws + WS_SSS + SSS_RSTD1))[mm_] = sqrtf(ms); \
        GAS u32x2* o8 = (GAS u32x2*)(XN + (size_t)mm_ * DM) + lane; \
        float ga[8] = {0.f, 0.f, 0.f, 0.f, 0.f, 0.f, 0.f, 0.f}; \
        _Pragma("unroll") for (int j = 0; j < 8; ++j) { V[j] = V[j] * rstd * gv[j]; u32x2 o; o.x = cvtpk(V[j].x, V[j].y); o.y = cvtpk(V[j].z, V[j].w); o8[64 * j] = o; \
            _Pragma("unroll") for (int c = 0; c < 8; ++c) { const f32x4 w = *(const LAS f32x4*)(WG + c * 2048 + 256 * j + 4 * lane); ga[c] += (V[j].x * w.x + V[j].y * w.y) + (V[j].z * w.z + V[j].w * w.w); } } \
        _Pragma("unroll") for (int c = 0; c < 8; ++c) ga[c] = wave_sum(ga[c]); \
        if (lane < 8) { float val = 0.f; \
            _Pragma("unroll") for (int c = 0; c < 8; ++c) if (lane == c) val = ga[c]; \
            if (lane < 4) val += A.in[12][lane]; else val = log_sigmoid(val + A.in[13][lane - 4]); \
            GATES[(size_t)mm_ * 8 + lane] = val; } } while (0)
      int m = gw;
      if (m < MT) { P0R_LOAD(va, m);
          for (;;) { const int m2 = m + NGW; if (m2 < MT) P0R_LOAD(vb, m2); P0R_PROC(va, m); if (m2 >= MT) break;
                     m = m2 + NGW; if (m < MT) P0R_LOAD(va, m); P0R_PROC(vb, m2); if (m >= MT) break; } }
#undef P0R_LOAD
#undef P0R_PROC
    }
}

template <int NACC, int K, class RowMap, class Epi>
__device__ __forceinline__ void skinny_gemm(const bf16* Arows, const bf16* Bt, LAS unsigned char* lds, int nitems, int first, int stride, int tid, int wave, int lane, RowMap rm, Epi epi) {
    const int fr = lane & 15, fq = lane >> 4;
    constexpr int KW = K / 8, NS = KW / 32;
    static_assert(KW % 32 == 0, "skinny_gemm: K must be a multiple of 256");
    const bf16* abase = Arows + (size_t)fr * K + wave * KW + 8 * fq;
    LAS f32x4* red = (LAS f32x4*)lds;
    for (int it = first; it < nitems; it += stride) {
        const bf16* brow[NACC]; f32x4 acc[NACC][8];
#pragma unroll
        for (int a = 0; a < NACC; ++a) { brow[a] = Bt + (size_t)rm(it, a, fr) * K + wave * KW + 8 * fq;
#pragma unroll
            for (int rb = 0; rb < 8; ++rb) acc[a][rb] = (f32x4){0.f, 0.f, 0.f, 0.f}; }
#pragma unroll 2
        for (int s = 0; s < NS; ++s) {
            bf16x8 av[8], bv[NACC];
#pragma unroll
            for (int a = 0; a < NACC; ++a) bv[a] = *(const bf16x8*)(brow[a] + 32 * s);
#pragma unroll
            for (int rb = 0; rb < 8; ++rb) av[rb] = *(const bf16x8*)(abase + (size_t)(16 * rb) * K + 32 * s);
#pragma unroll
            for (int rb = 0; rb < 8; ++rb)
#pragma unroll
                for (int a = 0; a < NACC; ++a) acc[a][rb] = mfma16(bv[a], av[rb], acc[a][rb]);
        }
#pragma unroll
        for (int a = 0; a < NACC; ++a)
#pragma unroll
            for (int rb = 0; rb < 8; ++rb) red[((a * 8 + wave) * 8 + rb) * 64 + lane] = acc[a][rb];
        __syncthreads();
        f32x4 fin[NACC];
#pragma unroll
        for (int a = 0; a < NACC; ++a) { f32x4 t = red[((a * 8 + 0) * 8 + wave) * 64 + lane];
#pragma unroll
            for (int w2 = 1; w2 < 8; ++w2) t += red[((a * 8 + w2) * 8 + wave) * 64 + lane];
            fin[a] = t; }
        __syncthreads();
        epi(it, 16 * wave + fr, fq, fin);
    }
}

__device__ __forceinline__ void p2_scalars(const Args& A, LAS unsigned char* lds, int lane, int wave, int item) {
    unsigned char* ws = A.ws;
    const float* GATES = (const float*)(ws + WS_GATES); float* SCAL = (float*)(ws + WS_SCAL);
    const int seq = item >> 2, h = item & 3; const bool sample = seq >= NBATCH; const int b = sample ? seq - NBATCH : seq;
    const int nch = sample ? 1 : NCH, L = sample ? SLEN : CH, row0 = sample ? MP + b * SLEN : b * SEQ, sc0 = sample ? NBATCH * NCH + b : b * NCH;
    LAS float* fl = (LAS float*)lds;
    float fc[4], a[4], pm[4];
#pragma unroll
    for (int i = 0; i < 4; ++i) { const int c = 4 * wave + i; float li = -INFINITY, lf = 0.f;
        if (c < nch && lane < L) { li = GATES[((size_t)row0 + c * CH + lane) * 8 + h]; lf = GATES[((size_t)row0 + c * CH + lane) * 8 + 4 + h]; }
        float f = lf;
#pragma unroll
        for (int d = 1; d < 64; d <<= 1) { const float o = __shfl_up(f, d); if (lane >= d) f += o; }
        const float aa = li - f; float p = aa;
#pragma unroll
        for (int d = 1; d < 64; d <<= 1) { const float o = __shfl_up(p, d); if (lane >= d) p = fmaxf(p, o); }
        fc[i] = f; a[i] = aa; pm[i] = p;
        if (lane == 63) { fl[c] = f; fl[32 + c] = p; } }
    __syncthreads();
    float m0c = 0.f, m0 = sample ? A.in[5][b * NH + h] : 0.f;
    for (int c = 0; c < nch; ++c) { if (lane == c) m0c = m0; m0 = fl[c] + fmaxf(fl[32 + c], m0); }
#pragma unroll
    for (int i = 0; i < 4; ++i) { const int c = 4 * wave + i;
        if (c < nch) { const float m0i = __shfl(m0c, c); const float mm = fmaxf(pm[i], m0i), mml = __shfl(mm, 63);
            float* o = SCAL + ((size_t)(sc0 + c) * 4 + h) * 384;
            o[lane] = a[i]; o[64 + lane] = mm; o[128 + lane] = __expf(m0i - mm); o[192 + lane] = __expf(-(fc[i] + mm)); o[256 + lane] = __expf(a[i] - mml);
            o[320 + lane] = (lane == 0) ? __expf(m0i - mml) : (__shfl(fc[i], 63) + mml); } }
    if (wave == 0 && lane == 0) A.out[(sample ? O_MS : O_MP) + b * NH + h] = m0;
    __syncthreads();
}
__device__ __forceinline__ void p2_conv(const Args& A, int tid, int vcu, int G) {
    unsigned char* ws = A.ws;
    const bf16* QKRAW = (const bf16*)(ws + WS_QKRAW); bf16* Q = (bf16*)(ws + WS_Q); bf16* Kb = (bf16*)(ws + WS_K);
    const int nthreads = G * NWAVES * 64;
    for (int it = vcu * (NWAVES * 64) + tid; it < (MT / 8) * 128; it += nthreads) {
        const int rb = it >> 7, ch = it & 127, rs = 8 * rb, col = 8 * ch;
        bool first, sample = rs >= MP; int b, tl, Lseq;
        if (!sample) { b = rs / SEQ; tl = rs % SEQ; Lseq = SEQ; } else { b = (rs - MP) / SLEN; tl = (rs - MP) % SLEN; Lseq = SLEN; }
        first = (tl == 0);
        float w[4][8], bc[8];
#pragma unroll
        for (int j = 0; j < 4; ++j) { const f32x4 a0 = *(const f32x4*)(A.in[10] + j * 1024 + col), a1 = *(const f32x4*)(A.in[10] + j * 1024 + col + 4);
            w[j][0] = a0[0]; w[j][1] = a0[1]; w[j][2] = a0[2]; w[j][3] = a0[3]; w[j][4] = a1[0]; w[j][5] = a1[1]; w[j][6] = a1[2]; w[j][7] = a1[3]; }
        { const f32x4 a0 = *(const f32x4*)(A.in[11] + col), a1 = *(const f32x4*)(A.in[11] + col + 4);
          bc[0] = a0[0]; bc[1] = a0[1]; bc[2] = a0[2]; bc[3] = a0[3]; bc[4] = a1[0]; bc[5] = a1[1]; bc[6] = a1[2]; bc[7] = a1[3]; }
        v4u raw[11];
#pragma unroll
        for (int r = 0; r < 11; ++r) { if (r >= 3 || !first) raw[r] = *(const GAS v4u*)(QKRAW + (size_t)(rs + r - 3) * 1024 + col); else raw[r] = (v4u){0u, 0u, 0u, 0u}; }
        float x0[8], x1[8], x2[8];
#define UNPK(dst, v) do { dst[0] = bflo(v.x); dst[1] = bfhi(v.x); dst[2] = bflo(v.y); dst[3] = bfhi(v.y); dst[4] = bflo(v.z); dst[5] = bfhi(v.z); dst[6] = bflo(v.w); dst[7] = bfhi(v.w); } while (0)
        if (first && sample) {
            const float* sp = A.in[2] + (size_t)b * 3 * 1024 + col;
#pragma unroll
            for (int i = 0; i < 8; ++i) { x0[i] = sp[i]; x1[i] = sp[1024 + i]; x2[i] = sp[2048 + i]; }
        } else { UNPK(x0, raw[0]); UNPK(x1, raw[1]); UNPK(x2, raw[2]); }
#pragma unroll
        for (int r = 0; r < 8; ++r) {
            float x3[8]; UNPK(x3, raw[r + 3]);
            float o[8];
#pragma unroll
            for (int i = 0; i < 8; ++i) { const float val = bc[i] + w[0][i] * x0[i] + w[1][i] * x1[i] + w[2][i] * x2[i] + w[3][i] * x3[i]; o[i] = val * sigmoidf_(val); }
            const size_t row = (size_t)rs + r;
            if (ch < 64) {
#pragma unroll
                for (int i = 0; i < 8; ++i) o[i] *= 0.08838834764831845f;
                v4u pk; pk.x = cvtpk(o[0], o[1]); pk.y = cvtpk(o[2], o[3]); pk.z = cvtpk(o[4], o[5]); pk.w = cvtpk(o[6], o[7]);
                *(GAS v4u*)(Q + row * 512 + col) = pk;
            } else {
                v4u pk; pk.x = cvtpk(o[0], o[1]); pk.y = cvtpk(o[2], o[3]); pk.z = cvtpk(o[4], o[5]); pk.w = cvtpk(o[6], o[7]);
                *(GAS v4u*)(Kb + row * 512 + (col - 512)) = pk;
            }
            const int tt = tl + r;
            if (tt >= Lseq - 3) { float* cv = A.out + (sample ? O_CONVS : O_CONVP) + ((size_t)b * 3 + (tt - (Lseq - 3))) * 1024 + col;
                *(f32x4*)cv = (f32x4){x3[0], x3[1], x3[2], x3[3]}; *(f32x4*)(cv + 4) = (f32x4){x3[4], x3[5], x3[6], x3[7]}; }
#pragma unroll
            for (int i = 0; i < 8; ++i) { x0[i] = x1[i]; x1[i] = x2[i]; x2[i] = x3[i]; }
        }
#undef UNPK
    }
}
constexpr int ML_QS = 0, ML_KS = 17408, ML_VS = 34816, ML_SC = 46080, ML_SET = 47616, ML_SS = 2 * ML_SET, ML_CB = ML_SS + 9216, ML_CBSZ = 21760;
static_assert(ML_CB + 2 * ML_CBSZ <= LDSCTL_OFF, "mLSTM LDS map");
constexpr int SC_A = 0, SC_MM = 64, SC_GI = 128, SC_EN = 192, SC_WS = 256, SC_MISC = 320;
__device__ __forceinline__ bf16x8 ldsfrag(const LAS unsigned char* p) { return *(const LAS bf16x8*)p; }
typedef __attribute__((address_space(3))) s16x4 lds_s16x4;
__device__ __forceinline__ bf16x8 trfrag(const LAS unsigned char* tile, int stride, int k0, int c0, int lane) {
    const int g = lane >> 4, q = (lane & 15) >> 2, p = lane & 3;
    const LAS unsigned char* a0 = tile + (k0 + 8 * g + q) * stride + (c0 + 4 * p) * 2;
    const s16x4 lo = __builtin_amdgcn_ds_read_tr16_b64_v4i16((lds_s16x4*)a0), hi = __builtin_amdgcn_ds_read_tr16_b64_v4i16((lds_s16x4*)(a0 + 4 * stride));
    return (bf16x8){lo[0], lo[1], lo[2], lo[3], hi[0], hi[1], hi[2], hi[3]};
}
#define LBAR() do { asm volatile("s_waitcnt lgkmcnt(0)" ::: "memory"); __builtin_amdgcn_s_barrier(); asm volatile("" ::: "memory"); } while (0)

__device__ __forceinline__ void mlstm_item(const Args& A, LAS unsigned char* lds, int tid, int lane, int wave, int item) {
    DBG_DECL
    unsigned char* ws = A.ws;
    const int fr = lane & 15, fq = lane >> 4;
    const bool sample = item >= NBATCH * NH * NSL; const int ii = sample ? item - NBATCH * NH * NSL : item;
    const int b = ii / (NH * NSL), h = (ii / NSL) % NH, sl = ii % NSL;
    const int nch = sample ? 1 : NCH, L = sample ? SLEN : CH;
    const int row0 = sample ? MP + b * SLEN : b * SEQ, sc0 = sample ? NBATCH * NCH + b : b * NCH;
    const bf16* Qg = (const bf16*)(ws + WS_Q); const bf16* Kg = (const bf16*)(ws + WS_K); const bf16* Vg = (const bf16*)(ws + WS_V);
    const float* SCAL = (const float*)(ws + WS_SCAL); bf16* HS = (bf16*)(ws + WS_HS); float* HSS = (float*)(ws + WS_HSS);
    if (tid < 256) { const int r = (tid >> 1) & 63, hf = tid & 1, st = tid >> 7; *(LAS v4u*)(lds + st * ML_SET + ML_VS + r * 176 + 128 + 16 * hf) = (v4u){hf == 0 ? 0x00003F80u : 0u, 0u, 0u, 0u}; }
    f32x4 Cst[5];
    if (sample) {
        const float* c0 = A.in[3] + ((size_t)(b * NH + h) * DV + DVS * sl) * DQK; const float* n0 = A.in[4] + (size_t)(b * NH + h) * DQK;
#pragma unroll
        for (int vb = 0; vb < 4; ++vb) Cst[vb] = *(const f32x4*)(c0 + (size_t)(16 * vb + fr) * DQK + 16 * wave + 4 * fq);
        Cst[4] = (fr == 0) ? *(const f32x4*)(n0 + 16 * wave + 4 * fq) : (f32x4){0.f, 0.f, 0.f, 0.f};
    } else {
#pragma unroll
        for (int vb = 0; vb < 5; ++vb) Cst[vb] = (f32x4){0.f, 0.f, 0.f, 0.f};
    }
#pragma unroll
    for (int vb = 0; vb < 5; ++vb) { u32x2 w; w.x = cvtpk_n(Cst[vb][0], Cst[vb][1]); w.y = cvtpk_n(Cst[vb][2], Cst[vb][3]); *(LAS u32x2*)(lds + ML_CB + (16 * vb + fr) * 272 + (16 * wave + 4 * fq) * 2) = w; }
    v4u pq[2], pk[2], pv; f32x4 psc = (f32x4){0.f, 0.f, 0.f, 0.f};
#define ML_ISSUE(c_) do { \
        const size_t r0_ = (size_t)row0 + (size_t)(c_) * CH; \
        _Pragma("unroll") for (int i = 0; i < 2; ++i) { const int e = tid + 512 * i, r = e >> 4, ch = e & 15; \
            if (r < L) { pq[i] = *(const GAS v4u*)(Qg + (r0_ + r) * 512 + 128 * h + 8 * ch); pk[i] = *(const GAS v4u*)(Kg + (r0_ + r) * 512 + 128 * h + 8 * ch); } \
            else { pq[i] = (v4u){0u, 0u, 0u, 0u}; pk[i] = (v4u){0u, 0u, 0u, 0u}; } } \
        { const int r = tid >> 3, ch = tid & 7; if (r < L) pv = *(const GAS v4u*)(Vg + (r0_ + r) * 1024 + DV * h + DVS * sl + 8 * ch); else pv = (v4u){0u, 0u, 0u, 0u}; } \
        if (tid < 96) psc = *(const GAS f32x4*)(SCAL + ((size_t)(sc0 + (c_)) * 4 + h) * 384 + 4 * tid); \
    } while (0)
#define ML_COMMIT(so_) do { LAS unsigned char* wl_ = lds + (so_); \
        _Pragma("unroll") for (int i = 0; i < 2; ++i) { const int e = tid + 512 * i, r = e >> 4, ch = e & 15; \
            *(LAS v4u*)(wl_ + ML_QS + r * 272 + ch * 16) = pq[i]; *(LAS v4u*)(wl_ + ML_KS + r * 272 + ch * 16) = pk[i]; } \
        { const int r = tid >> 3, ch = tid & 7; *(LAS v4u*)(wl_ + ML_VS + r * 176 + ch * 16) = pv; } \
        if (tid < 96) *(LAS f32x4*)((LAS float*)(wl_ + ML_SC) + 4 * tid) = psc; \
    } while (0)
    ML_ISSUE(0); ML_COMMIT(0);
    LBAR();
    const int tb = wave & 3, wh = wave >> 2, t = 16 * tb + fr;
    u32x2 hsw[2] = {(u32x2){0u, 0u}, (u32x2){0u, 0u}}; float hsp = 0.f;
#define ML_FLUSH(c_) do { const size_t grow = (size_t)row0 + (size_t)(c_) * CH + t; \
        if (t < L) { *(GAS u32x2*)(HS + grow * 1024 + h * DV + DVS * sl + 16 * (2 * wh) + 4 * fq) = hsw[0]; *(GAS u32x2*)(HS + grow * 1024 + h * DV + DVS * sl + 16 * (2 * wh + 1) + 4 * fq) = hsw[1]; \
                     if (fq == 0) HSS[grow * 32 + h * 8 + sl * 2 + wh] = hsp; } } while (0)
    DBG_BEGIN(8);
    for (int c = 0; c < nch; ++c) {
        if (c + 1 < nch) ML_ISSUE(c + 1);
        if (c > 0) ML_FLUSH(c - 1);
        const LAS unsigned char* cbr = lds + ML_CB + (c & 1) * ML_CBSZ; LAS unsigned char* cbw = lds + ML_CB + ((c + 1) & 1) * ML_CBSZ;
        const LAS unsigned char* tl = lds + (c & 1) * ML_SET; const LAS float* SC = (const LAS float*)(tl + ML_SC);
        DBG_BEGIN(4);
        bf16x8 qf[4];
#pragma unroll
        for (int ks = 0; ks < 4; ++ks) qf[ks] = ldsfrag(tl + ML_QS + t * 272 + ks * 64 + fq * 16);
        { bf16x8 kf[2][4];
#pragma unroll
          for (int i = 0; i < 2; ++i)
#pragma unroll
              for (int ks = 0; ks < 4; ++ks) kf[i][ks] = ldsfrag(tl + ML_KS + (16 * (2 * wh + i) + fr) * 272 + ks * 64 + fq * 16);
          const float mmt = SC[SC_MM + t]; f32x4 a4[2];
#pragma unroll
          for (int i = 0; i < 2; ++i) a4[i] = *(const LAS f32x4*)(SC + SC_A + 16 * (2 * wh + i) + 4 * fq);
          f32x4 g[2] = {(f32x4){0.f, 0.f, 0.f, 0.f}, (f32x4){0.f, 0.f, 0.f, 0.f}};
#pragma unroll
          for (int ks = 0; ks < 4; ++ks)
#pragma unroll
              for (int i = 0; i < 2; ++i) g[i] = mfma16(kf[i][ks], qf[ks], g[i]);
#pragma unroll
          for (int i = 0; i < 2; ++i) { const int s0 = 16 * (2 * wh + i) + 4 * fq; float v[4];
#pragma unroll
              for (int r = 0; r < 4; ++r) v[r] = (s0 + r <= t) ? g[i][r] * __expf(a4[i][r] - mmt) : 0.f;
              u32x2 w; w.x = cvtpk_n(v[0], v[1]); w.y = cvtpk_n(v[2], v[3]); *(LAS u32x2*)(lds + ML_SS + t * 144 + s0 * 2) = w; } }
        DBG_END(4);
        LBAR();
        DBG_BEGIN(5);
        { bf16x8 sf[2], vf[3][2], cf[3][4];
#pragma unroll
          for (int ks = 0; ks < 2; ++ks) sf[ks] = ldsfrag(lds + ML_SS + t * 144 + ks * 64 + fq * 16);
#pragma unroll
          for (int i = 0; i < 3; ++i) { const int vb = (i == 2) ? 4 : 2 * wh + i;
#pragma unroll
              for (int ks = 0; ks < 2; ++ks) vf[i][ks] = trfrag(tl + ML_VS, 176, 32 * ks, 16 * vb, lane);
#pragma unroll
              for (int ks = 0; ks < 4; ++ks) cf[i][ks] = ldsfrag(cbr + (16 * vb + fr) * 272 + ks * 64 + fq * 16); }
          const float git = SC[SC_GI + t], ent = SC[SC_EN + t];
          f32x4 ai[3], ae[3];
#pragma unroll
          for (int i = 0; i < 3; ++i) { ai[i] = (f32x4){0.f, 0.f, 0.f, 0.f}; ae[i] = (f32x4){0.f, 0.f, 0.f, 0.f}; }
#pragma unroll
          for (int ks = 0; ks < 4; ++ks)
#pragma unroll
              for (int i = 0; i < 3; ++i) { ae[i] = mfma16(cf[i][ks], qf[ks], ae[i]); if (ks < 2) ai[i] = mfma16(vf[i][ks], sf[ks], ai[i]); }
          f32x4 hh[3];
#pragma unroll
          for (int i = 0; i < 3; ++i) hh[i] = ai[i] + ae[i] * git;
          const float den = __shfl(hh[2][0], fr);
          const float isc = 1.0f / fmaxf(fabsf(den), ent); float p = 0.f;
#pragma unroll
          for (int i = 0; i < 2; ++i) { const f32x4 o = hh[i] * isc; p += (o[0] * o[0] + o[1] * o[1]) + (o[2] * o[2] + o[3] * o[3]);
              hsw[i].x = cvtpk_n(o[0], o[1]); hsw[i].y = cvtpk_n(o[2], o[3]); }
          p += __shfl_xor(p, 16); p += __shfl_xor(p, 32); hsp = p; }
        DBG_END(5); DBG_BEGIN(6);
        { const float decay = SC[SC_MISC];
          bf16x8 kw[2], vf[5][2];
#pragma unroll
          for (int vb = 0; vb < 5; ++vb)
#pragma unroll
              for (int ks = 0; ks < 2; ++ks) vf[vb][ks] = trfrag(tl + ML_VS, 176, 32 * ks, 16 * vb, lane);
#pragma unroll
          for (int ks = 0; ks < 2; ++ks) { const v4u kr = __builtin_bit_cast(v4u, trfrag(tl + ML_KS, 272, 32 * ks, 16 * wave, lane));
              const f32x4 w0 = *(const LAS f32x4*)(SC + SC_WS + 32 * ks + 8 * fq), w1 = *(const LAS f32x4*)(SC + SC_WS + 32 * ks + 8 * fq + 4);
              v4u o; o.x = cvtpk_n(bflo(kr.x) * w0[0], bfhi(kr.x) * w0[1]); o.y = cvtpk_n(bflo(kr.y) * w0[2], bfhi(kr.y) * w0[3]); o.z = cvtpk_n(bflo(kr.z) * w1[0], bfhi(kr.z) * w1[1]); o.w = cvtpk_n(bflo(kr.w) * w1[2], bfhi(kr.w) * w1[3]);
              kw[ks] = __builtin_bit_cast(bf16x8, o); }
#pragma unroll
          for (int vb = 0; vb < 5; ++vb) Cst[vb] = Cst[vb] * decay;
#pragma unroll
          for (int ks = 0; ks < 2; ++ks)
#pragma unroll
              for (int vb = 0; vb < 5; ++vb) Cst[vb] = mfma16(kw[ks], vf[vb][ks], Cst[vb]);
#pragma unroll
          for (int vb = 0; vb < 5; ++vb) { u32x2 w; w.x = cvtpk_n(Cst[vb][0], Cst[vb][1]); w.y = cvtpk_n(Cst[vb][2], Cst[vb][3]); *(LAS u32x2*)(cbw + (16 * vb + fr) * 272 + (16 * wave + 4 * fq) * 2) = w; } }
        DBG_END(6);
        DBG_BEGIN(7);
        if (c + 1 < nch) ML_COMMIT(((c + 1) & 1) * ML_SET);
        DBG_END(7);
        LBAR();
    }
    DBG_END(8); DBG_REPORT(item == 0);
    ML_FLUSH(nch - 1);
    { float* co = A.out + (sample ? O_CS : O_CP) + ((size_t)(b * NH + h) * DV + DVS * sl) * DQK;
#pragma unroll
      for (int vb = 0; vb < 4; ++vb) *(f32x4*)(co + (size_t)(16 * vb + fr) * DQK + 16 * wave + 4 * fq) = Cst[vb];
      if (sl == 0 && fr == 0) *(f32x4*)(A.out + (sample ? O_NS : O_NP) + (size_t)(b * NH + h) * DQK + 16 * wave + 4 * fq) = Cst[4]; }
    LBAR();
#undef ML_ISSUE
#undef ML_FLUSH
#undef ML_COMMIT
}

__device__ __forceinline__ float gelu_tanh(float y) { const float t = y * y, p = fmaf(t, 0.044715f, 1.0f);
    const float e = __builtin_amdgcn_exp2f(y * p * -2.302208198f); return y * __builtin_amdgcn_rcpf(1.0f + e); }
typedef float f32x2 __attribute__((ext_vector_type(2)));
__device__ __forceinline__ void s5_item(const Args& A, LAS unsigned char* slds, int lane, int role, int item) {
    DBG_DECL
    unsigned char* ws = A.ws;
    const int fr = lane & 15, fq = lane >> 4;
    const bool sample = item >= NBATCH * NG; const int ii = sample ? item - NBATCH * NG : item;
    const int b = ii / NG, g = ii % NG;
    const int T = sample ? SLEN : SEQ, row0 = sample ? MP + b * SLEN : b * SEQ;
    const bf16* U = (const bf16*)(ws + WS_U); bf16* Z = (bf16*)(ws + WS_Z);
    const float* LAM = (const float*)(ws + WS_S5P + S5P_LAM); const bf16* BBT = (const bf16*)(ws + WS_S5P + S5P_BBT); const bf16* CC = (const bf16*)(ws + WS_S5P + S5P_CC);
    const bf16x8 zf = (bf16x8){0, 0, 0, 0, 0, 0, 0, 0}; const f32x4 z4 = (f32x4){0.f, 0.f, 0.f, 0.f};
    const int nblk = T / 16;
    const bf16* ubase = U + (size_t)(row0 + fr) * 1024 + 16 * g + 8 * (fq & 1);
#define S5_LOADU(k_) (*(const bf16x8*)(ubase + (size_t)((k_) < nblk ? (k_) : nblk - 1) * 16 * 1024))
#define S5_BU(P_) ((LAS float*)(slds + (P_) * 8448))
#define S5_SB(P_) ((LAS bf16*)(slds + 16896 + (P_) * 4352))
    if (role == 0) {
        bf16x8 bbA[8];
#pragma unroll
        for (int rb = 0; rb < 8; ++rb) bbA[rb] = (fq < 2) ? *(const bf16x8*)(BBT + ((size_t)g * 128 + 16 * rb + fr) * 16 + 8 * fq) : zf;
        const float lr = LAM[(g * 64 + lane) * 2], li = LAM[(g * 64 + lane) * 2 + 1];
        float sr, si;
        if (sample) { sr = A.in[6][(size_t)(b * NG + g) * PST + lane]; si = A.in[7][(size_t)(b * NG + g) * PST + lane]; } else { sr = 0.f; si = 0.f; }
        bf16x8 ub = S5_LOADU(0), uc = S5_LOADU(1), ud = S5_LOADU(2);
#pragma unroll
        for (int rb = 0; rb < 8; ++rb) { const f32x4 d = mfma16(bbA[rb], ub, z4); *(LAS f32x4*)(S5_BU(0) + fr * 132 + 16 * rb + 4 * fq) = d; }
        LBAR();
#define S5_ITER_A(k_, P_) do { const int k = (k_); DBG_BEGIN(1); \
            f32x4 d[8]; \
            _Pragma("unroll") for (int rb = 0; rb < 8; ++rb) d[rb] = mfma16(bbA[rb], uc, z4);                                 \
            f32x2 bu[16]; { const LAS float* bc = S5_BU(P_); \
            _Pragma("unroll") for (int tt = 0; tt < 16; ++tt) bu[tt] = *(const LAS f32x2*)(bc + tt * 132 + 2 * lane); } \
            { LAS float* bn = S5_BU(1 - (P_)); \
            _Pragma("unroll") for (int rb = 0; rb < 8; ++rb) *(LAS f32x4*)(bn + fr * 132 + 16 * rb + 4 * fq) = d[rb]; } \
            { LAS bf16* sbc = S5_SB(P_); \
            f32x2 s2 = (f32x2){sr, si}; const f32x2 lr2 = (f32x2){lr, lr}, li2 = (f32x2){-li, li}; \
            _Pragma("unroll") for (int tt = 0; tt < 16; ++tt) { const f32x2 sw = __builtin_shufflevector(s2, s2, 1, 0); s2 = lr2 * s2 + (li2 * sw + bu[tt]);     \
                *(LAS unsigned*)(sbc + tt * 136 + 2 * lane) = cvtpk_n(s2[0], s2[1]); } sr = s2[0]; si = s2[1]; }                \
            uc = ud; ud = S5_LOADU(k + 3); DBG_END(1); \
            LBAR(); } while (0)
        DBG_BEGIN(2);
        for (int k2 = 0; k2 + 1 < nblk; k2 += 2) { S5_ITER_A(k2, 0); S5_ITER_A(k2 + 1, 1); }
        if (nblk & 1) S5_ITER_A(nblk - 1, 0);
        DBG_END(2); DBG_REPORT(!sample && item == 0);
#undef S5_ITER_A
        float* so = A.out + (sample ? O_SRS : O_SRP) + (size_t)(b * NG + g) * PST; float* io = A.out + (sample ? O_SIS : O_SIP) + (size_t)(b * NG + g) * PST;
        so[lane] = sr; io[lane] = si;
    } else {
        bf16x8 ccA[4], dA;
#pragma unroll
        for (int ks = 0; ks < 4; ++ks) ccA[ks] = *(const bf16x8*)(CC + ((size_t)g * 16 + fr) * 128 + 32 * ks + 8 * fq);
        { const short dv = (short)f2bf(A.in[22][g * 16 + fr]); dA = zf;
#pragma unroll
          for (int j = 0; j < 8; ++j) dA[j] = (fq < 2 && 8 * fq + j == fr) ? dv : (short)0; }
        bf16x8 ua = S5_LOADU(0), ub = S5_LOADU(0), uc = S5_LOADU(1);
        LBAR();
#define S5_Y(km1_, P_) do { const LAS bf16* sbp = S5_SB(P_); f32x4 y = z4; \
            _Pragma("unroll") for (int ks = 0; ks < 4; ++ks) y = mfma16(ccA[ks], *(const LAS bf16x8*)(sbp + fr * 136 + 32 * ks + 8 * fq), y); \
            y = mfma16(dA, ua, y); \
            u32x2 w; w.x = cvtpk_n(gelu_tanh(y[0]), gelu_tanh(y[1])); w.y = cvtpk_n(gelu_tanh(y[2]), gelu_tanh(y[3])); \
            *(GAS u32x2*)(Z + ((size_t)row0 + 16 * (km1_) + fr) * 1024 + 16 * g + 4 * fq) = w; } while (0)
#define S5_ITER_B(k_, P_) do { const int k = (k_); DBG_BEGIN(3); if (k >= 1) S5_Y(k - 1, 1 - (P_)); ua = ub; ub = uc; uc = S5_LOADU(k + 2); DBG_END(3); LBAR(); } while (0)
        for (int k2 = 0; k2 + 1 < nblk; k2 += 2) { S5_ITER_B(k2, 0); S5_ITER_B(k2 + 1, 1); }
        if (nblk & 1) S5_ITER_B(nblk - 1, 0);
        if ((nblk - 1) & 1) S5_Y(nblk - 1, 1); else S5_Y(nblk - 1, 0);
        DBG_REPORT(!sample && item == 0);
#undef S5_ITER_B
#undef S5_Y
    }
    LBAR();
#undef S5_BU
#undef S5_SB
#undef S5_LOADU
}

__device__ __forceinline__ void outa_rows(const Args& A, int lane, int gw, int NGW) {
    unsigned char* ws = A.ws;
    const bf16* HS = (const bf16*)(ws + WS_HS); const bf16* OG = (const bf16*)(ws + WS_OG); const float* HSS = (const float*)(ws + WS_HSS); bf16* MIXIN = (bf16*)(ws + WS_MIXIN);
    f32x4 gm[2][2];
#pragma unroll
    for (int i = 0; i < 2; ++i) { gm[i][0] = *(const f32x4*)(A.in[14] + 512 * i + 8 * lane); gm[i][1] = *(const f32x4*)(A.in[14] + 512 * i + 8 * lane + 4); }
    for (int m = gw; m < MT; m += NGW) {
        f32x4 p0[2], p1[2]; v4u hv[2], ov[2];
#pragma unroll
        for (int i = 0; i < 2; ++i) { const int col = 512 * i + 8 * lane, hh = col >> 8;
            p0[i] = *(const GAS f32x4*)(HSS + (size_t)m * 32 + hh * 8); p1[i] = *(const GAS f32x4*)(HSS + (size_t)m * 32 + hh * 8 + 4);
            hv[i] = *(const GAS v4u*)(HS + (size_t)m * 1024 + col); ov[i] = *(const GAS v4u*)(OG + (size_t)m * 1024 + col); }
        v4u o[2];
#pragma unroll
        for (int i = 0; i < 2; ++i) {
            const float ss = (p0[i][0] + p0[i][1]) + (p0[i][2] + p0[i][3]) + (p1[i][0] + p1[i][1]) + (p1[i][2] + p1[i][3]);
            const float rstd = 1.0f / sqrtf(ss * (1.0f / DV) + EPS);
            o[i].x = cvtpk(bflo(hv[i].x) * rstd * gm[i][0][0] * sigmoidf_(bflo(ov[i].x)), bfhi(hv[i].x) * rstd * gm[i][0][1] * sigmoidf_(bfhi(ov[i].x)));
            o[i].y = cvtpk(bflo(hv[i].y) * rstd * gm[i][0][2] * sigmoidf_(bflo(ov[i].y)), bfhi(hv[i].y) * rstd * gm[i][0][3] * sigmoidf_(bfhi(ov[i].y)));
            o[i].z = cvtpk(bflo(hv[i].z) * rstd * gm[i][1][0] * sigmoidf_(bflo(ov[i].z)), bfhi(hv[i].z) * rstd * gm[i][1][1] * sigmoidf_(bfhi(ov[i].z)));
            o[i].w = cvtpk(bflo(hv[i].w) * rstd * gm[i][1][2] * sigmoidf_(bflo(ov[i].w)), bfhi(hv[i].w) * rstd * gm[i][1][3] * sigmoidf_(bfhi(ov[i].w))); }
#pragma unroll
        for (int i = 0; i < 2; ++i) *(GAS v4u*)(MIXIN + (size_t)m * 2048 + 512 * i + 8 * lane) = o[i];
    }
}
__device__ __forceinline__ float row_ss_part(const float* SSp, const float* SSs, int m, int lane) {
    if (m < MP) return (lane < 32) ? SSp[(size_t)m * 32 + lane] : 0.f;
    return SSs[(size_t)(m - MP) * 128 + lane] + SSs[(size_t)(m - MP) * 128 + 64 + lane];
}
__device__ __forceinline__ void rowpass1(const Args& A, int lane, int gw, int NGW) {
    unsigned char* ws = A.ws;
    const bf16* MIX = (const bf16*)(ws + WS_MIX); bf16* X1B = (bf16*)(ws + WS_X1B); float* RSTD2 = (float*)(ws + WS_SSS + SSS_RSTD2);
    const float* SSp = (const float*)(ws + WS_SS1); const float* SSs = (const float*)(ws + WS_SSS + SSS_1);
    const float* RSTD1 = (const float*)(ws + WS_SSS + SSS_RSTD1);
    f32x4 g1[8], gi[8];
#pragma unroll
    for (int j = 0; j < 8; ++j) { g1[j] = *(const f32x4*)(A.in[26] + 256 * j + 4 * lane); const f32x4 g0 = *(const f32x4*)(A.in[8] + 256 * j + 4 * lane);
        gi[j] = (f32x4){1.0f / g0[0], 1.0f / g0[1], 1.0f / g0[2], 1.0f / g0[3]}; }
    u32x2 va[8], vb[8], ma[8], mb[8]; float sa = 0.f, sb = 0.f, ra = 0.f, rb = 0.f;
#define RP1_LOAD(V, M, S, R, m_) do { const int mm_ = (m_); \
        S = row_ss_part(SSp, SSs, mm_, lane); R = RSTD1[mm_]; \
        _Pragma("unroll") for (int j = 0; j < 8; ++j) { const int k = 256 * j + 4 * lane; V[j] = *(const GAS u32x2*)(X1B + (size_t)mm_ * DM + k); M[j] = *(const GAS u32x2*)(MIX + (size_t)mm_ * DM + k); } } while (0)
#define RP1_PROC(V, M, S, R, m_) do { const int mm_ = (m_); \
        const float rstd1 = 1.0f / sqrtf(wave_sum(S) * (1.0f / DM) + EPS); float s = 0.f; f32x4 O[8]; \
        _Pragma("unroll") for (int j = 0; j < 8; ++j) { f32x4 o; o[0] = bflo(V[j].x) * R * gi[j][0] + bflo(M[j].x) * rstd1 * g1[j][0]; o[1] = bfhi(V[j].x) * R * gi[j][1] + bfhi(M[j].x) * rstd1 * g1[j][1]; \
            o[2] = bflo(V[j].y) * R * gi[j][2] + bflo(M[j].y) * rstd1 * g1[j][2]; o[3] = bfhi(V[j].y) * R * gi[j][3] + bfhi(M[j].y) * rstd1 * g1[j][3]; \
            s += (o[0] * o[0] + o[1] * o[1]) + (o[2] * o[2] + o[3] * o[3]); O[j] = o; } \
        const float ms2 = wave_sum(s) * (1.0f / DM) + EPS, rstd2 = 1.0f / sqrtf(ms2); \
        _Pragma("unroll") for (int j = 0; j < 8; ++j) { u32x2 o; o.x = cvtpk(O[j][0] * rstd2, O[j][1] * rstd2); o.y = cvtpk(O[j][2] * rstd2, O[j][3] * rstd2); \
            *(GAS u32x2*)(X1B + (size_t)mm_ * DM + 256 * j + 4 * lane) = o; } \
        if (lane == 0) RSTD2[mm_] = sqrtf(ms2); } while (0)
    int m = gw;
    if (m < MT) { RP1_LOAD(va, ma, sa, ra, m);
        for (;;) { const int m2 = m + NGW; if (m2 < MT) RP1_LOAD(vb, mb, sb, rb, m2); RP1_PROC(va, ma, sa, ra, m); if (m2 >= MT) break;
                   m = m2 + NGW; if (m < MT) RP1_LOAD(va, ma, sa, ra, m); RP1_PROC(vb, mb, sb, rb, m2); if (m >= MT) break; } }
#undef RP1_LOAD
#undef RP1_PROC
}
__device__ __forceinline__ void rowpass2(const Args& A, int lane, int gw, int NGW) {
    unsigned char* ws = A.ws;
    const bf16* FF = (const bf16*)(ws + WS_FF); const bf16* X1B = (const bf16*)(ws + WS_X1B);
    const float* SSp = (const float*)(ws + WS_SS2); const float* SSs = (const float*)(ws + WS_SSS + SSS_2);
    f32x4 g3[8];
#pragma unroll
    for (int j = 0; j < 8; ++j) g3[j] = *(const f32x4*)(A.in[31] + 256 * j + 4 * lane);
    u32x2 xa[8], xb[8], fa[8], fb[8]; float sa = 0.f, sb = 0.f;
    const float* RSTD2 = (const float*)(ws + WS_SSS + SSS_RSTD2); float ra = 0.f, rb = 0.f;
#define RP2_LOAD(X, F, S, R, m_) do { const int mm_ = (m_); S = row_ss_part(SSp, SSs, mm_, lane); R = RSTD2[mm_]; \
        _Pragma("unroll") for (int j = 0; j < 8; ++j) { const int k = 256 * j + 4 * lane; X[j] = *(const GAS u32x2*)(X1B + (size_t)mm_ * DM + k); F[j] = *(const GAS u32x2*)(FF + (size_t)mm_ * DM + k); } } while (0)
#define RP2_PROC(X, F, S, R, m_) do { const int mm_ = (m_); float* orow = A.out + O_Y + (size_t)mm_ * DM; const float rstd = 1.0f / sqrtf(wave_sum(S) * (1.0f / DM) + EPS); f32x4 V[8]; \
        _Pragma("unroll") for (int j = 0; j < 8; ++j) { V[j][0] = bflo(X[j].x) * R + bflo(F[j].x) * rstd * g3[j][0]; V[j][1] = bfhi(X[j].x) * R + bfhi(F[j].x) * rstd * g3[j][1]; V[j][2] = bflo(X[j].y) * R + bflo(F[j].y) * rstd * g3[j][2]; V[j][3] = bfhi(X[j].y) * R + bfhi(F[j].y) * rstd * g3[j][3]; } \
        DBG_PERTURB(V, mm_); \
        _Pragma("unroll") for (int j = 0; j < 8; ++j) __builtin_nontemporal_store(V[j], (GAS f32x4*)(orow + 256 * j + 4 * lane)); } while (0)
    int m = gw;
    if (m < MT) { RP2_LOAD(xa, fa, sa, ra, m);
        for (;;) { const int m2 = m + NGW; if (m2 < MT) RP2_LOAD(xb, fb, sb, rb, m2); RP2_PROC(xa, fa, sa, ra, m); if (m2 >= MT) break;
                   m = m2 + NGW; if (m < MT) RP2_LOAD(xa, fa, sa, ra, m); RP2_PROC(xb, fb, sb, rb, m2); if (m >= MT) break; } }
#undef RP2_LOAD
#undef RP2_PROC
}
#ifndef MK_AL_P4
#define MK_AL_P4 true
#endif
#ifndef MK_AL_SS
#define MK_AL_SS true
#endif
#ifndef MK_WGM_P5
#define MK_WGM_P5 4
#endif
#ifndef MK_WGM_P1
#define MK_WGM_P1 2
#endif
#ifndef MK_WGM_P7
#define MK_WGM_P7 4
#endif
#ifndef MK_WGM_P8
#define MK_WGM_P8 1
#endif
#ifndef MK_GU_ALIGN
#define MK_GU_ALIGN true
#endif
#ifndef MK_GU_SP2
#define MK_GU_SP2 true
#endif
__global__ void __launch_bounds__(NWAVES * 64, 2) hymba_fwd(Args args) {
    extern __shared__ __attribute__((aligned(16))) unsigned char lds_raw[];
    LAS unsigned char* lds = (LAS unsigned char*)lds_raw;
    volatile LAS unsigned* MISC = (volatile LAS unsigned*)(lds + MISC_OFF);
    const int tid = threadIdx.x, lane = tid & 63, wave = __builtin_amdgcn_readfirstlane(tid >> 6);
    const int G = gridDim.x; const int bx = blockIdx.x; const int vcu = (G % 8 == 0) ? (bx % 8) * (G / 8) + bx / 8 : bx;
    unsigned char* ws = args.ws;
    gu32* ctl = (gu32*)(ws + WS_CTL);
    for (int u = tid; u < (LDS_BYTES - LDSCTL_OFF) / 4; u += NWAVES * 64) ((LAS unsigned*)(lds + LDSCTL_OFF))[u] = 0u;
    __syncthreads();
    const XcdBarrier bar = xcd_barrier_post((unsigned*)(ctl + CW_BAR) + args.li * XCD_BAR_WORDS, MISC + 8);
#define GRID_BAR() xcd_barrier(bar)
    const int lo = args.ph_lo, hi = args.ph_hi;
#define IN(k) (lo <= (k) && (k) < hi)
#define BOTH(k) (IN(k) && IN((k) + 1))

    const int gw = vcu * NWAVES + wave, NGW = G * NWAVES;

    if (IN(0)) { PHASE_IDS p0_prologue(args, lds, tid, lane, wave, vcu, G); if (BOTH(0)) GRID_BAR(); }

    if (IN(1)) { PHASE_IDS
        { pg8::Gemm g{(const bf16*)(ws + WS_XN), (const bf16*)(ws + WS_WIN), MP, 4096, DM}; pg8::StaticOrder S; S.init(MP, 4096, G, bx, MK_WGM_P1);
          pg8::EpiBf16<0> E{(bf16*)(ws + WS_QKRAW), 1024, nullptr, 1024, (size_t)WS_RSTRIDE / 2, 1.f};
          pg8::gemm_phase<pg8::EpiBf16<0>, pg8::StaticOrder, true, true>(lds + RING_OFF, g, S, E); }
        { PHASE_IDS bf16* O = (bf16*)(ws + WS_QKRAW);
          skinny_gemm<1, DM>((const bf16*)(ws + WS_XN) + (size_t)MP * DM, (const bf16*)(ws + WS_WIN), lds, 4096 / 16, vcu, G, tid, wave, lane,
              [](int it, int a, int fr) { return 16 * it + fr; },
              [O](int it, int row, int fq, const f32x4 (&acc)[1]) { const int col = 16 * it + 4 * fq, t = col >> 10;
                  u32x2 w; w.x = cvtpk_n(acc[0][0], acc[0][1]); w.y = cvtpk_n(acc[0][2], acc[0][3]);
                  *(GAS u32x2*)(O + (size_t)t * (WS_RSTRIDE / 2) + (size_t)(MP + row) * 1024 + (col & 1023)) = w; }); }
        if (BOTH(1)) GRID_BAR();
    }

    if (IN(2)) { PHASE_IDS if (vcu < 64) p2_scalars(args, lds, lane, wave, vcu); p2_conv(args, tid, vcu, G); if (BOTH(2)) GRID_BAR(); }

    if (IN(3)) { PHASE_IDS
        const int half = G / 2;
#ifndef MK_REP_M
#define MK_REP_M 1
#endif
#ifndef MK_REP_S
#define MK_REP_S 1
#endif
        if (vcu < half) { for (int rp_ = 0; rp_ < MK_REP_M; ++rp_) for (int it = vcu; it < NBATCH * NH * NSL; it += half) mlstm_item(args, lds, tid, lane, wave, it); }
        else { const int nb = G - half, bi = vcu - half;
               for (int rp_ = 0; rp_ < MK_REP_S; ++rp_)
               for (int it = bi * 4 + (wave & 3); it < 2 * NBATCH * NG; it += nb * 4) s5_item(args, lds + (wave & 3) * 25600, lane, wave >> 2, it); }
        if (vcu >= half) { __syncthreads(); for (int it = NBATCH * NH * NSL + (vcu - half); it < 2 * NBATCH * NH * NSL; it += G - half) mlstm_item(args, lds, tid, lane, wave, it); }
        if (BOTH(3)) GRID_BAR();
    }

    if (IN(4)) { PHASE_IDS
        { pg8::Gemm g{(const bf16*)(ws + WS_Z), (const bf16*)(ws + WS_WGLU), MP, 1024, 1024}; pg8::StaticOrder S; S.init(MP, 1024, G, bx);
          pg8::EpiGlu E{(const bf16*)(ws + WS_Z), (bf16*)(ws + WS_MIXIN), args.in[24]};
          pg8::gemm_phase<pg8::EpiGlu, pg8::StaticOrder, MK_AL_P4, true>(lds + RING_OFF, g, S, E); }
        { PHASE_IDS const bf16* Zb = (const bf16*)(ws + WS_Z); bf16* O = (bf16*)(ws + WS_MIXIN); const float* bias = args.in[24];
          skinny_gemm<1, 1024>(Zb + (size_t)MP * 1024, (const bf16*)(ws + WS_WGLU), lds, 1024 / 16, vcu, G, tid, wave, lane,
              [](int it, int a, int fr) { return 16 * it + fr; },
              [Zb, O, bias](int it, int row, int fq, const f32x4 (&acc)[1]) { const int col = 16 * it + 4 * fq; const size_t m = (size_t)(MP + row);
                  const u32x2 z = *(const GAS u32x2*)(Zb + m * 1024 + col); const f32x4 bv = *(const f32x4*)(bias + col);
                  u32x2 w; w.x = cvtpk(bflo(z.x) * sigmoidf_(acc[0][0] + bv[0]), bfhi(z.x) * sigmoidf_(acc[0][1] + bv[1]));
                  w.y = cvtpk(bflo(z.y) * sigmoidf_(acc[0][2] + bv[2]), bfhi(z.y) * sigmoidf_(acc[0][3] + bv[3]));
                  *(GAS u32x2*)(O + m * 2048 + 1024 + col) = w; }); }
        { PHASE_IDS outa_rows(args, lane, gw, NGW); }
        if (BOTH(4)) GRID_BAR();
    }

    if (IN(5)) { PHASE_IDS
        { pg8::Gemm g{(const bf16*)(ws + WS_MIXIN), (const bf16*)(ws + WS_WOUT), MP, DM, DM}; pg8::StaticOrder S; S.init(MP, DM, G, bx, MK_WGM_P5);
          pg8::EpiSS<false> E{(bf16*)(ws + WS_MIX), DM, (float*)(ws + WS_SS1), 1.0f};
          pg8::gemm_phase<pg8::EpiSS<false>, pg8::StaticOrder, MK_AL_SS, true>(lds + RING_OFF, g, S, E); }
        { PHASE_IDS bf16* O = (bf16*)(ws + WS_MIX); float* SSs = (float*)(ws + WS_SSS + SSS_1);
          skinny_gemm<1, DM>((const bf16*)(ws + WS_MIXIN) + (size_t)MP * DM, (const bf16*)(ws + WS_WOUT), lds, DM / 16, vcu, G, tid, wave, lane,
              [](int it, int a, int fr) { return 16 * it + fr; },
              [O, SSs](int it, int row, int fq, const f32x4 (&acc)[1]) { const int col = 16 * it + 4 * fq;
                  u32x2 w; w.x = cvtpk_n(acc[0][0], acc[0][1]); w.y = cvtpk_n(acc[0][2], acc[0][3]);
                  *(GAS u32x2*)(O + (size_t)(MP + row) * DM + col) = w;
                  float s = (acc[0][0] * acc[0][0] + acc[0][1] * acc[0][1]) + (acc[0][2] * acc[0][2] + acc[0][3] * acc[0][3]);
                  s += __shfl_xor(s, 16); s += __shfl_xor(s, 32);
                  if (fq == 0) SSs[(size_t)row * 128 + it] = s; }); }
        if (BOTH(5)) GRID_BAR();
    }

    if (IN(6)) { PHASE_IDS rowpass1(args, lane, gw, NGW); if (BOTH(6)) GRID_BAR(); }

    if (IN(7)) { PHASE_IDS
        { pg8::Gemm g{(const bf16*)(ws + WS_X1B), (const bf16*)(ws + WS_WGU), MP, 2 * DFF, DM}; pg8::StaticOrder S; S.init(MP, 2 * DFF, G, bx, MK_WGM_P7);
          pg8::EpiGU8 E{ws + WS_ACT8, DFF};
          pg8::gemm_phase<pg8::EpiGU8, pg8::StaticOrder, MK_GU_ALIGN, MK_GU_SP2>(lds + RING_OFF, g, S, E); }
        { PHASE_IDS bf16* O = (bf16*)(ws + WS_ACTS);
          skinny_gemm<2, DM>((const bf16*)(ws + WS_X1B) + (size_t)MP * DM, (const bf16*)(ws + WS_WGU), lds, DFF / 16, vcu, G, tid, wave, lane,
              [](int it, int a, int fr) { const int j = 16 * it + fr; return 256 * (j >> 7) + 128 * a + (j & 127); },
              [O](int it, int row, int fq, const f32x4 (&acc)[2]) { const int col = 16 * it + 4 * fq; const f32x4 g = acc[0], up = acc[1];
                  u32x2 w; w.x = cvtpk(g[0] * sigmoidf_(g[0]) * up[0], g[1] * sigmoidf_(g[1]) * up[1]);
                  w.y = cvtpk(g[2] * sigmoidf_(g[2]) * up[2], g[3] * sigmoidf_(g[3]) * up[3]);
                  *(GAS u32x2*)(O + (size_t)row * DFF + col) = w; }); }
        if (BOTH(7)) GRID_BAR();
    }

    if (IN(8)) { PHASE_IDS
        { pg8::Gemm g{(const bf16*)(ws + WS_ACT8), (const bf16*)(ws + WS_WD8), MP, DM, DFF / 2}; pg8::StaticOrder S; S.init(MP, DM, G, bx, MK_WGM_P8);
          pg8::EpiSS<true> E{(bf16*)(ws + WS_FF), DM, (float*)(ws + WS_SS2), 0.0009765625f};
          pg8::gemm_phase<pg8::EpiSS<true>, pg8::StaticOrder, MK_AL_SS, true, true>(lds + RING_OFF, g, S, E); }
        { PHASE_IDS bf16* O = (bf16*)(ws + WS_FF); float* SSs = (float*)(ws + WS_SSS + SSS_2);
          skinny_gemm<1, DFF>((const bf16*)(ws + WS_ACTS), (const bf16*)(ws + WS_WD), lds, DM / 16, vcu, G, tid, wave, lane,
              [](int it, int a, int fr) { return 16 * it + fr; },
              [O, SSs](int it, int row, int fq, const f32x4 (&acc)[1]) { const int col = 16 * it + 4 * fq;
                  u32x2 w; w.x = cvtpk_n(acc[0][0], acc[0][1]); w.y = cvtpk_n(acc[0][2], acc[0][3]);
                  *(GAS u32x2*)(O + (size_t)(MP + row) * DM + col) = w;
                  float s = (acc[0][0] * acc[0][0] + acc[0][1] * acc[0][1]) + (acc[0][2] * acc[0][2] + acc[0][3] * acc[0][3]);
                  s += __shfl_xor(s, 16); s += __shfl_xor(s, 32);
                  if (fq == 0) SSs[(size_t)row * 128 + it] = s; }); }
        if (BOTH(8)) GRID_BAR();
    }

    if (IN(9)) { PHASE_IDS rowpass2(args, lane, gw, NGW); }
#undef IN
#undef BOTH
}

#ifdef MK_DUMP_OFF
__global__ void dump_kernel(const unsigned short* src, float* dst, size_t n) {
    for (size_t i = (size_t)blockIdx.x * blockDim.x + threadIdx.x; i < n; i += (size_t)gridDim.x * blockDim.x) dst[i] = __uint_as_float((unsigned)src[i] << 16);
}
#endif
extern "C" void kernel_launch(void* const* d_in, const int* in_sizes, int n_in, void* d_out, int out_size, void* d_ws, size_t ws_size, hipStream_t stream) {
    static int grid = 0;
    if (grid == 0) {
        if (n_in != 32 || out_size != (int)O_END || ws_size < WS_END) { fprintf(stderr, "kernel_launch: unexpected problem: n_in %d out %d ws %zu\n", n_in, out_size, ws_size); grid = -1; return; }
        int dev = 0, cus = 0, per_cu = 0;
        if (hipGetDevice(&dev) != hipSuccess || hipDeviceGetAttribute(&cus, hipDeviceAttributeMultiprocessorCount, dev) != hipSuccess) { grid = -1; return; }
        if (hipFuncSetAttribute((const void*)hymba_fwd, hipFuncAttributeMaxDynamicSharedMemorySize, LDS_BYTES) != hipSuccess) { fprintf(stderr, "kernel_launch: hipFuncSetAttribute failed\n"); grid = -1; return; }
        if (hipOccupancyMaxActiveBlocksPerMultiprocessor(&per_cu, (const void*)hymba_fwd, NWAVES * 64, LDS_BYTES) != hipSuccess || per_cu < 1) { fprintf(stderr, "kernel_launch: occupancy query reports %d\n", per_cu); per_cu = 1; }
        (void)hipGetLastError();
        grid = cus;
    }
    if (grid < 0) return;
    Args a{};
    for (int i = 0; i < 32; ++i) a.in[i] = (const float*)d_in[i];
    a.out = (float*)d_out; a.ws = (unsigned char*)d_ws;
    int lo[N_PHASES + 2], hi[N_PHASES + 2], nl = 0;
#if defined(MK_REPEAT)
    lo[0] = 0; hi[0] = MK_REPEAT + 1; lo[1] = MK_REPEAT; hi[1] = MK_REPEAT + 1; lo[2] = MK_REPEAT + 1; hi[2] = N_PHASES; nl = 3;
#else
    if (N_LAUNCHES == 1) { lo[0] = 0; hi[0] = N_PHASES; nl = 1; } else { for (int k = 0; k < N_PHASES; ++k) { lo[k] = k; hi[k] = k + 1; } nl = N_PHASES; }
#endif
    if (hipMemsetAsync((char*)d_ws + WS_CTL, 0, (size_t)(CW_BAR + nl * XCD_BAR_WORDS) * 4, stream) != hipSuccess) return;
    for (int li = 0; li < nl; ++li) {
        a.ph_lo = lo[li]; a.ph_hi = hi[li]; a.li = li;
        hipLaunchKernelGGL(hymba_fwd, dim3(grid), dim3(NWAVES * 64), LDS_BYTES, stream, a);
    }
#ifdef MK_DUMP_OFF
    hipLaunchKernelGGL(dump_kernel, dim3(2048), dim3(256), 0, stream, (const unsigned short*)((const unsigned char*)d_ws + (size_t)(MK_DUMP_OFF) * MiB), (float*)d_out, (size_t)(MK_DUMP_N));
#endif
}
```

```cpp
#define MK_N_LAUNCHES 1
#include <hip/hip_runtime.h>
#include <cstdio>
#include <cstdint>
#include <cmath>
namespace pg8 {
#define PG8_LAS __attribute__((address_space(3)))
typedef unsigned short bf16_t;
typedef short bf16x8 __attribute__((ext_vector_type(8)));
typedef float f32x4 __attribute__((ext_vector_type(4)));
typedef unsigned u32x4 __attribute__((ext_vector_type(4)));
typedef int i32x4 __attribute__((ext_vector_type(4)));
typedef int i32x8 __attribute__((ext_vector_type(8)));
__device__ __forceinline__ i32x8 cat8(bf16x8 lo, bf16x8 hi) { return __builtin_shufflevector(__builtin_bit_cast(i32x4, lo), __builtin_bit_cast(i32x4, hi), 0, 1, 2, 3, 4, 5, 6, 7); }
constexpr int BM = 256, BK = 64, HALF = 128, HTB = HALF * BK * 2  , STAGE_BYTES = 8 * HTB, NXCD = 8, WGM = 4;

__host__ __device__ __forceinline__ int lds_byte(int r, int c) { const int st = (r >> 4) * 2 + (c >> 5), rr = r & 15, cc = c & 31, ob = rr * 64 + cc * 2; return st * 1024 + (ob ^ (((ob >> 9) & 1) << 5)); }
__host__ __device__ __forceinline__ void stage_rc(int b, int& R, int& C) { const int st = b / 1024, sb = b % 1024, swz = sb ^ (((sb >> 9) & 1) << 5); R = (st >> 1) * 16 + swz / 64; C = (st & 1) * 32 + (swz % 64) / 2; }
__host__ __device__ __forceinline__ int perm32(int rho) { const int n = rho >> 4, i = rho & 15; return 8 * (i >> 2) + 4 * n + (i & 3); }

struct Unit { int pm, pn; };
struct Gemm { const bf16_t* A; const bf16_t* Bt; int M, N, K; };

struct StaticOrder {
    int nM, nN, nwg, G, c, wgm;
    __host__ __device__ void init(int M, int N, int G_, int c_, int wgm_ = WGM) { nM = M / BM; nN = N / BM; nwg = nM * nN; G = G_; c = c_; wgm = wgm_; }
    __host__ __device__ bool next(int i, Unit& u) const {
        const long L = (long)i * G + c; if (L >= nwg) return false;
        int wgid = (int)L; { const int q = nwg / NXCD, r = nwg % NXCD, xcd = wgid % NXCD, off = wgid / NXCD; wgid = (xcd < r ? xcd * (q + 1) : r * (q + 1) + (xcd - r) * q) + off; }
        const int nig = wgm * nN, gid = wgid / nig, fm = gid * wgm, gsz = (nM - fm) < wgm ? (nM - fm) : wgm;
        u.pm = fm + ((wgid % nig) % gsz); u.pn = (wgid % nig) / gsz; return true;
    }
    __device__ __forceinline__ void a_ready(const Unit&) const {}
    __device__ __forceinline__ void done(const Unit&) const {}
};

__device__ __forceinline__ unsigned cvt_pk_bf16(float lo, float hi) { unsigned r; asm volatile("v_cvt_pk_bf16_f32 %0, %1, %2" : "=v"(r) : "v"(lo), "v"(hi)); return r; }
typedef float f32x2 __attribute__((ext_vector_type(2)));
__device__ __forceinline__ f32x2 gelu_pk(f32x2 v) {
    const f32x2 av = __builtin_elementwise_abs(v), d = av * 0.2316418882f + 1.0f;
    f32x2 t; t.x = __builtin_amdgcn_rcpf(d.x); t.y = __builtin_amdgcn_rcpf(d.y);
    f32x2 q = t * 0.5307027145f + (-0.7265760135f); q = q * t + 0.7107068705f; q = q * t + (-0.142248368f); q = q * t + 0.127414796f; q = q * t;
    const f32x2 s = (v * v) * (-0.72134752044f);
    f32x2 e; e.x = __builtin_amdgcn_exp2f(s.x); e.y = __builtin_amdgcn_exp2f(s.y);
    const f32x2 m = v * (q * e), r = v - m;
    f32x2 o; o.x = v.x < 0.f ? m.x : r.x; o.y = v.y < 0.f ? m.y : r.y; return o;
}

template <int ACT  > struct EpiBf16 {
    static constexpr bool PERM = true, AFTER_DRAIN = false; static_assert(ACT == 0 || ACT == 1, "EpiBf16: ACT is 0 (none) or 1 (gelu_pk)");
    bf16_t* O; int ldc; const float* bias; int split_cols; size_t split_stride; float scale0;
    __device__ __forceinline__ void operator()(const f32x4 (&acc)[2][2][4][2], const Unit& u, int wr, int wc, int fr, int fq) const {
        const int row0 = u.pm * BM + wr * 64 + fr; int colt = u.pn * BM; bf16_t* base = O;
        float sc = 1.f; if (split_cols) { const int t = colt / split_cols; base += (size_t)t * split_stride; colt -= t * split_cols; if (t == 0) sc = scale0; }
        const int col0 = colt + wc * 32 + 8 * fq, bcol0 = u.pn * BM + wc * 32 + 8 * fq;
        f32x4 bv[2][2];
#pragma unroll
        for (int bj = 0; bj < 2; ++bj)
#pragma unroll
            for (int n = 0; n < 2; ++n) bv[bj][n] = bias ? *(const f32x4*)(bias + bcol0 + bj * HALF + 4 * n) : (f32x4){0.f, 0.f, 0.f, 0.f};
#pragma unroll
        for (int ai = 0; ai < 2; ++ai)
#pragma unroll
            for (int m = 0; m < 4; ++m) { bf16_t* rowp = base + (size_t)(row0 + ai * HALF + m * 16) * ldc + col0;
#pragma unroll
                for (int bj = 0; bj < 2; ++bj) { f32x4 v0 = acc[ai][bj][m][0] + bv[bj][0], v1 = acc[ai][bj][m][1] + bv[bj][1];
                    if (ACT == 1) { f32x2 a = gelu_pk((f32x2){v0[0], v0[1]}), b = gelu_pk((f32x2){v0[2], v0[3]}), c = gelu_pk((f32x2){v1[0], v1[1]}), d = gelu_pk((f32x2){v1[2], v1[3]});
                        v0 = (f32x4){a.x, a.y, b.x, b.y}; v1 = (f32x4){c.x, c.y, d.x, d.y}; }
                    v0 = v0 * sc; v1 = v1 * sc; u32x4 w; w.x = cvt_pk_bf16(v0[0], v0[1]); w.y = cvt_pk_bf16(v0[2], v0[3]); w.z = cvt_pk_bf16(v1[0], v1[1]); w.w = cvt_pk_bf16(v1[2], v1[3]);
                    *(u32x4*)(rowp + bj * HALF) = w; } }
    }
};
__device__ __forceinline__ float fast_sigmoid(float v) { return __builtin_amdgcn_rcpf(1.0f + __expf(-v)); }
__device__ __forceinline__ float bf_lo(unsigned w) { return __uint_as_float(w << 16); }
__device__ __forceinline__ float bf_hi(unsigned w) { return __uint_as_float(w & 0xffff0000u); }
struct EpiGlu {
    static constexpr bool PERM = true, AFTER_DRAIN = false;
    const bf16_t* Z; bf16_t* O; const float* bias;
    __device__ __forceinline__ void operator()(const f32x4 (&acc)[2][2][4][2], const Unit& u, int wr, int wc, int fr, int fq) const {
        const int row0 = u.pm * BM + wr * 64 + fr, col0 = u.pn * BM + wc * 32 + 8 * fq;
        f32x4 bv[2][2];
#pragma unroll
        for (int bj = 0; bj < 2; ++bj)
#pragma unroll
            for (int n = 0; n < 2; ++n) bv[bj][n] = *(const f32x4*)(bias + col0 + bj * HALF + 4 * n);
#pragma unroll
        for (int ai = 0; ai < 2; ++ai) {
            u32x4 z[4][2];
#pragma unroll
            for (int m = 0; m < 4; ++m)
#pragma unroll
                for (int bj = 0; bj < 2; ++bj) z[m][bj] = *(const u32x4*)(Z + (size_t)(row0 + ai * HALF + m * 16) * 1024 + col0 + bj * HALF);
#pragma unroll
            for (int m = 0; m < 4; ++m) { const size_t row = (size_t)(row0 + ai * HALF + m * 16);
#pragma unroll
                for (int bj = 0; bj < 2; ++bj) { const int col = col0 + bj * HALF; const u32x4 zz = z[m][bj];
                    const f32x4 v0 = acc[ai][bj][m][0] + bv[bj][0], v1 = acc[ai][bj][m][1] + bv[bj][1];
                    u32x4 w;
                    w.x = cvt_pk_bf16(bf_lo(zz.x) * fast_sigmoid(v0[0]), bf_hi(zz.x) * fast_sigmoid(v0[1]));
                    w.y = cvt_pk_bf16(bf_lo(zz.y) * fast_sigmoid(v0[2]), bf_hi(zz.y) * fast_sigmoid(v0[3]));
                    w.z = cvt_pk_bf16(bf_lo(zz.z) * fast_sigmoid(v1[0]), bf_hi(zz.z) * fast_sigmoid(v1[1]));
                    w.w = cvt_pk_bf16(bf_lo(zz.w) * fast_sigmoid(v1[2]), bf_hi(zz.w) * fast_sigmoid(v1[3]));
                    *(u32x4*)(O + row * 2048 + 1024 + col) = w; } } }
    }
};
template <bool SCALED> struct EpiSS {
    static constexpr bool PERM = true, AFTER_DRAIN = false;
    bf16_t* O; int ldc; float* SS; float scale;
    __device__ __forceinline__ void operator()(const f32x4 (&acc)[2][2][4][2], const Unit& u, int wr, int wc, int fr, int fq) const {
        const int row0 = u.pm * BM + wr * 64 + fr, col0 = u.pn * BM + wc * 32 + 8 * fq;
        float s[2][4];
#pragma unroll
        for (int ai = 0; ai < 2; ++ai)
#pragma unroll
            for (int m = 0; m < 4; ++m) { const size_t row = (size_t)(row0 + ai * HALF + m * 16); float t = 0.f;
#pragma unroll
                for (int bj = 0; bj < 2; ++bj) { f32x4 v0 = acc[ai][bj][m][0], v1 = acc[ai][bj][m][1]; if (SCALED) { v0 = v0 * scale; v1 = v1 * scale; }
                    t += (v0[0] * v0[0] + v0[1] * v0[1]) + (v0[2] * v0[2] + v0[3] * v0[3]) + (v1[0] * v1[0] + v1[1] * v1[1]) + (v1[2] * v1[2] + v1[3] * v1[3]);
                    u32x4 w; w.x = cvt_pk_bf16(v0[0], v0[1]); w.y = cvt_pk_bf16(v0[2], v0[3]); w.z = cvt_pk_bf16(v1[0], v1[1]); w.w = cvt_pk_bf16(v1[2], v1[3]);
                    *(u32x4*)(O + row * ldc + col0 + bj * HALF) = w; }
                s[ai][m] = t; }
#pragma unroll
        for (int ai = 0; ai < 2; ++ai)
#pragma unroll
            for (int m = 0; m < 4; ++m) s[ai][m] += __shfl_xor(s[ai][m], 16);
#pragma unroll
        for (int ai = 0; ai < 2; ++ai)
#pragma unroll
            for (int m = 0; m < 4; ++m) s[ai][m] += __shfl_xor(s[ai][m], 32);
        if (fq == 0) {
#pragma unroll
            for (int ai = 0; ai < 2; ++ai)
#pragma unroll
                for (int m = 0; m < 4; ++m) SS[(size_t)(row0 + ai * HALF + m * 16) * 32 + u.pn * 4 + wc] = s[ai][m]; }
    }
};
struct EpiGU {
    static constexpr bool PERM = true, AFTER_DRAIN = false;
    bf16_t* O; int ldc;
    static __device__ __forceinline__ unsigned swiglu_pk(f32x2 g, f32x2 u) {
        const f32x2 t = g * -1.4426950408889634f; f32x2 e; e.x = __builtin_amdgcn_exp2f(t.x); e.y = __builtin_amdgcn_exp2f(t.y);
        const f32x2 d = e + 1.0f; f32x2 s; s.x = __builtin_amdgcn_rcpf(d.x); s.y = __builtin_amdgcn_rcpf(d.y);
        const f32x2 o = (g * u) * s; return cvt_pk_bf16(o.x, o.y);
    }
    __device__ __forceinline__ void operator()(const f32x4 (&acc)[2][2][4][2], const Unit& u, int wr, int wc, int fr, int fq) const {
        const int row0 = u.pm * BM + wr * 64 + fr, col0 = u.pn * HALF + wc * 32 + 8 * fq;
#pragma unroll
        for (int ai = 0; ai < 2; ++ai)
#pragma unroll
            for (int m = 0; m < 4; ++m) { const size_t row = (size_t)(row0 + ai * HALF + m * 16);
                const f32x4 g0 = acc[ai][0][m][0], g1 = acc[ai][0][m][1], u0 = acc[ai][1][m][0], u1 = acc[ai][1][m][1];
                u32x4 w;
                w.x = swiglu_pk((f32x2){g0[0], g0[1]}, (f32x2){u0[0], u0[1]});
                w.y = swiglu_pk((f32x2){g0[2], g0[3]}, (f32x2){u0[2], u0[3]});
                w.z = swiglu_pk((f32x2){g1[0], g1[1]}, (f32x2){u1[0], u1[1]});
                w.w = swiglu_pk((f32x2){g1[2], g1[3]}, (f32x2){u1[2], u1[3]});
                *(u32x4*)(O + row * ldc + col0) = w; }
    }
};
struct EpiGU8 {
    static constexpr bool PERM = true, AFTER_DRAIN = false;
    unsigned char* O; int ldc;
    static __device__ __forceinline__ f32x2 swiglu2(f32x2 g, f32x2 u) {
        const f32x2 t = g * -1.4426950408889634f; f32x2 e; e.x = __builtin_amdgcn_exp2f(t.x); e.y = __builtin_amdgcn_exp2f(t.y);
        const f32x2 d = e + 1.0f; f32x2 s; s.x = __builtin_amdgcn_rcpf(d.x); s.y = __builtin_amdgcn_rcpf(d.y);
        f32x2 o = (g * u) * s; o.x = __builtin_amdgcn_fmed3f(o.x, -448.f, 448.f); o.y = __builtin_amdgcn_fmed3f(o.y, -448.f, 448.f); return o;
    }
    __device__ __forceinline__ void operator()(const f32x4 (&acc)[2][2][4][2], const Unit& u, int wr, int wc, int fr, int fq) const {
        const int row0 = u.pm * BM + wr * 64 + fr, col0 = u.pn * HALF + wc * 32 + 8 * fq;
#pragma unroll
        for (int ai = 0; ai < 2; ++ai)
#pragma unroll
            for (int m = 0; m < 4; ++m) { const size_t row = (size_t)(row0 + ai * HALF + m * 16);
                const f32x4 g0 = acc[ai][0][m][0], g1 = acc[ai][0][m][1], u0 = acc[ai][1][m][0], u1 = acc[ai][1][m][1];
                const f32x2 a = swiglu2((f32x2){g0[0], g0[1]}, (f32x2){u0[0], u0[1]}), b = swiglu2((f32x2){g0[2], g0[3]}, (f32x2){u0[2], u0[3]});
                const f32x2 c = swiglu2((f32x2){g1[0], g1[1]}, (f32x2){u1[0], u1[1]}), d = swiglu2((f32x2){g1[2], g1[3]}, (f32x2){u1[2], u1[3]});
                int w0 = 0, w1 = 0;
                w0 = __builtin_amdgcn_cvt_pk_fp8_f32(a.x, a.y, w0, false); w0 = __builtin_amdgcn_cvt_pk_fp8_f32(b.x, b.y, w0, true);
                w1 = __builtin_amdgcn_cvt_pk_fp8_f32(c.x, c.y, w1, false); w1 = __builtin_amdgcn_cvt_pk_fp8_f32(d.x, d.y, w1, true);
                typedef unsigned u32x2_t __attribute__((ext_vector_type(2)));
                *(u32x2_t*)(O + row * ldc + col0) = (u32x2_t){(unsigned)w0, (unsigned)w1}; }
    }
};
template <class Epi, class Sched, bool ALIGN_EPI = false, bool SP2 = false, bool F8 = false>
__device__ __forceinline__ void gemm_phase(PG8_LAS unsigned char* lds, const Gemm g, const Sched& S, const Epi& E) {
    int tid = threadIdx.x; asm volatile("" : "+v"(tid));
    const int wid = __builtin_amdgcn_readfirstlane(tid >> 6), lane = tid & 63, wr = wid >> 2, wc = wid & 3, fr = lane & 15, fq = lane >> 4;
    const int K = g.K, nt = K / BK;
    unsigned voffA[2], voffB[2];
#pragma unroll
    for (int i = 0; i < 2; ++i) { int R, C; stage_rc(tid * 16 + i * 8192, R, C); const int Rb = Epi::PERM ? ((R & ~31) + perm32(R & 31)) : R;
        voffA[i] = (unsigned)(R * K + C) * 2u; voffB[i] = (unsigned)(Rb * K + C) * 2u; }
    const size_t kstep = (size_t)(BK * 2);
    const size_t hstep = (size_t)HALF * K * 2;
    const size_t tstep = 2 * hstep;
    const unsigned ldsw = (unsigned)wid * 1024u;
    const int aoff = lds_byte(wr * 64 + fr, fq * 8), boff = lds_byte(wc * 32 + fr, fq * 8);
#define PG8_SA(b, h) (((b) * 2 + (h)) * HTB)
#define PG8_SB(b, h) ((4 + (b) * 2 + (h)) * HTB)
#define PG8_STAGE(bufoff, gbase, voff) do { _Pragma("unroll") for (int _i = 0; _i < 2; ++_i) { unsigned _vo = (voff)[_i]; asm volatile("" : "+v"(_vo));     \
        __builtin_amdgcn_global_load_lds((const unsigned*)((const char*)(gbase) + _vo), (PG8_LAS unsigned*)(lds + (bufoff) + ldsw + _i * 8192), 16, 0, 0); } } while (0)
#define PG8_LDA(dst, b, h) do { _Pragma("unroll") for (int m = 0; m < 4; ++m) _Pragma("unroll") for (int k = 0; k < 2; ++k) dst[m][k] = *(const PG8_LAS bf16x8*)(lds + PG8_SA(b, h) + aoff + m * 2048 + k * 1024); } while (0)
#define PG8_LDB(dst, b, h) do { _Pragma("unroll") for (int n = 0; n < 2; ++n) _Pragma("unroll") for (int k = 0; k < 2; ++k) dst[n][k] = *(const PG8_LAS bf16x8*)(lds + PG8_SB(b, h) + boff + n * 2048 + k * 1024); } while (0)
#define PG8_MMA(ai, bj, At, Bt) do { __builtin_amdgcn_s_setprio(1); \
        if constexpr (F8) { _Pragma("unroll") for (int m = 0; m < 4; ++m) _Pragma("unroll") for (int n = 0; n < 2; ++n) \
            acc[ai][bj][m][n] = __builtin_amdgcn_mfma_scale_f32_16x16x128_f8f6f4(cat8(Bt[n][0], Bt[n][1]), cat8(At[m][0], At[m][1]), acc[ai][bj][m][n], 0, 0, 0, 0, 0, 0); } \
        else { _Pragma("unroll") for (int m = 0; m < 4; ++m) _Pragma("unroll") for (int n = 0; n < 2; ++n) _Pragma("unroll") for (int k = 0; k < 2; ++k) \
            acc[ai][bj][m][n] = __builtin_amdgcn_mfma_f32_16x16x32_bf16(Bt[n][k], At[m][k], acc[ai][bj][m][n], 0, 0, 0); } \
        __builtin_amdgcn_s_setprio(0); } while (0)
#define PG8_WAIT_V(n) asm volatile("s_waitcnt vmcnt(" #n ")" ::: "memory")
#define PG8_WAIT_L(n) asm volatile("s_waitcnt lgkmcnt(" #n ")" ::: "memory")
#define PG8_BAR __builtin_amdgcn_s_barrier()
#define PG8_SCHED __builtin_amdgcn_sched_barrier(0)
    Unit cur, nxt; int ui = 0;
    if (!S.next(0, cur)) return;
    f32x4 acc[2][2][4][2];
#pragma unroll
    for (int a = 0; a < 2; ++a)
#pragma unroll
        for (int b = 0; b < 2; ++b)
#pragma unroll
            for (int m = 0; m < 4; ++m)
#pragma unroll
                for (int n = 0; n < 2; ++n) acc[a][b][m][n] = (f32x4){0.f, 0.f, 0.f, 0.f};
    bf16x8 At[4][2], B0[2][2], B1[2][2];
    const char* cA = (const char*)g.A + (size_t)cur.pm * tstep; const char* cB = (const char*)g.Bt + (size_t)cur.pn * tstep;
    S.a_ready(cur);
    if constexpr (SP2) {
        PG8_STAGE(PG8_SB(0, 0), cB, voffB); PG8_STAGE(PG8_SB(0, 1), cB + hstep, voffB); PG8_STAGE(PG8_SA(0, 0), cA, voffA); PG8_STAGE(PG8_SA(0, 1), cA + hstep, voffA);
        if (wr == 1) PG8_BAR;
        PG8_WAIT_V(2); PG8_BAR;
        PG8_STAGE(PG8_SB(1, 0), cB + kstep, voffB); PG8_STAGE(PG8_SA(1, 0), cA + kstep, voffA); PG8_STAGE(PG8_SB(1, 1), cB + hstep + kstep, voffB);
        PG8_WAIT_V(6); PG8_BAR;
    } else {
        PG8_STAGE(PG8_SB(0, 0), cB, voffB); PG8_STAGE(PG8_SA(0, 0), cA, voffA); PG8_STAGE(PG8_SB(0, 1), cB + hstep, voffB); PG8_STAGE(PG8_SA(0, 1), cA + hstep, voffA);
        if (wr == 1) PG8_BAR;
        PG8_WAIT_V(4); PG8_BAR;
        PG8_STAGE(PG8_SB(1, 0), cB + kstep, voffB); PG8_STAGE(PG8_SA(1, 0), cA + kstep, voffA); PG8_STAGE(PG8_SB(1, 1), cB + hstep + kstep, voffB);
        PG8_WAIT_V(6); PG8_BAR;
    }
    for (;;) {
        const bool has_next = S.next(ui + 1, nxt);
        const char* nA = has_next ? (const char*)g.A + (size_t)nxt.pm * tstep : cA; const char* nB = has_next ? (const char*)g.Bt + (size_t)nxt.pn * tstep : cB;
        for (int t = 0; t < nt; t += 2) {
            const bool last = (t == nt - 2);
            const char* a1 = cA + (size_t)(t + 1) * kstep;
            const char* a2 = last ? nA : cA + (size_t)(t + 2) * kstep; const char* b2 = last ? nB : cB + (size_t)(t + 2) * kstep;
            const char* a3 = a2 + kstep; const char* b3 = b2 + kstep;
            if (last && has_next) S.a_ready(nxt);
            if constexpr (SP2) {
            PG8_LDB(B0, 0, 0); PG8_LDB(B1, 0, 1); PG8_SCHED; PG8_LDA(At, 0, 0); PG8_STAGE(PG8_SA(1, 1), a1 + hstep, voffA);
            PG8_WAIT_V(8); PG8_WAIT_L(0); PG8_BAR; PG8_MMA(0, 0, At, B0); PG8_MMA(0, 1, At, B1); PG8_BAR; PG8_SCHED;
            PG8_LDA(At, 0, 1); PG8_STAGE(PG8_SB(0, 0), b2, voffB); PG8_STAGE(PG8_SB(0, 1), b2 + hstep, voffB); PG8_STAGE(PG8_SA(0, 0), a2, voffA);
            PG8_WAIT_V(8); PG8_WAIT_L(0); PG8_BAR; PG8_MMA(1, 0, At, B0); PG8_MMA(1, 1, At, B1); PG8_BAR; PG8_SCHED;
            PG8_LDB(B0, 1, 0); PG8_LDB(B1, 1, 1); PG8_SCHED; PG8_LDA(At, 1, 0); PG8_STAGE(PG8_SA(0, 1), a2 + hstep, voffA);
            PG8_WAIT_V(8); PG8_WAIT_L(0); PG8_BAR; PG8_MMA(0, 0, At, B0); PG8_MMA(0, 1, At, B1); PG8_BAR; PG8_SCHED;
            PG8_LDA(At, 1, 1); PG8_STAGE(PG8_SB(1, 0), b3, voffB); PG8_STAGE(PG8_SB(1, 1), b3 + hstep, voffB); PG8_STAGE(PG8_SA(1, 0), a3, voffA);
            PG8_WAIT_V(8); PG8_WAIT_L(0); PG8_BAR; PG8_MMA(1, 0, At, B0); PG8_MMA(1, 1, At, B1); PG8_BAR; PG8_SCHED;
            } else {
            PG8_LDB(B0, 0, 0); PG8_SCHED; PG8_LDA(At, 0, 0); PG8_STAGE(PG8_SA(1, 1), a1 + hstep, voffA);
            PG8_WAIT_L(8); PG8_BAR; PG8_WAIT_L(0); PG8_MMA(0, 0, At, B0); PG8_BAR; PG8_SCHED;
            PG8_LDB(B1, 0, 1); PG8_STAGE(PG8_SB(0, 0), b2, voffB);
            PG8_BAR; PG8_WAIT_L(0); PG8_MMA(0, 1, At, B1); PG8_BAR;
            PG8_LDA(At, 0, 1); PG8_STAGE(PG8_SA(0, 0), a2, voffA);
            PG8_BAR; PG8_WAIT_L(0); PG8_MMA(1, 0, At, B0); PG8_BAR; PG8_SCHED;
            PG8_STAGE(PG8_SB(0, 1), b2 + hstep, voffB);
            PG8_WAIT_V(6); PG8_BAR; PG8_MMA(1, 1, At, B1); PG8_BAR;
            PG8_LDB(B0, 1, 0); PG8_SCHED; PG8_LDA(At, 1, 0); PG8_STAGE(PG8_SA(0, 1), a2 + hstep, voffA);
            PG8_WAIT_L(8); PG8_BAR; PG8_WAIT_L(0); PG8_MMA(0, 0, At, B0); PG8_BAR; PG8_SCHED;
            PG8_LDB(B1, 1, 1); PG8_STAGE(PG8_SB(1, 0), b3, voffB);
            PG8_BAR; PG8_WAIT_L(0); PG8_MMA(0, 1, At, B1); PG8_BAR;
            PG8_LDA(At, 1, 1); PG8_STAGE(PG8_SA(1, 0), a3, voffA);
            PG8_BAR; PG8_WAIT_L(0); PG8_MMA(1, 0, At, B0); PG8_BAR; PG8_SCHED;
            PG8_STAGE(PG8_SB(1, 1), b3 + hstep, voffB);
            PG8_WAIT_V(6); PG8_BAR; PG8_MMA(1, 1, At, B1); PG8_BAR;
            }
        }
        if constexpr (ALIGN_EPI) { if (wr == 0) PG8_BAR; }
        if constexpr (!Epi::AFTER_DRAIN) { int t2 = threadIdx.x; asm volatile("" : "+v"(t2)); E(acc, cur, wr, wc, t2 & 15, (t2 >> 4) & 3); S.done(cur); }
        if (!has_next) break;
#pragma unroll
        for (int a = 0; a < 2; ++a)
#pragma unroll
            for (int b = 0; b < 2; ++b)
#pragma unroll
                for (int m = 0; m < 4; ++m)
#pragma unroll
                    for (int n = 0; n < 2; ++n) acc[a][b][m][n] = (f32x4){0.f, 0.f, 0.f, 0.f};
        cur = nxt; cA = nA; cB = nB; ++ui;
        if constexpr (ALIGN_EPI) { if (wr == 1) PG8_BAR; }
    }
    PG8_WAIT_V(0);
    if constexpr (!ALIGN_EPI) { if (wr == 0) PG8_BAR; }
    PG8_BAR;
    if constexpr (Epi::AFTER_DRAIN) { E.fused(acc, cur, wr, wc, fr, fq, lds, wid, lane); S.done(cur); }
#undef PG8_SA
#undef PG8_SB
#undef PG8_STAGE
#undef PG8_LDA
#undef PG8_LDB
#undef PG8_MMA
#undef PG8_WAIT_V
#undef PG8_WAIT_L
#undef PG8_BAR
#undef PG8_SCHED
}
}
#define GAS __attribute__((address_space(1)))
#define LAS __attribute__((address_space(3)))
typedef unsigned short bf16;
typedef unsigned v4u __attribute__((ext_vector_type(4)));
typedef float f32x4 __attribute__((ext_vector_type(4)));
typedef short bf16x8 __attribute__((ext_vector_type(8)));
typedef GAS unsigned gu32;
typedef GAS unsigned long long gu64;
#define RLX_AGENT __ATOMIC_RELAXED, __HIP_MEMORY_SCOPE_AGENT
#define LDS_WAIT() asm volatile("s_waitcnt lgkmcnt(0)" ::: "memory")
#define VM_WAIT() asm volatile("s_waitcnt vmcnt(0)" ::: "memory")
__device__ __forceinline__ unsigned long long rt() { return __builtin_amdgcn_s_memrealtime(); }
__device__ __forceinline__ unsigned f2bf(float f) { unsigned u = __builtin_bit_cast(unsigned, f); return (u + 0x7fffu + ((u >> 16) & 1u)) >> 16; }
__device__ __forceinline__ unsigned pk2(float lo, float hi) { return f2bf(lo) | (f2bf(hi) << 16); }
#define XB_TMO      128
#define XB_XCNT(j)  (256  + 64 * (j))
#define XB_XSUB(j)  (1280 + 64 * (j))
#define XB_XGEN(j)  (2304 + 64 * (j))
#define XB_TOP      3328
#define XB_TOPGEN   3392
#define XCD_BAR_WORDS 3456
#define XB_SPIN_CAP (1u << 18)

__device__ __forceinline__ unsigned xb_ld(unsigned* p)              { return __hip_atomic_load(p, __ATOMIC_RELAXED, __HIP_MEMORY_SCOPE_AGENT); }
__device__ __forceinline__ unsigned xb_add(unsigned* p, unsigned v) { return __hip_atomic_fetch_add(p, v, __ATOMIC_RELAXED, __HIP_MEMORY_SCOPE_AGENT); }
__device__ __forceinline__ unsigned xb_xcc_id() { return (unsigned)__builtin_amdgcn_s_getreg((3 << 11) | 20) & 0xFu; }
#define XB_SPIN(cond, bar) do { unsigned _sp = 0; while (cond) { __builtin_amdgcn_s_sleep(1); \
    if ((++_sp & 255u) == 0u) { if (xb_ld(&(bar)[XB_TMO])) break; if (_sp > XB_SPIN_CAP) { atomicAdd(&(bar)[XB_TMO], 1u); break; } } } } while (0)

struct XcdBarrier {
    unsigned* bar; unsigned x;
    volatile LAS unsigned* st;
};

__device__ __forceinline__ XcdBarrier xcd_barrier_post(unsigned* bar, volatile LAS unsigned* st) {
    XcdBarrier b; b.bar = bar; b.x = xb_xcc_id(); b.st = st;
    if (threadIdx.x == 0) (void)xb_add(&bar[XB_XCNT(b.x)], 1u);
    return b;
}
__device__ __forceinline__ void xcd_barrier_complete(unsigned* bar, unsigned x, unsigned& nloc, unsigned& nx) {
    const unsigned G = gridDim.x * gridDim.y * gridDim.z;
    unsigned sum, cnt, mine, sp = 0u;
    for (;;) {
        sum = 0u; cnt = 0u; mine = 0u;
#pragma unroll
        for (unsigned j = 0; j < 16; ++j) { const unsigned c = xb_ld(&bar[XB_XCNT(j)]); sum += c; cnt += (c > 0u) ? 1u : 0u; mine = (j == x) ? c : mine; }
        if (sum == G) break;
        __builtin_amdgcn_s_sleep(1);
        if ((++sp & 255u) == 0u) { if (xb_ld(&bar[XB_TMO])) break; if (sp > XB_SPIN_CAP) { atomicAdd(&bar[XB_TMO], 1u); break; } }
    }
    nloc = mine > 0u ? mine : 1u; nx = cnt > 0u ? cnt : 1u;
}

__device__ __forceinline__ void xcd_barrier(const XcdBarrier& b) {
    asm volatile("s_waitcnt vmcnt(0)" ::: "memory");
    __syncthreads();
    if (threadIdx.x == 0) {
        unsigned* bar = b.bar;
        __builtin_amdgcn_s_waitcnt(0);
        unsigned nloc = b.st[0], nx = b.st[1];
        if (nloc == 0u) { xcd_barrier_complete(bar, b.x, nloc, nx); b.st[0] = nloc; b.st[1] = nx; }
        const unsigned old = xb_add(&bar[XB_XSUB(b.x)], 1u);
        const unsigned gen = old / nloc;
        if (old + 1u == (gen + 1u) * nloc) {
            __builtin_amdgcn_fence(__ATOMIC_RELEASE, "agent");
            asm volatile("s_waitcnt vmcnt(0)" ::: "memory");
            const unsigned og = xb_add(&bar[XB_TOP], 1u);
            const unsigned tg = og / nx;
            if (og + 1u == (tg + 1u) * nx) xb_add(&bar[XB_TOPGEN], 1u);
            else XB_SPIN(xb_ld(&bar[XB_TOPGEN]) == tg, bar);
            __builtin_amdgcn_fence(__ATOMIC_ACQUIRE, "agent");
            asm volatile("s_waitcnt vmcnt(0)" ::: "memory");
        } else {
            __builtin_amdgcn_fence(__ATOMIC_ACQUIRE, "agent");
            XB_SPIN(xb_ld(&bar[XB_TOPGEN]) == gen, bar);
            asm volatile("s_waitcnt vmcnt(0)" ::: "memory");
        }
    }
    __syncthreads();
}
constexpr int NWAVES = 8;
#ifndef MK_N_LAUNCHES
#define MK_N_LAUNCHES 1
#endif
constexpr int N_PHASES = 10;
constexpr int N_LAUNCHES = MK_N_LAUNCHES;

constexpr int DM = 2048, NBATCH = 8, SEQ = 2048, MP = NBATCH * SEQ, SBATCH = 8, SLEN = 16, MS = SBATCH * SLEN, MT = MP + MS;
constexpr int NH = 4, DV = 256, DQK = 128, QKW = 1024, NG = 64, GCH = 16, PST = 64, DFF = 5632, NIN = 4104;
constexpr int CH = 64, NCH = SEQ / CH;
constexpr int NSC = NBATCH * NCH + SBATCH;
constexpr float EPS = 1e-6f;
constexpr int DVS = 64, NSL = DV / DVS;

constexpr size_t O_Y = 0, O_CONVP = (size_t)MT * DM, O_CP = O_CONVP + 8 * 3 * 1024, O_NP = O_CP + 8 * 4 * 256 * 128, O_MP = O_NP + 8 * 4 * 128,
                 O_SRP = O_MP + 32, O_SIP = O_SRP + 8 * 64 * 64, O_CONVS = O_SIP + 8 * 64 * 64, O_CS = O_CONVS + 8 * 3 * 1024, O_NS = O_CS + 8 * 4 * 256 * 128,
                 O_MS = O_NS + 8 * 4 * 128, O_SRS = O_MS + 32, O_SIS = O_SRS + 8 * 64 * 64, O_END = O_SIS + 8 * 64 * 64;
static_assert(O_END == 36102208, "d_out map");

constexpr size_t MiB = 1u << 20;
constexpr size_t WS_CTL = 0, CTL_ZERO_BYTES = 1 * MiB;
constexpr size_t WS_WIN = 2 * MiB, WS_WGLU = 18 * MiB, WS_WOUT = 20 * MiB, WS_WGU = 28 * MiB, WS_WD = 72 * MiB;
constexpr size_t WS_XN = 96 * MiB;
constexpr size_t WS_R0 = 162 * MiB, WS_RSTRIDE = 33 * MiB;
constexpr size_t WS_QKRAW = WS_R0, WS_V = WS_R0 + WS_RSTRIDE, WS_OG = WS_R0 + 2 * WS_RSTRIDE, WS_U = WS_R0 + 3 * WS_RSTRIDE;
constexpr size_t WS_Q = 294 * MiB, WS_K = 311 * MiB;
constexpr size_t WS_Z = WS_QKRAW;
constexpr size_t WS_MIXIN = WS_Q;
constexpr size_t WS_MIX = WS_R0;
constexpr size_t WS_ACT8 = WS_R0;
constexpr size_t WS_ACTS = WS_R0 + 90 * MiB;
constexpr size_t WS_X1B = WS_XN;
constexpr size_t WS_FF = 427 * MiB;
constexpr size_t WS_GATES = 378 * MiB, WS_HSS = 379 * MiB, WS_SS1 = 382 * MiB, WS_SS2 = 385 * MiB, WS_S5P = 388 * MiB, WS_SSS = 389 * MiB;
constexpr size_t WS_HS = 390 * MiB;
constexpr size_t WS_SCAL = 423 * MiB, WS_WD8 = 492 * MiB, WS_END = 504 * MiB;
static_assert(WS_XN + (size_t)MT * DM * 2 <= WS_R0 && WS_QKRAW + (size_t)MT * 1024 * 2 <= WS_V && WS_U + (size_t)MT * 1024 * 2 <= WS_Q && WS_Q + (size_t)MT * 512 * 2 <= WS_K &&
              WS_K + (size_t)MT * 512 * 2 <= WS_GATES && WS_MIXIN + (size_t)MT * DM * 2 <= WS_GATES && WS_MIX + (size_t)MT * DM * 2 <= WS_OG && WS_ACT8 + (size_t)MP * DFF <= WS_ACTS && WS_ACTS + (size_t)MS * DFF * 2 <= WS_GATES && WS_FF + (size_t)MT * DM * 2 <= WS_WD8 && WS_WD8 + (size_t)DM * DFF <= WS_END &&
              WS_WD + (size_t)DM * DFF * 2 <= WS_XN && WS_WGU + (size_t)2 * DFF * DM * 2 <= WS_WD && WS_HSS + (size_t)MT * 32 * 4 <= WS_SS1 && WS_SS1 + (size_t)MT * 32 * 4 <= WS_SS2 &&
              WS_SS2 + (size_t)MT * 32 * 4 <= WS_S5P && WS_GATES + (size_t)MT * 8 * 4 <= WS_HSS && WS_HS + (size_t)MT * 1024 * 2 <= WS_SCAL && WS_SCAL + (size_t)NSC * 4 * 384 * 4 <= WS_FF && WS_FF + (size_t)MT * DM * 2 <= WS_END, "d_ws map");
constexpr size_t S5P_LAM = 0, S5P_BBT = 64 * 1024, S5P_CC = S5P_BBT + 64 * 128 * 16 * 2;
constexpr size_t SSS_1 = 0, SSS_2 = 128 * 128 * 4, SSS_RSTD2 = 256 * 1024, SSS_RSTD1 = 384 * 1024;
constexpr int CW_TMO = 0, CW_CODE = 1, CW_BAR = 4096;

constexpr int RING_OFF = 0, RING_BYTES = 131072;
constexpr int LDSCTL_OFF = 151552, MISC_OFF = LDSCTL_OFF + 320;
constexpr int LDS_BYTES = 155648;
typedef short s16x4 __attribute__((ext_vector_type(4)));
typedef unsigned u32x2 __attribute__((ext_vector_type(2)));
struct Frame {
    LAS unsigned char* lds;
    volatile LAS unsigned* MISC;
    gu32* ctl;
    int tid, lane, wave;
    int vcu, G;
    const float* const* in;
    float* out; unsigned char* ws;
};
__device__ __forceinline__ float wave_sum(float v) {
#pragma unroll
    for (int o = 1; o < 64; o <<= 1) v += __shfl_xor(v, o);
    return v;
}
__device__ __forceinline__ unsigned cvtpk(float lo, float hi) { unsigned r; asm volatile("v_cvt_pk_bf16_f32 %0, %1, %2" : "=v"(r) : "v"(lo), "v"(hi)); return r; }
typedef __bf16 bf16x2n_t __attribute__((ext_vector_type(2)));
__device__ __forceinline__ unsigned cvtpk_n(float lo, float hi) { const bf16x2n_t v = {(__bf16)lo, (__bf16)hi}; return __builtin_bit_cast(unsigned, v); }
__device__ __forceinline__ float bflo(unsigned w) { return __uint_as_float(w << 16); }
__device__ __forceinline__ float bfhi(unsigned w) { return __uint_as_float(w & 0xffff0000u); }
__device__ __forceinline__ float bf2f(bf16 h) { return __uint_as_float((unsigned)h << 16); }
__device__ __forceinline__ float sigmoidf_(float v) { return __builtin_amdgcn_rcpf(1.0f + __expf(-v)); }
__device__ __forceinline__ f32x4 mfma16(bf16x8 a, bf16x8 b, f32x4 c) { return __builtin_amdgcn_mfma_f32_16x16x32_bf16(a, b, c, 0, 0, 0); }
#define WAVE_SYNC() do { asm volatile("s_waitcnt lgkmcnt(0)" ::: "memory"); __builtin_amdgcn_wave_barrier(); } while (0)

#ifdef MK_STAMP
#ifndef MK_STAMP_SCALE
#define MK_STAMP_SCALE 0.002f
#endif
#define DBG_DECL unsigned long long dbg_acc_ = 0, dbg_t0_ = 0;
__device__ __forceinline__ unsigned long long dbg_rt() { unsigned long long t; __builtin_amdgcn_sched_barrier(0);
#ifdef MK_STAMP_CYC
    asm volatile("s_memtime %0\n\ts_waitcnt lgkmcnt(0)" : "=s"(t) :: "memory");
#else
    asm volatile("s_memrealtime %0\n\ts_waitcnt lgkmcnt(0)" : "=s"(t) :: "memory");
#endif
 __builtin_amdgcn_sched_barrier(0); return t; }
#define DBG_BEGIN(id) do { if ((id) == MK_STAMP) dbg_t0_ = dbg_rt(); } while (0)
#define DBG_END(id) do { if ((id) == MK_STAMP) dbg_acc_ += dbg_rt() - dbg_t0_; } while (0)
#define DBG_REPORT(cond) do { if ((cond) && (threadIdx.x & 63) == 0 && (threadIdx.x >> 6) == MK_STAMP_WAVE) ((unsigned*)(A.ws + WS_CTL))[16] = (unsigned)dbg_acc_; } while (0)
#define DBG_PERTURB(V, m_) do { if ((m_) == 0 && lane == 0) V[0][0] += (float)__hip_atomic_load((unsigned*)(A.ws + WS_CTL) + 16, __ATOMIC_RELAXED, __HIP_MEMORY_SCOPE_AGENT) * MK_STAMP_SCALE; } while (0)
#else
#define DBG_DECL
#define DBG_BEGIN(id)
#define DBG_END(id)
#define DBG_REPORT(cond)
#define DBG_PERTURB(V, m_)
#endif
struct Args { const float* in[32]; float* out; unsigned char* ws; int ph_lo, ph_hi, li, pad; };
__device__ __forceinline__ int fresh_tid() { int t = threadIdx.x; asm volatile("" : "+v"(t)); return t; }
#define PHASE_IDS const int tid = fresh_tid(), lane = tid & 63; (void)tid; (void)lane;

__device__ __forceinline__ void p0_transpose_item(const float* W, int ldw, int src_col0, int k0, bf16* WT, int K, int out_row0, LAS float* scr, int lane, const float* kscale = nullptr) {
    if (kscale) {
#pragma unroll 8
        for (int i = 0; i < 32; ++i) { const int kk = 2 * i + (lane >> 5); scr[kk * 33 + (lane & 31)] = __builtin_nontemporal_load(W + (size_t)(k0 + kk) * ldw + src_col0 + (lane & 31)) * kscale[k0 + kk]; }
    } else {
#pragma unroll 8
    for (int i = 0; i < 32; ++i) { const int kk = 2 * i + (lane >> 5); scr[kk * 33 + (lane & 31)] = __builtin_nontemporal_load(W + (size_t)(k0 + kk) * ldw + src_col0 + (lane & 31)); }
    }
    LDS_WAIT(); asm volatile("" ::: "memory");
    const int c = lane & 7;
#pragma unroll
    for (int j = 0; j < 4; ++j) { const int n = (lane >> 3) + 8 * j; const LAS float* s = scr + (8 * c) * 33 + n;
        v4u o; o.x = pk2(s[0 * 33], s[1 * 33]); o.y = pk2(s[2 * 33], s[3 * 33]); o.z = pk2(s[4 * 33], s[5 * 33]); o.w = pk2(s[6 * 33], s[7 * 33]);
        *(GAS v4u*)(WT + (size_t)(out_row0 + n) * K + k0 + 8 * c) = o; }
    LDS_WAIT(); asm volatile("" ::: "memory");
}
__device__ __forceinline__ float log_sigmoid(float x) { return fminf(x, 0.f) - log1pf(__expf(-fabsf(x))); }

struct CvtItem { const float* W; int ldw, sc, k0; bf16* WT; int K, orow; const float* ks; unsigned char* W8; };
constexpr int CV_I_IN = (DM / 64) * (4096 / 32), CV_I_GLU = (1024 / 64) * (1024 / 32), CV_I_OUT = (DM / 64) * (DM / 32), CV_I_GU = (DM / 64) * (2 * DFF / 32), CV_I_D = (DFF / 64) * (DM / 32);
__device__ __forceinline__ CvtItem cvt_item(const Args& A, int it) {
    unsigned char* ws = A.ws; int r = it; CvtItem c;
    if (r < CV_I_IN) { const int nnb = 4096 / 32, kb = r / nnb, nb = r % nnb, orow = 32 * nb; c = CvtItem{A.in[9], NIN, orow < 3072 ? orow : orow + 8, 64 * kb, (bf16*)(ws + WS_WIN), DM, orow, nullptr, nullptr}; return c; } r -= CV_I_IN;
    if (r < CV_I_GLU) { const int nnb = 1024 / 32, kb = r / nnb, nb = r % nnb; c = CvtItem{A.in[23], 1024, 32 * nb, 64 * kb, (bf16*)(ws + WS_WGLU), 1024, 32 * nb, nullptr, nullptr}; return c; } r -= CV_I_GLU;
    if (r < CV_I_OUT) { const int nnb = DM / 32, kb = r / nnb, nb = r % nnb; c = CvtItem{A.in[25], DM, 32 * nb, 64 * kb, (bf16*)(ws + WS_WOUT), DM, 32 * nb, nullptr, nullptr}; return c; } r -= CV_I_OUT;
    if (r < CV_I_GU) { const int nnb = 2 * DFF / 32, kb = r / nnb, nb = r % nnb, orow = 32 * nb, pn = orow >> 8, cc = orow & 255;
        c = CvtItem{cc < 128 ? A.in[28] : A.in[29], DFF, 128 * pn + (cc & 127), 64 * kb, (bf16*)(ws + WS_WGU), DM, orow, A.in[27], nullptr}; return c; } r -= CV_I_GU;
    { const int nnb = DM / 32, kb = r / nnb, nb = r % nnb; c = CvtItem{A.in[30], DM, 32 * nb, 64 * kb, (bf16*)(ws + WS_WD), DFF, 32 * nb, nullptr, ws + WS_WD8}; return c; }
}
__device__ __forceinline__ void p0_prologue(const Args& A, LAS unsigned char* lds, int tid, int lane, int wave, int vcu, int G) {
    unsigned char* ws = A.ws;
    LAS float* WG = (LAS float*)lds;
    LAS float* scr = (LAS float*)(lds + wave * 8448);
    const int gw = vcu * NWAVES + wave, NGW = G * NWAVES;
    { constexpr int NIT = CV_I_IN + CV_I_GLU + CV_I_OUT + CV_I_GU + CV_I_D;
      float ra[32], rb[32]; CvtItem ia, ib;
#define CV_LOAD(R, I, it_) do { I = cvt_item(A, (it_)); \
        _Pragma("unroll") for (int i = 0; i < 32; ++i) { const int kk = 2 * i + (lane >> 5); R[i] = __builtin_nontemporal_load(I.W + (size_t)(I.k0 + kk) * I.ldw + I.sc + (lane & 31)); } } while (0)
#define F8C(v_) __builtin_amdgcn_fmed3f((v_) * 1024.0f, -448.f, 448.f)
#define CV_PROC(R, I) do { \
        if (I.ks) { _Pragma("unroll") for (int i = 0; i < 32; ++i) { const int kk = 2 * i + (lane >> 5); scr[kk * 33 + (lane & 31)] = R[i] * I.ks[I.k0 + kk]; } } \
        else { _Pragma("unroll") for (int i = 0; i < 32; ++i) { const int kk = 2 * i + (lane >> 5); scr[kk * 33 + (lane & 31)] = R[i]; } } \
        LDS_WAIT(); asm volatile("" ::: "memory"); \
        { const int c = lane & 7; \
          _Pragma("unroll") for (int j = 0; j < 4; ++j) { const int n = (lane >> 3) + 8 * j; const LAS float* s = scr + (8 * c) * 33 + n; \
              v4u o; o.x = pk2(s[0 * 33], s[1 * 33]); o.y = pk2(s[2 * 33], s[3 * 33]); o.z = pk2(s[4 * 33], s[5 * 33]); o.w = pk2(s[6 * 33], s[7 * 33]); \
              *(GAS v4u*)(I.WT + (size_t)(I.orow + n) * I.K + I.k0 + 8 * c) = o; \
              if (I.W8) { int w0 = 0, w1 = 0; \
                  w0 = __builtin_amdgcn_cvt_pk_fp8_f32(F8C(s[0 * 33]), F8C(s[1 * 33]), w0, false); w0 = __builtin_amdgcn_cvt_pk_fp8_f32(F8C(s[2 * 33]), F8C(s[3 * 33]), w0, true); \
                  w1 = __builtin_amdgcn_cvt_pk_fp8_f32(F8C(s[4 * 33]), F8C(s[5 * 33]), w1, false); w1 = __builtin_amdgcn_cvt_pk_fp8_f32(F8C(s[6 * 33]), F8C(s[7 * 33]), w1, true); \
                  *(GAS u32x2*)(I.W8 + (size_t)(I.orow + n) * I.K + I.k0 + 8 * c) = (u32x2){(unsigned)w0, (unsigned)w1}; } } } \
        LDS_WAIT(); asm volatile("" ::: "memory"); } while (0)
      int it = gw;
      if (it < NIT) { CV_LOAD(ra, ia, it);
          for (;;) { const int it2 = it + NGW; if (it2 < NIT) CV_LOAD(rb, ib, it2); CV_PROC(ra, ia); if (it2 >= NIT) break;
                     it = it2 + NGW; if (it < NIT) CV_LOAD(ra, ia, it); CV_PROC(rb, ib); if (it >= NIT) break; } }
#undef CV_LOAD
#undef CV_PROC
#undef F8C
    }
    { const int gt = vcu * (NWAVES * 64) + tid;
      if (gt < NG * PST) {
        const int g = gt >> 6, p = gt & 63;
        const double lr = (double)A.in[15][gt], li = (double)A.in[16][gt], dt = exp((double)A.in[17][g]);
        const double mag = exp(lr * dt), ang = li * dt, lbr = mag * cos(ang), lbi = mag * sin(ang);
        const double den = lr * lr + li * li, nr = lbr - 1.0, fre = (nr * lr + lbi * li) / den, fim = (lbi * lr - nr * li) / den;
        float* LAM = (float*)(ws + WS_S5P + S5P_LAM); LAM[gt * 2] = (float)lbr; LAM[gt * 2 + 1] = (float)lbi;
        bf16* BBT = (bf16*)(ws + WS_S5P + S5P_BBT); bf16* CC = (bf16*)(ws + WS_S5P + S5P_CC);
        const float* bre = A.in[18] + (size_t)gt * 16; const float* bim = A.in[19] + (size_t)gt * 16;
#pragma unroll
        for (int i = 0; i < 16; ++i) { const double br = bre[i], bi = bim[i];
            BBT[((size_t)g * 128 + 2 * p) * 16 + i] = (bf16)f2bf((float)(fre * br - fim * bi));
            BBT[((size_t)g * 128 + 2 * p + 1) * 16 + i] = (bf16)f2bf((float)(fre * bi + fim * br));
            CC[((size_t)g * 16 + i) * 128 + 2 * p] = (bf16)f2bf(A.in[20][((size_t)g * 16 + i) * 64 + p]);
            CC[((size_t)g * 16 + i) * 128 + 2 * p + 1] = (bf16)f2bf(-A.in[21][((size_t)g * 16 + i) * 64 + p]); }
      } }
    __syncthreads();
    { const float* win = A.in[9];
      for (int e = tid; e < 8 * 2048; e += NWAVES * 64) { const int k = e >> 3, c = e & 7; WG[c * 2048 + k] = win[(size_t)k * NIN + 3072 + c]; } }
    __syncthreads();
    { const GAS f32x4* gp = (const GAS f32x4*)A.in[8] + lane; f32x4 gv[8];
#pragma unroll
      for (int j = 0; j < 8; ++j) gv[j] = gp[64 * j];
      bf16* XN = (bf16*)(ws + WS_XN); float* GATES = (float*)(ws + WS_GATES);
      f32x4 va[8], vb[8];
#define P0R_LOAD(V, m_) do { const int mm_ = (m_); const float* xrow = mm_ < MP ? A.in[0] + (size_t)mm_ * DM : A.in[1] + (size_t)(mm_ - MP) * DM; const GAS f32x4* xr = (const GAS f32x4*)xrow + lane; \
        _Pragma("unroll") for (int j = 0; j < 8; ++j) V[j] = __builtin_nontemporal_load(xr + 64 * j); } while (0)
#define P0R_PROC(V, m_) do { const int mm_ = (m_); float s = 0.f; \
        _Pragma("unroll") for (int j = 0; j < 8; ++j) s += (V[j].x * V[j].x + V[j].y * V[j].y) + (V[j].z * V[j].z + V[j].w * V[j].w); \
        const float ms = wave_sum(s) * (1.0f / DM) + EPS, rstd = 1.0f / sqrtf(ms); \
        if (lane == 0) ((float*)(ws + WS_SSS + SSS_RSTD1))[mm_] = sqrtf(ms); \
        GAS u32x2* o8 = (GAS u32x2*)(XN + (size_t)mm_ * DM) + lane; \
        float ga[8] = {0.f, 0.f, 0.f, 0.f, 0.f, 0.f, 0.f, 0.f}; \
        _Pragma("unroll") for (int j = 0; j < 8; ++j) { V[j] = V[j] * rstd * gv[j]; u32x2 o; o.x = cvtpk(V[j].x, V[j].y); o.y = cvtpk(V[j].z, V[j].w); o8[64 * j] = o; \
            _Pragma("unroll") for (int c = 0; c < 8; ++c) { const f32x4 w = *(const LAS f32x4*)(WG + c * 2048 + 256 * j + 4 * lane); ga[c] += (V[j].x * w.x + V[j].y * w.y) + (V[j].z * w.z + V[j].w * w.w); } } \
        _Pragma("unroll") for (int c = 0; c < 8; ++c) ga[c] = wave_sum(ga[c]); \
        if (lane < 8) { float val = 0.f; \
            _Pragma("unroll") for (int c = 0; c < 8; ++c) if (lane == c) val = ga[c]; \
            if (lane < 4) val += A.in[12][lane]; else val = log_sigmoid(val + A.in[13][lane - 4]); \
            GATES[(size_t)mm_ * 8 + lane] = val; } } while (0)
      int m = gw;
      if (m < MT) { P0R_LOAD(va, m);
          for (;;) { const int m2 = m + NGW; if (m2 < MT) P0R_LOAD(vb, m2); P0R_PROC(va, m); if (m2 >= MT) break;
                     m = m2 + NGW; if (m < MT) P0R_LOAD(va, m); P0R_PROC(vb, m2); if (m >= MT) break; } }
#undef P0R_LOAD
#undef P0R_PROC
    }
}

template <int NACC, int K, class RowMap, class Epi>
__device__ __forceinline__ void skinny_gemm(const bf16* Arows, const bf16* Bt, LAS unsigned char* lds, int nitems, int first, int stride, int tid, int wave, int lane, RowMap rm, Epi epi) {
    const int fr = lane & 15, fq = lane >> 4;
    constexpr int KW = K / 8, NS = KW / 32;
    static_assert(KW % 32 == 0, "skinny_gemm: K must be a multiple of 256");
    const bf16* abase = Arows + (size_t)fr * K + wave * KW + 8 * fq;
    LAS f32x4* red = (LAS f32x4*)lds;
    for (int it = first; it < nitems; it += stride) {
        const bf16* brow[NACC]; f32x4 acc[NACC][8];
#pragma unroll
        for (int a = 0; a < NACC; ++a) { brow[a] = Bt + (size_t)rm(it, a, fr) * K + wave * KW + 8 * fq;
#pragma unroll
            for (int rb = 0; rb < 8; ++rb) acc[a][rb] = (f32x4){0.f, 0.f, 0.f, 0.f}; }
#pragma unroll 2
        for (int s = 0; s < NS; ++s) {
            bf16x8 av[8], bv[NACC];
#pragma unroll
            for (int a = 0; a < NACC; ++a) bv[a] = *(const bf16x8*)(brow[a] + 32 * s);
#pragma unroll
            for (int rb = 0; rb < 8; ++rb) av[rb] = *(const bf16x8*)(abase + (size_t)(16 * rb) * K + 32 * s);
#pragma unroll
            for (int rb = 0; rb < 8; ++rb)
#pragma unroll
                for (int a = 0; a < NACC; ++a) acc[a][rb] = mfma16(bv[a], av[rb], acc[a][rb]);
        }
#pragma unroll
        for (int a = 0; a < NACC; ++a)
#pragma unroll
            for (int rb = 0; rb < 8; ++rb) red[((a * 8 + wave) * 8 + rb) * 64 + lane] = acc[a][rb];
        __syncthreads();
        f32x4 fin[NACC];
#pragma unroll
        for (int a = 0; a < NACC; ++a) { f32x4 t = red[((a * 8 + 0) * 8 + wave) * 64 + lane];
#pragma unroll
            for (int w2 = 1; w2 < 8; ++w2) t += red[((a * 8 + w2) * 8 + wave) * 64 + lane];
            fin[a] = t; }
        __syncthreads();
        epi(it, 16 * wave + fr, fq, fin);
    }
}

__device__ __forceinline__ void p2_scalars(const Args& A, LAS unsigned char* lds, int lane, int wave, int item) {
    unsigned char* ws = A.ws;
    const float* GATES = (const float*)(ws + WS_GATES); float* SCAL = (float*)(ws + WS_SCAL);
    const int seq = item >> 2, h = item & 3; const bool sample = seq >= NBATCH; const int b = sample ? seq - NBATCH : seq;
    const int nch = sample ? 1 : NCH, L = sample ? SLEN : CH, row0 = sample ? MP + b * SLEN : b * SEQ, sc0 = sample ? NBATCH * NCH + b : b * NCH;
    LAS float* fl = (LAS float*)lds;
    float fc[4], a[4], pm[4];
#pragma unroll
    for (int i = 0; i < 4; ++i) { const int c = 4 * wave + i; float li = -INFINITY, lf = 0.f;
        if (c < nch && lane < L) { li = GATES[((size_t)row0 + c * CH + lane) * 8 + h]; lf = GATES[((size_t)row0 + c * CH + lane) * 8 + 4 + h]; }
        float f = lf;
#pragma unroll
        for (int d = 1; d < 64; d <<= 1) { const float o = __shfl_up(f, d); if (lane >= d) f += o; }
        const float aa = li - f; float p = aa;
#pragma unroll
        for (int d = 1; d < 64; d <<= 1) { const float o = __shfl_up(p, d); if (lane >= d) p = fmaxf(p, o); }
        fc[i] = f; a[i] = aa; pm[i] = p;
        if (lane == 63) { fl[c] = f; fl[32 + c] = p; } }
    __syncthreads();
    float m0c = 0.f, m0 = sample ? A.in[5][b * NH + h] : 0.f;
    for (int c = 0; c < nch; ++c) { if (lane == c) m0c = m0; m0 = fl[c] + fmaxf(fl[32 + c], m0); }
#pragma unroll
    for (int i = 0; i < 4; ++i) { const int c = 4 * wave + i;
        if (c < nch) { const float m0i = __shfl(m0c, c); const float mm = fmaxf(pm[i], m0i), mml = __shfl(mm, 63);
            float* o = SCAL + ((size_t)(sc0 + c) * 4 + h) * 384;
            o[lane] = a[i]; o[64 + lane] = mm; o[128 + lane] = __expf(m0i - mm); o[192 + lane] = __expf(-(fc[i] + mm)); o[256 + lane] = __expf(a[i] - mml);
            o[320 + lane] = (lane == 0) ? __expf(m0i - mml) : (__shfl(fc[i], 63) + mml); } }
    if (wave == 0 && lane == 0) A.out[(sample ? O_MS : O_MP) + b * NH + h] = m0;
    __syncthreads();
}
__device__ __forceinline__ void p2_conv(const Args& A, int tid, int vcu, int G) {
    unsigned char* ws = A.ws;
    const bf16* QKRAW = (const bf16*)(ws + WS_QKRAW); bf16* Q = (bf16*)(ws + WS_Q); bf16* Kb = (bf16*)(ws + WS_K);
    const int nthreads = G * NWAVES * 64;
    for (int it = vcu * (NWAVES * 64) + tid; it < (MT / 8) * 128; it += nthreads) {
        const int rb = it >> 7, ch = it & 127, rs = 8 * rb, col = 8 * ch;
        bool first, sample = rs >= MP; int b, tl, Lseq;
        if (!sample) { b = rs / SEQ; tl = rs % SEQ; Lseq = SEQ; } else { b = (rs - MP) / SLEN; tl = (rs - MP) % SLEN; Lseq = SLEN; }
        first = (tl == 0);
        float w[4][8], bc[8];
#pragma unroll
        for (int j = 0; j < 4; ++j) { const f32x4 a0 = *(const f32x4*)(A.in[10] + j * 1024 + col), a1 = *(const f32x4*)(A.in[10] + j * 1024 + col + 4);
            w[j][0] = a0[0]; w[j][1] = a0[1]; w[j][2] = a0[2]; w[j][3] = a0[3]; w[j][4] = a1[0]; w[j][5] = a1[1]; w[j][6] = a1[2]; w[j][7] = a1[3]; }
        { const f32x4 a0 = *(const f32x4*)(A.in[11] + col), a1 = *(const f32x4*)(A.in[11] + col + 4);
          bc[0] = a0[0]; bc[1] = a0[1]; bc[2] = a0[2]; bc[3] = a0[3]; bc[4] = a1[0]; bc[5] = a1[1]; bc[6] = a1[2]; bc[7] = a1[3]; }
        v4u raw[11];
#pragma unroll
        for (int r = 0; r < 11; ++r) { if (r >= 3 || !first) raw[r] = *(const GAS v4u*)(QKRAW + (size_t)(rs + r - 3) * 1024 + col); else raw[r] = (v4u){0u, 0u, 0u, 0u}; }
        float x0[8], x1[8], x2[8];
#define UNPK(dst, v) do { dst[0] = bflo(v.x); dst[1] = bfhi(v.x); dst[2] = bflo(v.y); dst[3] = bfhi(v.y); dst[4] = bflo(v.z); dst[5] = bfhi(v.z); dst[6] = bflo(v.w); dst[7] = bfhi(v.w); } while (0)
        if (first && sample) {
            const float* sp = A.in[2] + (size_t)b * 3 * 1024 + col;
#pragma unroll
            for (int i = 0; i < 8; ++i) { x0[i] = sp[i]; x1[i] = sp[1024 + i]; x2[i] = sp[2048 + i]; }
        } else { UNPK(x0, raw[0]); UNPK(x1, raw[1]); UNPK(x2, raw[2]); }
#pragma unroll
        for (int r = 0; r < 8; ++r) {
            float x3[8]; UNPK(x3, raw[r + 3]);
            float o[8];
#pragma unroll
            for (int i = 0; i < 8; ++i) { const float val = bc[i] + w[0][i] * x0[i] + w[1][i] * x1[i] + w[2][i] * x2[i] + w[3][i] * x3[i]; o[i] = val * sigmoidf_(val); }
            const size_t row = (size_t)rs + r;
            if (ch < 64) {
#pragma unroll
                for (int i = 0; i < 8; ++i) o[i] *= 0.08838834764831845f;
                v4u pk; pk.x = cvtpk(o[0], o[1]); pk.y = cvtpk(o[2], o[3]); pk.z = cvtpk(o[4], o[5]); pk.w = cvtpk(o[6], o[7]);
                *(GAS v4u*)(Q + row * 512 + col) = pk;
            } else {
                v4u pk; pk.x = cvtpk(o[0], o[1]); pk.y = cvtpk(o[2], o[3]); pk.z = cvtpk(o[4], o[5]); pk.w = cvtpk(o[6], o[7]);
                *(GAS v4u*)(Kb + row * 512 + (col - 512)) = pk;
            }
            const int tt = tl + r;
            if (tt >= Lseq - 3) { float* cv = A.out + (sample ? O_CONVS : O_CONVP) + ((size_t)b * 3 + (tt - (Lseq - 3))) * 1024 + col;
                *(f32x4*)cv = (f32x4){x3[0], x3[1], x3[2], x3[3]}; *(f32x4*)(cv + 4) = (f32x4){x3[4], x3[5], x3[6], x3[7]}; }
#pragma unroll
            for (int i = 0; i < 8; ++i) { x0[i] = x1[i]; x1[i] = x2[i]; x2[i] = x3[i]; }
        }
#undef UNPK
    }
}
constexpr int ML_QS = 0, ML_KS = 17408, ML_VS = 34816, ML_SC = 46080, ML_SET = 47616, ML_SS = 2 * ML_SET, ML_CB = ML_SS + 9216, ML_CBSZ = 21760;
static_assert(ML_CB + 2 * ML_CBSZ <= LDSCTL_OFF, "mLSTM LDS map");
constexpr int SC_A = 0, SC_MM = 64, SC_GI = 128, SC_EN = 192, SC_WS = 256, SC_MISC = 320;
__device__ __forceinline__ bf16x8 ldsfrag(const LAS unsigned char* p) { return *(const LAS bf16x8*)p; }
typedef __attribute__((address_space(3))) s16x4 lds_s16x4;
__device__ __forceinline__ bf16x8 trfrag(const LAS unsigned char* tile, int stride, int k0, int c0, int lane) {
    const int g = lane >> 4, q = (lane & 15) >> 2, p = lane & 3;
    const LAS unsigned char* a0 = tile + (k0 + 8 * g + q) * stride + (c0 + 4 * p) * 2;
    const s16x4 lo = __builtin_amdgcn_ds_read_tr16_b64_v4i16((lds_s16x4*)a0), hi = __builtin_amdgcn_ds_read_tr16_b64_v4i16((lds_s16x4*)(a0 + 4 * stride));
    return (bf16x8){lo[0], lo[1], lo[2], lo[3], hi[0], hi[1], hi[2], hi[3]};
}
#define LBAR() do { asm volatile("s_waitcnt lgkmcnt(0)" ::: "memory"); __builtin_amdgcn_s_barrier(); asm volatile("" ::: "memory"); } while (0)

__device__ __forceinline__ void mlstm_item(const Args& A, LAS unsigned char* lds, int tid, int lane, int wave, int item) {
    DBG_DECL
    unsigned char* ws = A.ws;
    const int fr = lane & 15, fq = lane >> 4;
    const bool sample = item >= NBATCH * NH * NSL; const int ii = sample ? item - NBATCH * NH * NSL : item;
    const int b = ii / (NH * NSL), h = (ii / NSL) % NH, sl = ii % NSL;
    const int nch = sample ? 1 : NCH, L = sample ? SLEN : CH;
    const int row0 = sample ? MP + b * SLEN : b * SEQ, sc0 = sample ? NBATCH * NCH + b : b * NCH;
    const bf16* Qg = (const bf16*)(ws + WS_Q); const bf16* Kg = (const bf16*)(ws + WS_K); const bf16* Vg = (const bf16*)(ws + WS_V);
    const float* SCAL = (const float*)(ws + WS_SCAL); bf16* HS = (bf16*)(ws + WS_HS); float* HSS = (float*)(ws + WS_HSS);
    if (tid < 256) { const int r = (tid >> 1) & 63, hf = tid & 1, st = tid >> 7; *(LAS v4u*)(lds + st * ML_SET + ML_VS + r * 176 + 128 + 16 * hf) = (v4u){hf == 0 ? 0x00003F80u : 0u, 0u, 0u, 0u}; }
    f32x4 Cst[5];
    if (sample) {
        const float* c0 = A.in[3] + ((size_t)(b * NH + h) * DV + DVS * sl) * DQK; const float* n0 = A.in[4] + (size_t)(b * NH + h) * DQK;
#pragma unroll
        for (int vb = 0; vb < 4; ++vb) Cst[vb] = *(const f32x4*)(c0 + (size_t)(16 * vb + fr) * DQK + 16 * wave + 4 * fq);
        Cst[4] = (fr == 0) ? *(const f32x4*)(n0 + 16 * wave + 4 * fq) : (f32x4){0.f, 0.f, 0.f, 0.f};
    } else {
#pragma unroll
        for (int vb = 0; vb < 5; ++vb) Cst[vb] = (f32x4){0.f, 0.f, 0.f, 0.f};
    }
#pragma unroll
    for (int vb = 0; vb < 5; ++vb) { u32x2 w; w.x = cvtpk_n(Cst[vb][0], Cst[vb][1]); w.y = cvtpk_n(Cst[vb][2], Cst[vb][3]); *(LAS u32x2*)(lds + ML_CB + (16 * vb + fr) * 272 + (16 * wave + 4 * fq) * 2) = w; }
    v4u pq[2], pk[2], pv; f32x4 psc = (f32x4){0.f, 0.f, 0.f, 0.f};
#define ML_ISSUE(c_) do { \
        const size_t r0_ = (size_t)row0 + (size_t)(c_) * CH; \
        _Pragma("unroll") for (int i = 0; i < 2; ++i) { const int e = tid + 512 * i, r = e >> 4, ch = e & 15; \
            if (r < L) { pq[i] = *(const GAS v4u*)(Qg + (r0_ + r) * 512 + 128 * h + 8 * ch); pk[i] = *(const GAS v4u*)(Kg + (r0_ + r) * 512 + 128 * h + 8 * ch); } \
            else { pq[i] = (v4u){0u, 0u, 0u, 0u}; pk[i] = (v4u){0u, 0u, 0u, 0u}; } } \
        { const int r = tid >> 3, ch = tid & 7; if (r < L) pv = *(const GAS v4u*)(Vg + (r0_ + r) * 1024 + DV * h + DVS * sl + 8 * ch); else pv = (v4u){0u, 0u, 0u, 0u}; } \
        if (tid < 96) psc = *(const GAS f32x4*)(SCAL + ((size_t)(sc0 + (c_)) * 4 + h) * 384 + 4 * tid); \
    } while (0)
#define ML_COMMIT(so_) do { LAS unsigned char* wl_ = lds + (so_); \
        _Pragma("unroll") for (int i = 0; i < 2; ++i) { const int e = tid + 512 * i, r = e >> 4, ch = e & 15; \
            *(LAS v4u*)(wl_ + ML_QS + r * 272 + ch * 16) = pq[i]; *(LAS v4u*)(wl_ + ML_KS + r * 272 + ch * 16) = pk[i]; } \
        { const int r = tid >> 3, ch = tid & 7; *(LAS v4u*)(wl_ + ML_VS + r * 176 + ch * 16) = pv; } \
        if (tid < 96) *(LAS f32x4*)((LAS float*)(wl_ + ML_SC) + 4 * tid) = psc; \
    } while (0)
    ML_ISSUE(0); ML_COMMIT(0);
    LBAR();
    const int tb = wave & 3, wh = wave >> 2, t = 16 * tb + fr;
    u32x2 hsw[2] = {(u32x2){0u, 0u}, (u32x2){0u, 0u}}; float hsp = 0.f;
#define ML_FLUSH(c_) do { const size_t grow = (size_t)row0 + (size_t)(c_) * CH + t; \
        if (t < L) { *(GAS u32x2*)(HS + grow * 1024 + h * DV + DVS * sl + 16 * (2 * wh) + 4 * fq) = hsw[0]; *(GAS u32x2*)(HS + grow * 1024 + h * DV + DVS * sl + 16 * (2 * wh + 1) + 4 * fq) = hsw[1]; \
                     if (fq == 0) HSS[grow * 32 + h * 8 + sl * 2 + wh] = hsp; } } while (0)
    DBG_BEGIN(8);
    for (int c = 0; c < nch; ++c) {
        if (c + 1 < nch) ML_ISSUE(c + 1);
        if (c > 0) ML_FLUSH(c - 1);
        const LAS unsigned char* cbr = lds + ML_CB + (c & 1) * ML_CBSZ; LAS unsigned char* cbw = lds + ML_CB + ((c + 1) & 1) * ML_CBSZ;
        const LAS unsigned char* tl = lds + (c & 1) * ML_SET; const LAS float* SC = (const LAS float*)(tl + ML_SC);
        DBG_BEGIN(4);
        bf16x8 qf[4];
#pragma unroll
        for (int ks = 0; ks < 4; ++ks) qf[ks] = ldsfrag(tl + ML_QS + t * 272 + ks * 64 + fq * 16);
        { bf16x8 kf[2][4];
#pragma unroll
          for (int i = 0; i < 2; ++i)
#pragma unroll
              for (int ks = 0; ks < 4; ++ks) kf[i][ks] = ldsfrag(tl + ML_KS + (16 * (2 * wh + i) + fr) * 272 + ks * 64 + fq * 16);
          const float mmt = SC[SC_MM + t]; f32x4 a4[2];
#pragma unroll
          for (int i = 0; i < 2; ++i) a4[i] = *(const LAS f32x4*)(SC + SC_A + 16 * (2 * wh + i) + 4 * fq);
          f32x4 g[2] = {(f32x4){0.f, 0.f, 0.f, 0.f}, (f32x4){0.f, 0.f, 0.f, 0.f}};
#pragma unroll
          for (int ks = 0; ks < 4; ++ks)
#pragma unroll
              for (int i = 0; i < 2; ++i) g[i] = mfma16(kf[i][ks], qf[ks], g[i]);
#pragma unroll
          for (int i = 0; i < 2; ++i) { const int s0 = 16 * (2 * wh + i) + 4 * fq; float v[4];
#pragma unroll
              for (int r = 0; r < 4; ++r) v[r] = (s0 + r <= t) ? g[i][r] * __expf(a4[i][r] - mmt) : 0.f;
              u32x2 w; w.x = cvtpk_n(v[0], v[1]); w.y = cvtpk_n(v[2], v[3]); *(LAS u32x2*)(lds + ML_SS + t * 144 + s0 * 2) = w; } }
        DBG_END(4);
        LBAR();
        DBG_BEGIN(5);
        { bf16x8 sf[2], vf[3][2], cf[3][4];
#pragma unroll
          for (int ks = 0; ks < 2; ++ks) sf[ks] = ldsfrag(lds + ML_SS + t * 144 + ks * 64 + fq * 16);
#pragma unroll
          for (int i = 0; i < 3; ++i) { const int vb = (i == 2) ? 4 : 2 * wh + i;
#pragma unroll
              for (int ks = 0; ks < 2; ++ks) vf[i][ks] = trfrag(tl + ML_VS, 176, 32 * ks, 16 * vb, lane);
#pragma unroll
              for (int ks = 0; ks < 4; ++ks) cf[i][ks] = ldsfrag(cbr + (16 * vb + fr) * 272 + ks * 64 + fq * 16); }
          const float git = SC[SC_GI + t], ent = SC[SC_EN + t];
          f32x4 ai[3], ae[3];
#pragma unroll
          for (int i = 0; i < 3; ++i) { ai[i] = (f32x4){0.f, 0.f, 0.f, 0.f}; ae[i] = (f32x4){0.f, 0.f, 0.f, 0.f}; }
#pragma unroll
          for (int ks = 0; ks < 4; ++ks)
#pragma unroll
              for (int i = 0; i < 3; ++i) { ae[i] = mfma16(cf[i][ks], qf[ks], ae[i]); if (ks < 2) ai[i] = mfma16(vf[i][ks], sf[ks], ai[i]); }
          f32x4 hh[3];
#pragma unroll
          for (int i = 0; i < 3; ++i) hh[i] = ai[i] + ae[i] * git;
          const float den = __shfl(hh[2][0], fr);
          const float isc = 1.0f / fmaxf(fabsf(den), ent); float p = 0.f;
#pragma unroll
          for (int i = 0; i < 2; ++i) { const f32x4 o = hh[i] * isc; p += (o[0] * o[0] + o[1] * o[1]) + (o[2] * o[2] + o[3] * o[3]);
              hsw[i].x = cvtpk_n(o[0], o[1]); hsw[i].y = cvtpk_n(o[2], o[3]); }
          p += __shfl_xor(p, 16); p += __shfl_xor(p, 32); hsp = p; }
        DBG_END(5); DBG_BEGIN(6);
        { const float decay = SC[SC_MISC];
          bf16x8 kw[2], vf[5][2];
#pragma unroll
          for (int vb = 0; vb < 5; ++vb)
#pragma unroll
              for (int ks = 0; ks < 2; ++ks) vf[vb][ks] = trfrag(tl + ML_VS, 176, 32 * ks, 16 * vb, lane);
#pragma unroll
          for (int ks = 0; ks < 2; ++ks) { const v4u kr = __builtin_bit_cast(v4u, trfrag(tl + ML_KS, 272, 32 * ks, 16 * wave, lane));
              const f32x4 w0 = *(const LAS f32x4*)(SC + SC_WS + 32 * ks + 8 * fq), w1 = *(const LAS f32x4*)(SC + SC_WS + 32 * ks + 8 * fq + 4);
              v4u o; o.x = cvtpk_n(bflo(kr.x) * w0[0], bfhi(kr.x) * w0[1]); o.y = cvtpk_n(bflo(kr.y) * w0[2], bfhi(kr.y) * w0[3]); o.z = cvtpk_n(bflo(kr.z) * w1[0], bfhi(kr.z) * w1[1]); o.w = cvtpk_n(bflo(kr.w) * w1[2], bfhi(kr.w) * w1[3]);
              kw[ks] = __builtin_bit_cast(bf16x8, o); }
#pragma unroll
          for (int vb = 0; vb < 5; ++vb) Cst[vb] = Cst[vb] * decay;
#pragma unroll
          for (int ks = 0; ks < 2; ++ks)
#pragma unroll
              for (int vb = 0; vb < 5; ++vb) Cst[vb] = mfma16(kw[ks], vf[vb][ks], Cst[vb]);
#pragma unroll
          for (int vb = 0; vb < 5; ++vb) { u32x2 w; w.x = cvtpk_n(Cst[vb][0], Cst[vb][1]); w.y = cvtpk_n(Cst[vb][2], Cst[vb][3]); *(LAS u32x2*)(cbw + (16 * vb + fr) * 272 + (16 * wave + 4 * fq) * 2) = w; } }
        DBG_END(6);
        DBG_BEGIN(7);
        if (c + 1 < nch) ML_COMMIT(((c + 1) & 1) * ML_SET);
        DBG_END(7);
        LBAR();
    }
    DBG_END(8); DBG_REPORT(item == 0);
    ML_FLUSH(nch - 1);
    { float* co = A.out + (sample ? O_CS : O_CP) + ((size_t)(b * NH + h) * DV + DVS * sl) * DQK;
#pragma unroll
      for (int vb = 0; vb < 4; ++vb) *(f32x4*)(co + (size_t)(16 * vb + fr) * DQK + 16 * wave + 4 * fq) = Cst[vb];
      if (sl == 0 && fr == 0) *(f32x4*)(A.out + (sample ? O_NS : O_NP) + (size_t)(b * NH + h) * DQK + 16 * wave + 4 * fq) = Cst[4]; }
    LBAR();
#undef ML_ISSUE
#undef ML_FLUSH
#undef ML_COMMIT
}

__device__ __forceinline__ float gelu_tanh(float y) { const float t = y * y, p = fmaf(t, 0.044715f, 1.0f);
    const float e = __builtin_amdgcn_exp2f(y * p * -2.302208198f); return y * __builtin_amdgcn_rcpf(1.0f + e); }
typedef float f32x2 __attribute__((ext_vector_type(2)));
__device__ __forceinline__ void s5_item(const Args& A, LAS unsigned char* slds, int lane, int role, int item) {
    DBG_DECL
    unsigned char* ws = A.ws;
    const int fr = lane & 15, fq = lane >> 4;
    const bool sample = item >= NBATCH * NG; const int ii = sample ? item - NBATCH * NG : item;
    const int b = ii / NG, g = ii % NG;
    const int T = sample ? SLEN : SEQ, row0 = sample ? MP + b * SLEN : b * SEQ;
    const bf16* U = (const bf16*)(ws + WS_U); bf16* Z = (bf16*)(ws + WS_Z);
    const float* LAM = (const float*)(ws + WS_S5P + S5P_LAM); const bf16* BBT = (const bf16*)(ws + WS_S5P + S5P_BBT); const bf16* CC = (const bf16*)(ws + WS_S5P + S5P_CC);
    const bf16x8 zf = (bf16x8){0, 0, 0, 0, 0, 0, 0, 0}; const f32x4 z4 = (f32x4){0.f, 0.f, 0.f, 0.f};
    const int nblk = T / 16;
    const bf16* ubase = U + (size_t)(row0 + fr) * 1024 + 16 * g + 8 * (fq & 1);
#define S5_LOADU(k_) (*(const bf16x8*)(ubase + (size_t)((k_) < nblk ? (k_) : nblk - 1) * 16 * 1024))
#define S5_BU(P_) ((LAS float*)(slds + (P_) * 8448))
#define S5_SB(P_) ((LAS bf16*)(slds + 16896 + (P_) * 4352))
    if (role == 0) {
        bf16x8 bbA[8];
#pragma unroll
        for (int rb = 0; rb < 8; ++rb) bbA[rb] = (fq < 2) ? *(const bf16x8*)(BBT + ((size_t)g * 128 + 16 * rb + fr) * 16 + 8 * fq) : zf;
        const float lr = LAM[(g * 64 + lane) * 2], li = LAM[(g * 64 + lane) * 2 + 1];
        float sr, si;
        if (sample) { sr = A.in[6][(size_t)(b * NG + g) * PST + lane]; si = A.in[7][(size_t)(b * NG + g) * PST + lane]; } else { sr = 0.f; si = 0.f; }
        bf16x8 ub = S5_LOADU(0), uc = S5_LOADU(1), ud = S5_LOADU(2);
#pragma unroll
        for (int rb = 0; rb < 8; ++rb) { const f32x4 d = mfma16(bbA[rb], ub, z4); *(LAS f32x4*)(S5_BU(0) + fr * 132 + 16 * rb + 4 * fq) = d; }
        LBAR();
#define S5_ITER_A(k_, P_) do { const int k = (k_); DBG_BEGIN(1); \
            f32x4 d[8]; \
            _Pragma("unroll") for (int rb = 0; rb < 8; ++rb) d[rb] = mfma16(bbA[rb], uc, z4);                                 \
            f32x2 bu[16]; { const LAS float* bc = S5_BU(P_); \
            _Pragma("unroll") for (int tt = 0; tt < 16; ++tt) bu[tt] = *(const LAS f32x2*)(bc + tt * 132 + 2 * lane); } \
            { LAS float* bn = S5_BU(1 - (P_)); \
            _Pragma("unroll") for (int rb = 0; rb < 8; ++rb) *(LAS f32x4*)(bn + fr * 132 + 16 * rb + 4 * fq) = d[rb]; } \
            { LAS bf16* sbc = S5_SB(P_); \
            f32x2 s2 = (f32x2){sr, si}; const f32x2 lr2 = (f32x2){lr, lr}, li2 = (f32x2){-li, li}; \
            _Pragma("unroll") for (int tt = 0; tt < 16; ++tt) { const f32x2 sw = __builtin_shufflevector(s2, s2, 1, 0); s2 = lr2 * s2 + (li2 * sw + bu[tt]);     \
                *(LAS unsigned*)(sbc + tt * 136 + 2 * lane) = cvtpk_n(s2[0], s2[1]); } sr = s2[0]; si = s2[1]; }                \
            uc = ud; ud = S5_LOADU(k + 3); DBG_END(1); \
            LBAR(); } while (0)
        DBG_BEGIN(2);
        for (int k2 = 0; k2 + 1 < nblk; k2 += 2) { S5_ITER_A(k2, 0); S5_ITER_A(k2 + 1, 1); }
        if (nblk & 1) S5_ITER_A(nblk - 1, 0);
        DBG_END(2); DBG_REPORT(!sample && item == 0);
#undef S5_ITER_A
        float* so = A.out + (sample ? O_SRS : O_SRP) + (size_t)(b * NG + g) * PST; float* io = A.out + (sample ? O_SIS : O_SIP) + (size_t)(b * NG + g) * PST;
        so[lane] = sr; io[lane] = si;
    } else {
        bf16x8 ccA[4], dA;
#pragma unroll
        for (int ks = 0; ks < 4; ++ks) ccA[ks] = *(const bf16x8*)(CC + ((size_t)g * 16 + fr) * 128 + 32 * ks + 8 * fq);
        { const short dv = (short)f2bf(A.in[22][g * 16 + fr]); dA = zf;
#pragma unroll
          for (int j = 0; j < 8; ++j) dA[j] = (fq < 2 && 8 * fq + j == fr) ? dv : (short)0; }
        bf16x8 ua = S5_LOADU(0), ub = S5_LOADU(0), uc = S5_LOADU(1);
        LBAR();
#define S5_Y(km1_, P_) do { const LAS bf16* sbp = S5_SB(P_); f32x4 y = z4; \
            _Pragma("unroll") for (int ks = 0; ks < 4; ++ks) y = mfma16(ccA[ks], *(const LAS bf16x8*)(sbp + fr * 136 + 32 * ks + 8 * fq), y); \
            y = mfma16(dA, ua, y); \
            u32x2 w; w.x = cvtpk_n(gelu_tanh(y[0]), gelu_tanh(y[1])); w.y = cvtpk_n(gelu_tanh(y[2]), gelu_tanh(y[3])); \
            *(GAS u32x2*)(Z + ((size_t)row0 + 16 * (km1_) + fr) * 1024 + 16 * g + 4 * fq) = w; } while (0)
#define S5_ITER_B(k_, P_) do { const int k = (k_); DBG_BEGIN(3); if (k >= 1) S5_Y(k - 1, 1 - (P_)); ua = ub; ub = uc; uc = S5_LOADU(k + 2); DBG_END(3); LBAR(); } while (0)
        for (int k2 = 0; k2 + 1 < nblk; k2 += 2) { S5_ITER_B(k2, 0); S5_ITER_B(k2 + 1, 1); }
        if (nblk & 1) S5_ITER_B(nblk - 1, 0);
        if ((nblk - 1) & 1) S5_Y(nblk - 1, 1); else S5_Y(nblk - 1, 0);
        DBG_REPORT(!sample && item == 0);
#undef S5_ITER_B
#undef S5_Y
    }
    LBAR();
#undef S5_BU
#undef S5_SB
#undef S5_LOADU
}

__device__ __forceinline__ void outa_rows(const Args& A, int lane, int gw, int NGW) {
    unsigned char* ws = A.ws;
    const bf16* HS = (const bf16*)(ws + WS_HS); const bf16* OG = (const bf16*)(ws + WS_OG); const float* HSS = (const float*)(ws + WS_HSS); bf16* MIXIN = (bf16*)(ws + WS_MIXIN);
    f32x4 gm[2][2];
#pragma unroll
    for (int i = 0; i < 2; ++i) { gm[i][0] = *(const f32x4*)(A.in[14] + 512 * i + 8 * lane); gm[i][1] = *(const f32x4*)(A.in[14] + 512 * i + 8 * lane + 4); }
    for (int m = gw; m < MT; m += NGW) {
        f32x4 p0[2], p1[2]; v4u hv[2], ov[2];
#pragma unroll
        for (int i = 0; i < 2; ++i) { const int col = 512 * i + 8 * lane, hh = col >> 8;
            p0[i] = *(const GAS f32x4*)(HSS + (size_t)m * 32 + hh * 8); p1[i] = *(const GAS f32x4*)(HSS + (size_t)m * 32 + hh * 8 + 4);
            hv[i] = *(const GAS v4u*)(HS + (size_t)m * 1024 + col); ov[i] = *(const GAS v4u*)(OG + (size_t)m * 1024 + col); }
        v4u o[2];
#pragma unroll
        for (int i = 0; i < 2; ++i) {
            const float ss = (p0[i][0] + p0[i][1]) + (p0[i][2] + p0[i][3]) + (p1[i][0] + p1[i][1]) + (p1[i][2] + p1[i][3]);
            const float rstd = 1.0f / sqrtf(ss * (1.0f / DV) + EPS);
            o[i].x = cvtpk(bflo(hv[i].x) * rstd * gm[i][0][0] * sigmoidf_(bflo(ov[i].x)), bfhi(hv[i].x) * rstd * gm[i][0][1] * sigmoidf_(bfhi(ov[i].x)));
            o[i].y = cvtpk(bflo(hv[i].y) * rstd * gm[i][0][2] * sigmoidf_(bflo(ov[i].y)), bfhi(hv[i].y) * rstd * gm[i][0][3] * sigmoidf_(bfhi(ov[i].y)));
            o[i].z = cvtpk(bflo(hv[i].z) * rstd * gm[i][1][0] * sigmoidf_(bflo(ov[i].z)), bfhi(hv[i].z) * rstd * gm[i][1][1] * sigmoidf_(bfhi(ov[i].z)));
            o[i].w = cvtpk(bflo(hv[i].w) * rstd * gm[i][1][2] * sigmoidf_(bflo(ov[i].w)), bfhi(hv[i].w) * rstd * gm[i][1][3] * sigmoidf_(bfhi(ov[i].w))); }
#pragma unroll
        for (int i = 0; i < 2; ++i) *(GAS v4u*)(MIXIN + (size_t)m * 2048 + 512 * i + 8 * lane) = o[i];
    }
}
__device__ __forceinline__ float row_ss_part(const float* SSp, const float* SSs, int m, int lane) {
    if (m < MP) return (lane < 32) ? SSp[(size_t)m * 32 + lane] : 0.f;
    return SSs[(size_t)(m - MP) * 128 + lane] + SSs[(size_t)(m - MP) * 128 + 64 + lane];
}
__device__ __forceinline__ void rowpass1(const Args& A, int lane, int gw, int NGW) {
    unsigned char* ws = A.ws;
    const bf16* MIX = (const bf16*)(ws + WS_MIX); bf16* X1B = (bf16*)(ws + WS_X1B); float* RSTD2 = (float*)(ws + WS_SSS + SSS_RSTD2);
    const float* SSp = (const float*)(ws + WS_SS1); const float* SSs = (const float*)(ws + WS_SSS + SSS_1);
    const float* RSTD1 = (const float*)(ws + WS_SSS + SSS_RSTD1);
    f32x4 g1[8], gi[8];
#pragma unroll
    for (int j = 0; j < 8; ++j) { g1[j] = *(const f32x4*)(A.in[26] + 256 * j + 4 * lane); const f32x4 g0 = *(const f32x4*)(A.in[8] + 256 * j + 4 * lane);
        gi[j] = (f32x4){1.0f / g0[0], 1.0f / g0[1], 1.0f / g0[2], 1.0f / g0[3]}; }
    u32x2 va[8], vb[8], ma[8], mb[8]; float sa = 0.f, sb = 0.f, ra = 0.f, rb = 0.f;
#define RP1_LOAD(V, M, S, R, m_) do { const int mm_ = (m_); \
        S = row_ss_part(SSp, SSs, mm_, lane); R = RSTD1[mm_]; \
        _Pragma("unroll") for (int j = 0; j < 8; ++j) { const int k = 256 * j + 4 * lane; V[j] = *(const GAS u32x2*)(X1B + (size_t)mm_ * DM + k); M[j] = *(const GAS u32x2*)(MIX + (size_t)mm_ * DM + k); } } while (0)
#define RP1_PROC(V, M, S, R, m_) do { const int mm_ = (m_); \
        const float rstd1 = 1.0f / sqrtf(wave_sum(S) * (1.0f / DM) + EPS); float s = 0.f; f32x4 O[8]; \
        _Pragma("unroll") for (int j = 0; j < 8; ++j) { f32x4 o; o[0] = bflo(V[j].x) * R * gi[j][0] + bflo(M[j].x) * rstd1 * g1[j][0]; o[1] = bfhi(V[j].x) * R * gi[j][1] + bfhi(M[j].x) * rstd1 * g1[j][1]; \
            o[2] = bflo(V[j].y) * R * gi[j][2] + bflo(M[j].y) * rstd1 * g1[j][2]; o[3] = bfhi(V[j].y) * R * gi[j][3] + bfhi(M[j].y) * rstd1 * g1[j][3]; \
            s += (o[0] * o[0] + o[1] * o[1]) + (o[2] * o[2] + o[3] * o[3]); O[j] = o; } \
        const float ms2 = wave_sum(s) * (1.0f / DM) + EPS, rstd2 = 1.0f / sqrtf(ms2); \
        _Pragma("unroll") for (int j = 0; j < 8; ++j) { u32x2 o; o.x = cvtpk(O[j][0] * rstd2, O[j][1] * rstd2); o.y = cvtpk(O[j][2] * rstd2, O[j][3] * rstd2); \
            *(GAS u32x2*)(X1B + (size_t)mm_ * DM + 256 * j + 4 * lane) = o; } \
        if (lane == 0) RSTD2[mm_] = sqrtf(ms2); } while (0)
    int m = gw;
    if (m < MT) { RP1_LOAD(va, ma, sa, ra, m);
        for (;;) { const int m2 = m + NGW; if (m2 < MT) RP1_LOAD(vb, mb, sb, rb, m2); RP1_PROC(va, ma, sa, ra, m); if (m2 >= MT) break;
                   m = m2 + NGW; if (m < MT) RP1_LOAD(va, ma, sa, ra, m); RP1_PROC(vb, mb, sb, rb, m2); if (m >= MT) break; } }
#undef RP1_LOAD
#undef RP1_PROC
}
__device__ __forceinline__ void rowpass2(const Args& A, int lane, int gw, int NGW) {
    unsigned char* ws = A.ws;
    const bf16* FF = (const bf16*)(ws + WS_FF); const bf16* X1B = (const bf16*)(ws + WS_X1B);
    const float* SSp = (const float*)(ws + WS_SS2); const float* SSs = (const float*)(ws + WS_SSS + SSS_2);
    f32x4 g3[8];
#pragma unroll
    for (int j = 0; j < 8; ++j) g3[j] = *(const f32x4*)(A.in[31] + 256 * j + 4 * lane);
    u32x2 xa[8], xb[8], fa[8], fb[8]; float sa = 0.f, sb = 0.f;
    const float* RSTD2 = (const float*)(ws + WS_SSS + SSS_RSTD2); float ra = 0.f, rb = 0.f;
#define RP2_LOAD(X, F, S, R, m_) do { const int mm_ = (m_); S = row_ss_part(SSp, SSs, mm_, lane); R = RSTD2[mm_]; \
        _Pragma("unroll") for (int j = 0; j < 8; ++j) { const int k = 256 * j + 4 * lane; X[j] = *(const GAS u32x2*)(X1B + (size_t)mm_ * DM + k); F[j] = *(const GAS u32x2*)(FF + (size_t)mm_ * DM + k); } } while (0)
#define RP2_PROC(X, F, S, R, m_) do { const int mm_ = (m_); float* orow = A.out + O_Y + (size_t)mm_ * DM; const float rstd = 1.0f / sqrtf(wave_sum(S) * (1.0f / DM) + EPS); f32x4 V[8]; \
        _Pragma("unroll") for (int j = 0; j < 8; ++j) { V[j][0] = bflo(X[j].x) * R + bflo(F[j].x) * rstd * g3[j][0]; V[j][1] = bfhi(X[j].x) * R + bfhi(F[j].x) * rstd * g3[j][1]; V[j][2] = bflo(X[j].y) * R + bflo(F[j].y) * rstd * g3[j][2]; V[j][3] = bfhi(X[j].y) * R + bfhi(F[j].y) * rstd * g3[j][3]; } \
        DBG_PERTURB(V, mm_); \
        _Pragma("unroll") for (int j = 0; j < 8; ++j) __builtin_nontemporal_store(V[j], (GAS f32x4*)(orow + 256 * j + 4 * lane)); } while (0)
    int m = gw;
    if (m < MT) { RP2_LOAD(xa, fa, sa, ra, m);
        for (;;) { const int m2 = m + NGW; if (m2 < MT) RP2_LOAD(xb, fb, sb, rb, m2); RP2_PROC(xa, fa, sa, ra, m); if (m2 >= MT) break;
                   m = m2 + NGW; if (m < MT) RP2_LOAD(xa, fa, sa, ra, m); RP2_PROC(xb, fb, sb, rb, m2); if (m >= MT) break; } }
#undef RP2_LOAD
#undef RP2_PROC
}
#ifndef MK_AL_P4
#define MK_AL_P4 true
#endif
#ifndef MK_AL_SS
#define MK_AL_SS true
#endif
#ifndef MK_WGM_P5
#define MK_WGM_P5 4
#endif
#ifndef MK_WGM_P1
#define MK_WGM_P1 2
#endif
#ifndef MK_WGM_P7
#define MK_WGM_P7 4
#endif
#ifndef MK_WGM_P8
#define MK_WGM_P8 1
#endif
#ifndef MK_GU_ALIGN
#define MK_GU_ALIGN true
#endif
#ifndef MK_GU_SP2
#define MK_GU_SP2 true
#endif
__global__ void __launch_bounds__(NWAVES * 64, 2) hymba_fwd(Args args) {
    extern __shared__ __attribute__((aligned(16))) unsigned char lds_raw[];
    LAS unsigned char* lds = (LAS unsigned char*)lds_raw;
    volatile LAS unsigned* MISC = (volatile LAS unsigned*)(lds + MISC_OFF);
    const int tid = threadIdx.x, lane = tid & 63, wave = __builtin_amdgcn_readfirstlane(tid >> 6);
    const int G = gridDim.x; const int bx = blockIdx.x; const int vcu = (G % 8 == 0) ? (bx % 8) * (G / 8) + bx / 8 : bx;
    unsigned char* ws = args.ws;
    gu32* ctl = (gu32*)(ws + WS_CTL);
    for (int u = tid; u < (LDS_BYTES - LDSCTL_OFF) / 4; u += NWAVES * 64) ((LAS unsigned*)(lds + LDSCTL_OFF))[u] = 0u;
    __syncthreads();
    const XcdBarrier bar = xcd_barrier_post((unsigned*)(ctl + CW_BAR) + args.li * XCD_BAR_WORDS, MISC + 8);
#define GRID_BAR() xcd_barrier(bar)
    const int lo = args.ph_lo, hi = args.ph_hi;
#define IN(k) (lo <= (k) && (k) < hi)
#define BOTH(k) (IN(k) && IN((k) + 1))

    const int gw = vcu * NWAVES + wave, NGW = G * NWAVES;

    if (IN(0)) { PHASE_IDS p0_prologue(args, lds, tid, lane, wave, vcu, G); if (BOTH(0)) GRID_BAR(); }

    if (IN(1)) { PHASE_IDS
        { pg8::Gemm g{(const bf16*)(ws + WS_XN), (const bf16*)(ws + WS_WIN), MP, 4096, DM}; pg8::StaticOrder S; S.init(MP, 4096, G, bx, MK_WGM_P1);
          pg8::EpiBf16<0> E{(bf16*)(ws + WS_QKRAW), 1024, nullptr, 1024, (size_t)WS_RSTRIDE / 2, 1.f};
          pg8::gemm_phase<pg8::EpiBf16<0>, pg8::StaticOrder, true, true>(lds + RING_OFF, g, S, E); }
        { PHASE_IDS bf16* O = (bf16*)(ws + WS_QKRAW);
          skinny_gemm<1, DM>((const bf16*)(ws + WS_XN) + (size_t)MP * DM, (const bf16*)(ws + WS_WIN), lds, 4096 / 16, vcu, G, tid, wave, lane,
              [](int it, int a, int fr) { return 16 * it + fr; },
              [O](int it, int row, int fq, const f32x4 (&acc)[1]) { const int col = 16 * it + 4 * fq, t = col >> 10;
                  u32x2 w; w.x = cvtpk_n(acc[0][0], acc[0][1]); w.y = cvtpk_n(acc[0][2], acc[0][3]);
                  *(GAS u32x2*)(O + (size_t)t * (WS_RSTRIDE / 2) + (size_t)(MP + row) * 1024 + (col & 1023)) = w; }); }
        if (BOTH(1)) GRID_BAR();
    }

    if (IN(2)) { PHASE_IDS if (vcu < 64) p2_scalars(args, lds, lane, wave, vcu); p2_conv(args, tid, vcu, G); if (BOTH(2)) GRID_BAR(); }

    if (IN(3)) { PHASE_IDS
        const int half = G / 2;
#ifndef MK_REP_M
#define MK_REP_M 1
#endif
#ifndef MK_REP_S
#define MK_REP_S 1
#endif
        if (vcu < half) { for (int rp_ = 0; rp_ < MK_REP_M; ++rp_) for (int it = vcu; it < NBATCH * NH * NSL; it += half) mlstm_item(args, lds, tid, lane, wave, it); }
        else { const int nb = G - half, bi = vcu - half;
               for (int rp_ = 0; rp_ < MK_REP_S; ++rp_)
               for (int it = bi * 4 + (wave & 3); it < 2 * NBATCH * NG; it += nb * 4) s5_item(args, lds + (wave & 3) * 25600, lane, wave >> 2, it); }
        if (vcu >= half) { __syncthreads(); for (int it = NBATCH * NH * NSL + (vcu - half); it < 2 * NBATCH * NH * NSL; it += G - half) mlstm_item(args, lds, tid, lane, wave, it); }
        if (BOTH(3)) GRID_BAR();
    }

    if (IN(4)) { PHASE_IDS
        { pg8::Gemm g{(const bf16*)(ws + WS_Z), (const bf16*)(ws + WS_WGLU), MP, 1024, 1024}; pg8::StaticOrder S; S.init(MP, 1024, G, bx);
          pg8::EpiGlu E{(const bf16*)(ws + WS_Z), (bf16*)(ws + WS_MIXIN), args.in[24]};
          pg8::gemm_phase<pg8::EpiGlu, pg8::StaticOrder, MK_AL_P4, true>(lds + RING_OFF, g, S, E); }
        { PHASE_IDS const bf16* Zb = (const bf16*)(ws + WS_Z); bf16* O = (bf16*)(ws + WS_MIXIN); const float* bias = args.in[24];
          skinny_gemm<1, 1024>(Zb + (size_t)MP * 1024, (const bf16*)(ws + WS_WGLU), lds, 1024 / 16, vcu, G, tid, wave, lane,
              [](int it, int a, int fr) { return 16 * it + fr; },
              [Zb, O, bias](int it, int row, int fq, const f32x4 (&acc)[1]) { const int col = 16 * it + 4 * fq; const size_t m = (size_t)(MP + row);
                  const u32x2 z = *(const GAS u32x2*)(Zb + m * 1024 + col); const f32x4 bv = *(const f32x4*)(bias + col);
                  u32x2 w; w.x = cvtpk(bflo(z.x) * sigmoidf_(acc[0][0] + bv[0]), bfhi(z.x) * sigmoidf_(acc[0][1] + bv[1]));
                  w.y = cvtpk(bflo(z.y) * sigmoidf_(acc[0][2] + bv[2]), bfhi(z.y) * sigmoidf_(acc[0][3] + bv[3]));
                  *(GAS u32x2*)(O + m * 2048 + 1024 + col) = w; }); }
        { PHASE_IDS outa_rows(args, lane, gw, NGW); }
        if (BOTH(4)) GRID_BAR();
    }

    if (IN(5)) { PHASE_IDS
        { pg8::Gemm g{(const bf16*)(ws + WS_MIXIN), (const bf16*)(ws + WS_WOUT), MP, DM, DM}; pg8::StaticOrder S; S.init(MP, DM, G, bx, MK_WGM_P5);
          pg8::EpiSS<false> E{(bf16*)(ws + WS_MIX), DM, (float*)(ws + WS_SS1), 1.0f};
          pg8::gemm_phase<pg8::EpiSS<false>, pg8::StaticOrder, MK_AL_SS, true>(lds + RING_OFF, g, S, E); }
        { PHASE_IDS bf16* O = (bf16*)(ws + WS_MIX); float* SSs = (float*)(ws + WS_SSS + SSS_1);
          skinny_gemm<1, DM>((const bf16*)(ws + WS_MIXIN) + (size_t)MP * DM, (const bf16*)(ws + WS_WOUT), lds, DM / 16, vcu, G, tid, wave, lane,
              [](int it, int a, int fr) { return 16 * it + fr; },
              [O, SSs](int it, int row, int fq, const f32x4 (&acc)[1]) { const int col = 16 * it + 4 * fq;
                  u32x2 w; w.x = cvtpk_n(acc[0][0], acc[0][1]); w.y = cvtpk_n(acc[0][2], acc[0][3]);
                  *(GAS u32x2*)(O + (size_t)(MP + row) * DM + col) = w;
                  float s = (acc[0][0] * acc[0][0] + acc[0][1] * acc[0][1]) + (acc[0][2] * acc[0][2] + acc[0][3] * acc[0][3]);
                  s += __shfl_xor(s, 16); s += __shfl_xor(s, 32);
                  if (fq == 0) SSs[(size_t)row * 128 + it] = s; }); }
        if (BOTH(5)) GRID_BAR();
    }

    if (IN(6)) { PHASE_IDS rowpass1(args, lane, gw, NGW); if (BOTH(6)) GRID_BAR(); }

    if (IN(7)) { PHASE_IDS
        { pg8::Gemm g{(const bf16*)(ws + WS_X1B), (const bf16*)(ws + WS_WGU), MP, 2 * DFF, DM}; pg8::StaticOrder S; S.init(MP, 2 * DFF, G, bx, MK_WGM_P7);
          pg8::EpiGU8 E{ws + WS_ACT8, DFF};
          pg8::gemm_phase<pg8::EpiGU8, pg8::StaticOrder, MK_GU_ALIGN, MK_GU_SP2>(lds + RING_OFF, g, S, E); }
        { PHASE_IDS bf16* O = (bf16*)(ws + WS_ACTS);
          skinny_gemm<2, DM>((const bf16*)(ws + WS_X1B) + (size_t)MP * DM, (const bf16*)(ws + WS_WGU), lds, DFF / 16, vcu, G, tid, wave, lane,
              [](int it, int a, int fr) { const int j = 16 * it + fr; return 256 * (j >> 7) + 128 * a + (j & 127); },
              [O](int it, int row, int fq, const f32x4 (&acc)[2]) { const int col = 16 * it + 4 * fq; const f32x4 g = acc[0], up = acc[1];
                  u32x2 w; w.x = cvtpk(g[0] * sigmoidf_(g[0]) * up[0], g[1] * sigmoidf_(g[1]) * up[1]);
                  w.y = cvtpk(g[2] * sigmoidf_(g[2]) * up[2], g[3] * sigmoidf_(g[3]) * up[3]);
                  *(GAS u32x2*)(O + (size_t)row * DFF + col) = w; }); }
        if (BOTH(7)) GRID_BAR();
    }

    if (IN(8)) { PHASE_IDS
        { pg8::Gemm g{(const bf16*)(ws + WS_ACT8), (const bf16*)(ws + WS_WD8), MP, DM, DFF / 2}; pg8::StaticOrder S; S.init(MP, DM, G, bx, MK_WGM_P8);
          pg8::EpiSS<true> E{(bf16*)(ws + WS_FF), DM, (float*)(ws + WS_SS2), 0.0009765625f};
          pg8::gemm_phase<pg8::EpiSS<true>, pg8::StaticOrder, MK_AL_SS, true, true>(lds + RING_OFF, g, S, E); }
        { PHASE_IDS bf16* O = (bf16*)(ws + WS_FF); float* SSs = (float*)(ws + WS_SSS + SSS_2);
          skinny_gemm<1, DFF>((const bf16*)(ws + WS_ACTS), (const bf16*)(ws + WS_WD), lds, DM / 16, vcu, G, tid, wave, lane,
              [](int it, int a, int fr) { return 16 * it + fr; },
              [O, SSs](int it, int row, int fq, const f32x4 (&acc)[1]) { const int col = 16 * it + 4 * fq;
                  u32x2 w; w.x = cvtpk_n(acc[0][0], acc[0][1]); w.y = cvtpk_n(acc[0][2], acc[0][3]);
                  *(GAS u32x2*)(O + (size_t)(MP + row) * DM + col) = w;
                  float s = (acc[0][0] * acc[0][0] + acc[0][1] * acc[0][1]) + (acc[0][2] * acc[0][2] + acc[0][3] * acc[0][3]);
                  s += __shfl_xor(s, 16); s += __shfl_xor(s, 32);
                  if (fq == 0) SSs[(size_t)row * 128 + it] = s; }); }
        if (BOTH(8)) GRID_BAR();
    }

    if (IN(9)) { PHASE_IDS rowpass2(args, lane, gw, NGW); }
#undef IN
#undef BOTH
}

#ifdef MK_DUMP_OFF
__global__ void dump_kernel(const unsigned short* src, float* dst, size_t n) {
    for (size_t i = (size_t)blockIdx.x * blockDim.x + threadIdx.x; i < n; i += (size_t)gridDim.x * blockDim.x) dst[i] = __uint_as_float((unsigned)src[i] << 16);
}
#endif
extern "C" void kernel_launch(void* const* d_in, const int* in_sizes, int n_in, void* d_out, int out_size, void* d_ws, size_t ws_size, hipStream_t stream) {
    static int grid = 0;
    if (grid == 0) {
        if (n_in != 32 || out_size != (int)O_END || ws_size < WS_END) { fprintf(stderr, "kernel_launch: unexpected problem: n_in %d out %d ws %zu\n", n_in, out_size, ws_size); grid = -1; return; }
        int dev = 0, cus = 0, per_cu = 0;
        if (hipGetDevice(&dev) != hipSuccess || hipDeviceGetAttribute(&cus, hipDeviceAttributeMultiprocessorCount, dev) != hipSuccess) { grid = -1; return; }
        if (hipFuncSetAttribute((const void*)hymba_fwd, hipFuncAttributeMaxDynamicSharedMemorySize, LDS_BYTES) != hipSuccess) { fprintf(stderr, "kernel_launch: hipFuncSetAttribute failed\n"); grid = -1; return; }
        if (hipOccupancyMaxActiveBlocksPerMultiprocessor(&per_cu, (const void*)hymba_fwd, NWAVES * 64, LDS_BYTES) != hipSuccess || per_cu < 1) { fprintf(stderr, "kernel_launch: occupancy query reports %d\n", per_cu); per_cu = 1; }
        (void)hipGetLastError();
        grid = cus;
    }
    if (grid < 0) return;
    Args a{};
    for (int i = 0; i < 32; ++i) a.in[i] = (const float*)d_in[i];
    a.out = (float*)d_out; a.ws = (unsigned char*)d_ws;
    int lo[N_PHASES + 2], hi[N_PHASES + 2], nl = 0;
#if defined(MK_REPEAT)
    lo[0] = 0; hi[0] = MK_REPEAT + 1; lo[1] = MK_REPEAT; hi[1] = MK_REPEAT + 1; lo[2] = MK_REPEAT + 1; hi[2] = N_PHASES; nl = 3;
#else
    if (N_LAUNCHES == 1) { lo[0] = 0; hi[0] = N_PHASES; nl = 1; } else { for (int k = 0; k < N_PHASES; ++k) { lo[k] = k; hi[k] = k + 1; } nl = N_PHASES; }
#endif
    if (hipMemsetAsync((char*)d_ws + WS_CTL, 0, (size_t)(CW_BAR + nl * XCD_BAR_WORDS) * 4, stream) != hipSuccess) return;
    for (int li = 0; li < nl; ++li) {
        a.ph_lo = lo[li]; a.ph_hi = hi[li]; a.li = li;
        hipLaunchKernelGGL(hymba_fwd, dim3(grid), dim3(NWAVES * 64), LDS_BYTES, stream, a);
    }
#ifdef MK_DUMP_OFF
    hipLaunchKernelGGL(dump_kernel, dim3(2048), dim3(256), 0, stream, (const unsigned short*)((const unsigned char*)d_ws + (size_t)(MK_DUMP_OFF) * MiB), (float*)d_out, (size_t)(MK_DUMP_N));
#endif
}
```

```cpp
#define MK_N_LAUNCHES 1
#include <hip/hip_runtime.h>
#include <cstdio>
#include <cstdint>
#include <cmath>
namespace pg8 {
#define PG8_LAS __attribute__((address_space(3)))
typedef unsigned short bf16_t;
typedef short bf16x8 __attribute__((ext_vector_type(8)));
typedef float f32x4 __attribute__((ext_vector_type(4)));
typedef unsigned u32x4 __attribute__((ext_vector_type(4)));
typedef int i32x4 __attribute__((ext_vector_type(4)));
typedef int i32x8 __attribute__((ext_vector_type(8)));
__device__ __forceinline__ i32x8 cat8(bf16x8 lo, bf16x8 hi) { return __builtin_shufflevector(__builtin_bit_cast(i32x4, lo), __builtin_bit_cast(i32x4, hi), 0, 1, 2, 3, 4, 5, 6, 7); }
constexpr int BM = 256, BK = 64, HALF = 128, HTB = HALF * BK * 2  , STAGE_BYTES = 8 * HTB, NXCD = 8, WGM = 4;

__host__ __device__ __forceinline__ int lds_byte(int r, int c) { const int st = (r >> 4) * 2 + (c >> 5), rr = r & 15, cc = c & 31, ob = rr * 64 + cc * 2; return st * 1024 + (ob ^ (((ob >> 9) & 1) << 5)); }
__host__ __device__ __forceinline__ void stage_rc(int b, int& R, int& C) { const int st = b / 1024, sb = b % 1024, swz = sb ^ (((sb >> 9) & 1) << 5); R = (st >> 1) * 16 + swz / 64; C = (st & 1) * 32 + (swz % 64) / 2; }
__host__ __device__ __forceinline__ int perm32(int rho) { const int n = rho >> 4, i = rho & 15; return 8 * (i >> 2) + 4 * n + (i & 3); }

struct Unit { int pm, pn; };
struct Gemm { const bf16_t* A; const bf16_t* Bt; int M, N, K; };

struct StaticOrder {
    int nM, nN, nwg, G, c, wgm;
    __host__ __device__ void init(int M, int N, int G_, int c_, int wgm_ = WGM) { nM = M / BM; nN = N / BM; nwg = nM * nN; G = G_; c = c_; wgm = wgm_; }
    __host__ __device__ bool next(int i, Unit& u) const {
        const long L = (long)i * G + c; if (L >= nwg) return false;
        int wgid = (int)L; { const int q = nwg / NXCD, r = nwg % NXCD, xcd = wgid % NXCD, off = wgid / NXCD; wgid = (xcd < r ? xcd * (q + 1) : r * (q + 1) + (xcd - r) * q) + off; }
        const int nig = wgm * nN, gid = wgid / nig, fm = gid * wgm, gsz = (nM - fm) < wgm ? (nM - fm) : wgm;
        u.pm = fm + ((wgid % nig) % gsz); u.pn = (wgid % nig) / gsz; return true;
    }
    __device__ __forceinline__ void a_ready(const Unit&) const {}
    __device__ __forceinline__ void done(const Unit&) const {}
};

__device__ __forceinline__ unsigned cvt_pk_bf16(float lo, float hi) { unsigned r; asm volatile("v_cvt_pk_bf16_f32 %0, %1, %2" : "=v"(r) : "v"(lo), "v"(hi)); return r; }
typedef float f32x2 __attribute__((ext_vector_type(2)));
__device__ __forceinline__ f32x2 gelu_pk(f32x2 v) {
    const f32x2 av = __builtin_elementwise_abs(v), d = av * 0.2316418882f + 1.0f;
    f32x2 t; t.x = __builtin_amdgcn_rcpf(d.x); t.y = __builtin_amdgcn_rcpf(d.y);
    f32x2 q = t * 0.5307027145f + (-0.7265760135f); q = q * t + 0.7107068705f; q = q * t + (-0.142248368f); q = q * t + 0.127414796f; q = q * t;
    const f32x2 s = (v * v) * (-0.72134752044f);
    f32x2 e; e.x = __builtin_amdgcn_exp2f(s.x); e.y = __builtin_amdgcn_exp2f(s.y);
    const f32x2 m = v * (q * e), r = v - m;
    f32x2 o; o.x = v.x < 0.f ? m.x : r.x; o.y = v.y < 0.f ? m.y : r.y; return o;
}

template <int ACT  > struct EpiBf16 {
    static constexpr bool PERM = true, AFTER_DRAIN = false; static_assert(ACT == 0 || ACT == 1, "EpiBf16: ACT is 0 (none) or 1 (gelu_pk)");
    bf16_t* O; int ldc; const float* bias; int split_cols; size_t split_stride; float scale0;
    __device__ __forceinline__ void operator()(const f32x4 (&acc)[2][2][4][2], const Unit& u, int wr, int wc, int fr, int fq) const {
        const int row0 = u.pm * BM + wr * 64 + fr; int colt = u.pn * BM; bf16_t* base = O;
        float sc = 1.f; if (split_cols) { const int t = colt / split_cols; base += (size_t)t * split_stride; colt -= t * split_cols; if (t == 0) sc = scale0; }
        const int col0 = colt + wc * 32 + 8 * fq, bcol0 = u.pn * BM + wc * 32 + 8 * fq;
        f32x4 bv[2][2];
#pragma unroll
        for (int bj = 0; bj < 2; ++bj)
#pragma unroll
            for (int n = 0; n < 2; ++n) bv[bj][n] = bias ? *(const f32x4*)(bias + bcol0 + bj * HALF + 4 * n) : (f32x4){0.f, 0.f, 0.f, 0.f};
#pragma unroll
        for (int ai = 0; ai < 2; ++ai)
#pragma unroll
            for (int m = 0; m < 4; ++m) { bf16_t* rowp = base + (size_t)(row0 + ai * HALF + m * 16) * ldc + col0;
#pragma unroll
                for (int bj = 0; bj < 2; ++bj) { f32x4 v0 = acc[ai][bj][m][0] + bv[bj][0], v1 = acc[ai][bj][m][1] + bv[bj][1];
                    if (ACT == 1) { f32x2 a = gelu_pk((f32x2){v0[0], v0[1]}), b = gelu_pk((f32x2){v0[2], v0[3]}), c = gelu_pk((f32x2){v1[0], v1[1]}), d = gelu_pk((f32x2){v1[2], v1[3]});
                        v0 = (f32x4){a.x, a.y, b.x, b.y}; v1 = (f32x4){c.x, c.y, d.x, d.y}; }
                    v0 = v0 * sc; v1 = v1 * sc; u32x4 w; w.x = cvt_pk_bf16(v0[0], v0[1]); w.y = cvt_pk_bf16(v0[2], v0[3]); w.z = cvt_pk_bf16(v1[0], v1[1]); w.w = cvt_pk_bf16(v1[2], v1[3]);
                    *(u32x4*)(rowp + bj * HALF) = w; } }
    }
};
__device__ __forceinline__ float fast_sigmoid(float v) { return __builtin_amdgcn_rcpf(1.0f + __expf(-v)); }
__device__ __forceinline__ float bf_lo(unsigned w) { return __uint_as_float(w << 16); }
__device__ __forceinline__ float bf_hi(unsigned w) { return __uint_as_float(w & 0xffff0000u); }
struct EpiGlu {
    static constexpr bool PERM = true, AFTER_DRAIN = false;
    const bf16_t* Z; bf16_t* O; const float* bias;
    __device__ __forceinline__ void operator()(const f32x4 (&acc)[2][2][4][2], const Unit& u, int wr, int wc, int fr, int fq) const {
        const int row0 = u.pm * BM + wr * 64 + fr, col0 = u.pn * BM + wc * 32 + 8 * fq;
        f32x4 bv[2][2];
#pragma unroll
        for (int bj = 0; bj < 2; ++bj)
#pragma unroll
            for (int n = 0; n < 2; ++n) bv[bj][n] = *(const f32x4*)(bias + col0 + bj * HALF + 4 * n);
#pragma unroll
        for (int ai = 0; ai < 2; ++ai) {
            u32x4 z[4][2];
#pragma unroll
            for (int m = 0; m < 4; ++m)
#pragma unroll
                for (int bj = 0; bj < 2; ++bj) z[m][bj] = *(const u32x4*)(Z + (size_t)(row0 + ai * HALF + m * 16) * 1024 + col0 + bj * HALF);
#pragma unroll
            for (int m = 0; m < 4; ++m) { const size_t row = (size_t)(row0 + ai * HALF + m * 16);
#pragma unroll
                for (int bj = 0; bj < 2; ++bj) { const int col = col0 + bj * HALF; const u32x4 zz = z[m][bj];
                    const f32x4 v0 = acc[ai][bj][m][0] + bv[bj][0], v1 = acc[ai][bj][m][1] + bv[bj][1];
                    u32x4 w;
                    w.x = cvt_pk_bf16(bf_lo(zz.x) * fast_sigmoid(v0[0]), bf_hi(zz.x) * fast_sigmoid(v0[1]));
                    w.y = cvt_pk_bf16(bf_lo(zz.y) * fast_sigmoid(v0[2]), bf_hi(zz.y) * fast_sigmoid(v0[3]));
                    w.z = cvt_pk_bf16(bf_lo(zz.z) * fast_sigmoid(v1[0]), bf_hi(zz.z) * fast_sigmoid(v1[1]));
                    w.w = cvt_pk_bf16(bf_lo(zz.w) * fast_sigmoid(v1[2]), bf_hi(zz.w) * fast_sigmoid(v1[3]));
                    *(u32x4*)(O + row * 2048 + 1024 + col) = w; } } }
    }
};
template <bool SCALED> struct EpiSS {
    static constexpr bool PERM = true, AFTER_DRAIN = false;
    bf16_t* O; int ldc; float* SS; float scale;
    __device__ __forceinline__ void operator()(const f32x4 (&acc)[2][2][4][2], const Unit& u, int wr, int wc, int fr, int fq) const {
        const int row0 = u.pm * BM + wr * 64 + fr, col0 = u.pn * BM + wc * 32 + 8 * fq;
        float s[2][4];
#pragma unroll
        for (int ai = 0; ai < 2; ++ai)
#pragma unroll
            for (int m = 0; m < 4; ++m) { const size_t row = (size_t)(row0 + ai * HALF + m * 16); float t = 0.f;
#pragma unroll
                for (int bj = 0; bj < 2; ++bj) { f32x4 v0 = acc[ai][bj][m][0], v1 = acc[ai][bj][m][1]; if (SCALED) { v0 = v0 * scale; v1 = v1 * scale; }
                    t += (v0[0] * v0[0] + v0[1] * v0[1]) + (v0[2] * v0[2] + v0[3] * v0[3]) + (v1[0] * v1[0] + v1[1] * v1[1]) + (v1[2] * v1[2] + v1[3] * v1[3]);
                    u32x4 w; w.x = cvt_pk_bf16(v0[0], v0[1]); w.y = cvt_pk_bf16(v0[2], v0[3]); w.z = cvt_pk_bf16(v1[0], v1[1]); w.w = cvt_pk_bf16(v1[2], v1[3]);
                    *(u32x4*)(O + row * ldc + col0 + bj * HALF) = w; }
                s[ai][m] = t; }
#pragma unroll
        for (int ai = 0; ai < 2; ++ai)
#pragma unroll
            for (int m = 0; m < 4; ++m) s[ai][m] += __shfl_xor(s[ai][m], 16);
#pragma unroll
        for (int ai = 0; ai < 2; ++ai)
#pragma unroll
            for (int m = 0; m < 4; ++m) s[ai][m] += __shfl_xor(s[ai][m], 32);
        if (fq == 0) {
#pragma unroll
            for (int ai = 0; ai < 2; ++ai)
#pragma unroll
                for (int m = 0; m < 4; ++m) SS[(size_t)(row0 + ai * HALF + m * 16) * 32 + u.pn * 4 + wc] = s[ai][m]; }
    }
};
struct EpiGU {
    static constexpr bool PERM = true, AFTER_DRAIN = false;
    bf16_t* O; int ldc;
    static __device__ __forceinline__ unsigned swiglu_pk(f32x2 g, f32x2 u) {
        const f32x2 t = g * -1.4426950408889634f; f32x2 e; e.x = __builtin_amdgcn_exp2f(t.x); e.y = __builtin_amdgcn_exp2f(t.y);
        const f32x2 d = e + 1.0f; f32x2 s; s.x = __builtin_amdgcn_rcpf(d.x); s.y = __builtin_amdgcn_rcpf(d.y);
        const f32x2 o = (g * u) * s; return cvt_pk_bf16(o.x, o.y);
    }
    __device__ __forceinline__ void operator()(const f32x4 (&acc)[2][2][4][2], const Unit& u, int wr, int wc, int fr, int fq) const {
        const int row0 = u.pm * BM + wr * 64 + fr, col0 = u.pn * HALF + wc * 32 + 8 * fq;
#pragma unroll
        for (int ai = 0; ai < 2; ++ai)
#pragma unroll
            for (int m = 0; m < 4; ++m) { const size_t row = (size_t)(row0 + ai * HALF + m * 16);
                const f32x4 g0 = acc[ai][0][m][0], g1 = acc[ai][0][m][1], u0 = acc[ai][1][m][0], u1 = acc[ai][1][m][1];
                u32x4 w;
                w.x = swiglu_pk((f32x2){g0[0], g0[1]}, (f32x2){u0[0], u0[1]});
                w.y = swiglu_pk((f32x2){g0[2], g0[3]}, (f32x2){u0[2], u0[3]});
                w.z = swiglu_pk((f32x2){g1[0], g1[1]}, (f32x2){u1[0], u1[1]});
                w.w = swiglu_pk((f32x2){g1[2], g1[3]}, (f32x2){u1[2], u1[3]});
                *(u32x4*)(O + row * ldc + col0) = w; }
    }
};
struct EpiGU8 {
    static constexpr bool PERM = true, AFTER_DRAIN = false;
    unsigned char* O; int ldc;
    static __device__ __forceinline__ f32x2 swiglu2(f32x2 g, f32x2 u) {
        const f32x2 t = g * -1.4426950408889634f; f32x2 e; e.x = __builtin_amdgcn_exp2f(t.x); e.y = __builtin_amdgcn_exp2f(t.y);
        const f32x2 d = e + 1.0f; f32x2 s; s.x = __builtin_amdgcn_rcpf(d.x); s.y = __builtin_amdgcn_rcpf(d.y);
        f32x2 o = (g * u) * s; o.x = __builtin_amdgcn_fmed3f(o.x, -448.f, 448.f); o.y = __builtin_amdgcn_fmed3f(o.y, -448.f, 448.f); return o;
    }
    __device__ __forceinline__ void operator()(const f32x4 (&acc)[2][2][4][2], const Unit& u, int wr, int wc, int fr, int fq) const {
        const int row0 = u.pm * BM + wr * 64 + fr, col0 = u.pn * HALF + wc * 32 + 8 * fq;
#pragma unroll
        for (int ai = 0; ai < 2; ++ai)
#pragma unroll
            for (int m = 0; m < 4; ++m) { const size_t row = (size_t)(row0 + ai * HALF + m * 16);
                const f32x4 g0 = acc[ai][0][m][0], g1 = acc[ai][0][m][1], u0 = acc[ai][1][m][0], u1 = acc[ai][1][m][1];
                const f32x2 a = swiglu2((f32x2){g0[0], g0[1]}, (f32x2){u0[0], u0[1]}), b = swiglu2((f32x2){g0[2], g0[3]}, (f32x2){u0[2], u0[3]});
                const f32x2 c = swiglu2((f32x2){g1[0], g1[1]}, (f32x2){u1[0], u1[1]}), d = swiglu2((f32x2){g1[2], g1[3]}, (f32x2){u1[2], u1[3]});
                int w0 = 0, w1 = 0;
                w0 = __builtin_amdgcn_cvt_pk_fp8_f32(a.x, a.y, w0, false); w0 = __builtin_amdgcn_cvt_pk_fp8_f32(b.x, b.y, w0, true);
                w1 = __builtin_amdgcn_cvt_pk_fp8_f32(c.x, c.y, w1, false); w1 = __builtin_amdgcn_cvt_pk_fp8_f32(d.x, d.y, w1, true);
                typedef unsigned u32x2_t __attribute__((ext_vector_type(2)));
                *(u32x2_t*)(O + row * ldc + col0) = (u32x2_t){(unsigned)w0, (unsigned)w1}; }
    }
};
template <class Epi, class Sched, bool ALIGN_EPI = false, bool SP2 = false, bool F8 = false>
__device__ __forceinline__ void gemm_phase(PG8_LAS unsigned char* lds, const Gemm g, const Sched& S, const Epi& E) {
    int tid = threadIdx.x; asm volatile("" : "+v"(tid));
    const int wid = __builtin_amdgcn_readfirstlane(tid >> 6), lane = tid & 63, wr = wid >> 2, wc = wid & 3, fr = lane & 15, fq = lane >> 4;
    const int K = g.K, nt = K / BK;
    unsigned voffA[2], voffB[2];
#pragma unroll
    for (int i = 0; i < 2; ++i) { int R, C; stage_rc(tid * 16 + i * 8192, R, C); const int Rb = Epi::PERM ? ((R & ~31) + perm32(R & 31)) : R;
        voffA[i] = (unsigned)(R * K + C) * 2u; voffB[i] = (unsigned)(Rb * K + C) * 2u; }
    const size_t kstep = (size_t)(BK * 2);
    const size_t hstep = (size_t)HALF * K * 2;
    const size_t tstep = 2 * hstep;
    const unsigned ldsw = (unsigned)wid * 1024u;
    const int aoff = lds_byte(wr * 64 + fr, fq * 8), boff = lds_byte(wc * 32 + fr, fq * 8);
#define PG8_SA(b, h) (((b) * 2 + (h)) * HTB)
#define PG8_SB(b, h) ((4 + (b) * 2 + (h)) * HTB)
#define PG8_STAGE(bufoff, gbase, voff) do { _Pragma("unroll") for (int _i = 0; _i < 2; ++_i) { unsigned _vo = (voff)[_i]; asm volatile("" : "+v"(_vo));     \
        __builtin_amdgcn_global_load_lds((const unsigned*)((const char*)(gbase) + _vo), (PG8_LAS unsigned*)(lds + (bufoff) + ldsw + _i * 8192), 16, 0, 0); } } while (0)
#define PG8_LDA(dst, b, h) do { _Pragma("unroll") for (int m = 0; m < 4; ++m) _Pragma("unroll") for (int k = 0; k < 2; ++k) dst[m][k] = *(const PG8_LAS bf16x8*)(lds + PG8_SA(b, h) + aoff + m * 2048 + k * 1024); } while (0)
#define PG8_LDB(dst, b, h) do { _Pragma("unroll") for (int n = 0; n < 2; ++n) _Pragma("unroll") for (int k = 0; k < 2; ++k) dst[n][k] = *(const PG8_LAS bf16x8*)(lds + PG8_SB(b, h) + boff + n * 2048 + k * 1024); } while (0)
#define PG8_MMA(ai, bj, At, Bt) do { __builtin_amdgcn_s_setprio(1); \
        if constexpr (F8) { _Pragma("unroll") for (int m = 0; m < 4; ++m) _Pragma("unroll") for (int n = 0; n < 2; ++n) \
            acc[ai][bj][m][n] = __builtin_amdgcn_mfma_scale_f32_16x16x128_f8f6f4(cat8(Bt[n][0], Bt[n][1]), cat8(At[m][0], At[m][1]), acc[ai][bj][m][n], 0, 0, 0, 0, 0, 0); } \
        else { _Pragma("unroll") for (int m = 0; m < 4; ++m) _Pragma("unroll") for (int n = 0; n < 2; ++n) _Pragma("unroll") for (int k = 0; k < 2; ++k) \
            acc[ai][bj][m][n] = __builtin_amdgcn_mfma_f32_16x16x32_bf16(Bt[n][k], At[m][k], acc[ai][bj][m][n], 0, 0, 0); } \
        __builtin_amdgcn_s_setprio(0); } while (0)
#define PG8_WAIT_V(n) asm volatile("s_waitcnt vmcnt(" #n ")" ::: "memory")
#define PG8_WAIT_L(n) asm volatile("s_waitcnt lgkmcnt(" #n ")" ::: "memory")
#define PG8_BAR __builtin_amdgcn_s_barrier()
#define PG8_SCHED __builtin_amdgcn_sched_barrier(0)
    Unit cur, nxt; int ui = 0;
    if (!S.next(0, cur)) return;
    f32x4 acc[2][2][4][2];
#pragma unroll
    for (int a = 0; a < 2; ++a)
#pragma unroll
        for (int b = 0; b < 2; ++b)
#pragma unroll
            for (int m = 0; m < 4; ++m)
#pragma unroll
                for (int n = 0; n < 2; ++n) acc[a][b][m][n] = (f32x4){0.f, 0.f, 0.f, 0.f};
    bf16x8 At[4][2], B0[2][2], B1[2][2];
    const char* cA = (const char*)g.A + (size_t)cur.pm * tstep; const char* cB = (const char*)g.Bt + (size_t)cur.pn * tstep;
    S.a_ready(cur);
    if constexpr (SP2) {
        PG8_STAGE(PG8_SB(0, 0), cB, voffB); PG8_STAGE(PG8_SB(0, 1), cB + hstep, voffB); PG8_STAGE(PG8_SA(0, 0), cA, voffA); PG8_STAGE(PG8_SA(0, 1), cA + hstep, voffA);
        if (wr == 1) PG8_BAR;
        PG8_WAIT_V(2); PG8_BAR;
        PG8_STAGE(PG8_SB(1, 0), cB + kstep, voffB); PG8_STAGE(PG8_SA(1, 0), cA + kstep, voffA); PG8_STAGE(PG8_SB(1, 1), cB + hstep + kstep, voffB);
        PG8_WAIT_V(6); PG8_BAR;
    } else {
        PG8_STAGE(PG8_SB(0, 0), cB, voffB); PG8_STAGE(PG8_SA(0, 0), cA, voffA); PG8_STAGE(PG8_SB(0, 1), cB + hstep, voffB); PG8_STAGE(PG8_SA(0, 1), cA + hstep, voffA);
        if (wr == 1) PG8_BAR;
        PG8_WAIT_V(4); PG8_BAR;
        PG8_STAGE(PG8_SB(1, 0), cB + kstep, voffB); PG8_STAGE(PG8_SA(1, 0), cA + kstep, voffA); PG8_STAGE(PG8_SB(1, 1), cB + hstep + kstep, voffB);
        PG8_WAIT_V(6); PG8_BAR;
    }
    for (;;) {
        const bool has_next = S.next(ui + 1, nxt);
        const char* nA = has_next ? (const char*)g.A + (size_t)nxt.pm * tstep : cA; const char* nB = has_next ? (const char*)g.Bt + (size_t)nxt.pn * tstep : cB;
        for (int t = 0; t < nt; t += 2) {
            const bool last = (t == nt - 2);
            const char* a1 = cA + (size_t)(t + 1) * kstep;
            const char* a2 = last ? nA : cA + (size_t)(t + 2) * kstep; const char* b2 = last ? nB : cB + (size_t)(t + 2) * kstep;
            const char* a3 = a2 + kstep; const char* b3 = b2 + kstep;
            if (last && has_next) S.a_ready(nxt);
            if constexpr (SP2) {
            PG8_LDB(B0, 0, 0); PG8_LDB(B1, 0, 1); PG8_SCHED; PG8_LDA(At, 0, 0); PG8_STAGE(PG8_SA(1, 1), a1 + hstep, voffA);
            PG8_WAIT_V(8); PG8_WAIT_L(0); PG8_BAR; PG8_MMA(0, 0, At, B0); PG8_MMA(0, 1, At, B1); PG8_BAR; PG8_SCHED;
            PG8_LDA(At, 0, 1); PG8_STAGE(PG8_SB(0, 0), b2, voffB); PG8_STAGE(PG8_SB(0, 1), b2 + hstep, voffB); PG8_STAGE(PG8_SA(0, 0), a2, voffA);
            PG8_WAIT_V(8); PG8_WAIT_L(0); PG8_BAR; PG8_MMA(1, 0, At, B0); PG8_MMA(1, 1, At, B1); PG8_BAR; PG8_SCHED;
            PG8_LDB(B0, 1, 0); PG8_LDB(B1, 1, 1); PG8_SCHED; PG8_LDA(At, 1, 0); PG8_STAGE(PG8_SA(0, 1), a2 + hstep, voffA);
            PG8_WAIT_V(8); PG8_WAIT_L(0); PG8_BAR; PG8_MMA(0, 0, At, B0); PG8_MMA(0, 1, At, B1); PG8_BAR; PG8_SCHED;
            PG8_LDA(At, 1, 1); PG8_STAGE(PG8_SB(1, 0), b3, voffB); PG8_STAGE(PG8_SB(1, 1), b3 + hstep, voffB); PG8_STAGE(PG8_SA(1, 0), a3, voffA);
            PG8_WAIT_V(8); PG8_WAIT_L(0); PG8_BAR; PG8_MMA(1, 0, At, B0); PG8_MMA(1, 1, At, B1); PG8_BAR; PG8_SCHED;
            } else {
            PG8_LDB(B0, 0, 0); PG8_SCHED; PG8_LDA(At, 0, 0); PG8_STAGE(PG8_SA(1, 1), a1 + hstep, voffA);
            PG8_WAIT_L(8); PG8_BAR; PG8_WAIT_L(0); PG8_MMA(0, 0, At, B0); PG8_BAR; PG8_SCHED;
            PG8_LDB(B1, 0, 1); PG8_STAGE(PG8_SB(0, 0), b2, voffB);
            PG8_BAR; PG8_WAIT_L(0); PG8_MMA(0, 1, At, B1); PG8_BAR;
            PG8_LDA(At, 0, 1); PG8_STAGE(PG8_SA(0, 0), a2, voffA);
            PG8_BAR; PG8_WAIT_L(0); PG8_MMA(1, 0, At, B0); PG8_BAR; PG8_SCHED;
            PG8_STAGE(PG8_SB(0, 1), b2 + hstep, voffB);
            PG8_WAIT_V(6); PG8_BAR; PG8_MMA(1, 1, At, B1); PG8_BAR;
            PG8_LDB(B0, 1, 0); PG8_SCHED; PG8_LDA(At, 1, 0); PG8_STAGE(PG8_SA(0, 1), a2 + hstep, voffA);
            PG8_WAIT_L(8); PG8_BAR; PG8_WAIT_L(0); PG8_MMA(0, 0, At, B0); PG8_BAR; PG8_SCHED;
            PG8_LDB(B1, 1, 1); PG8_STAGE(PG8_SB(1, 0), b3, voffB);
            PG8_BAR; PG8_WAIT_L(0); PG8_MMA(0, 1, At, B1); PG8_BAR;
            PG8_LDA(At, 1, 1); PG8_STAGE(PG8_SA(1, 0), a3, voffA);
            PG8_BAR; PG8_WAIT_L(0); PG8_MMA(1, 0, At, B0); PG8_BAR; PG8_SCHED;
            PG8_STAGE(PG8_SB(1, 1), b3 + hstep, voffB);
            PG8_WAIT_V(6); PG8_BAR; PG8_MMA(1, 1, At, B1); PG8_BAR;
            }
        }
        if constexpr (ALIGN_EPI) { if (wr == 0) PG8_BAR; }
        if constexpr (!Epi::AFTER_DRAIN) { int t2 = threadIdx.x; asm volatile("" : "+v"(t2)); E(acc, cur, wr, wc, t2 & 15, (t2 >> 4) & 3); S.done(cur); }
        if (!has_next) break;
#pragma unroll
        for (int a = 0; a < 2; ++a)
#pragma unroll
            for (int b = 0; b < 2; ++b)
#pragma unroll
                for (int m = 0; m < 4; ++m)
#pragma unroll
                    for (int n = 0; n < 2; ++n) acc[a][b][m][n] = (f32x4){0.f, 0.f, 0.f, 0.f};
        cur = nxt; cA = nA; cB = nB; ++ui;
        if constexpr (ALIGN_EPI) { if (wr == 1) PG8_BAR; }
    }
    PG8_WAIT_V(0);
    if constexpr (!ALIGN_EPI) { if (wr == 0) PG8_BAR; }
    PG8_BAR;
    if constexpr (Epi::AFTER_DRAIN) { E.fused(acc, cur, wr, wc, fr, fq, lds, wid, lane); S.done(cur); }
#undef PG8_SA
#undef PG8_SB
#undef PG8_STAGE
#undef PG8_LDA
#undef PG8_LDB
#undef PG8_MMA
#undef PG8_WAIT_V
#undef PG8_WAIT_L
#undef PG8_BAR
#undef PG8_SCHED
}
}
#define GAS __attribute__((address_space(1)))
#define LAS __attribute__((address_space(3)))
typedef unsigned short bf16;
typedef unsigned v4u __attribute__((ext_vector_type(4)));
typedef float f32x4 __attribute__((ext_vector_type(4)));
typedef short bf16x8 __attribute__((ext_vector_type(8)));
typedef GAS unsigned gu32;
typedef GAS unsigned long long gu64;
#define RLX_AGENT __ATOMIC_RELAXED, __HIP_MEMORY_SCOPE_AGENT
#define LDS_WAIT() asm volatile("s_waitcnt lgkmcnt(0)" ::: "memory")
#define VM_WAIT() asm volatile("s_waitcnt vmcnt(0)" ::: "memory")
__device__ __forceinline__ unsigned long long rt() { return __builtin_amdgcn_s_memrealtime(); }
__device__ __forceinline__ unsigned f2bf(float f) { unsigned u = __builtin_bit_cast(unsigned, f); return (u + 0x7fffu + ((u >> 16) & 1u)) >> 16; }
__device__ __forceinline__ unsigned pk2(float lo, float hi) { return f2bf(lo) | (f2bf(hi) << 16); }
#define XB_TMO      128
#define XB_XCNT(j)  (256  + 64 * (j))
#define XB_XSUB(j)  (1280 + 64 * (j))
#define XB_XGEN(j)  (2304 + 64 * (j))
#define XB_TOP      3328
#define XB_TOPGEN   3392
#define XCD_BAR_WORDS 3456
#define XB_SPIN_CAP (1u << 18)

__device__ __forceinline__ unsigned xb_ld(unsigned* p)              { return __hip_atomic_load(p, __ATOMIC_RELAXED, __HIP_MEMORY_SCOPE_AGENT); }
__device__ __forceinline__ unsigned xb_add(unsigned* p, unsigned v) { return __hip_atomic_fetch_add(p, v, __ATOMIC_RELAXED, __HIP_MEMORY_SCOPE_AGENT); }
__device__ __forceinline__ unsigned xb_xcc_id() { return (unsigned)__builtin_amdgcn_s_getreg((3 << 11) | 20) & 0xFu; }
#define XB_SPIN(cond, bar) do { unsigned _sp = 0; while (cond) { __builtin_amdgcn_s_sleep(1); \
    if ((++_sp & 255u) == 0u) { if (xb_ld(&(bar)[XB_TMO])) break; if (_sp > XB_SPIN_CAP) { atomicAdd(&(bar)[XB_TMO], 1u); break; } } } } while (0)

struct XcdBarrier {
    unsigned* bar; unsigned x;
    volatile LAS unsigned* st;
};

__device__ __forceinline__ XcdBarrier xcd_barrier_post(unsigned* bar, volatile LAS unsigned* st) {
    XcdBarrier b; b.bar = bar; b.x = xb_xcc_id(); b.st = st;
    if (threadIdx.x == 0) (void)xb_add(&bar[XB_XCNT(b.x)], 1u);
    return b;
}
__device__ __forceinline__ void xcd_barrier_complete(unsigned* bar, unsigned x, unsigned& nloc, unsigned& nx) {
    const unsigned G = gridDim.x * gridDim.y * gridDim.z;
    unsigned sum, cnt, mine, sp = 0u;
    for (;;) {
        sum = 0u; cnt = 0u; mine = 0u;
#pragma unroll
        for (unsigned j = 0; j < 16; ++j) { const unsigned c = xb_ld(&bar[XB_XCNT(j)]); sum += c; cnt += (c > 0u) ? 1u : 0u; mine = (j == x) ? c : mine; }
        if (sum == G) break;
        __builtin_amdgcn_s_sleep(1);
        if ((++sp & 255u) == 0u) { if (xb_ld(&bar[XB_TMO])) break; if (sp > XB_SPIN_CAP) { atomicAdd(&bar[XB_TMO], 1u); break; } }
    }
    nloc = mine > 0u ? mine : 1u; nx = cnt > 0u ? cnt : 1u;
}

__device__ __forceinline__ void xcd_barrier(const XcdBarrier& b) {
    asm volatile("s_waitcnt vmcnt(0)" ::: "memory");
    __syncthreads();
    if (threadIdx.x == 0) {
        unsigned* bar = b.bar;
        __builtin_amdgcn_s_waitcnt(0);
        unsigned nloc = b.st[0], nx = b.st[1];
        if (nloc == 0u) { xcd_barrier_complete(bar, b.x, nloc, nx); b.st[0] = nloc; b.st[1] = nx; }
        const unsigned old = xb_add(&bar[XB_XSUB(b.x)], 1u);
        const unsigned gen = old / nloc;
        if (old + 1u == (gen + 1u) * nloc) {
            __builtin_amdgcn_fence(__ATOMIC_RELEASE, "agent");
            asm volatile("s_waitcnt vmcnt(0)" ::: "memory");
            const unsigned og = xb_add(&bar[XB_TOP], 1u);
            const unsigned tg = og / nx;
            if (og + 1u == (tg + 1u) * nx) xb_add(&bar[XB_TOPGEN], 1u);
            else XB_SPIN(xb_ld(&bar[XB_TOPGEN]) == tg, bar);
            __builtin_amdgcn_fence(__ATOMIC_ACQUIRE, "agent");
            asm volatile("s_waitcnt vmcnt(0)" ::: "memory");
        } else {
            __builtin_amdgcn_fence(__ATOMIC_ACQUIRE, "agent");
            XB_SPIN(xb_ld(&bar[XB_TOPGEN]) == gen, bar);
            asm volatile("s_waitcnt vmcnt(0)" ::: "memory");
        }
    }
    __syncthreads();
}
constexpr int NWAVES = 8;
#ifndef MK_N_LAUNCHES
#define MK_N_LAUNCHES 1
#endif
constexpr int N_PHASES = 10;
constexpr int N_LAUNCHES = MK_N_LAUNCHES;

constexpr int DM = 2048, NBATCH = 8, SEQ = 2048, MP = NBATCH * SEQ, SBATCH = 8, SLEN = 16, MS = SBATCH * SLEN, MT = MP + MS;
constexpr int NH = 4, DV = 256, DQK = 128, QKW = 1024, NG = 64, GCH = 16, PST = 64, DFF = 5632, NIN = 4104;
constexpr int CH = 64, NCH = SEQ / CH;
constexpr int NSC = NBATCH * NCH + SBATCH;
constexpr float EPS = 1e-6f;
constexpr int DVS = 64, NSL = DV / DVS;

constexpr size_t O_Y = 0, O_CONVP = (size_t)MT * DM, O_CP = O_CONVP + 8 * 3 * 1024, O_NP = O_CP + 8 * 4 * 256 * 128, O_MP = O_NP + 8 * 4 * 128,
                 O_SRP = O_MP + 32, O_SIP = O_SRP + 8 * 64 * 64, O_CONVS = O_SIP + 8 * 64 * 64, O_CS = O_CONVS + 8 * 3 * 1024, O_NS = O_CS + 8 * 4 * 256 * 128,
                 O_MS = O_NS + 8 * 4 * 128, O_SRS = O_MS + 32, O_SIS = O_SRS + 8 * 64 * 64, O_END = O_SIS + 8 * 64 * 64;
static_assert(O_END == 36102208, "d_out map");

constexpr size_t MiB = 1u << 20;
constexpr size_t WS_CTL = 0, CTL_ZERO_BYTES = 1 * MiB;
constexpr size_t WS_WIN = 2 * MiB, WS_WGLU = 18 * MiB, WS_WOUT = 20 * MiB, WS_WGU = 28 * MiB, WS_WD = 72 * MiB;
constexpr size_t WS_XN = 96 * MiB;
constexpr size_t WS_R0 = 162 * MiB, WS_RSTRIDE = 33 * MiB;
constexpr size_t WS_QKRAW = WS_R0, WS_V = WS_R0 + WS_RSTRIDE, WS_OG = WS_R0 + 2 * WS_RSTRIDE, WS_U = WS_R0 + 3 * WS_RSTRIDE;
constexpr size_t WS_Q = 294 * MiB, WS_K = 311 * MiB;
constexpr size_t WS_Z = WS_QKRAW;
constexpr size_t WS_MIXIN = WS_Q;
constexpr size_t WS_MIX = WS_R0;
constexpr size_t WS_ACT8 = WS_R0;
constexpr size_t WS_ACTS = WS_R0 + 90 * MiB;
constexpr size_t WS_X1B = WS_XN;
constexpr size_t WS_FF = 427 * MiB;
constexpr size_t WS_GATES = 378 * MiB, WS_HSS = 379 * MiB, WS_SS1 = 382 * MiB, WS_SS2 = 385 * MiB, WS_S5P = 388 * MiB, WS_SSS = 389 * MiB;
constexpr size_t WS_HS = 390 * MiB;
constexpr size_t WS_SCAL = 423 * MiB, WS_WD8 = 492 * MiB, WS_END = 504 * MiB;
static_assert(WS_XN + (size_t)MT * DM * 2 <= WS_R0 && WS_QKRAW + (size_t)MT * 1024 * 2 <= WS_V && WS_U + (size_t)MT * 1024 * 2 <= WS_Q && WS_Q + (size_t)MT * 512 * 2 <= WS_K &&
              WS_K + (size_t)MT * 512 * 2 <= WS_GATES && WS_MIXIN + (size_t)MT * DM * 2 <= WS_GATES && WS_MIX + (size_t)MT * DM * 2 <= WS_OG && WS_ACT8 + (size_t)MP * DFF <= WS_ACTS && WS_ACTS + (size_t)MS * DFF * 2 <= WS_GATES && WS_FF + (size_t)MT * DM * 2 <= WS_WD8 && WS_WD8 + (size_t)DM * DFF <= WS_END &&
              WS_WD + (size_t)DM * DFF * 2 <= WS_XN && WS_WGU + (size_t)2 * DFF * DM * 2 <= WS_WD && WS_HSS + (size_t)MT * 32 * 4 <= WS_SS1 && WS_SS1 + (size_t)MT * 32 * 4 <= WS_SS2 &&
              WS_SS2 + (size_t)MT * 32 * 4 <= WS_S5P && WS_GATES + (size_t)MT * 8 * 4 <= WS_HSS && WS_HS + (size_t)MT * 1024 * 2 <= WS_SCAL && WS_SCAL + (size_t)NSC * 4 * 384 * 4 <= WS_FF && WS_FF + (size_t)MT * DM * 2 <= WS_END, "d_ws map");
constexpr size_t S5P_LAM = 0, S5P_BBT = 64 * 1024, S5P_CC = S5P_BBT + 64 * 128 * 16 * 2;
constexpr size_t SSS_1 = 0, SSS_2 = 128 * 128 * 4, SSS_RSTD2 = 256 * 1024, SSS_RSTD1 = 384 * 1024;
constexpr int CW_TMO = 0, CW_CODE = 1, CW_BAR = 4096;

constexpr int RING_OFF = 0, RING_BYTES = 131072;
constexpr int LDSCTL_OFF = 151552, MISC_OFF = LDSCTL_OFF + 320;
constexpr int LDS_BYTES = 155648;
typedef short s16x4 __attribute__((ext_vector_type(4)));
typedef unsigned u32x2 __attribute__((ext_vector_type(2)));
struct Frame {
    LAS unsigned char* lds;
    volatile LAS unsigned* MISC;
    gu32* ctl;
    int tid, lane, wave;
    int vcu, G;
    const float* const* in;
    float* out; unsigned char* ws;
};
__device__ __forceinline__ float wave_sum(float v) {
#pragma unroll
    for (int o = 1; o < 64; o <<= 1) v += __shfl_xor(v, o);
    return v;
}
__device__ __forceinline__ unsigned cvtpk(float lo, float hi) { unsigned r; asm volatile("v_cvt_pk_bf16_f32 %0, %1, %2" : "=v"(r) : "v"(lo), "v"(hi)); return r; }
typedef __bf16 bf16x2n_t __attribute__((ext_vector_type(2)));
__device__ __forceinline__ unsigned cvtpk_n(float lo, float hi) { const bf16x2n_t v = {(__bf16)lo, (__bf16)hi}; return __builtin_bit_cast(unsigned, v); }
__device__ __forceinline__ float bflo(unsigned w) { return __uint_as_float(w << 16); }
__device__ __forceinline__ float bfhi(unsigned w) { return __uint_as_float(w & 0xffff0000u); }
__device__ __forceinline__ float bf2f(bf16 h) { return __uint_as_float((unsigned)h << 16); }
__device__ __forceinline__ float sigmoidf_(float v) { return __builtin_amdgcn_rcpf(1.0f + __expf(-v)); }
__device__ __forceinline__ f32x4 mfma16(bf16x8 a, bf16x8 b, f32x4 c) { return __builtin_amdgcn_mfma_f32_16x16x32_bf16(a, b, c, 0, 0, 0); }
#define WAVE_SYNC() do { asm volatile("s_waitcnt lgkmcnt(0)" ::: "memory"); __builtin_amdgcn_wave_barrier(); } while (0)

#ifdef MK_STAMP
#ifndef MK_STAMP_SCALE
#define MK_STAMP_SCALE 0.002f
#endif
#define DBG_DECL unsigned long long dbg_acc_ = 0, dbg_t0_ = 0;
__device__ __forceinline__ unsigned long long dbg_rt() { unsigned long long t; __builtin_amdgcn_sched_barrier(0);
#ifdef MK_STAMP_CYC
    asm volatile("s_memtime %0\n\ts_waitcnt lgkmcnt(0)" : "=s"(t) :: "memory");
#else
    asm volatile("s_memrealtime %0\n\ts_waitcnt lgkmcnt(0)" : "=s"(t) :: "memory");
#endif
 __builtin_amdgcn_sched_barrier(0); return t; }
#define DBG_BEGIN(id) do { if ((id) == MK_STAMP) dbg_t0_ = dbg_rt(); } while (0)
#define DBG_END(id) do { if ((id) == MK_STAMP) dbg_acc_ += dbg_rt() - dbg_t0_; } while (0)
#define DBG_REPORT(cond) do { if ((cond) && (threadIdx.x & 63) == 0 && (threadIdx.x >> 6) == MK_STAMP_WAVE) ((unsigned*)(A.ws + WS_CTL))[16] = (unsigned)dbg_acc_; } while (0)
#define DBG_PERTURB(V, m_) do { if ((m_) == 0 && lane == 0) V[0][0] += (float)__hip_atomic_load((unsigned*)(A.ws + WS_CTL) + 16, __ATOMIC_RELAXED, __HIP_MEMORY_SCOPE_AGENT) * MK_STAMP_SCALE; } while (0)
#else
#define DBG_DECL
#define DBG_BEGIN(id)
#define DBG_END(id)
#define DBG_REPORT(cond)
#define DBG_PERTURB(V, m_)
#endif
struct Args { const float* in[32]; float* out; unsigned char* ws; int ph_lo, ph_hi, li, pad; };
__device__ __forceinline__ int fresh_tid() { int t = threadIdx.x; asm volatile("" : "+v"(t)); return t; }
#define PHASE_IDS const int tid = fresh_tid(), lane = tid & 63; (void)tid; (void)lane;

__device__ __forceinline__ void p0_transpose_item(const float* W, int ldw, int src_col0, int k0, bf16* WT, int K, int out_row0, LAS float* scr, int lane, const float* kscale = nullptr) {
    if (kscale) {
#pragma unroll 8
        for (int i = 0; i < 32; ++i) { const int kk = 2 * i + (lane >> 5); scr[kk * 33 + (lane & 31)] = __builtin_nontemporal_load(W + (size_t)(k0 + kk) * ldw + src_col0 + (lane & 31)) * kscale[k0 + kk]; }
    } else {
#pragma unroll 8
    for (int i = 0; i < 32; ++i) { const int kk = 2 * i + (lane >> 5); scr[kk * 33 + (lane & 31)] = __builtin_nontemporal_load(W + (size_t)(k0 + kk) * ldw + src_col0 + (lane & 31)); }
    }
    LDS_WAIT(); asm volatile("" ::: "memory");
    const int c = lane & 7;
#pragma unroll
    for (int j = 0; j < 4; ++j) { const int n = (lane >> 3) + 8 * j; const LAS float* s = scr + (8 * c) * 33 + n;
        v4u o; o.x = pk2(s[0 * 33], s[1 * 33]); o.y = pk2(s[2 * 33], s[3 * 33]); o.z = pk2(s[4 * 33], s[5 * 33]); o.w = pk2(s[6 * 33], s[7 * 33]);
        *(GAS v4u*)(WT + (size_t)(out_row0 + n) * K + k0 + 8 * c) = o; }
    LDS_WAIT(); asm volatile("" ::: "memory");
}
__device__ __forceinline__ float log_sigmoid(float x) { return fminf(x, 0.f) - log1pf(__expf(-fabsf(x))); }

struct CvtItem { const float* W; int ldw, sc, k0; bf16* WT; int K, orow; const float* ks; unsigned char* W8; };
constexpr int CV_I_IN = (DM / 64) * (4096 / 32), CV_I_GLU = (1024 / 64) * (1024 / 32), CV_I_OUT = (DM / 64) * (DM / 32), CV_I_GU = (DM / 64) * (2 * DFF / 32), CV_I_D = (DFF / 64) * (DM / 32);
__device__ __forceinline__ CvtItem cvt_item(const Args& A, int it) {
    unsigned char* ws = A.ws; int r = it; CvtItem c;
    if (r < CV_I_IN) { const int nnb = 4096 / 32, kb = r / nnb, nb = r % nnb, orow = 32 * nb; c = CvtItem{A.in[9], NIN, orow < 3072 ? orow : orow + 8, 64 * kb, (bf16*)(ws + WS_WIN), DM, orow, nullptr, nullptr}; return c; } r -= CV_I_IN;
    if (r < CV_I_GLU) { const int nnb = 1024 / 32, kb = r / nnb, nb = r % nnb; c = CvtItem{A.in[23], 1024, 32 * nb, 64 * kb, (bf16*)(ws + WS_WGLU), 1024, 32 * nb, nullptr, nullptr}; return c; } r -= CV_I_GLU;
    if (r < CV_I_OUT) { const int nnb = DM / 32, kb = r / nnb, nb = r % nnb; c = CvtItem{A.in[25], DM, 32 * nb, 64 * kb, (bf16*)(ws + WS_WOUT), DM, 32 * nb, nullptr, nullptr}; return c; } r -= CV_I_OUT;
    if (r < CV_I_GU) { const int nnb = 2 * DFF / 32, kb = r / nnb, nb = r % nnb, orow = 32 * nb, pn = orow >> 8, cc = orow & 255;
        c = CvtItem{cc < 128 ? A.in[28] : A.in[29], DFF, 128 * pn + (cc & 127), 64 * kb, (bf16*)(ws + WS_WGU), DM, orow, A.in[27], nullptr}; return c; } r -= CV_I_GU;
    { const int nnb = DM / 32, kb = r / nnb, nb = r % nnb; c = CvtItem{A.in[30], DM, 32 * nb, 64 * kb, (bf16*)(ws + WS_WD), DFF, 32 * nb, nullptr, ws + WS_WD8}; return c; }
}
__device__ __forceinline__ void p0_prologue(const Args& A, LAS unsigned char* lds, int tid, int lane, int wave, int vcu, int G) {
    unsigned char* ws = A.ws;
    LAS float* WG = (LAS float*)lds;
    LAS float* scr = (LAS float*)(lds + wave * 8448);
    const int gw = vcu * NWAVES + wave, NGW = G * NWAVES;
    { constexpr int NIT = CV_I_IN + CV_I_GLU + CV_I_OUT + CV_I_GU + CV_I_D;
      float ra[32], rb[32]; CvtItem ia, ib;
#define CV_LOAD(R, I, it_) do { I = cvt_item(A, (it_)); \
        _Pragma("unroll") for (int i = 0; i < 32; ++i) { const int kk = 2 * i + (lane >> 5); R[i] = __builtin_nontemporal_load(I.W + (size_t)(I.k0 + kk) * I.ldw + I.sc + (lane & 31)); } } while (0)
#define F8C(v_) __builtin_amdgcn_fmed3f((v_) * 1024.0f, -448.f, 448.f)
#define CV_PROC(R, I) do { \
        if (I.ks) { _Pragma("unroll") for (int i = 0; i < 32; ++i) { const int kk = 2 * i + (lane >> 5); scr[kk * 33 + (lane & 31)] = R[i] * I.ks[I.k0 + kk]; } } \
        else { _Pragma("unroll") for (int i = 0; i < 32; ++i) { const int kk = 2 * i + (lane >> 5); scr[kk * 33 + (lane & 31)] = R[i]; } } \
        LDS_WAIT(); asm volatile("" ::: "memory"); \
        { const int c = lane & 7; \
          _Pragma("unroll") for (int j = 0; j < 4; ++j) { const int n = (lane >> 3) + 8 * j; const LAS float* s = scr + (8 * c) * 33 + n; \
              v4u o; o.x = pk2(s[0 * 33], s[1 * 33]); o.y = pk2(s[2 * 33], s[3 * 33]); o.z = pk2(s[4 * 33], s[5 * 33]); o.w = pk2(s[6 * 33], s[7 * 33]); \
              *(GAS v4u*)(I.WT + (size_t)(I.orow + n) * I.K + I.k0 + 8 * c) = o; \
              if (I.W8) { int w0 = 0, w1 = 0; \
                  w0 = __builtin_amdgcn_cvt_pk_fp8_f32(F8C(s[0 * 33]), F8C(s[1 * 33]), w0, false); w0 = __builtin_amdgcn_cvt_pk_fp8_f32(F8C(s[2 * 33]), F8C(s[3 * 33]), w0, true); \
                  w1 = __builtin_amdgcn_cvt_pk_fp8_f32(F8C(s[4 * 33]), F8C(s[5 * 33]), w1, false); w1 = __builtin_amdgcn_cvt_pk_fp8_f32(F8C(s[6 * 33]), F8C(s[7 * 33]), w1, true); \
                  *(GAS u32x2*)(I.W8 + (size_t)(I.orow + n) * I.K + I.k0 + 8 * c) = (u32x2){(unsigned)w0, (unsigned)w1}; } } } \
        LDS_WAIT(); asm volatile("" ::: "memory"); } while (0)
      int it = gw;
      if (it < NIT) { CV_LOAD(ra, ia, it);
          for (;;) { const int it2 = it + NGW; if (it2 < NIT) CV_LOAD(rb, ib, it2); CV_PROC(ra, ia); if (it2 >= NIT) break;
                     it = it2 + NGW; if (it < NIT) CV_LOAD(ra, ia, it); CV_PROC(rb, ib); if (it >= NIT) break; } }
#undef CV_LOAD
#undef CV_PROC
#undef F8C
    }
    { const int gt = vcu * (NWAVES * 64) + tid;
      if (gt < NG * PST) {
        const int g = gt >> 6, p = gt & 63;
        const double lr = (double)A.in[15][gt], li = (double)A.in[16][gt], dt = exp((double)A.in[17][g]);
        const double mag = exp(lr * dt), ang = li * dt, lbr = mag * cos(ang), lbi = mag * sin(ang);
        const double den = lr * lr + li * li, nr = lbr - 1.0, fre = (nr * lr + lbi * li) / den, fim = (lbi * lr - nr * li) / den;
        float* LAM = (float*)(ws + WS_S5P + S5P_LAM); LAM[gt * 2] = (float)lbr; LAM[gt * 2 + 1] = (float)lbi;
        bf16* BBT = (bf16*)(ws + WS_S5P + S5P_BBT); bf16* CC = (bf16*)(ws + WS_S5P + S5P_CC);
        const float* bre = A.in[18] + (size_t)gt * 16; const float* bim = A.in[19] + (size_t)gt * 16;
#pragma unroll
        for (int i = 0; i < 16; ++i) { const double br = bre[i], bi = bim[i];
            BBT[((size_t)g * 128 + 2 * p) * 16 + i] = (bf16)f2bf((float)(fre * br - fim * bi));
            BBT[((size_t)g * 128 + 2 * p + 1) * 16 + i] = (bf16)f2bf((float)(fre * bi + fim * br));
            CC[((size_t)g * 16 + i) * 128 + 2 * p] = (bf16)f2bf(A.in[20][((size_t)g * 16 + i) * 64 + p]);
            CC[((size_t)g * 16 + i) * 128 + 2 * p + 1] = (bf16)f2bf(-A.in[21][((size_t)g * 16 + i) * 64 + p]); }
      } }
    __syncthreads();
    { const float* win = A.in[9];
      for (int e = tid; e < 8 * 2048; e += NWAVES * 64) { const int k = e >> 3, c = e & 7; WG[c * 2048 + k] = win[(size_t)k * NIN + 3072 + c]; } }
    __syncthreads();
    { const GAS f32x4* gp = (const GAS f32x4*)A.in[8] + lane; f32x4 gv[8];
#pragma unroll
      for (int j = 0; j < 8; ++j) gv[j] = gp[64 * j];
      bf16* XN = (bf16*)(ws + WS_XN); float* GATES = (float*)(ws + WS_GATES);
      f32x4 va[8], vb[8];
#define P0R_LOAD(V, m_) do { const int mm_ = (m_); const float* xrow = mm_ < MP ? A.in[0] + (size_t)mm_ * DM : A.in[1] + (size_t)(mm_ - MP) * DM; const GAS f32x4* xr = (const GAS f32x4*)xrow + lane; \
        _Pragma("unroll") for (int j = 0; j < 8; ++j) V[j] = __builtin_nontemporal_load(xr + 64 * j); } while (0)
#define P0R_PROC(V, m_) do { const int mm_ = (m_); float s = 0.f; \
        _Pragma("unroll") for (int j = 0; j < 8; ++j) s += (V[j].x * V[j].x + V[j].y * V[j].y) + (V[j].z * V[j].z + V[j].w * V[j].w); \
        const float ms = wave_sum(s) * (1.0f / DM) + EPS, rstd = 1.0f / sqrtf(ms); \
        if (lane == 0) ((float*)(ws + WS_SSS + SSS_RSTD1))[mm_] = sqrtf(ms); \
        GAS u32x2* o8 = (GAS u32x2*)(XN + (size_t)mm_ * DM) + lane; \
        float ga[8] = {0.f, 0.f, 0.f, 0.f, 0.f, 0.f, 0.f, 0.f}; \
        _Pragma("unroll") for (int j = 0; j < 8; ++j) { V[j] = V[j] * rstd * gv[j]; u32x2 o; o.x = cvtpk(V[j].x, V[j].y); o.y = cvtpk(V[j].z, V[j].w); o8[64 * j] = o; \
            _Pragma("unroll") for (int c = 0; c < 8; ++c) { const f32x4 w = *(const LAS f32x4*)(WG + c * 2048 + 256 * j + 4 * lane); ga[c] += (V[j].x * w.x + V[j].y * w.y) + (V[j].z * w.z + V[j].w * w.w); } } \
        _Pragma("unroll") for (int c = 0; c < 8; ++c) ga[c] = wave_sum(ga[c]); \
        if (lane < 8) { float val = 0.f; \
            _Pragma("unroll") for (int c = 0; c < 8; ++c) if (lane == c) val = ga[c]; \
            if (lane < 4) val += A.in[12][lane]; else val = log_sigmoid(val + A.in[13][lane - 4]); \
            GATES[(size_t)mm_ * 8 + lane] = val; } } while (0)
      int m = gw;
      if (m < MT) { P0R_LOAD(va, m);
          for (;;) { const int m2 = m + NGW; if (m2 < MT) P0R_LOAD(vb, m2); P0R_PROC(va, m); if (m2 >= MT) break;
                     m = m2 + NGW; if (m < MT) P0R_LOAD(va, m); P0R_PROC(vb, m2); if (m >= MT) break; } }
#undef P0R_LOAD
#undef P0R_PROC
    }
}

template <int NACC, int K, int RBN = 8, class RowMap, class Epi>
__device__ __forceinline__ void skinny_gemm(const bf16* Arows, const bf16* Bt, LAS unsigned char* lds, int nitems, int first, int stride, int tid, int wave, int lane, RowMap rm, Epi epi) {
    const int fr = lane & 15, fq = lane >> 4;
    constexpr int KW = K / 8, NS = KW / 32, NSPLIT = 8 / RBN;
    static_assert(KW % 32 == 0, "skinny_gemm: K must be a multiple of 256");
    const bf16* abase = Arows + (size_t)fr * K + wave * KW + 8 * fq;
    LAS f32x4* red = (LAS f32x4*)lds;
    for (int piece = first; piece < nitems * NSPLIT; piece += stride) {
        const int it = piece / NSPLIT, rh = piece % NSPLIT;
        const bf16* brow[NACC]; f32x4 acc[NACC][RBN];
#pragma unroll
        for (int a = 0; a < NACC; ++a) { brow[a] = Bt + (size_t)rm(it, a, fr) * K + wave * KW + 8 * fq;
#pragma unroll
            for (int rb = 0; rb < RBN; ++rb) acc[a][rb] = (f32x4){0.f, 0.f, 0.f, 0.f}; }
        const bf16* ab = abase + (size_t)(16 * RBN * rh) * K;
#pragma unroll 2
        for (int s = 0; s < NS; ++s) {
            bf16x8 av[RBN], bv[NACC];
#pragma unroll
            for (int a = 0; a < NACC; ++a) bv[a] = *(const bf16x8*)(brow[a] + 32 * s);
#pragma unroll
            for (int rb = 0; rb < RBN; ++rb) av[rb] = *(const bf16x8*)(ab + (size_t)(16 * rb) * K + 32 * s);
#pragma unroll
            for (int rb = 0; rb < RBN; ++rb)
#pragma unroll
                for (int a = 0; a < NACC; ++a) acc[a][rb] = mfma16(bv[a], av[rb], acc[a][rb]);
        }
#pragma unroll
        for (int a = 0; a < NACC; ++a)
#pragma unroll
            for (int rb = 0; rb < RBN; ++rb) red[((a * 8 + wave) * RBN + rb) * 64 + lane] = acc[a][rb];
        __syncthreads();
        if (wave < RBN) {
            f32x4 fin[NACC];
#pragma unroll
            for (int a = 0; a < NACC; ++a) { f32x4 t = red[((a * 8 + 0) * RBN + wave) * 64 + lane];
#pragma unroll
                for (int w2 = 1; w2 < 8; ++w2) t += red[((a * 8 + w2) * RBN + wave) * 64 + lane];
                fin[a] = t; }
            epi(it, 16 * (RBN * rh + wave) + fr, fq, fin);
        }
        __syncthreads();
    }
}

__device__ __forceinline__ void p2_scalars(const Args& A, LAS unsigned char* lds, int lane, int wave, int item) {
    unsigned char* ws = A.ws;
    const float* GATES = (const float*)(ws + WS_GATES); float* SCAL = (float*)(ws + WS_SCAL);
    const int seq = item >> 2, h = item & 3; const bool sample = seq >= NBATCH; const int b = sample ? seq - NBATCH : seq;
    const int nch = sample ? 1 : NCH, L = sample ? SLEN : CH, row0 = sample ? MP + b * SLEN : b * SEQ, sc0 = sample ? NBATCH * NCH + b : b * NCH;
    LAS float* fl = (LAS float*)lds;
    float fc[4], a[4], pm[4];
#pragma unroll
    for (int i = 0; i < 4; ++i) { const int c = 4 * wave + i; float li = -INFINITY, lf = 0.f;
        if (c < nch && lane < L) { li = GATES[((size_t)row0 + c * CH + lane) * 8 + h]; lf = GATES[((size_t)row0 + c * CH + lane) * 8 + 4 + h]; }
        float f = lf;
#pragma unroll
        for (int d = 1; d < 64; d <<= 1) { const float o = __shfl_up(f, d); if (lane >= d) f += o; }
        const float aa = li - f; float p = aa;
#pragma unroll
        for (int d = 1; d < 64; d <<= 1) { const float o = __shfl_up(p, d); if (lane >= d) p = fmaxf(p, o); }
        fc[i] = f; a[i] = aa; pm[i] = p;
        if (lane == 63) { fl[c] = f; fl[32 + c] = p; } }
    __syncthreads();
    float m0c = 0.f, m0 = sample ? A.in[5][b * NH + h] : 0.f;
    for (int c = 0; c < nch; ++c) { if (lane == c) m0c = m0; m0 = fl[c] + fmaxf(fl[32 + c], m0); }
#pragma unroll
    for (int i = 0; i < 4; ++i) { const int c = 4 * wave + i;
        if (c < nch) { const float m0i = __shfl(m0c, c); const float mm = fmaxf(pm[i], m0i), mml = __shfl(mm, 63);
            float* o = SCAL + ((size_t)(sc0 + c) * 4 + h) * 384;
            o[lane] = a[i]; o[64 + lane] = mm; o[128 + lane] = __expf(m0i - mm); o[192 + lane] = __expf(-(fc[i] + mm)); o[256 + lane] = __expf(a[i] - mml);
            o[320 + lane] = (lane == 0) ? __expf(m0i - mml) : (__shfl(fc[i], 63) + mml); } }
    if (wave == 0 && lane == 0) A.out[(sample ? O_MS : O_MP) + b * NH + h] = m0;
    __syncthreads();
}
__device__ __forceinline__ void p2_conv(const Args& A, int tid, int vcu, int G) {
    unsigned char* ws = A.ws;
    const bf16* QKRAW = (const bf16*)(ws + WS_QKRAW); bf16* Q = (bf16*)(ws + WS_Q); bf16* Kb = (bf16*)(ws + WS_K);
    const int nthreads = G * NWAVES * 64;
    for (int it = vcu * (NWAVES * 64) + tid; it < (MT / 8) * 128; it += nthreads) {
        const int rb = it >> 7, ch = it & 127, rs = 8 * rb, col = 8 * ch;
        bool first, sample = rs >= MP; int b, tl, Lseq;
        if (!sample) { b = rs / SEQ; tl = rs % SEQ; Lseq = SEQ; } else { b = (rs - MP) / SLEN; tl = (rs - MP) % SLEN; Lseq = SLEN; }
        first = (tl == 0);
        float w[4][8], bc[8];
#pragma unroll
        for (int j = 0; j < 4; ++j) { const f32x4 a0 = *(const f32x4*)(A.in[10] + j * 1024 + col), a1 = *(const f32x4*)(A.in[10] + j * 1024 + col + 4);
            w[j][0] = a0[0]; w[j][1] = a0[1]; w[j][2] = a0[2]; w[j][3] = a0[3]; w[j][4] = a1[0]; w[j][5] = a1[1]; w[j][6] = a1[2]; w[j][7] = a1[3]; }
        { const f32x4 a0 = *(const f32x4*)(A.in[11] + col), a1 = *(const f32x4*)(A.in[11] + col + 4);
          bc[0] = a0[0]; bc[1] = a0[1]; bc[2] = a0[2]; bc[3] = a0[3]; bc[4] = a1[0]; bc[5] = a1[1]; bc[6] = a1[2]; bc[7] = a1[3]; }
        v4u raw[11];
#pragma unroll
        for (int r = 0; r < 11; ++r) { if (r >= 3 || !first) raw[r] = *(const GAS v4u*)(QKRAW + (size_t)(rs + r - 3) * 1024 + col); else raw[r] = (v4u){0u, 0u, 0u, 0u}; }
        float x0[8], x1[8], x2[8];
#define UNPK(dst, v) do { dst[0] = bflo(v.x); dst[1] = bfhi(v.x); dst[2] = bflo(v.y); dst[3] = bfhi(v.y); dst[4] = bflo(v.z); dst[5] = bfhi(v.z); dst[6] = bflo(v.w); dst[7] = bfhi(v.w); } while (0)
        if (first && sample) {
            const float* sp = A.in[2] + (size_t)b * 3 * 1024 + col;
#pragma unroll
            for (int i = 0; i < 8; ++i) { x0[i] = sp[i]; x1[i] = sp[1024 + i]; x2[i] = sp[2048 + i]; }
        } else { UNPK(x0, raw[0]); UNPK(x1, raw[1]); UNPK(x2, raw[2]); }
#pragma unroll
        for (int r = 0; r < 8; ++r) {
            float x3[8]; UNPK(x3, raw[r + 3]);
            float o[8];
#pragma unroll
            for (int i = 0; i < 8; ++i) { const float val = bc[i] + w[0][i] * x0[i] + w[1][i] * x1[i] + w[2][i] * x2[i] + w[3][i] * x3[i]; o[i] = val * sigmoidf_(val); }
            const size_t row = (size_t)rs + r;
            if (ch < 64) {
#pragma unroll
                for (int i = 0; i < 8; ++i) o[i] *= 0.08838834764831845f;
                v4u pk; pk.x = cvtpk(o[0], o[1]); pk.y = cvtpk(o[2], o[3]); pk.z = cvtpk(o[4], o[5]); pk.w = cvtpk(o[6], o[7]);
                *(GAS v4u*)(Q + row * 512 + col) = pk;
            } else {
                v4u pk; pk.x = cvtpk(o[0], o[1]); pk.y = cvtpk(o[2], o[3]); pk.z = cvtpk(o[4], o[5]); pk.w = cvtpk(o[6], o[7]);
                *(GAS v4u*)(Kb + row * 512 + (col - 512)) = pk;
            }
            const int tt = tl + r;
            if (tt >= Lseq - 3) { float* cv = A.out + (sample ? O_CONVS : O_CONVP) + ((size_t)b * 3 + (tt - (Lseq - 3))) * 1024 + col;
                *(f32x4*)cv = (f32x4){x3[0], x3[1], x3[2], x3[3]}; *(f32x4*)(cv + 4) = (f32x4){x3[4], x3[5], x3[6], x3[7]}; }
#pragma unroll
            for (int i = 0; i < 8; ++i) { x0[i] = x1[i]; x1[i] = x2[i]; x2[i] = x3[i]; }
        }
#undef UNPK
    }
}
constexpr int ML_QS = 0, ML_KS = 17408, ML_VS = 34816, ML_SC = 46080, ML_SET = 47616, ML_SS = 2 * ML_SET, ML_CB = ML_SS + 9216, ML_CBSZ = 21760;
static_assert(ML_CB + 2 * ML_CBSZ <= LDSCTL_OFF, "mLSTM LDS map");
constexpr int SC_A = 0, SC_MM = 64, SC_GI = 128, SC_EN = 192, SC_WS = 256, SC_MISC = 320;
__device__ __forceinline__ bf16x8 ldsfrag(const LAS unsigned char* p) { return *(const LAS bf16x8*)p; }
typedef __attribute__((address_space(3))) s16x4 lds_s16x4;
__device__ __forceinline__ bf16x8 trfrag(const LAS unsigned char* tile, int stride, int k0, int c0, int lane) {
    const int g = lane >> 4, q = (lane & 15) >> 2, p = lane & 3;
    const LAS unsigned char* a0 = tile + (k0 + 8 * g + q) * stride + (c0 + 4 * p) * 2;
    const s16x4 lo = __builtin_amdgcn_ds_read_tr16_b64_v4i16((lds_s16x4*)a0), hi = __builtin_amdgcn_ds_read_tr16_b64_v4i16((lds_s16x4*)(a0 + 4 * stride));
    return (bf16x8){lo[0], lo[1], lo[2], lo[3], hi[0], hi[1], hi[2], hi[3]};
}
#define LBAR() do { asm volatile("s_waitcnt lgkmcnt(0)" ::: "memory"); __builtin_amdgcn_s_barrier(); asm volatile("" ::: "memory"); } while (0)

__device__ __forceinline__ void mlstm_item(const Args& A, LAS unsigned char* lds, int tid, int lane, int wave, int item) {
    DBG_DECL
    unsigned char* ws = A.ws;
    const int fr = lane & 15, fq = lane >> 4;
    const bool sample = item >= NBATCH * NH * NSL; const int ii = sample ? item - NBATCH * NH * NSL : item;
    const int b = ii / (NH * NSL), h = (ii / NSL) % NH, sl = ii % NSL;
    const int nch = sample ? 1 : NCH, L = sample ? SLEN : CH;
    const int row0 = sample ? MP + b * SLEN : b * SEQ, sc0 = sample ? NBATCH * NCH + b : b * NCH;
    const bf16* Qg = (const bf16*)(ws + WS_Q); const bf16* Kg = (const bf16*)(ws + WS_K); const bf16* Vg = (const bf16*)(ws + WS_V);
    const float* SCAL = (const float*)(ws + WS_SCAL); bf16* HS = (bf16*)(ws + WS_HS); float* HSS = (float*)(ws + WS_HSS);
    if (tid < 256) { const int r = (tid >> 1) & 63, hf = tid & 1, st = tid >> 7; *(LAS v4u*)(lds + st * ML_SET + ML_VS + r * 176 + 128 + 16 * hf) = (v4u){hf == 0 ? 0x00003F80u : 0u, 0u, 0u, 0u}; }
    f32x4 Cst[5];
    if (sample) {
        const float* c0 = A.in[3] + ((size_t)(b * NH + h) * DV + DVS * sl) * DQK; const float* n0 = A.in[4] + (size_t)(b * NH + h) * DQK;
#pragma unroll
        for (int vb = 0; vb < 4; ++vb) Cst[vb] = *(const f32x4*)(c0 + (size_t)(16 * vb + fr) * DQK + 16 * wave + 4 * fq);
        Cst[4] = (fr == 0) ? *(const f32x4*)(n0 + 16 * wave + 4 * fq) : (f32x4){0.f, 0.f, 0.f, 0.f};
    } else {
#pragma unroll
        for (int vb = 0; vb < 5; ++vb) Cst[vb] = (f32x4){0.f, 0.f, 0.f, 0.f};
    }
#pragma unroll
    for (int vb = 0; vb < 5; ++vb) { u32x2 w; w.x = cvtpk_n(Cst[vb][0], Cst[vb][1]); w.y = cvtpk_n(Cst[vb][2], Cst[vb][3]); *(LAS u32x2*)(lds + ML_CB + (16 * vb + fr) * 272 + (16 * wave + 4 * fq) * 2) = w; }
    v4u pq[2], pk[2], pv; f32x4 psc = (f32x4){0.f, 0.f, 0.f, 0.f};
#define ML_ISSUE(c_) do { \
        const size_t r0_ = (size_t)row0 + (size_t)(c_) * CH; \
        _Pragma("unroll") for (int i = 0; i < 2; ++i) { const int e = tid + 512 * i, r = e >> 4, ch = e & 15; \
            if (r < L) { pq[i] = *(const GAS v4u*)(Qg + (r0_ + r) * 512 + 128 * h + 8 * ch); pk[i] = *(const GAS v4u*)(Kg + (r0_ + r) * 512 + 128 * h + 8 * ch); } \
            else { pq[i] = (v4u){0u, 0u, 0u, 0u}; pk[i] = (v4u){0u, 0u, 0u, 0u}; } } \
        { const int r = tid >> 3, ch = tid & 7; if (r < L) pv = *(const GAS v4u*)(Vg + (r0_ + r) * 1024 + DV * h + DVS * sl + 8 * ch); else pv = (v4u){0u, 0u, 0u, 0u}; } \
        if (tid < 96) psc = *(const GAS f32x4*)(SCAL + ((size_t)(sc0 + (c_)) * 4 + h) * 384 + 4 * tid); \
    } while (0)
#define ML_COMMIT(so_) do { LAS unsigned char* wl_ = lds + (so_); \
        _Pragma("unroll") for (int i = 0; i < 2; ++i) { const int e = tid + 512 * i, r = e >> 4, ch = e & 15; \
            *(LAS v4u*)(wl_ + ML_QS + r * 272 + ch * 16) = pq[i]; *(LAS v4u*)(wl_ + ML_KS + r * 272 + ch * 16) = pk[i]; } \
        { const int r = tid >> 3, ch = tid & 7; *(LAS v4u*)(wl_ + ML_VS + r * 176 + ch * 16) = pv; } \
        if (tid < 96) *(LAS f32x4*)((LAS float*)(wl_ + ML_SC) + 4 * tid) = psc; \
    } while (0)
    ML_ISSUE(0); ML_COMMIT(0);
    LBAR();
    const int tb = wave & 3, wh = wave >> 2, t = 16 * tb + fr;
    u32x2 hsw[2] = {(u32x2){0u, 0u}, (u32x2){0u, 0u}}; float hsp = 0.f;
#define ML_FLUSH(c_) do { const size_t grow = (size_t)row0 + (size_t)(c_) * CH + t; \
        if (t < L) { *(GAS u32x2*)(HS + grow * 1024 + h * DV + DVS * sl + 16 * (2 * wh) + 4 * fq) = hsw[0]; *(GAS u32x2*)(HS + grow * 1024 + h * DV + DVS * sl + 16 * (2 * wh + 1) + 4 * fq) = hsw[1]; \
                     if (fq == 0) HSS[grow * 32 + h * 8 + sl * 2 + wh] = hsp; } } while (0)
    DBG_BEGIN(8);
    for (int c = 0; c < nch; ++c) {
        if (c + 1 < nch) ML_ISSUE(c + 1);
        if (c > 0) ML_FLUSH(c - 1);
        const LAS unsigned char* cbr = lds + ML_CB + (c & 1) * ML_CBSZ; LAS unsigned char* cbw = lds + ML_CB + ((c + 1) & 1) * ML_CBSZ;
        const LAS unsigned char* tl = lds + (c & 1) * ML_SET; const LAS float* SC = (const LAS float*)(tl + ML_SC);
        DBG_BEGIN(4);
        bf16x8 qf[4];
#pragma unroll
        for (int ks = 0; ks < 4; ++ks) qf[ks] = ldsfrag(tl + ML_QS + t * 272 + ks * 64 + fq * 16);
        { bf16x8 kf[2][4];
#pragma unroll
          for (int i = 0; i < 2; ++i)
#pragma unroll
              for (int ks = 0; ks < 4; ++ks) kf[i][ks] = ldsfrag(tl + ML_KS + (16 * (2 * wh + i) + fr) * 272 + ks * 64 + fq * 16);
          const float mmt = SC[SC_MM + t]; f32x4 a4[2];
#pragma unroll
          for (int i = 0; i < 2; ++i) a4[i] = *(const LAS f32x4*)(SC + SC_A + 16 * (2 * wh + i) + 4 * fq);
          f32x4 g[2] = {(f32x4){0.f, 0.f, 0.f, 0.f}, (f32x4){0.f, 0.f, 0.f, 0.f}};
#pragma unroll
          for (int ks = 0; ks < 4; ++ks)
#pragma unroll
              for (int i = 0; i < 2; ++i) g[i] = mfma16(kf[i][ks], qf[ks], g[i]);
#pragma unroll
          for (int i = 0; i < 2; ++i) { const int s0 = 16 * (2 * wh + i) + 4 * fq; float v[4];
#pragma unroll
              for (int r = 0; r < 4; ++r) v[r] = (s0 + r <= t) ? g[i][r] * __expf(a4[i][r] - mmt) : 0.f;
              u32x2 w; w.x = cvtpk_n(v[0], v[1]); w.y = cvtpk_n(v[2], v[3]); *(LAS u32x2*)(lds + ML_SS + t * 144 + s0 * 2) = w; } }
        DBG_END(4);
        LBAR();
        DBG_BEGIN(5);
        { bf16x8 sf[2], vf[3][2], cf[3][4];
#pragma unroll
          for (int ks = 0; ks < 2; ++ks) sf[ks] = ldsfrag(lds + ML_SS + t * 144 + ks * 64 + fq * 16);
#pragma unroll
          for (int i = 0; i < 3; ++i) { const int vb = (i == 2) ? 4 : 2 * wh + i;
#pragma unroll
              for (int ks = 0; ks < 2; ++ks) vf[i][ks] = trfrag(tl + ML_VS, 176, 32 * ks, 16 * vb, lane);
#pragma unroll
              for (int ks = 0; ks < 4; ++ks) cf[i][ks] = ldsfrag(cbr + (16 * vb + fr) * 272 + ks * 64 + fq * 16); }
          const float git = SC[SC_GI + t], ent = SC[SC_EN + t];
          f32x4 ai[3], ae[3];
#pragma unroll
          for (int i = 0; i < 3; ++i) { ai[i] = (f32x4){0.f, 0.f, 0.f, 0.f}; ae[i] = (f32x4){0.f, 0.f, 0.f, 0.f}; }
#pragma unroll
          for (int ks = 0; ks < 4; ++ks)
#pragma unroll
              for (int i = 0; i < 3; ++i) { ae[i] = mfma16(cf[i][ks], qf[ks], ae[i]); if (ks < 2) ai[i] = mfma16(vf[i][ks], sf[ks], ai[i]); }
          f32x4 hh[3];
#pragma unroll
          for (int i = 0; i < 3; ++i) hh[i] = ai[i] + ae[i] * git;
          const float den = __shfl(hh[2][0], fr);
          const float isc = 1.0f / fmaxf(fabsf(den), ent); float p = 0.f;
#pragma unroll
          for (int i = 0; i < 2; ++i) { const f32x4 o = hh[i] * isc; p += (o[0] * o[0] + o[1] * o[1]) + (o[2] * o[2] + o[3] * o[3]);
              hsw[i].x = cvtpk_n(o[0], o[1]); hsw[i].y = cvtpk_n(o[2], o[3]); }
          p += __shfl_xor(p, 16); p += __shfl_xor(p, 32); hsp = p; }
        DBG_END(5); DBG_BEGIN(6);
        { const float decay = SC[SC_MISC];
          bf16x8 kw[2], vf[5][2];
#pragma unroll
          for (int vb = 0; vb < 5; ++vb)
#pragma unroll
              for (int ks = 0; ks < 2; ++ks) vf[vb][ks] = trfrag(tl + ML_VS, 176, 32 * ks, 16 * vb, lane);
#pragma unroll
          for (int ks = 0; ks < 2; ++ks) { const v4u kr = __builtin_bit_cast(v4u, trfrag(tl + ML_KS, 272, 32 * ks, 16 * wave, lane));
              const f32x4 w0 = *(const LAS f32x4*)(SC + SC_WS + 32 * ks + 8 * fq), w1 = *(const LAS f32x4*)(SC + SC_WS + 32 * ks + 8 * fq + 4);
              v4u o; o.x = cvtpk_n(bflo(kr.x) * w0[0], bfhi(kr.x) * w0[1]); o.y = cvtpk_n(bflo(kr.y) * w0[2], bfhi(kr.y) * w0[3]); o.z = cvtpk_n(bflo(kr.z) * w1[0], bfhi(kr.z) * w1[1]); o.w = cvtpk_n(bflo(kr.w) * w1[2], bfhi(kr.w) * w1[3]);
              kw[ks] = __builtin_bit_cast(bf16x8, o); }
#pragma unroll
          for (int vb = 0; vb < 5; ++vb) Cst[vb] = Cst[vb] * decay;
#pragma unroll
          for (int ks = 0; ks < 2; ++ks)
#pragma unroll
              for (int vb = 0; vb < 5; ++vb) Cst[vb] = mfma16(kw[ks], vf[vb][ks], Cst[vb]);
#pragma unroll
          for (int vb = 0; vb < 5; ++vb) { u32x2 w; w.x = cvtpk_n(Cst[vb][0], Cst[vb][1]); w.y = cvtpk_n(Cst[vb][2], Cst[vb][3]); *(LAS u32x2*)(cbw + (16 * vb + fr) * 272 + (16 * wave + 4 * fq) * 2) = w; } }
        DBG_END(6);
        DBG_BEGIN(7);
        if (c + 1 < nch) ML_COMMIT(((c + 1) & 1) * ML_SET);
        DBG_END(7);
        LBAR();
    }
    DBG_END(8); DBG_REPORT(item == 0);
    ML_FLUSH(nch - 1);
    { float* co = A.out + (sample ? O_CS : O_CP) + ((size_t)(b * NH + h) * DV + DVS * sl) * DQK;
#pragma unroll
      for (int vb = 0; vb < 4; ++vb) *(f32x4*)(co + (size_t)(16 * vb + fr) * DQK + 16 * wave + 4 * fq) = Cst[vb];
      if (sl == 0 && fr == 0) *(f32x4*)(A.out + (sample ? O_NS : O_NP) + (size_t)(b * NH + h) * DQK + 16 * wave + 4 * fq) = Cst[4]; }
    LBAR();
#undef ML_ISSUE
#undef ML_FLUSH
#undef ML_COMMIT
}

__device__ __forceinline__ float gelu_tanh(float y) { const float t = y * y, p = fmaf(t, 0.044715f, 1.0f);
    const float e = __builtin_amdgcn_exp2f(y * p * -2.302208198f); return y * __builtin_amdgcn_rcpf(1.0f + e); }
typedef float f32x2 __attribute__((ext_vector_type(2)));
__device__ __forceinline__ void s5_item(const Args& A, LAS unsigned char* slds, int lane, int role, int item) {
    DBG_DECL
    unsigned char* ws = A.ws;
    const int fr = lane & 15, fq = lane >> 4;
    const bool sample = item >= NBATCH * NG; const int ii = sample ? item - NBATCH * NG : item;
    const int b = ii / NG, g = ii % NG;
    const int T = sample ? SLEN : SEQ, row0 = sample ? MP + b * SLEN : b * SEQ;
    const bf16* U = (const bf16*)(ws + WS_U); bf16* Z = (bf16*)(ws + WS_Z);
    const float* LAM = (const float*)(ws + WS_S5P + S5P_LAM); const bf16* BBT = (const bf16*)(ws + WS_S5P + S5P_BBT); const bf16* CC = (const bf16*)(ws + WS_S5P + S5P_CC);
    const bf16x8 zf = (bf16x8){0, 0, 0, 0, 0, 0, 0, 0}; const f32x4 z4 = (f32x4){0.f, 0.f, 0.f, 0.f};
    const int nblk = T / 16;
    const bf16* ubase = U + (size_t)(row0 + fr) * 1024 + 16 * g + 8 * (fq & 1);
#define S5_LOADU(k_) (*(const bf16x8*)(ubase + (size_t)((k_) < nblk ? (k_) : nblk - 1) * 16 * 1024))
#define S5_BU(P_) ((LAS float*)(slds + (P_) * 8448))
#define S5_SB(P_) ((LAS bf16*)(slds + 16896 + (P_) * 4352))
    if (role == 0) {
        bf16x8 bbA[8];
#pragma unroll
        for (int rb = 0; rb < 8; ++rb) bbA[rb] = (fq < 2) ? *(const bf16x8*)(BBT + ((size_t)g * 128 + 16 * rb + fr) * 16 + 8 * fq) : zf;
        const float lr = LAM[(g * 64 + lane) * 2], li = LAM[(g * 64 + lane) * 2 + 1];
        float sr, si;
        if (sample) { sr = A.in[6][(size_t)(b * NG + g) * PST + lane]; si = A.in[7][(size_t)(b * NG + g) * PST + lane]; } else { sr = 0.f; si = 0.f; }
        bf16x8 ub = S5_LOADU(0), uc = S5_LOADU(1), ud = S5_LOADU(2);
#pragma unroll
        for (int rb = 0; rb < 8; ++rb) { const f32x4 d = mfma16(bbA[rb], ub, z4); *(LAS f32x4*)(S5_BU(0) + fr * 132 + 16 * rb + 4 * fq) = d; }
        LBAR();
#define S5_ITER_A(k_, P_) do { const int k = (k_); DBG_BEGIN(1); \
            f32x4 d[8]; \
            _Pragma("unroll") for (int rb = 0; rb < 8; ++rb) d[rb] = mfma16(bbA[rb], uc, z4);                                 \
            f32x2 bu[16]; { const LAS float* bc = S5_BU(P_); \
            _Pragma("unroll") for (int tt = 0; tt < 16; ++tt) bu[tt] = *(const LAS f32x2*)(bc + tt * 132 + 2 * lane); } \
            { LAS float* bn = S5_BU(1 - (P_)); \
            _Pragma("unroll") for (int rb = 0; rb < 8; ++rb) *(LAS f32x4*)(bn + fr * 132 + 16 * rb + 4 * fq) = d[rb]; } \
            { LAS bf16* sbc = S5_SB(P_); \
            f32x2 s2 = (f32x2){sr, si}; const f32x2 lr2 = (f32x2){lr, lr}, li2 = (f32x2){-li, li}; \
            _Pragma("unroll") for (int tt = 0; tt < 16; ++tt) { const f32x2 sw = __builtin_shufflevector(s2, s2, 1, 0); s2 = lr2 * s2 + (li2 * sw + bu[tt]);     \
                *(LAS unsigned*)(sbc + tt * 136 + 2 * lane) = cvtpk_n(s2[0], s2[1]); } sr = s2[0]; si = s2[1]; }                \
            uc = ud; ud = S5_LOADU(k + 3); DBG_END(1); \
            LBAR(); } while (0)
        DBG_BEGIN(2);
        for (int k2 = 0; k2 + 1 < nblk; k2 += 2) { S5_ITER_A(k2, 0); S5_ITER_A(k2 + 1, 1); }
        if (nblk & 1) S5_ITER_A(nblk - 1, 0);
        DBG_END(2); DBG_REPORT(!sample && item == 0);
#undef S5_ITER_A
        float* so = A.out + (sample ? O_SRS : O_SRP) + (size_t)(b * NG + g) * PST; float* io = A.out + (sample ? O_SIS : O_SIP) + (size_t)(b * NG + g) * PST;
        so[lane] = sr; io[lane] = si;
    } else {
        bf16x8 ccA[4], dA;
#pragma unroll
        for (int ks = 0; ks < 4; ++ks) ccA[ks] = *(const bf16x8*)(CC + ((size_t)g * 16 + fr) * 128 + 32 * ks + 8 * fq);
        { const short dv = (short)f2bf(A.in[22][g * 16 + fr]); dA = zf;
#pragma unroll
          for (int j = 0; j < 8; ++j) dA[j] = (fq < 2 && 8 * fq + j == fr) ? dv : (short)0; }
        bf16x8 ua = S5_LOADU(0), ub = S5_LOADU(0), uc = S5_LOADU(1);
        LBAR();
#define S5_Y(km1_, P_) do { const LAS bf16* sbp = S5_SB(P_); f32x4 y = z4; \
            _Pragma("unroll") for (int ks = 0; ks < 4; ++ks) y = mfma16(ccA[ks], *(const LAS bf16x8*)(sbp + fr * 136 + 32 * ks + 8 * fq), y); \
            y = mfma16(dA, ua, y); \
            u32x2 w; w.x = cvtpk_n(gelu_tanh(y[0]), gelu_tanh(y[1])); w.y = cvtpk_n(gelu_tanh(y[2]), gelu_tanh(y[3])); \
            *(GAS u32x2*)(Z + ((size_t)row0 + 16 * (km1_) + fr) * 1024 + 16 * g + 4 * fq) = w; } while (0)
#define S5_ITER_B(k_, P_) do { const int k = (k_); DBG_BEGIN(3); if (k >= 1) S5_Y(k - 1, 1 - (P_)); ua = ub; ub = uc; uc = S5_LOADU(k + 2); DBG_END(3); LBAR(); } while (0)
        for (int k2 = 0; k2 + 1 < nblk; k2 += 2) { S5_ITER_B(k2, 0); S5_ITER_B(k2 + 1, 1); }
        if (nblk & 1) S5_ITER_B(nblk - 1, 0);
        if ((nblk - 1) & 1) S5_Y(nblk - 1, 1); else S5_Y(nblk - 1, 0);
        DBG_REPORT(!sample && item == 0);
#undef S5_ITER_B
#undef S5_Y
    }
    LBAR();
#undef S5_BU
#undef S5_SB
#undef S5_LOADU
}

__device__ __forceinline__ void outa_rows(const Args& A, int lane, int gw, int NGW) {
    unsigned char* ws = A.ws;
    const bf16* HS = (const bf16*)(ws + WS_HS); const bf16* OG = (const bf16*)(ws + WS_OG); const float* HSS = (const float*)(ws + WS_HSS); bf16* MIXIN = (bf16*)(ws + WS_MIXIN);
    f32x4 gm[2][2];
#pragma unroll
    for (int i = 0; i < 2; ++i) { gm[i][0] = *(const f32x4*)(A.in[14] + 512 * i + 8 * lane); gm[i][1] = *(const f32x4*)(A.in[14] + 512 * i + 8 * lane + 4); }
    for (int m = gw; m < MT; m += NGW) {
        f32x4 p0[2], p1[2]; v4u hv[2], ov[2];
#pragma unroll
        for (int i = 0; i < 2; ++i) { const int col = 512 * i + 8 * lane, hh = col >> 8;
            p0[i] = *(const GAS f32x4*)(HSS + (size_t)m * 32 + hh * 8); p1[i] = *(const GAS f32x4*)(HSS + (size_t)m * 32 + hh * 8 + 4);
            hv[i] = *(const GAS v4u*)(HS + (size_t)m * 1024 + col); ov[i] = *(const GAS v4u*)(OG + (size_t)m * 1024 + col); }
        v4u o[2];
#pragma unroll
        for (int i = 0; i < 2; ++i) {
            const float ss = (p0[i][0] + p0[i][1]) + (p0[i][2] + p0[i][3]) + (p1[i][0] + p1[i][1]) + (p1[i][2] + p1[i][3]);
            const float rstd = 1.0f / sqrtf(ss * (1.0f / DV) + EPS);
            o[i].x = cvtpk(bflo(hv[i].x) * rstd * gm[i][0][0] * sigmoidf_(bflo(ov[i].x)), bfhi(hv[i].x) * rstd * gm[i][0][1] * sigmoidf_(bfhi(ov[i].x)));
            o[i].y = cvtpk(bflo(hv[i].y) * rstd * gm[i][0][2] * sigmoidf_(bflo(ov[i].y)), bfhi(hv[i].y) * rstd * gm[i][0][3] * sigmoidf_(bfhi(ov[i].y)));
            o[i].z = cvtpk(bflo(hv[i].z) * rstd * gm[i][1][0] * sigmoidf_(bflo(ov[i].z)), bfhi(hv[i].z) * rstd * gm[i][1][1] * sigmoidf_(bfhi(ov[i].z)));
            o[i].w = cvtpk(bflo(hv[i].w) * rstd * gm[i][1][2] * sigmoidf_(bflo(ov[i].w)), bfhi(hv[i].w) * rstd * gm[i][1][3] * sigmoidf_(bfhi(ov[i].w))); }
#pragma unroll
        for (int i = 0; i < 2; ++i) *(GAS v4u*)(MIXIN + (size_t)m * 2048 + 512 * i + 8 * lane) = o[i];
    }
}
__device__ __forceinline__ float row_ss_part(const float* SSp, const float* SSs, int m, int lane) {
    if (m < MP) return (lane < 32) ? SSp[(size_t)m * 32 + lane] : 0.f;
    return SSs[(size_t)(m - MP) * 128 + lane] + SSs[(size_t)(m - MP) * 128 + 64 + lane];
}
__device__ __forceinline__ void rowpass1(const Args& A, int lane, int gw, int NGW) {
    unsigned char* ws = A.ws;
    const bf16* MIX = (const bf16*)(ws + WS_MIX); bf16* X1B = (bf16*)(ws + WS_X1B); float* RSTD2 = (float*)(ws + WS_SSS + SSS_RSTD2);
    const float* SSp = (const float*)(ws + WS_SS1); const float* SSs = (const float*)(ws + WS_SSS + SSS_1);
    const float* RSTD1 = (const float*)(ws + WS_SSS + SSS_RSTD1);
    f32x4 g1[8], gi[8];
#pragma unroll
    for (int j = 0; j < 8; ++j) { g1[j] = *(const f32x4*)(A.in[26] + 256 * j + 4 * lane); const f32x4 g0 = *(const f32x4*)(A.in[8] + 256 * j + 4 * lane);
        gi[j] = (f32x4){1.0f / g0[0], 1.0f / g0[1], 1.0f / g0[2], 1.0f / g0[3]}; }
    u32x2 va[8], vb[8], ma[8], mb[8]; float sa = 0.f, sb = 0.f, ra = 0.f, rb = 0.f;
#define RP1_LOAD(V, M, S, R, m_) do { const int mm_ = (m_); \
        S = row_ss_part(SSp, SSs, mm_, lane); R = RSTD1[mm_]; \
        _Pragma("unroll") for (int j = 0; j < 8; ++j) { const int k = 256 * j + 4 * lane; V[j] = *(const GAS u32x2*)(X1B + (size_t)mm_ * DM + k); M[j] = *(const GAS u32x2*)(MIX + (size_t)mm_ * DM + k); } } while (0)
#define RP1_PROC(V, M, S, R, m_) do { const int mm_ = (m_); \
        const float rstd1 = 1.0f / sqrtf(wave_sum(S) * (1.0f / DM) + EPS); float s = 0.f; f32x4 O[8]; \
        _Pragma("unroll") for (int j = 0; j < 8; ++j) { f32x4 o; o[0] = bflo(V[j].x) * R * gi[j][0] + bflo(M[j].x) * rstd1 * g1[j][0]; o[1] = bfhi(V[j].x) * R * gi[j][1] + bfhi(M[j].x) * rstd1 * g1[j][1]; \
            o[2] = bflo(V[j].y) * R * gi[j][2] + bflo(M[j].y) * rstd1 * g1[j][2]; o[3] = bfhi(V[j].y) * R * gi[j][3] + bfhi(M[j].y) * rstd1 * g1[j][3]; \
            s += (o[0] * o[0] + o[1] * o[1]) + (o[2] * o[2] + o[3] * o[3]); O[j] = o; } \
        const float ms2 = wave_sum(s) * (1.0f / DM) + EPS, rstd2 = 1.0f / sqrtf(ms2); \
        _Pragma("unroll") for (int j = 0; j < 8; ++j) { u32x2 o; o.x = cvtpk(O[j][0] * rstd2, O[j][1] * rstd2); o.y = cvtpk(O[j][2] * rstd2, O[j][3] * rstd2); \
            *(GAS u32x2*)(X1B + (size_t)mm_ * DM + 256 * j + 4 * lane) = o; } \
        if (lane == 0) RSTD2[mm_] = sqrtf(ms2); } while (0)
    int m = gw;
    if (m < MT) { RP1_LOAD(va, ma, sa, ra, m);
        for (;;) { const int m2 = m + NGW; if (m2 < MT) RP1_LOAD(vb, mb, sb, rb, m2); RP1_PROC(va, ma, sa, ra, m); if (m2 >= MT) break;
                   m = m2 + NGW; if (m < MT) RP1_LOAD(va, ma, sa, ra, m); RP1_PROC(vb, mb, sb, rb, m2); if (m >= MT) break; } }
#undef RP1_LOAD
#undef RP1_PROC
}
__device__ __forceinline__ void rowpass2(const Args& A, int lane, int gw, int NGW) {
    unsigned char* ws = A.ws;
    const bf16* FF = (const bf16*)(ws + WS_FF); const bf16* X1B = (const bf16*)(ws + WS_X1B);
    const float* SSp = (const float*)(ws + WS_SS2); const float* SSs = (const float*)(ws + WS_SSS + SSS_2);
    f32x4 g3[8];
#pragma unroll
    for (int j = 0; j < 8; ++j) g3[j] = *(const f32x4*)(A.in[31] + 256 * j + 4 * lane);
    u32x2 xa[8], xb[8], fa[8], fb[8]; float sa = 0.f, sb = 0.f;
    const float* RSTD2 = (const float*)(ws + WS_SSS + SSS_RSTD2); float ra = 0.f, rb = 0.f;
#define RP2_LOAD(X, F, S, R, m_) do { const int mm_ = (m_); S = row_ss_part(SSp, SSs, mm_, lane); R = RSTD2[mm_]; \
        _Pragma("unroll") for (int j = 0; j < 8; ++j) { const int k = 256 * j + 4 * lane; X[j] = *(const GAS u32x2*)(X1B + (size_t)mm_ * DM + k); F[j] = *(const GAS u32x2*)(FF + (size_t)mm_ * DM + k); } } while (0)
#define RP2_PROC(X, F, S, R, m_) do { const int mm_ = (m_); float* orow = A.out + O_Y + (size_t)mm_ * DM; const float rstd = 1.0f / sqrtf(wave_sum(S) * (1.0f / DM) + EPS); f32x4 V[8]; \
        _Pragma("unroll") for (int j = 0; j < 8; ++j) { V[j][0] = bflo(X[j].x) * R + bflo(F[j].x) * rstd * g3[j][0]; V[j][1] = bfhi(X[j].x) * R + bfhi(F[j].x) * rstd * g3[j][1]; V[j][2] = bflo(X[j].y) * R + bflo(F[j].y) * rstd * g3[j][2]; V[j][3] = bfhi(X[j].y) * R + bfhi(F[j].y) * rstd * g3[j][3]; } \
        DBG_PERTURB(V, mm_); \
        _Pragma("unroll") for (int j = 0; j < 8; ++j) __builtin_nontemporal_store(V[j], (GAS f32x4*)(orow + 256 * j + 4 * lane)); } while (0)
    int m = gw;
    if (m < MT) { RP2_LOAD(xa, fa, sa, ra, m);
        for (;;) { const int m2 = m + NGW; if (m2 < MT) RP2_LOAD(xb, fb, sb, rb, m2); RP2_PROC(xa, fa, sa, ra, m); if (m2 >= MT) break;
                   m = m2 + NGW; if (m < MT) RP2_LOAD(xa, fa, sa, ra, m); RP2_PROC(xb, fb, sb, rb, m2); if (m >= MT) break; } }
#undef RP2_LOAD
#undef RP2_PROC
}
#ifndef MK_AL_P4
#define MK_AL_P4 true
#endif
#ifndef MK_AL_SS
#define MK_AL_SS true
#endif
#ifndef MK_WGM_P5
#define MK_WGM_P5 4
#endif
#ifndef MK_WGM_P1
#define MK_WGM_P1 2
#endif
#ifndef MK_WGM_P7
#define MK_WGM_P7 4
#endif
#ifndef MK_WGM_P8
#define MK_WGM_P8 1
#endif
#ifndef MK_GU_ALIGN
#define MK_GU_ALIGN true
#endif
#ifndef MK_GU_SP2
#define MK_GU_SP2 true
#endif
__global__ void __launch_bounds__(NWAVES * 64, 2) hymba_fwd(Args args) {
    extern __shared__ __attribute__((aligned(16))) unsigned char lds_raw[];
    LAS unsigned char* lds = (LAS unsigned char*)lds_raw;
    volatile LAS unsigned* MISC = (volatile LAS unsigned*)(lds + MISC_OFF);
    const int tid = threadIdx.x, lane = tid & 63, wave = __builtin_amdgcn_readfirstlane(tid >> 6);
    const int G = gridDim.x; const int bx = blockIdx.x; const int vcu = (G % 8 == 0) ? (bx % 8) * (G / 8) + bx / 8 : bx;
    unsigned char* ws = args.ws;
    gu32* ctl = (gu32*)(ws + WS_CTL);
    for (int u = tid; u < (LDS_BYTES - LDSCTL_OFF) / 4; u += NWAVES * 64) ((LAS unsigned*)(lds + LDSCTL_OFF))[u] = 0u;
    __syncthreads();
    const XcdBarrier bar = xcd_barrier_post((unsigned*)(ctl + CW_BAR) + args.li * XCD_BAR_WORDS, MISC + 8);
#define GRID_BAR() xcd_barrier(bar)
    const int lo = args.ph_lo, hi = args.ph_hi;
#define IN(k) (lo <= (k) && (k) < hi)
#define BOTH(k) (IN(k) && IN((k) + 1))

    const int gw = vcu * NWAVES + wave, NGW = G * NWAVES;

    if (IN(0)) { PHASE_IDS p0_prologue(args, lds, tid, lane, wave, vcu, G); if (BOTH(0)) GRID_BAR(); }

    if (IN(1)) { PHASE_IDS
        { pg8::Gemm g{(const bf16*)(ws + WS_XN), (const bf16*)(ws + WS_WIN), MP, 4096, DM}; pg8::StaticOrder S; S.init(MP, 4096, G, bx, MK_WGM_P1);
          pg8::EpiBf16<0> E{(bf16*)(ws + WS_QKRAW), 1024, nullptr, 1024, (size_t)WS_RSTRIDE / 2, 1.f};
          pg8::gemm_phase<pg8::EpiBf16<0>, pg8::StaticOrder, true, true>(lds + RING_OFF, g, S, E); }
        { PHASE_IDS bf16* O = (bf16*)(ws + WS_QKRAW);
          skinny_gemm<1, DM>((const bf16*)(ws + WS_XN) + (size_t)MP * DM, (const bf16*)(ws + WS_WIN), lds, 4096 / 16, vcu, G, tid, wave, lane,
              [](int it, int a, int fr) { return 16 * it + fr; },
              [O](int it, int row, int fq, const f32x4 (&acc)[1]) { const int col = 16 * it + 4 * fq, t = col >> 10;
                  u32x2 w; w.x = cvtpk_n(acc[0][0], acc[0][1]); w.y = cvtpk_n(acc[0][2], acc[0][3]);
                  *(GAS u32x2*)(O + (size_t)t * (WS_RSTRIDE / 2) + (size_t)(MP + row) * 1024 + (col & 1023)) = w; }); }
        if (BOTH(1)) GRID_BAR();
    }

    if (IN(2)) { PHASE_IDS if (vcu < 64) p2_scalars(args, lds, lane, wave, vcu); p2_conv(args, tid, vcu, G); if (BOTH(2)) GRID_BAR(); }

    if (IN(3)) { PHASE_IDS
        const int half = G / 2;
#ifndef MK_REP_M
#define MK_REP_M 1
#endif
#ifndef MK_REP_S
#define MK_REP_S 1
#endif
        if (vcu < half) { for (int rp_ = 0; rp_ < MK_REP_M; ++rp_) for (int it = vcu; it < NBATCH * NH * NSL; it += half) mlstm_item(args, lds, tid, lane, wave, it); }
        else { const int nb = G - half, bi = vcu - half;
               for (int rp_ = 0; rp_ < MK_REP_S; ++rp_)
               for (int it = bi * 4 + (wave & 3); it < 2 * NBATCH * NG; it += nb * 4) s5_item(args, lds + (wave & 3) * 25600, lane, wave >> 2, it); }
        if (vcu >= half) { __syncthreads(); for (int it = NBATCH * NH * NSL + (vcu - half); it < 2 * NBATCH * NH * NSL; it += G - half) mlstm_item(args, lds, tid, lane, wave, it); }
        if (BOTH(3)) GRID_BAR();
    }

    if (IN(4)) { PHASE_IDS
        { pg8::Gemm g{(const bf16*)(ws + WS_Z), (const bf16*)(ws + WS_WGLU), MP, 1024, 1024}; pg8::StaticOrder S; S.init(MP, 1024, G, bx);
          pg8::EpiGlu E{(const bf16*)(ws + WS_Z), (bf16*)(ws + WS_MIXIN), args.in[24]};
          pg8::gemm_phase<pg8::EpiGlu, pg8::StaticOrder, MK_AL_P4, true>(lds + RING_OFF, g, S, E); }
        { PHASE_IDS const bf16* Zb = (const bf16*)(ws + WS_Z); bf16* O = (bf16*)(ws + WS_MIXIN); const float* bias = args.in[24];
          skinny_gemm<1, 1024, 2>(Zb + (size_t)MP * 1024, (const bf16*)(ws + WS_WGLU), lds, 1024 / 16, vcu, G, tid, wave, lane,
              [](int it, int a, int fr) { return 16 * it + fr; },
              [Zb, O, bias](int it, int row, int fq, const f32x4 (&acc)[1]) { const int col = 16 * it + 4 * fq; const size_t m = (size_t)(MP + row);
                  const u32x2 z = *(const GAS u32x2*)(Zb + m * 1024 + col); const f32x4 bv = *(const f32x4*)(bias + col);
                  u32x2 w; w.x = cvtpk(bflo(z.x) * sigmoidf_(acc[0][0] + bv[0]), bfhi(z.x) * sigmoidf_(acc[0][1] + bv[1]));
                  w.y = cvtpk(bflo(z.y) * sigmoidf_(acc[0][2] + bv[2]), bfhi(z.y) * sigmoidf_(acc[0][3] + bv[3]));
                  *(GAS u32x2*)(O + m * 2048 + 1024 + col) = w; }); }
        { PHASE_IDS outa_rows(args, lane, gw, NGW); }
        if (BOTH(4)) GRID_BAR();
    }

    if (IN(5)) { PHASE_IDS
        { pg8::Gemm g{(const bf16*)(ws + WS_MIXIN), (const bf16*)(ws + WS_WOUT), MP, DM, DM}; pg8::StaticOrder S; S.init(MP, DM, G, bx, MK_WGM_P5);
          pg8::EpiSS<false> E{(bf16*)(ws + WS_MIX), DM, (float*)(ws + WS_SS1), 1.0f};
          pg8::gemm_phase<pg8::EpiSS<false>, pg8::StaticOrder, MK_AL_SS, true>(lds + RING_OFF, g, S, E); }
        { PHASE_IDS bf16* O = (bf16*)(ws + WS_MIX); float* SSs = (float*)(ws + WS_SSS + SSS_1);
          skinny_gemm<1, DM, 4>((const bf16*)(ws + WS_MIXIN) + (size_t)MP * DM, (const bf16*)(ws + WS_WOUT), lds, DM / 16, vcu, G, tid, wave, lane,
              [](int it, int a, int fr) { return 16 * it + fr; },
              [O, SSs](int it, int row, int fq, const f32x4 (&acc)[1]) { const int col = 16 * it + 4 * fq;
                  u32x2 w; w.x = cvtpk_n(acc[0][0], acc[0][1]); w.y = cvtpk_n(acc[0][2], acc[0][3]);
                  *(GAS u32x2*)(O + (size_t)(MP + row) * DM + col) = w;
                  float s = (acc[0][0] * acc[0][0] + acc[0][1] * acc[0][1]) + (acc[0][2] * acc[0][2] + acc[0][3] * acc[0][3]);
                  s += __shfl_xor(s, 16); s += __shfl_xor(s, 32);
                  if (fq == 0) SSs[(size_t)row * 128 + it] = s; }); }
        if (BOTH(5)) GRID_BAR();
    }

    if (IN(6)) { PHASE_IDS rowpass1(args, lane, gw, NGW); if (BOTH(6)) GRID_BAR(); }

    if (IN(7)) { PHASE_IDS
        { pg8::Gemm g{(const bf16*)(ws + WS_X1B), (const bf16*)(ws + WS_WGU), MP, 2 * DFF, DM}; pg8::StaticOrder S; S.init(MP, 2 * DFF, G, bx, MK_WGM_P7);
          pg8::EpiGU8 E{ws + WS_ACT8, DFF};
          pg8::gemm_phase<pg8::EpiGU8, pg8::StaticOrder, MK_GU_ALIGN, MK_GU_SP2>(lds + RING_OFF, g, S, E); }
        { PHASE_IDS bf16* O = (bf16*)(ws + WS_ACTS);
          skinny_gemm<2, DM, 4>((const bf16*)(ws + WS_X1B) + (size_t)MP * DM, (const bf16*)(ws + WS_WGU), lds, DFF / 16, vcu, G, tid, wave, lane,
              [](int it, int a, int fr) { const int j = 16 * it + fr; return 256 * (j >> 7) + 128 * a + (j & 127); },
              [O](int it, int row, int fq, const f32x4 (&acc)[2]) { const int col = 16 * it + 4 * fq; const f32x4 g = acc[0], up = acc[1];
                  u32x2 w; w.x = cvtpk(g[0] * sigmoidf_(g[0]) * up[0], g[1] * sigmoidf_(g[1]) * up[1]);
                  w.y = cvtpk(g[2] * sigmoidf_(g[2]) * up[2], g[3] * sigmoidf_(g[3]) * up[3]);
                  *(GAS u32x2*)(O + (size_t)row * DFF + col) = w; }); }
        if (BOTH(7)) GRID_BAR();
    }

    if (IN(8)) { PHASE_IDS
        { pg8::Gemm g{(const bf16*)(ws + WS_ACT8), (const bf16*)(ws + WS_WD8), MP, DM, DFF / 2}; pg8::StaticOrder S; S.init(MP, DM, G, bx, MK_WGM_P8);
          pg8::EpiSS<true> E{(bf16*)(ws + WS_FF), DM, (float*)(ws + WS_SS2), 0.0009765625f};
          pg8::gemm_phase<pg8::EpiSS<true>, pg8::StaticOrder, MK_AL_SS, true, true>(lds + RING_OFF, g, S, E); }
        { PHASE_IDS bf16* O = (bf16*)(ws + WS_FF); float* SSs = (float*)(ws + WS_SSS + SSS_2);
          skinny_gemm<1, DFF, 4>((const bf16*)(ws + WS_ACTS), (const bf16*)(ws + WS_WD), lds, DM / 16, vcu, G, tid, wave, lane,
              [](int it, int a, int fr) { return 16 * it + fr; },
              [O, SSs](int it, int row, int fq, const f32x4 (&acc)[1]) { const int col = 16 * it + 4 * fq;
                  u32x2 w; w.x = cvtpk_n(acc[0][0], acc[0][1]); w.y = cvtpk_n(acc[0][2], acc[0][3]);
                  *(GAS u32x2*)(O + (size_t)(MP + row) * DM + col) = w;
                  float s = (acc[0][0] * acc[0][0] + acc[0][1] * acc[0][1]) + (acc[0][2] * acc[0][2] + acc[0][3] * acc[0][3]);
                  s += __shfl_xor(s, 16); s += __shfl_xor(s, 32);
                  if (fq == 0) SSs[(size_t)row * 128 + it] = s; }); }
        if (BOTH(8)) GRID_BAR();
    }

    if (IN(9)) { PHASE_IDS rowpass2(args, lane, gw, NGW); }
#undef IN
#undef BOTH
}

#ifdef MK_DUMP_OFF
__global__ void dump_kernel(const unsigned short* src, float* dst, size_t n) {
    for (size_t i = (size_t)blockIdx.x * blockDim.x + threadIdx.x; i < n; i += (size_t)gridDim.x * blockDim.x) dst[i] = __uint_as_float((unsigned)src[i] << 16);
}
#endif
extern "C" void kernel_launch(void* const* d_in, const int* in_sizes, int n_in, void* d_out, int out_size, void* d_ws, size_t ws_size, hipStream_t stream) {
    static int grid = 0;
    if (grid == 0) {
        if (n_in != 32 || out_size != (int)O_END || ws_size < WS_END) { fprintf(stderr, "kernel_launch: unexpected problem: n_in %d out %d ws %zu\n", n_in, out_size, ws_size); grid = -1; return; }
        int dev = 0, cus = 0, per_cu = 0;
        if (hipGetDevice(&dev) != hipSuccess || hipDeviceGetAttribute(&cus, hipDeviceAttributeMultiprocessorCount, dev) != hipSuccess) { grid = -1; return; }
        if (hipFuncSetAttribute((const void*)hymba_fwd, hipFuncAttributeMaxDynamicSharedMemorySize, LDS_BYTES) != hipSuccess) { fprintf(stderr, "kernel_launch: hipFuncSetAttribute failed\n"); grid = -1; return; }
        if (hipOccupancyMaxActiveBlocksPerMultiprocessor(&per_cu, (const void*)hymba_fwd, NWAVES * 64, LDS_BYTES) != hipSuccess || per_cu < 1) { fprintf(stderr, "kernel_launch: occupancy query reports %d\n", per_cu); per_cu = 1; }
        (void)hipGetLastError();
        grid = cus;
    }
    if (grid < 0) return;
    Args a{};
    for (int i = 0; i < 32; ++i) a.in[i] = (const float*)d_in[i];
    a.out = (float*)d_out; a.ws = (unsigned char*)d_ws;
    int lo[N_PHASES + 2], hi[N_PHASES + 2], nl = 0;
#if defined(MK_REPEAT)
    lo[0] = 0; hi[0] = MK_REPEAT + 1; lo[1] = MK_REPEAT; hi[1] = MK_REPEAT + 1; lo[2] = MK_REPEAT + 1; hi[2] = N_PHASES; nl = 3;
#else
    if (N_LAUNCHES == 1) { lo[0] = 0; hi[0] = N_PHASES; nl = 1; } else { for (int k = 0; k < N_PHASES; ++k) { lo[k] = k; hi[k] = k + 1; } nl = N_PHASES; }
#endif
    if (hipMemsetAsync((char*)d_ws + WS_CTL, 0, (size_t)(CW_BAR + nl * XCD_BAR_WORDS) * 4, stream) != hipSuccess) return;
    for (int li = 0; li < nl; ++li) {
        a.ph_lo = lo[li]; a.ph_hi = hi[li]; a.li = li;
        hipLaunchKernelGGL(hymba_fwd, dim3(grid), dim3(NWAVES * 64), LDS_BYTES, stream, a);
    }
#ifdef MK_DUMP_OFF
    hipLaunchKernelGGL(dump_kernel, dim3(2048), dim3(256), 0, stream, (const unsigned short*)((const unsigned char*)d_ws + (size_t)(MK_DUMP_OFF) * MiB), (float*)d_out, (size_t)(MK_DUMP_N));
#endif
}
```

```cpp
#define MK_N_LAUNCHES 1
#include <hip/hip_runtime.h>
#include <cstdio>
#include <cstdint>
#include <cmath>
namespace pg8 {
#define PG8_LAS __attribute__((address_space(3)))
typedef unsigned short bf16_t;
typedef short bf16x8 __attribute__((ext_vector_type(8)));
typedef float f32x4 __attribute__((ext_vector_type(4)));
typedef unsigned u32x4 __attribute__((ext_vector_type(4)));
typedef int i32x4 __attribute__((ext_vector_type(4)));
typedef int i32x8 __attribute__((ext_vector_type(8)));
__device__ __forceinline__ i32x8 cat8(bf16x8 lo, bf16x8 hi) { return __builtin_shufflevector(__builtin_bit_cast(i32x4, lo), __builtin_bit_cast(i32x4, hi), 0, 1, 2, 3, 4, 5, 6, 7); }
constexpr int BM = 256, BK = 64, HALF = 128, HTB = HALF * BK * 2  , STAGE_BYTES = 8 * HTB, NXCD = 8, WGM = 4;

__host__ __device__ __forceinline__ int lds_byte(int r, int c) { const int st = (r >> 4) * 2 + (c >> 5), rr = r & 15, cc = c & 31, ob = rr * 64 + cc * 2; return st * 1024 + (ob ^ (((ob >> 9) & 1) << 5)); }
__host__ __device__ __forceinline__ void stage_rc(int b, int& R, int& C) { const int st = b / 1024, sb = b % 1024, swz = sb ^ (((sb >> 9) & 1) << 5); R = (st >> 1) * 16 + swz / 64; C = (st & 1) * 32 + (swz % 64) / 2; }
__host__ __device__ __forceinline__ int perm32(int rho) { const int n = rho >> 4, i = rho & 15; return 8 * (i >> 2) + 4 * n + (i & 3); }

struct Unit { int pm, pn; };
struct Gemm { const bf16_t* A; const bf16_t* Bt; int M, N, K; };

struct StaticOrder {
    int nM, nN, nwg, G, c, wgm;
    __host__ __device__ void init(int M, int N, int G_, int c_, int wgm_ = WGM) { nM = M / BM; nN = N / BM; nwg = nM * nN; G = G_; c = c_; wgm = wgm_; }
    __host__ __device__ bool next(int i, Unit& u) const {
        const long L = (long)i * G + c; if (L >= nwg) return false;
        int wgid = (int)L; { const int q = nwg / NXCD, r = nwg % NXCD, xcd = wgid % NXCD, off = wgid / NXCD; wgid = (xcd < r ? xcd * (q + 1) : r * (q + 1) + (xcd - r) * q) + off; }
        const int nig = wgm * nN, gid = wgid / nig, fm = gid * wgm, gsz = (nM - fm) < wgm ? (nM - fm) : wgm;
        u.pm = fm + ((wgid % nig) % gsz); u.pn = (wgid % nig) / gsz; return true;
    }
    __device__ __forceinline__ void a_ready(const Unit&) const {}
    __device__ __forceinline__ void done(const Unit&) const {}
};

__device__ __forceinline__ unsigned cvt_pk_bf16(float lo, float hi) { unsigned r; asm volatile("v_cvt_pk_bf16_f32 %0, %1, %2" : "=v"(r) : "v"(lo), "v"(hi)); return r; }
typedef float f32x2 __attribute__((ext_vector_type(2)));
__device__ __forceinline__ f32x2 gelu_pk(f32x2 v) {
    const f32x2 av = __builtin_elementwise_abs(v), d = av * 0.2316418882f + 1.0f;
    f32x2 t; t.x = __builtin_amdgcn_rcpf(d.x); t.y = __builtin_amdgcn_rcpf(d.y);
    f32x2 q = t * 0.5307027145f + (-0.7265760135f); q = q * t + 0.7107068705f; q = q * t + (-0.142248368f); q = q * t + 0.127414796f; q = q * t;
    const f32x2 s = (v * v) * (-0.72134752044f);
    f32x2 e; e.x = __builtin_amdgcn_exp2f(s.x); e.y = __builtin_amdgcn_exp2f(s.y);
    const f32x2 m = v * (q * e), r = v - m;
    f32x2 o; o.x = v.x < 0.f ? m.x : r.x; o.y = v.y < 0.f ? m.y : r.y; return o;
}

template <int ACT  > struct EpiBf16 {
    static constexpr bool PERM = true, AFTER_DRAIN = false; static_assert(ACT == 0 || ACT == 1, "EpiBf16: ACT is 0 (none) or 1 (gelu_pk)");
    bf16_t* O; int ldc; const float* bias; int split_cols; size_t split_stride; float scale0;
    __device__ __forceinline__ void operator()(const f32x4 (&acc)[2][2][4][2], const Unit& u, int wr, int wc, int fr, int fq) const {
        const int row0 = u.pm * BM + wr * 64 + fr; int colt = u.pn * BM; bf16_t* base = O;
        float sc = 1.f; if (split_cols) { const int t = colt / split_cols; base += (size_t)t * split_stride; colt -= t * split_cols; if (t == 0) sc = scale0; }
        const int col0 = colt + wc * 32 + 8 * fq, bcol0 = u.pn * BM + wc * 32 + 8 * fq;
        f32x4 bv[2][2];
#pragma unroll
        for (int bj = 0; bj < 2; ++bj)
#pragma unroll
            for (int n = 0; n < 2; ++n) bv[bj][n] = bias ? *(const f32x4*)(bias + bcol0 + bj * HALF + 4 * n) : (f32x4){0.f, 0.f, 0.f, 0.f};
#pragma unroll
        for (int ai = 0; ai < 2; ++ai)
#pragma unroll
            for (int m = 0; m < 4; ++m) { bf16_t* rowp = base + (size_t)(row0 + ai * HALF + m * 16) * ldc + col0;
#pragma unroll
                for (int bj = 0; bj < 2; ++bj) { f32x4 v0 = acc[ai][bj][m][0] + bv[bj][0], v1 = acc[ai][bj][m][1] + bv[bj][1];
                    if (ACT == 1) { f32x2 a = gelu_pk((f32x2){v0[0], v0[1]}), b = gelu_pk((f32x2){v0[2], v0[3]}), c = gelu_pk((f32x2){v1[0], v1[1]}), d = gelu_pk((f32x2){v1[2], v1[3]});
                        v0 = (f32x4){a.x, a.y, b.x, b.y}; v1 = (f32x4){c.x, c.y, d.x, d.y}; }
                    v0 = v0 * sc; v1 = v1 * sc; u32x4 w; w.x = cvt_pk_bf16(v0[0], v0[1]); w.y = cvt_pk_bf16(v0[2], v0[3]); w.z = cvt_pk_bf16(v1[0], v1[1]); w.w = cvt_pk_bf16(v1[2], v1[3]);
                    *(u32x4*)(rowp + bj * HALF) = w; } }
    }
};
__device__ __forceinline__ float fast_sigmoid(float v) { return __builtin_amdgcn_rcpf(1.0f + __expf(-v)); }
__device__ __forceinline__ float bf_lo(unsigned w) { return __uint_as_float(w << 16); }
__device__ __forceinline__ float bf_hi(unsigned w) { return __uint_as_float(w & 0xffff0000u); }
struct EpiGlu {
    static constexpr bool PERM = true, AFTER_DRAIN = false;
    const bf16_t* Z; bf16_t* O; const float* bias;
    __device__ __forceinline__ void operator()(const f32x4 (&acc)[2][2][4][2], const Unit& u, int wr, int wc, int fr, int fq) const {
        const int row0 = u.pm * BM + wr * 64 + fr, col0 = u.pn * BM + wc * 32 + 8 * fq;
        f32x4 bv[2][2];
#pragma unroll
        for (int bj = 0; bj < 2; ++bj)
#pragma unroll
            for (int n = 0; n < 2; ++n) bv[bj][n] = *(const f32x4*)(bias + col0 + bj * HALF + 4 * n);
#pragma unroll
        for (int ai = 0; ai < 2; ++ai) {
            u32x4 z[4][2];
#pragma unroll
            for (int m = 0; m < 4; ++m)
#pragma unroll
                for (int bj = 0; bj < 2; ++bj) z[m][bj] = *(const u32x4*)(Z + (size_t)(row0 + ai * HALF + m * 16) * 1024 + col0 + bj * HALF);
#pragma unroll
            for (int m = 0; m < 4; ++m) { const size_t row = (size_t)(row0 + ai * HALF + m * 16);
#pragma unroll
                for (int bj = 0; bj < 2; ++bj) { const int col = col0 + bj * HALF; const u32x4 zz = z[m][bj];
                    const f32x4 v0 = acc[ai][bj][m][0] + bv[bj][0], v1 = acc[ai][bj][m][1] + bv[bj][1];
                    u32x4 w;
                    w.x = cvt_pk_bf16(bf_lo(zz.x) * fast_sigmoid(v0[0]), bf_hi(zz.x) * fast_sigmoid(v0[1]));
                    w.y = cvt_pk_bf16(bf_lo(zz.y) * fast_sigmoid(v0[2]), bf_hi(zz.y) * fast_sigmoid(v0[3]));
                    w.z = cvt_pk_bf16(bf_lo(zz.z) * fast_sigmoid(v1[0]), bf_hi(zz.z) * fast_sigmoid(v1[1]));
                    w.w = cvt_pk_bf16(bf_lo(zz.w) * fast_sigmoid(v1[2]), bf_hi(zz.w) * fast_sigmoid(v1[3]));
                    *(u32x4*)(O + row * 2048 + 1024 + col) = w; } } }
    }
};
template <bool SCALED> struct EpiSS {
    static constexpr bool PERM = true, AFTER_DRAIN = false;
    bf16_t* O; int ldc; float* SS; float scale;
    __device__ __forceinline__ void operator()(const f32x4 (&acc)[2][2][4][2], const Unit& u, int wr, int wc, int fr, int fq) const {
        const int row0 = u.pm * BM + wr * 64 + fr, col0 = u.pn * BM + wc * 32 + 8 * fq;
        float s[2][4];
#pragma unroll
        for (int ai = 0; ai < 2; ++ai)
#pragma unroll
            for (int m = 0; m < 4; ++m) { const size_t row = (size_t)(row0 + ai * HALF + m * 16); float t = 0.f;
#pragma unroll
                for (int bj = 0; bj < 2; ++bj) { f32x4 v0 = acc[ai][bj][m][0], v1 = acc[ai][bj][m][1]; if (SCALED) { v0 = v0 * scale; v1 = v1 * scale; }
                    t += (v0[0] * v0[0] + v0[1] * v0[1]) + (v0[2] * v0[2] + v0[3] * v0[3]) + (v1[0] * v1[0] + v1[1] * v1[1]) + (v1[2] * v1[2] + v1[3] * v1[3]);
                    u32x4 w; w.x = cvt_pk_bf16(v0[0], v0[1]); w.y = cvt_pk_bf16(v0[2], v0[3]); w.z = cvt_pk_bf16(v1[0], v1[1]); w.w = cvt_pk_bf16(v1[2], v1[3]);
                    *(u32x4*)(O + row * ldc + col0 + bj * HALF) = w; }
                s[ai][m] = t; }
#pragma unroll
        for (int ai = 0; ai < 2; ++ai)
#pragma unroll
            for (int m = 0; m < 4; ++m) s[ai][m] += __shfl_xor(s[ai][m], 16);
#pragma unroll
        for (int ai = 0; ai < 2; ++ai)
#pragma unroll
            for (int m = 0; m < 4; ++m) s[ai][m] += __shfl_xor(s[ai][m], 32);
        if (fq == 0) {
#pragma unroll
            for (int ai = 0; ai < 2; ++ai)
#pragma unroll
                for (int m = 0; m < 4; ++m) SS[(size_t)(row0 + ai * HALF + m * 16) * 32 + u.pn * 4 + wc] = s[ai][m]; }
    }
};
struct EpiGU {
    static constexpr bool PERM = true, AFTER_DRAIN = false;
    bf16_t* O; int ldc;
    static __device__ __forceinline__ unsigned swiglu_pk(f32x2 g, f32x2 u) {
        const f32x2 t = g * -1.4426950408889634f; f32x2 e; e.x = __builtin_amdgcn_exp2f(t.x); e.y = __builtin_amdgcn_exp2f(t.y);
        const f32x2 d = e + 1.0f; f32x2 s; s.x = __builtin_amdgcn_rcpf(d.x); s.y = __builtin_amdgcn_rcpf(d.y);
        const f32x2 o = (g * u) * s; return cvt_pk_bf16(o.x, o.y);
    }
    __device__ __forceinline__ void operator()(const f32x4 (&acc)[2][2][4][2], const Unit& u, int wr, int wc, int fr, int fq) const {
        const int row0 = u.pm * BM + wr * 64 + fr, col0 = u.pn * HALF + wc * 32 + 8 * fq;
#pragma unroll
        for (int ai = 0; ai < 2; ++ai)
#pragma unroll
            for (int m = 0; m < 4; ++m) { const size_t row = (size_t)(row0 + ai * HALF + m * 16);
                const f32x4 g0 = acc[ai][0][m][0], g1 = acc[ai][0][m][1], u0 = acc[ai][1][m][0], u1 = acc[ai][1][m][1];
                u32x4 w;
                w.x = swiglu_pk((f32x2){g0[0], g0[1]}, (f32x2){u0[0], u0[1]});
                w.y = swiglu_pk((f32x2){g0[2], g0[3]}, (f32x2){u0[2], u0[3]});
                w.z = swiglu_pk((f32x2){g1[0], g1[1]}, (f32x2){u1[0], u1[1]});
                w.w = swiglu_pk((f32x2){g1[2], g1[3]}, (f32x2){u1[2], u1[3]});
                *(u32x4*)(O + row * ldc + col0) = w; }
    }
};
struct EpiGU8 {
    static constexpr bool PERM = true, AFTER_DRAIN = false;
    unsigned char* O; int ldc;
    static __device__ __forceinline__ f32x2 swiglu2(f32x2 g, f32x2 u) {
        const f32x2 t = g * -1.4426950408889634f; f32x2 e; e.x = __builtin_amdgcn_exp2f(t.x); e.y = __builtin_amdgcn_exp2f(t.y);
        const f32x2 d = e + 1.0f; f32x2 s; s.x = __builtin_amdgcn_rcpf(d.x); s.y = __builtin_amdgcn_rcpf(d.y);
        f32x2 o = (g * u) * s; o.x = __builtin_amdgcn_fmed3f(o.x, -448.f, 448.f); o.y = __builtin_amdgcn_fmed3f(o.y, -448.f, 448.f); return o;
    }
    __device__ __forceinline__ void operator()(const f32x4 (&acc)[2][2][4][2], const Unit& u, int wr, int wc, int fr, int fq) const {
        const int row0 = u.pm * BM + wr * 64 + fr, col0 = u.pn * HALF + wc * 32 + 8 * fq;
#pragma unroll
        for (int ai = 0; ai < 2; ++ai)
#pragma unroll
            for (int m = 0; m < 4; ++m) { const size_t row = (size_t)(row0 + ai * HALF + m * 16);
                const f32x4 g0 = acc[ai][0][m][0], g1 = acc[ai][0][m][1], u0 = acc[ai][1][m][0], u1 = acc[ai][1][m][1];
                const f32x2 a = swiglu2((f32x2){g0[0], g0[1]}, (f32x2){u0[0], u0[1]}), b = swiglu2((f32x2){g0[2], g0[3]}, (f32x2){u0[2], u0[3]});
                const f32x2 c = swiglu2((f32x2){g1[0], g1[1]}, (f32x2){u1[0], u1[1]}), d = swiglu2((f32x2){g1[2], g1[3]}, (f32x2){u1[2], u1[3]});
                int w0 = 0, w1 = 0;
                w0 = __builtin_amdgcn_cvt_pk_fp8_f32(a.x, a.y, w0, false); w0 = __builtin_amdgcn_cvt_pk_fp8_f32(b.x, b.y, w0, true);
                w1 = __builtin_amdgcn_cvt_pk_fp8_f32(c.x, c.y, w1, false); w1 = __builtin_amdgcn_cvt_pk_fp8_f32(d.x, d.y, w1, true);
                typedef unsigned u32x2_t __attribute__((ext_vector_type(2)));
                *(u32x2_t*)(O + row * ldc + col0) = (u32x2_t){(unsigned)w0, (unsigned)w1}; }
    }
};
template <class Epi, class Sched, bool ALIGN_EPI = false, bool SP2 = false, bool F8 = false>
__device__ __forceinline__ void gemm_phase(PG8_LAS unsigned char* lds, const Gemm g, const Sched& S, const Epi& E) {
    int tid = threadIdx.x; asm volatile("" : "+v"(tid));
    const int wid = __builtin_amdgcn_readfirstlane(tid >> 6), lane = tid & 63, wr = wid >> 2, wc = wid & 3, fr = lane & 15, fq = lane >> 4;
    const int K = g.K, nt = K / BK;
    unsigned voffA[2], voffB[2];
#pragma unroll
    for (int i = 0; i < 2; ++i) { int R, C; stage_rc(tid * 16 + i * 8192, R, C); const int Rb = Epi::PERM ? ((R & ~31) + perm32(R & 31)) : R;
        voffA[i] = (unsigned)(R * K + C) * 2u; voffB[i] = (unsigned)(Rb * K + C) * 2u; }
    const size_t kstep = (size_t)(BK * 2);
    const size_t hstep = (size_t)HALF * K * 2;
    const size_t tstep = 2 * hstep;
    const unsigned ldsw = (unsigned)wid * 1024u;
    const int aoff = lds_byte(wr * 64 + fr, fq * 8), boff = lds_byte(wc * 32 + fr, fq * 8);
#define PG8_SA(b, h) (((b) * 2 + (h)) * HTB)
#define PG8_SB(b, h) ((4 + (b) * 2 + (h)) * HTB)
#define PG8_STAGE(bufoff, gbase, voff) do { _Pragma("unroll") for (int _i = 0; _i < 2; ++_i) { unsigned _vo = (voff)[_i]; asm volatile("" : "+v"(_vo));     \
        __builtin_amdgcn_global_load_lds((const unsigned*)((const char*)(gbase) + _vo), (PG8_LAS unsigned*)(lds + (bufoff) + ldsw + _i * 8192), 16, 0, 0); } } while (0)
#define PG8_LDA(dst, b, h) do { _Pragma("unroll") for (int m = 0; m < 4; ++m) _Pragma("unroll") for (int k = 0; k < 2; ++k) dst[m][k] = *(const PG8_LAS bf16x8*)(lds + PG8_SA(b, h) + aoff + m * 2048 + k * 1024); } while (0)
#define PG8_LDB(dst, b, h) do { _Pragma("unroll") for (int n = 0; n < 2; ++n) _Pragma("unroll") for (int k = 0; k < 2; ++k) dst[n][k] = *(const PG8_LAS bf16x8*)(lds + PG8_SB(b, h) + boff + n * 2048 + k * 1024); } while (0)
#define PG8_MMA(ai, bj, At, Bt) do { __builtin_amdgcn_s_setprio(1); \
        if constexpr (F8) { _Pragma("unroll") for (int m = 0; m < 4; ++m) _Pragma("unroll") for (int n = 0; n < 2; ++n) \
            acc[ai][bj][m][n] = __builtin_amdgcn_mfma_scale_f32_16x16x128_f8f6f4(cat8(Bt[n][0], Bt[n][1]), cat8(At[m][0], At[m][1]), acc[ai][bj][m][n], 0, 0, 0, 0, 0, 0); } \
        else { _Pragma("unroll") for (int m = 0; m < 4; ++m) _Pragma("unroll") for (int n = 0; n < 2; ++n) _Pragma("unroll") for (int k = 0; k < 2; ++k) \
            acc[ai][bj][m][n] = __builtin_amdgcn_mfma_f32_16x16x32_bf16(Bt[n][k], At[m][k], acc[ai][bj][m][n], 0, 0, 0); } \
        __builtin_amdgcn_s_setprio(0); } while (0)
#define PG8_WAIT_V(n) asm volatile("s_waitcnt vmcnt(" #n ")" ::: "memory")
#define PG8_WAIT_L(n) asm volatile("s_waitcnt lgkmcnt(" #n ")" ::: "memory")
#define PG8_BAR __builtin_amdgcn_s_barrier()
#define PG8_SCHED __builtin_amdgcn_sched_barrier(0)
    Unit cur, nxt; int ui = 0;
    if (!S.next(0, cur)) return;
    f32x4 acc[2][2][4][2];
#pragma unroll
    for (int a = 0; a < 2; ++a)
#pragma unroll
        for (int b = 0; b < 2; ++b)
#pragma unroll
            for (int m = 0; m < 4; ++m)
#pragma unroll
                for (int n = 0; n < 2; ++n) acc[a][b][m][n] = (f32x4){0.f, 0.f, 0.f, 0.f};
    bf16x8 At[4][2], B0[2][2], B1[2][2];
    const char* cA = (const char*)g.A + (size_t)cur.pm * tstep; const char* cB = (const char*)g.Bt + (size_t)cur.pn * tstep;
    S.a_ready(cur);
    if constexpr (SP2) {
        PG8_STAGE(PG8_SB(0, 0), cB, voffB); PG8_STAGE(PG8_SB(0, 1), cB + hstep, voffB); PG8_STAGE(PG8_SA(0, 0), cA, voffA); PG8_STAGE(PG8_SA(0, 1), cA + hstep, voffA);
        if (wr == 1) PG8_BAR;
        PG8_WAIT_V(2); PG8_BAR;
        PG8_STAGE(PG8_SB(1, 0), cB + kstep, voffB); PG8_STAGE(PG8_SA(1, 0), cA + kstep, voffA); PG8_STAGE(PG8_SB(1, 1), cB + hstep + kstep, voffB);
        PG8_WAIT_V(6); PG8_BAR;
    } else {
        PG8_STAGE(PG8_SB(0, 0), cB, voffB); PG8_STAGE(PG8_SA(0, 0), cA, voffA); PG8_STAGE(PG8_SB(0, 1), cB + hstep, voffB); PG8_STAGE(PG8_SA(0, 1), cA + hstep, voffA);
        if (wr == 1) PG8_BAR;
        PG8_WAIT_V(4); PG8_BAR;
        PG8_STAGE(PG8_SB(1, 0), cB + kstep, voffB); PG8_STAGE(PG8_SA(1, 0), cA + kstep, voffA); PG8_STAGE(PG8_SB(1, 1), cB + hstep + kstep, voffB);
        PG8_WAIT_V(6); PG8_BAR;
    }
    for (;;) {
        const bool has_next = S.next(ui + 1, nxt);
        const char* nA = has_next ? (const char*)g.A + (size_t)nxt.pm * tstep : cA; const char* nB = has_next ? (const char*)g.Bt + (size_t)nxt.pn * tstep : cB;
        for (int t = 0; t < nt; t += 2) {
            const bool last = (t == nt - 2);
            const char* a1 = cA + (size_t)(t + 1) * kstep;
            const char* a2 = last ? nA : cA + (size_t)(t + 2) * kstep; const char* b2 = last ? nB : cB + (size_t)(t + 2) * kstep;
            const char* a3 = a2 + kstep; const char* b3 = b2 + kstep;
            if (last && has_next) S.a_ready(nxt);
            if constexpr (SP2) {
            PG8_LDB(B0, 0, 0); PG8_LDB(B1, 0, 1); PG8_SCHED; PG8_LDA(At, 0, 0); PG8_STAGE(PG8_SA(1, 1), a1 + hstep, voffA);
            PG8_WAIT_V(8); PG8_WAIT_L(0); PG8_BAR; PG8_MMA(0, 0, At, B0); PG8_MMA(0, 1, At, B1); PG8_BAR; PG8_SCHED;
            PG8_LDA(At, 0, 1); PG8_STAGE(PG8_SB(0, 0), b2, voffB); PG8_STAGE(PG8_SB(0, 1), b2 + hstep, voffB); PG8_STAGE(PG8_SA(0, 0), a2, voffA);
            PG8_WAIT_V(8); PG8_WAIT_L(0); PG8_BAR; PG8_MMA(1, 0, At, B0); PG8_MMA(1, 1, At, B1); PG8_BAR; PG8_SCHED;
            PG8_LDB(B0, 1, 0); PG8_LDB(B1, 1, 1); PG8_SCHED; PG8_LDA(At, 1, 0); PG8_STAGE(PG8_SA(0, 1), a2 + hstep, voffA);
            PG8_WAIT_V(8); PG8_WAIT_L(0); PG8_BAR; PG8_MMA(0, 0, At, B0); PG8_MMA(0, 1, At, B1); PG8_BAR; PG8_SCHED;
            PG8_LDA(At, 1, 1); PG8_STAGE(PG8_SB(1, 0), b3, voffB); PG8_STAGE(PG8_SB(1, 1), b3 + hstep, voffB); PG8_STAGE(PG8_SA(1, 0), a3, voffA);
            PG8_WAIT_V(8); PG8_WAIT_L(0); PG8_BAR; PG8_MMA(1, 0, At, B0); PG8_MMA(1, 1, At, B1); PG8_BAR; PG8_SCHED;
            } else {
            PG8_LDB(B0, 0, 0); PG8_SCHED; PG8_LDA(At, 0, 0); PG8_STAGE(PG8_SA(1, 1), a1 + hstep, voffA);
            PG8_WAIT_L(8); PG8_BAR; PG8_WAIT_L(0); PG8_MMA(0, 0, At, B0); PG8_BAR; PG8_SCHED;
            PG8_LDB(B1, 0, 1); PG8_STAGE(PG8_SB(0, 0), b2, voffB);
            PG8_BAR; PG8_WAIT_L(0); PG8_MMA(0, 1, At, B1); PG8_BAR;
            PG8_LDA(At, 0, 1); PG8_STAGE(PG8_SA(0, 0), a2, voffA);
            PG8_BAR; PG8_WAIT_L(0); PG8_MMA(1, 0, At, B0); PG8_BAR; PG8_SCHED;
            PG8_STAGE(PG8_SB(0, 1), b2 + hstep, voffB);
            PG8_WAIT_V(6); PG8_BAR; PG8_MMA(1, 1, At, B1); PG8_BAR;
            PG8_LDB(B0, 1, 0); PG8_SCHED; PG8_LDA(At, 1, 0); PG8_STAGE(PG8_SA(0, 1), a2 + hstep, voffA);
            PG8_WAIT_L(8); PG8_BAR; PG8_WAIT_L(0); PG8_MMA(0, 0, At, B0); PG8_BAR; PG8_SCHED;
            PG8_LDB(B1, 1, 1); PG8_STAGE(PG8_SB(1, 0), b3, voffB);
            PG8_BAR; PG8_WAIT_L(0); PG8_MMA(0, 1, At, B1); PG8_BAR;
            PG8_LDA(At, 1, 1); PG8_STAGE(PG8_SA(1, 0), a3, voffA);
            PG8_BAR; PG8_WAIT_L(0); PG8_MMA(1, 0, At, B0); PG8_BAR; PG8_SCHED;
            PG8_STAGE(PG8_SB(1, 1), b3 + hstep, voffB);
            PG8_WAIT_V(6); PG8_BAR; PG8_MMA(1, 1, At, B1); PG8_BAR;
            }
        }
        if constexpr (ALIGN_EPI) { if (wr == 0) PG8_BAR; }
        if constexpr (!Epi::AFTER_DRAIN) { int t2 = threadIdx.x; asm volatile("" : "+v"(t2)); E(acc, cur, wr, wc, t2 & 15, (t2 >> 4) & 3); S.done(cur); }
        if (!has_next) break;
#pragma unroll
        for (int a = 0; a < 2; ++a)
#pragma unroll
            for (int b = 0; b < 2; ++b)
#pragma unroll
                for (int m = 0; m < 4; ++m)
#pragma unroll
                    for (int n = 0; n < 2; ++n) acc[a][b][m][n] = (f32x4){0.f, 0.f, 0.f, 0.f};
        cur = nxt; cA = nA; cB = nB; ++ui;
        if constexpr (ALIGN_EPI) { if (wr == 1) PG8_BAR; }
    }
    PG8_WAIT_V(0);
    if constexpr (!ALIGN_EPI) { if (wr == 0) PG8_BAR; }
    PG8_BAR;
    if constexpr (Epi::AFTER_DRAIN) { E.fused(acc, cur, wr, wc, fr, fq, lds, wid, lane); S.done(cur); }
#undef PG8_SA
#undef PG8_SB
#undef PG8_STAGE
#undef PG8_LDA
#undef PG8_LDB
#undef PG8_MMA
#undef PG8_WAIT_V
#undef PG8_WAIT_L
#undef PG8_BAR
#undef PG8_SCHED
}
}
#define GAS __attribute__((address_space(1)))
#define LAS __attribute__((address_space(3)))
typedef unsigned short bf16;
typedef unsigned v4u __attribute__((ext_vector_type(4)));
typedef float f32x4 __attribute__((ext_vector_type(4)));
typedef short bf16x8 __attribute__((ext_vector_type(8)));
typedef GAS unsigned gu32;
typedef GAS unsigned long long gu64;
#define RLX_AGENT __ATOMIC_RELAXED, __HIP_MEMORY_SCOPE_AGENT
#define LDS_WAIT() asm volatile("s_waitcnt lgkmcnt(0)" ::: "memory")
#define VM_WAIT() asm volatile("s_waitcnt vmcnt(0)" ::: "memory")
__device__ __forceinline__ unsigned long long rt() { return __builtin_amdgcn_s_memrealtime(); }
__device__ __forceinline__ unsigned f2bf(float f) { unsigned u = __builtin_bit_cast(unsigned, f); return (u + 0x7fffu + ((u >> 16) & 1u)) >> 16; }
__device__ __forceinline__ unsigned pk2(float lo, float hi) { return f2bf(lo) | (f2bf(hi) << 16); }
#define XB_TMO      128
#define XB_XCNT(j)  (256  + 64 * (j))
#define XB_XSUB(j)  (1280 + 64 * (j))
#define XB_XGEN(j)  (2304 + 64 * (j))
#define XB_TOP      3328
#define XB_TOPGEN   3392
#define XCD_BAR_WORDS 3456
#define XB_SPIN_CAP (1u << 18)

__device__ __forceinline__ unsigned xb_ld(unsigned* p)              { return __hip_atomic_load(p, __ATOMIC_RELAXED, __HIP_MEMORY_SCOPE_AGENT); }
__device__ __forceinline__ unsigned xb_add(unsigned* p, unsigned v) { return __hip_atomic_fetch_add(p, v, __ATOMIC_RELAXED, __HIP_MEMORY_SCOPE_AGENT); }
__device__ __forceinline__ unsigned xb_xcc_id() { return (unsigned)__builtin_amdgcn_s_getreg((3 << 11) | 20) & 0xFu; }
#define XB_SPIN(cond, bar) do { unsigned _sp = 0; while (cond) { __builtin_amdgcn_s_sleep(1); \
    if ((++_sp & 255u) == 0u) { if (xb_ld(&(bar)[XB_TMO])) break; if (_sp > XB_SPIN_CAP) { atomicAdd(&(bar)[XB_TMO], 1u); break; } } } } while (0)

struct XcdBarrier {
    unsigned* bar; unsigned x;
    volatile LAS unsigned* st;
};

__device__ __forceinline__ XcdBarrier xcd_barrier_post(unsigned* bar, volatile LAS unsigned* st) {
    XcdBarrier b; b.bar = bar; b.x = xb_xcc_id(); b.st = st;
    if (threadIdx.x == 0) (void)xb_add(&bar[XB_XCNT(b.x)], 1u);
    return b;
}
__device__ __forceinline__ void xcd_barrier_complete(unsigned* bar, unsigned x, unsigned& nloc, unsigned& nx) {
    const unsigned G = gridDim.x * gridDim.y * gridDim.z;
    unsigned sum, cnt, mine, sp = 0u;
    for (;;) {
        sum = 0u; cnt = 0u; mine = 0u;
#pragma unroll
        for (unsigned j = 0; j < 16; ++j) { const unsigned c = xb_ld(&bar[XB_XCNT(j)]); sum += c; cnt += (c > 0u) ? 1u : 0u; mine = (j == x) ? c : mine; }
        if (sum == G) break;
        __builtin_amdgcn_s_sleep(1);
        if ((++sp & 255u) == 0u) { if (xb_ld(&bar[XB_TMO])) break; if (sp > XB_SPIN_CAP) { atomicAdd(&bar[XB_TMO], 1u); break; } }
    }
    nloc = mine > 0u ? mine : 1u; nx = cnt > 0u ? cnt : 1u;
}

__device__ __forceinline__ void xcd_barrier(const XcdBarrier& b) {
    asm volatile("s_waitcnt vmcnt(0)" ::: "memory");
    __syncthreads();
    if (threadIdx.x == 0) {
        unsigned* bar = b.bar;
        __builtin_amdgcn_s_waitcnt(0);
        unsigned nloc = b.st[0], nx = b.st[1];
        if (nloc == 0u) { xcd_barrier_complete(bar, b.x, nloc, nx); b.st[0] = nloc; b.st[1] = nx; }
        const unsigned old = xb_add(&bar[XB_XSUB(b.x)], 1u);
        const unsigned gen = old / nloc;
        if (old + 1u == (gen + 1u) * nloc) {
            __builtin_amdgcn_fence(__ATOMIC_RELEASE, "agent");
            asm volatile("s_waitcnt vmcnt(0)" ::: "memory");
            const unsigned og = xb_add(&bar[XB_TOP], 1u);
            const unsigned tg = og / nx;
            if (og + 1u == (tg + 1u) * nx) xb_add(&bar[XB_TOPGEN], 1u);
            else XB_SPIN(xb_ld(&bar[XB_TOPGEN]) == tg, bar);
            __builtin_amdgcn_fence(__ATOMIC_ACQUIRE, "agent");
            asm volatile("s_waitcnt vmcnt(0)" ::: "memory");
        } else {
            __builtin_amdgcn_fence(__ATOMIC_ACQUIRE, "agent");
            XB_SPIN(xb_ld(&bar[XB_TOPGEN]) == gen, bar);
            asm volatile("s_waitcnt vmcnt(0)" ::: "memory");
        }
    }
    __syncthreads();
}
constexpr int NWAVES = 8;
#ifndef MK_N_LAUNCHES
#define MK_N_LAUNCHES 1
#endif
constexpr int N_PHASES = 10;
constexpr int N_LAUNCHES = MK_N_LAUNCHES;

constexpr int DM = 2048, NBATCH = 8, SEQ = 2048, MP = NBATCH * SEQ, SBATCH = 8, SLEN = 16, MS = SBATCH * SLEN, MT = MP + MS;
constexpr int NH = 4, DV = 256, DQK = 128, QKW = 1024, NG = 64, GCH = 16, PST = 64, DFF = 5632, NIN = 4104;
constexpr int CH = 64, NCH = SEQ / CH;
constexpr int NSC = NBATCH * NCH + SBATCH;
constexpr float EPS = 1e-6f;
constexpr int DVS = 64, NSL = DV / DVS;

constexpr size_t O_Y = 0, O_CONVP = (size_t)MT * DM, O_CP = O_CONVP + 8 * 3 * 1024, O_NP = O_CP + 8 * 4 * 256 * 128, O_MP = O_NP + 8 * 4 * 128,
                 O_SRP = O_MP + 32, O_SIP = O_SRP + 8 * 64 * 64, O_CONVS = O_SIP + 8 * 64 * 64, O_CS = O_CONVS + 8 * 3 * 1024, O_NS = O_CS + 8 * 4 * 256 * 128,
                 O_MS = O_NS + 8 * 4 * 128, O_SRS = O_MS + 32, O_SIS = O_SRS + 8 * 64 * 64, O_END = O_SIS + 8 * 64 * 64;
static_assert(O_END == 36102208, "d_out map");

constexpr size_t MiB = 1u << 20;
constexpr size_t WS_CTL = 0, CTL_ZERO_BYTES = 1 * MiB;
constexpr size_t WS_WIN = 2 * MiB, WS_WGLU = 18 * MiB, WS_WOUT = 20 * MiB, WS_WGU = 28 * MiB, WS_WD = 72 * MiB;
constexpr size_t WS_XN = 96 * MiB;
constexpr size_t WS_R0 = 162 * MiB, WS_RSTRIDE = 33 * MiB;
constexpr size_t WS_QKRAW = WS_R0, WS_V = WS_R0 + WS_RSTRIDE, WS_OG = WS_R0 + 2 * WS_RSTRIDE, WS_U = WS_R0 + 3 * WS_RSTRIDE;
constexpr size_t WS_Q = 294 * MiB, WS_K = 311 * MiB;
constexpr size_t WS_Z = WS_QKRAW;
constexpr size_t WS_MIXIN = WS_Q;
constexpr size_t WS_MIX = WS_R0;
constexpr size_t WS_ACT8 = WS_R0;
constexpr size_t WS_ACTS = WS_R0 + 90 * MiB;
constexpr size_t WS_X1B = WS_XN;
constexpr size_t WS_FF = 427 * MiB;
constexpr size_t WS_GATES = 378 * MiB, WS_HSS = 379 * MiB, WS_SS1 = 382 * MiB, WS_SS2 = 385 * MiB, WS_S5P = 388 * MiB, WS_SSS = 389 * MiB;
constexpr size_t WS_HS = 390 * MiB;
constexpr size_t WS_SCAL = 423 * MiB, WS_WD8 = 492 * MiB, WS_END = 504 * MiB;
static_assert(WS_XN + (size_t)MT * DM * 2 <= WS_R0 && WS_QKRAW + (size_t)MT * 1024 * 2 <= WS_V && WS_U + (size_t)MT * 1024 * 2 <= WS_Q && WS_Q + (size_t)MT * 512 * 2 <= WS_K &&
              WS_K + (size_t)MT * 512 * 2 <= WS_GATES && WS_MIXIN + (size_t)MT * DM * 2 <= WS_GATES && WS_MIX + (size_t)MT * DM * 2 <= WS_OG && WS_ACT8 + (size_t)MP * DFF <= WS_ACTS && WS_ACTS + (size_t)MS * DFF * 2 <= WS_GATES && WS_FF + (size_t)MT * DM * 2 <= WS_WD8 && WS_WD8 + (size_t)DM * DFF <= WS_END &&
              WS_WD + (size_t)DM * DFF * 2 <= WS_XN && WS_WGU + (size_t)2 * DFF * DM * 2 <= WS_WD && WS_HSS + (size_t)MT * 32 * 4 <= WS_SS1 && WS_SS1 + (size_t)MT * 32 * 4 <= WS_SS2 &&
              WS_SS2 + (size_t)MT * 32 * 4 <= WS_S5P && WS_GATES + (size_t)MT * 8 * 4 <= WS_HSS && WS_HS + (size_t)MT * 1024 * 2 <= WS_SCAL && WS_SCAL + (size_t)NSC * 4 * 384 * 4 <= WS_FF && WS_FF + (size_t)MT * DM * 2 <= WS_END, "d_ws map");
constexpr size_t S5P_LAM = 0, S5P_BBT = 64 * 1024, S5P_CC = S5P_BBT + 64 * 128 * 16 * 2;
constexpr size_t SSS_1 = 0, SSS_2 = 128 * 128 * 4, SSS_RSTD2 = 256 * 1024, SSS_RSTD1 = 384 * 1024;
constexpr int CW_TMO = 0, CW_CODE = 1, CW_BAR = 4096;
constexpr int CW_KS = 49152, CW_KS1 = CW_KS, CW_KS4 = CW_KS + 256, CW_KS5 = CW_KS4 + 64, CW_KS7 = CW_KS5 + 128, CW_KS8 = CW_KS7 + 352, CW_END = CW_KS8 + 128;
constexpr size_t WS_PARTA = 427 * MiB, WS_PARTB = 294 * MiB;
static_assert((size_t)8 * 2 * MS * DFF * 4 <= 65 * MiB && (size_t)8 * MS * 2048 * 4 <= 64 * MiB, "partial-sum arrays");

constexpr int RING_OFF = 0, RING_BYTES = 131072;
constexpr int LDSCTL_OFF = 151552, MISC_OFF = LDSCTL_OFF + 320;
constexpr int LDS_BYTES = 155648;
typedef short s16x4 __attribute__((ext_vector_type(4)));
typedef unsigned u32x2 __attribute__((ext_vector_type(2)));
struct Frame {
    LAS unsigned char* lds;
    volatile LAS unsigned* MISC;
    gu32* ctl;
    int tid, lane, wave;
    int vcu, G;
    const float* const* in;
    float* out; unsigned char* ws;
};
__device__ __forceinline__ float wave_sum(float v) {
#pragma unroll
    for (int o = 1; o < 64; o <<= 1) v += __shfl_xor(v, o);
    return v;
}
__device__ __forceinline__ unsigned cvtpk(float lo, float hi) { unsigned r; asm volatile("v_cvt_pk_bf16_f32 %0, %1, %2" : "=v"(r) : "v"(lo), "v"(hi)); return r; }
typedef __bf16 bf16x2n_t __attribute__((ext_vector_type(2)));
__device__ __forceinline__ unsigned cvtpk_n(float lo, float hi) { const bf16x2n_t v = {(__bf16)lo, (__bf16)hi}; return __builtin_bit_cast(unsigned, v); }
__device__ __forceinline__ float bflo(unsigned w) { return __uint_as_float(w << 16); }
__device__ __forceinline__ float bfhi(unsigned w) { return __uint_as_float(w & 0xffff0000u); }
__device__ __forceinline__ float bf2f(bf16 h) { return __uint_as_float((unsigned)h << 16); }
__device__ __forceinline__ float sigmoidf_(float v) { return __builtin_amdgcn_rcpf(1.0f + __expf(-v)); }
__device__ __forceinline__ f32x4 mfma16(bf16x8 a, bf16x8 b, f32x4 c) { return __builtin_amdgcn_mfma_f32_16x16x32_bf16(a, b, c, 0, 0, 0); }
#define WAVE_SYNC() do { asm volatile("s_waitcnt lgkmcnt(0)" ::: "memory"); __builtin_amdgcn_wave_barrier(); } while (0)
#define LBAR() do { asm volatile("s_waitcnt lgkmcnt(0)" ::: "memory"); __builtin_amdgcn_s_barrier(); asm volatile("" ::: "memory"); } while (0)

#ifdef MK_STAMP
#ifndef MK_STAMP_SCALE
#define MK_STAMP_SCALE 0.002f
#endif
#define DBG_DECL unsigned long long dbg_acc_ = 0, dbg_t0_ = 0;
__device__ __forceinline__ unsigned long long dbg_rt() { unsigned long long t; __builtin_amdgcn_sched_barrier(0);
#ifdef MK_STAMP_CYC
    asm volatile("s_memtime %0\n\ts_waitcnt lgkmcnt(0)" : "=s"(t) :: "memory");
#else
    asm volatile("s_memrealtime %0\n\ts_waitcnt lgkmcnt(0)" : "=s"(t) :: "memory");
#endif
 __builtin_amdgcn_sched_barrier(0); return t; }
#define DBG_BEGIN(id) do { if ((id) == MK_STAMP) dbg_t0_ = dbg_rt(); } while (0)
#define DBG_END(id) do { if ((id) == MK_STAMP) dbg_acc_ += dbg_rt() - dbg_t0_; } while (0)
#define DBG_REPORT(cond) do { if ((cond) && (threadIdx.x & 63) == 0 && (threadIdx.x >> 6) == MK_STAMP_WAVE) ((unsigned*)(A.ws + WS_CTL))[16] = (unsigned)dbg_acc_; } while (0)
#define DBG_PERTURB(V, m_) do { if ((m_) == 0 && lane == 0) V[0][0] += (float)__hip_atomic_load((unsigned*)(A.ws + WS_CTL) + 16, __ATOMIC_RELAXED, __HIP_MEMORY_SCOPE_AGENT) * MK_STAMP_SCALE; } while (0)
#else
#define DBG_DECL
#define DBG_BEGIN(id)
#define DBG_END(id)
#define DBG_REPORT(cond)
#define DBG_PERTURB(V, m_)
#endif
struct Args { const float* in[32]; float* out; unsigned char* ws; int ph_lo, ph_hi, li, pad; };
__device__ __forceinline__ int fresh_tid() { int t = threadIdx.x; asm volatile("" : "+v"(t)); return t; }
#define PHASE_IDS const int tid = fresh_tid(), lane = tid & 63; (void)tid; (void)lane;

__device__ __forceinline__ void p0_transpose_item(const float* W, int ldw, int src_col0, int k0, bf16* WT, int K, int out_row0, LAS float* scr, int lane, const float* kscale = nullptr) {
    if (kscale) {
#pragma unroll 8
        for (int i = 0; i < 32; ++i) { const int kk = 2 * i + (lane >> 5); scr[kk * 33 + (lane & 31)] = __builtin_nontemporal_load(W + (size_t)(k0 + kk) * ldw + src_col0 + (lane & 31)) * kscale[k0 + kk]; }
    } else {
#pragma unroll 8
    for (int i = 0; i < 32; ++i) { const int kk = 2 * i + (lane >> 5); scr[kk * 33 + (lane & 31)] = __builtin_nontemporal_load(W + (size_t)(k0 + kk) * ldw + src_col0 + (lane & 31)); }
    }
    LDS_WAIT(); asm volatile("" ::: "memory");
    const int c = lane & 7;
#pragma unroll
    for (int j = 0; j < 4; ++j) { const int n = (lane >> 3) + 8 * j; const LAS float* s = scr + (8 * c) * 33 + n;
        v4u o; o.x = pk2(s[0 * 33], s[1 * 33]); o.y = pk2(s[2 * 33], s[3 * 33]); o.z = pk2(s[4 * 33], s[5 * 33]); o.w = pk2(s[6 * 33], s[7 * 33]);
        *(GAS v4u*)(WT + (size_t)(out_row0 + n) * K + k0 + 8 * c) = o; }
    LDS_WAIT(); asm volatile("" ::: "memory");
}
__device__ __forceinline__ float log_sigmoid(float x) { return fminf(x, 0.f) - log1pf(__expf(-fabsf(x))); }

struct CvtItem { const float* W; int ldw, sc, k0; bf16* WT; int K, orow; const float* ks; unsigned char* W8; };
constexpr int CV_I_IN = (DM / 64) * (4096 / 32), CV_I_GLU = (1024 / 64) * (1024 / 32), CV_I_OUT = (DM / 64) * (DM / 32), CV_I_GU = (DM / 64) * (2 * DFF / 32), CV_I_D = (DFF / 64) * (DM / 32);
__device__ __forceinline__ CvtItem cvt_item(const Args& A, int it) {
    unsigned char* ws = A.ws; int r = it; CvtItem c;
    if (r < CV_I_IN) { const int nnb = 4096 / 32, kb = r / nnb, nb = r % nnb, orow = 32 * nb; c = CvtItem{A.in[9], NIN, orow < 3072 ? orow : orow + 8, 64 * kb, (bf16*)(ws + WS_WIN), DM, orow, nullptr, nullptr}; return c; } r -= CV_I_IN;
    if (r < CV_I_GLU) { const int nnb = 1024 / 32, kb = r / nnb, nb = r % nnb; c = CvtItem{A.in[23], 1024, 32 * nb, 64 * kb, (bf16*)(ws + WS_WGLU), 1024, 32 * nb, nullptr, nullptr}; return c; } r -= CV_I_GLU;
    if (r < CV_I_OUT) { const int nnb = DM / 32, kb = r / nnb, nb = r % nnb; c = CvtItem{A.in[25], DM, 32 * nb, 64 * kb, (bf16*)(ws + WS_WOUT), DM, 32 * nb, nullptr, nullptr}; return c; } r -= CV_I_OUT;
    if (r < CV_I_GU) { const int nnb = 2 * DFF / 32, kb = r / nnb, nb = r % nnb, orow = 32 * nb, pn = orow >> 8, cc = orow & 255;
        c = CvtItem{cc < 128 ? A.in[28] : A.in[29], DFF, 128 * pn + (cc & 127), 64 * kb, (bf16*)(ws + WS_WGU), DM, orow, A.in[27], nullptr}; return c; } r -= CV_I_GU;
    { const int nnb = DM / 32, kb = r / nnb, nb = r % nnb; c = CvtItem{A.in[30], DM, 32 * nb, 64 * kb, (bf16*)(ws + WS_WD), DFF, 32 * nb, nullptr, ws + WS_WD8}; return c; }
}
__device__ __forceinline__ void p0_prologue(const Args& A, LAS unsigned char* lds, int tid, int lane, int wave, int vcu, int G) {
    unsigned char* ws = A.ws;
    LAS float* WG = (LAS float*)lds;
    LAS float* scr = (LAS float*)(lds + wave * 8448);
    const int gw = vcu * NWAVES + wave, NGW = G * NWAVES;
    { constexpr int NIT = CV_I_IN + CV_I_GLU + CV_I_OUT + CV_I_GU + CV_I_D;
      float ra[32], rb[32]; CvtItem ia, ib;
#define CV_LOAD(R, I, it_) do { I = cvt_item(A, (it_)); \
        _Pragma("unroll") for (int i = 0; i < 32; ++i) { const int kk = 2 * i + (lane >> 5); R[i] = __builtin_nontemporal_load(I.W + (size_t)(I.k0 + kk) * I.ldw + I.sc + (lane & 31)); } } while (0)
#define F8C(v_) __builtin_amdgcn_fmed3f((v_) * 1024.0f, -448.f, 448.f)
#define CV_PROC(R, I) do { \
        if (I.ks) { _Pragma("unroll") for (int i = 0; i < 32; ++i) { const int kk = 2 * i + (lane >> 5); scr[kk * 33 + (lane & 31)] = R[i] * I.ks[I.k0 + kk]; } } \
        else { _Pragma("unroll") for (int i = 0; i < 32; ++i) { const int kk = 2 * i + (lane >> 5); scr[kk * 33 + (lane & 31)] = R[i]; } } \
        LDS_WAIT(); asm volatile("" ::: "memory"); \
        { const int c = lane & 7; \
          _Pragma("unroll") for (int j = 0; j < 4; ++j) { const int n = (lane >> 3) + 8 * j; const LAS float* s = scr + (8 * c) * 33 + n; \
              v4u o; o.x = pk2(s[0 * 33], s[1 * 33]); o.y = pk2(s[2 * 33], s[3 * 33]); o.z = pk2(s[4 * 33], s[5 * 33]); o.w = pk2(s[6 * 33], s[7 * 33]); \
              *(GAS v4u*)(I.WT + (size_t)(I.orow + n) * I.K + I.k0 + 8 * c) = o; \
              if (I.W8) { int w0 = 0, w1 = 0; \
                  w0 = __builtin_amdgcn_cvt_pk_fp8_f32(F8C(s[0 * 33]), F8C(s[1 * 33]), w0, false); w0 = __builtin_amdgcn_cvt_pk_fp8_f32(F8C(s[2 * 33]), F8C(s[3 * 33]), w0, true); \
                  w1 = __builtin_amdgcn_cvt_pk_fp8_f32(F8C(s[4 * 33]), F8C(s[5 * 33]), w1, false); w1 = __builtin_amdgcn_cvt_pk_fp8_f32(F8C(s[6 * 33]), F8C(s[7 * 33]), w1, true); \
                  *(GAS u32x2*)(I.W8 + (size_t)(I.orow + n) * I.K + I.k0 + 8 * c) = (u32x2){(unsigned)w0, (unsigned)w1}; } } } \
        LDS_WAIT(); asm volatile("" ::: "memory"); } while (0)
      int it = gw;
      if (it < NIT) { CV_LOAD(ra, ia, it);
          for (;;) { const int it2 = it + NGW; if (it2 < NIT) CV_LOAD(rb, ib, it2); CV_PROC(ra, ia); if (it2 >= NIT) break;
                     it = it2 + NGW; if (it < NIT) CV_LOAD(ra, ia, it); CV_PROC(rb, ib); if (it >= NIT) break; } }
#undef CV_LOAD
#undef CV_PROC
#undef F8C
    }
    { const int gt = vcu * (NWAVES * 64) + tid;
      if (gt < NG * PST) {
        const int g = gt >> 6, p = gt & 63;
        const double lr = (double)A.in[15][gt], li = (double)A.in[16][gt], dt = exp((double)A.in[17][g]);
        const double mag = exp(lr * dt), ang = li * dt, lbr = mag * cos(ang), lbi = mag * sin(ang);
        const double den = lr * lr + li * li, nr = lbr - 1.0, fre = (nr * lr + lbi * li) / den, fim = (lbi * lr - nr * li) / den;
        float* LAM = (float*)(ws + WS_S5P + S5P_LAM); LAM[gt * 2] = (float)lbr; LAM[gt * 2 + 1] = (float)lbi;
        bf16* BBT = (bf16*)(ws + WS_S5P + S5P_BBT); bf16* CC = (bf16*)(ws + WS_S5P + S5P_CC);
        const float* bre = A.in[18] + (size_t)gt * 16; const float* bim = A.in[19] + (size_t)gt * 16;
#pragma unroll
        for (int i = 0; i < 16; ++i) { const double br = bre[i], bi = bim[i];
            BBT[((size_t)g * 128 + 2 * p) * 16 + i] = (bf16)f2bf((float)(fre * br - fim * bi));
            BBT[((size_t)g * 128 + 2 * p + 1) * 16 + i] = (bf16)f2bf((float)(fre * bi + fim * br));
            CC[((size_t)g * 16 + i) * 128 + 2 * p] = (bf16)f2bf(A.in[20][((size_t)g * 16 + i) * 64 + p]);
            CC[((size_t)g * 16 + i) * 128 + 2 * p + 1] = (bf16)f2bf(-A.in[21][((size_t)g * 16 + i) * 64 + p]); }
      } }
    __syncthreads();
    { const float* win = A.in[9];
      for (int e = tid; e < 8 * 2048; e += NWAVES * 64) { const int k = e >> 3, c = e & 7; WG[c * 2048 + k] = win[(size_t)k * NIN + 3072 + c]; } }
    __syncthreads();
    { const GAS f32x4* gp = (const GAS f32x4*)A.in[8] + lane; f32x4 gv[8];
#pragma unroll
      for (int j = 0; j < 8; ++j) gv[j] = gp[64 * j];
      bf16* XN = (bf16*)(ws + WS_XN); float* GATES = (float*)(ws + WS_GATES);
      f32x4 va[8], vb[8];
#define P0R_LOAD(V, m_) do { const int mm_ = (m_); const float* xrow = mm_ < MP ? A.in[0] + (size_t)mm_ * DM : A.in[1] + (size_t)(mm_ - MP) * DM; const GAS f32x4* xr = (const GAS f32x4*)xrow + lane; \
        _Pragma("unroll") for (int j = 0; j < 8; ++j) V[j] = __builtin_nontemporal_load(xr + 64 * j); } while (0)
#define P0R_PROC(V, m_) do { const int mm_ = (m_); float s = 0.f; \
        _Pragma("unroll") for (int j = 0; j < 8; ++j) s += (V[j].x * V[j].x + V[j].y * V[j].y) + (V[j].z * V[j].z + V[j].w * V[j].w); \
        const float ms = wave_sum(s) * (1.0f / DM) + EPS, rstd = 1.0f / sqrtf(ms); \
        if (lane == 0) ((float*)(ws + WS_SSS + SSS_RSTD1))[mm_] = sqrtf(ms); \
        GAS u32x2* o8 = (GAS u32x2*)(XN + (size_t)mm_ * DM) + lane; \
        float ga[8] = {0.f, 0.f, 0.f, 0.f, 0.f, 0.f, 0.f, 0.f}; \
        _Pragma("unroll") for (int j = 0; j < 8; ++j) { V[j] = V[j] * rstd * gv[j]; u32x2 o; o.x = cvtpk(V[j].x, V[j].y); o.y = cvtpk(V[j].z, V[j].w); o8[64 * j] = o; \
            _Pragma("unroll") for (int c = 0; c < 8; ++c) { const f32x4 w = *(const LAS f32x4*)(WG + c * 2048 + 256 * j + 4 * lane); ga[c] += (V[j].x * w.x + V[j].y * w.y) + (V[j].z * w.z + V[j].w * w.w); } } \
        _Pragma("unroll") for (int c = 0; c < 8; ++c) ga[c] = wave_sum(ga[c]); \
        if (lane < 8) { float val = 0.f; \
            _Pragma("unroll") for (int c = 0; c < 8; ++c) if (lane == c) val = ga[c]; \
            if (lane < 4) val += A.in[12][lane]; else val = log_sigmoid(val + A.in[13][lane - 4]); \
            GATES[(size_t)mm_ * 8 + lane] = val; } } while (0)
      int m = gw;
      if (m < MT) { P0R_LOAD(va, m);
          for (;;) { const int m2 = m + NGW; if (m2 < MT) P0R_LOAD(vb, m2); P0R_PROC(va, m); if (m2 >= MT) break;
                     m = m2 + NGW; if (m < MT) P0R_LOAD(va, m); P0R_PROC(vb, m2); if (m >= MT) break; } }
#undef P0R_LOAD
#undef P0R_PROC
    }
}

template <int NACC, int K, int RBN = 8, class RowMap, class Epi>
__device__ __forceinline__ void skinny_gemm(const bf16* Arows, const bf16* Bt, LAS unsigned char* lds, int nitems, int first, int stride, int tid, int wave, int lane, RowMap rm, Epi epi) {
    const int fr = lane & 15, fq = lane >> 4;
    constexpr int KW = K / 8, NS = KW / 32, NSPLIT = 8 / RBN;
    static_assert(KW % 32 == 0, "skinny_gemm: K must be a multiple of 256");
    const bf16* abase = Arows + (size_t)fr * K + wave * KW + 16 * fq;
    LAS f32x4* red = (LAS f32x4*)lds;
    for (int piece = first; piece < nitems * NSPLIT; piece += stride) {
        const int it = piece / NSPLIT, rh = piece % NSPLIT;
        const bf16* brow[NACC]; f32x4 acc[NACC][RBN];
#pragma unroll
        for (int a = 0; a < NACC; ++a) { brow[a] = Bt + (size_t)rm(it, a, fr) * K + wave * KW + 16 * fq;
#pragma unroll
            for (int rb = 0; rb < RBN; ++rb) acc[a][rb] = (f32x4){0.f, 0.f, 0.f, 0.f}; }
        const bf16* ab = abase + (size_t)(16 * RBN * rh) * K;
        { constexpr int UN = 2, NSET = NS / UN, FR = UN * (RBN + NACC), R0 = 48 / FR, R = R0 < 2 ? 2 : (R0 > NSET ? NSET : R0);
          static_assert(NS % UN == 0 && NSET >= 2, "skinny_gemm: an even number (>= 4) of 32-deep steps per wave");
          bf16x8 av[R][UN][RBN], bv[R][UN][NACC];
#define SK_LOAD(q_) do { _Pragma("unroll") for (int a = 0; a < NACC; ++a) _Pragma("unroll") for (int u = 0; u < UN; ++u) bv[(q_) % R][u][a] = *(const bf16x8*)(brow[a] + 64 * (q_) + 8 * u); \
              _Pragma("unroll") for (int rb = 0; rb < RBN; ++rb) _Pragma("unroll") for (int u = 0; u < UN; ++u) av[(q_) % R][u][rb] = *(const bf16x8*)(ab + (size_t)(16 * rb) * K + 64 * (q_) + 8 * u); } while (0)
#pragma unroll
          for (int q = 0; q < R - 1; ++q) SK_LOAD(q);
          __builtin_amdgcn_sched_barrier(0);
#pragma unroll
          for (int q = 0; q < NSET; ++q) {
              if (q + R - 1 < NSET) SK_LOAD(q + R - 1);
              __builtin_amdgcn_sched_barrier(0);
#pragma unroll
              for (int u = 0; u < UN; ++u)
#pragma unroll
                  for (int rb = 0; rb < RBN; ++rb)
#pragma unroll
                      for (int a = 0; a < NACC; ++a) acc[a][rb] = mfma16(bv[q % R][u][a], av[q % R][u][rb], acc[a][rb]);
              __builtin_amdgcn_sched_barrier(0);
          }
#undef SK_LOAD
        }
#pragma unroll
        for (int a = 0; a < NACC; ++a)
#pragma unroll
            for (int rb = 0; rb < RBN; ++rb) red[((a * 8 + wave) * RBN + rb) * 64 + lane] = acc[a][rb];
        __syncthreads();
        if (wave < RBN) {
            f32x4 fin[NACC];
#pragma unroll
            for (int a = 0; a < NACC; ++a) { f32x4 t = red[((a * 8 + 0) * RBN + wave) * 64 + lane];
#pragma unroll
                for (int w2 = 1; w2 < 8; ++w2) t += red[((a * 8 + w2) * RBN + wave) * 64 + lane];
                fin[a] = t; }
            epi(it, 16 * (RBN * rh + wave) + fr, fq, fin);
        }
        __syncthreads();
    }
}

template <int NACC, int K, int S, class RowMap, class Epi>
__device__ __forceinline__ void skinny_ks(const bf16* Arows, const bf16* Bt, float* PART, int ldacc, unsigned* CNT, LAS unsigned char* lds, int ncb, int vcu, int G, int wave, int lane, RowMap rm, Epi epi) {
    constexpr int KS = K / S, NS = KS / 32, NF = NACC * NS, FPW = (NF + 7) / 8;
    static_assert(K % (32 * S) == 0, "skinny_ks: K must be a multiple of 32 S");
    const int fr = lane & 15, fq = lane >> 4;
    const int sl = vcu % S, j = vcu / S, nj = (G - sl + S - 1) / S;
    const int nmine = (j < ncb) ? (ncb - j + nj - 1) / nj : 0;
    const size_t koff = (size_t)sl * KS + 8 * fq;
    bf16x8 af[NS];
    { const bf16* ap = Arows + (size_t)(16 * wave + fr) * K + koff;
#pragma unroll
      for (int s2 = 0; s2 < NS; ++s2) af[s2] = *(const bf16x8*)(ap + 32 * s2); }
    LAS bf16x8* fb = (LAS bf16x8*)lds;
    LAS unsigned* flag = (LAS unsigned*)(lds + 2 * NF * 1024);
    const __amdgpu_buffer_rsrc_t prs = __builtin_amdgcn_make_buffer_rsrc((void*)PART, 0, 0x7FFFFFFF, 0x00020000);
    const unsigned rowoff = (unsigned)((16 * wave + fr) * ldacc + 4 * fq) * 4u, astr = (unsigned)(MS * ldacc) * 4u;
    bf16x8 pre[FPW];
#define KS_ISSUE(cb_) do { _Pragma("unroll") for (int i2 = 0; i2 < FPW; ++i2) { const int f = wave + 8 * i2; if (f < NF) { const int a = f / NS, s2 = f % NS; \
            pre[i2] = *(const bf16x8*)(Bt + (size_t)rm((cb_), a, fr) * K + koff + 32 * s2); } } } while (0)
    if (nmine > 0) KS_ISSUE(j);
    for (int i = 0; i < nmine; ++i) {
        const int cb = j + nj * i, buf = i & 1;
#pragma unroll
        for (int i2 = 0; i2 < FPW; ++i2) { const int f = wave + 8 * i2; if (f < NF) fb[(buf * NF + f) * 64 + lane] = pre[i2]; }
        if (i + 1 < nmine) KS_ISSUE(cb + nj);
        LBAR();
#pragma unroll
        for (int a = 0; a < NACC; ++a) { f32x4 acc = (f32x4){0.f, 0.f, 0.f, 0.f};
#pragma unroll
            for (int s2 = 0; s2 < NS; ++s2) acc = mfma16(fb[(buf * NF + a * NS + s2) * 64 + lane], af[s2], acc);
            __builtin_amdgcn_raw_buffer_store_b128(__builtin_bit_cast(v4u, acc), prs, (unsigned)(sl * NACC + a) * astr + rowoff + (unsigned)cb * 64u, 0, 16); }
    }
#undef KS_ISSUE
    VM_WAIT();
    __syncthreads();
    if (wave == 0) { unsigned last = 0u;
        if (lane < nmine) last = (__hip_atomic_fetch_add(CNT + j + nj * lane, 1u, __ATOMIC_RELAXED, __HIP_MEMORY_SCOPE_AGENT) == (unsigned)(S - 1)) ? 1u : 0u;
        const unsigned long long m = __ballot(last != 0u);
        if (lane == 0) { flag[0] = (unsigned)m; flag[1] = (unsigned)(m >> 32); } }
    __syncthreads();
    unsigned long long m = ((unsigned long long)flag[1] << 32) | flag[0];
    while (m) { const int i = __builtin_ctzll(m); m &= m - 1; const int cb = j + nj * i;
        f32x4 fin[NACC];
#pragma unroll
        for (int a = 0; a < NACC; ++a) { v4u p[S];
#pragma unroll
            for (int s2 = 0; s2 < S; ++s2) p[s2] = __builtin_amdgcn_raw_buffer_load_b128(prs, (unsigned)(s2 * NACC + a) * astr + rowoff + (unsigned)cb * 64u, 0, 16);
            f32x4 t = __builtin_bit_cast(f32x4, p[0]);
#pragma unroll
            for (int s2 = 1; s2 < S; ++s2) t += __builtin_bit_cast(f32x4, p[s2]);
            fin[a] = t; }
        epi(cb, 16 * wave + fr, fq, fin); }
    __syncthreads();
}

__device__ __forceinline__ void p2_scalars(const Args& A, LAS unsigned char* lds, int lane, int wave, int item) {
    unsigned char* ws = A.ws;
    const float* GATES = (const float*)(ws + WS_GATES); float* SCAL = (float*)(ws + WS_SCAL);
    const int seq = item >> 2, h = item & 3; const bool sample = seq >= NBATCH; const int b = sample ? seq - NBATCH : seq;
    const int nch = sample ? 1 : NCH, L = sample ? SLEN : CH, row0 = sample ? MP + b * SLEN : b * SEQ, sc0 = sample ? NBATCH * NCH + b : b * NCH;
    LAS float* fl = (LAS float*)lds;
    float fc[4], a[4], pm[4];
#pragma unroll
    for (int i = 0; i < 4; ++i) { const int c = 4 * wave + i; float li = -INFINITY, lf = 0.f;
        if (c < nch && lane < L) { li = GATES[((size_t)row0 + c * CH + lane) * 8 + h]; lf = GATES[((size_t)row0 + c * CH + lane) * 8 + 4 + h]; }
        float f = lf;
#pragma unroll
        for (int d = 1; d < 64; d <<= 1) { const float o = __shfl_up(f, d); if (lane >= d) f += o; }
        const float aa = li - f; float p = aa;
#pragma unroll
        for (int d = 1; d < 64; d <<= 1) { const float o = __shfl_up(p, d); if (lane >= d) p = fmaxf(p, o); }
        fc[i] = f; a[i] = aa; pm[i] = p;
        if (lane == 63) { fl[c] = f; fl[32 + c] = p; } }
    __syncthreads();
    float m0c = 0.f, m0 = sample ? A.in[5][b * NH + h] : 0.f;
    for (int c = 0; c < nch; ++c) { if (lane == c) m0c = m0; m0 = fl[c] + fmaxf(fl[32 + c], m0); }
#pragma unroll
    for (int i = 0; i < 4; ++i) { const int c = 4 * wave + i;
        if (c < nch) { const float m0i = __shfl(m0c, c); const float mm = fmaxf(pm[i], m0i), mml = __shfl(mm, 63);
            float* o = SCAL + ((size_t)(sc0 + c) * 4 + h) * 384;
            o[lane] = a[i]; o[64 + lane] = mm; o[128 + lane] = __expf(m0i - mm); o[192 + lane] = __expf(-(fc[i] + mm)); o[256 + lane] = __expf(a[i] - mml);
            o[320 + lane] = (lane == 0) ? __expf(m0i - mml) : (__shfl(fc[i], 63) + mml); } }
    if (wave == 0 && lane == 0) A.out[(sample ? O_MS : O_MP) + b * NH + h] = m0;
    __syncthreads();
}
__device__ __forceinline__ void p2_conv(const Args& A, int tid, int vcu, int G) {
    unsigned char* ws = A.ws;
    const bf16* QKRAW = (const bf16*)(ws + WS_QKRAW); bf16* Q = (bf16*)(ws + WS_Q); bf16* Kb = (bf16*)(ws + WS_K);
    const int nthreads = G * NWAVES * 64;
    for (int it = vcu * (NWAVES * 64) + tid; it < (MT / 8) * 128; it += nthreads) {
        const int rb = it >> 7, ch = it & 127, rs = 8 * rb, col = 8 * ch;
        bool first, sample = rs >= MP; int b, tl, Lseq;
        if (!sample) { b = rs / SEQ; tl = rs % SEQ; Lseq = SEQ; } else { b = (rs - MP) / SLEN; tl = (rs - MP) % SLEN; Lseq = SLEN; }
        first = (tl == 0);
        float w[4][8], bc[8];
#pragma unroll
        for (int j = 0; j < 4; ++j) { const f32x4 a0 = *(const f32x4*)(A.in[10] + j * 1024 + col), a1 = *(const f32x4*)(A.in[10] + j * 1024 + col + 4);
            w[j][0] = a0[0]; w[j][1] = a0[1]; w[j][2] = a0[2]; w[j][3] = a0[3]; w[j][4] = a1[0]; w[j][5] = a1[1]; w[j][6] = a1[2]; w[j][7] = a1[3]; }
        { const f32x4 a0 = *(const f32x4*)(A.in[11] + col), a1 = *(const f32x4*)(A.in[11] + col + 4);
          bc[0] = a0[0]; bc[1] = a0[1]; bc[2] = a0[2]; bc[3] = a0[3]; bc[4] = a1[0]; bc[5] = a1[1]; bc[6] = a1[2]; bc[7] = a1[3]; }
        v4u raw[11];
#pragma unroll
        for (int r = 0; r < 11; ++r) { if (r >= 3 || !first) raw[r] = *(const GAS v4u*)(QKRAW + (size_t)(rs + r - 3) * 1024 + col); else raw[r] = (v4u){0u, 0u, 0u, 0u}; }
        float x0[8], x1[8], x2[8];
#define UNPK(dst, v) do { dst[0] = bflo(v.x); dst[1] = bfhi(v.x); dst[2] = bflo(v.y); dst[3] = bfhi(v.y); dst[4] = bflo(v.z); dst[5] = bfhi(v.z); dst[6] = bflo(v.w); dst[7] = bfhi(v.w); } while (0)
        if (first && sample) {
            const float* sp = A.in[2] + (size_t)b * 3 * 1024 + col;
#pragma unroll
            for (int i = 0; i < 8; ++i) { x0[i] = sp[i]; x1[i] = sp[1024 + i]; x2[i] = sp[2048 + i]; }
        } else { UNPK(x0, raw[0]); UNPK(x1, raw[1]); UNPK(x2, raw[2]); }
#pragma unroll
        for (int r = 0; r < 8; ++r) {
            float x3[8]; UNPK(x3, raw[r + 3]);
            float o[8];
#pragma unroll
            for (int i = 0; i < 8; ++i) { const float val = bc[i] + w[0][i] * x0[i] + w[1][i] * x1[i] + w[2][i] * x2[i] + w[3][i] * x3[i]; o[i] = val * sigmoidf_(val); }
            const size_t row = (size_t)rs + r;
            if (ch < 64) {
#pragma unroll
                for (int i = 0; i < 8; ++i) o[i] *= 0.08838834764831845f;
                v4u pk; pk.x = cvtpk(o[0], o[1]); pk.y = cvtpk(o[2], o[3]); pk.z = cvtpk(o[4], o[5]); pk.w = cvtpk(o[6], o[7]);
                *(GAS v4u*)(Q + row * 512 + col) = pk;
            } else {
                v4u pk; pk.x = cvtpk(o[0], o[1]); pk.y = cvtpk(o[2], o[3]); pk.z = cvtpk(o[4], o[5]); pk.w = cvtpk(o[6], o[7]);
                *(GAS v4u*)(Kb + row * 512 + (col - 512)) = pk;
            }
            const int tt = tl + r;
            if (tt >= Lseq - 3) { float* cv = A.out + (sample ? O_CONVS : O_CONVP) + ((size_t)b * 3 + (tt - (Lseq - 3))) * 1024 + col;
                *(f32x4*)cv = (f32x4){x3[0], x3[1], x3[2], x3[3]}; *(f32x4*)(cv + 4) = (f32x4){x3[4], x3[5], x3[6], x3[7]}; }
#pragma unroll
            for (int i = 0; i < 8; ++i) { x0[i] = x1[i]; x1[i] = x2[i]; x2[i] = x3[i]; }
        }
#undef UNPK
    }
}
constexpr int ML_QS = 0, ML_KS = 17408, ML_VS = 34816, ML_SC = 46080, ML_SET = 47616, ML_SS = 2 * ML_SET, ML_CB = ML_SS + 9216, ML_CBSZ = 21760;
static_assert(ML_CB + 2 * ML_CBSZ <= LDSCTL_OFF, "mLSTM LDS map");
constexpr int SC_A = 0, SC_MM = 64, SC_GI = 128, SC_EN = 192, SC_WS = 256, SC_MISC = 320;
__device__ __forceinline__ bf16x8 ldsfrag(const LAS unsigned char* p) { return *(const LAS bf16x8*)p; }
typedef __attribute__((address_space(3))) s16x4 lds_s16x4;
__device__ __forceinline__ bf16x8 trfrag(const LAS unsigned char* tile, int stride, int k0, int c0, int lane) {
    const int g = lane >> 4, q = (lane & 15) >> 2, p = lane & 3;
    const LAS unsigned char* a0 = tile + (k0 + 8 * g + q) * stride + (c0 + 4 * p) * 2;
    const s16x4 lo = __builtin_amdgcn_ds_read_tr16_b64_v4i16((lds_s16x4*)a0), hi = __builtin_amdgcn_ds_read_tr16_b64_v4i16((lds_s16x4*)(a0 + 4 * stride));
    return (bf16x8){lo[0], lo[1], lo[2], lo[3], hi[0], hi[1], hi[2], hi[3]};
}

__device__ __forceinline__ void mlstm_item(const Args& A, LAS unsigned char* lds, int tid, int lane, int wave, int item) {
    DBG_DECL
    unsigned char* ws = A.ws;
    const int fr = lane & 15, fq = lane >> 4;
    const bool sample = item >= NBATCH * NH * NSL; const int ii = sample ? item - NBATCH * NH * NSL : item;
    const int b = ii / (NH * NSL), h = (ii / NSL) % NH, sl = ii % NSL;
    const int nch = sample ? 1 : NCH, L = sample ? SLEN : CH;
    const int row0 = sample ? MP + b * SLEN : b * SEQ, sc0 = sample ? NBATCH * NCH + b : b * NCH;
    const bf16* Qg = (const bf16*)(ws + WS_Q); const bf16* Kg = (const bf16*)(ws + WS_K); const bf16* Vg = (const bf16*)(ws + WS_V);
    const float* SCAL = (const float*)(ws + WS_SCAL); bf16* HS = (bf16*)(ws + WS_HS); float* HSS = (float*)(ws + WS_HSS);
    if (tid < 256) { const int r = (tid >> 1) & 63, hf = tid & 1, st = tid >> 7; *(LAS v4u*)(lds + st * ML_SET + ML_VS + r * 176 + 128 + 16 * hf) = (v4u){hf == 0 ? 0x00003F80u : 0u, 0u, 0u, 0u}; }
    f32x4 Cst[5];
    if (sample) {
        const float* c0 = A.in[3] + ((size_t)(b * NH + h) * DV + DVS * sl) * DQK; const float* n0 = A.in[4] + (size_t)(b * NH + h) * DQK;
#pragma unroll
        for (int vb = 0; vb < 4; ++vb) Cst[vb] = *(const f32x4*)(c0 + (size_t)(16 * vb + fr) * DQK + 16 * wave + 4 * fq);
        Cst[4] = (fr == 0) ? *(const f32x4*)(n0 + 16 * wave + 4 * fq) : (f32x4){0.f, 0.f, 0.f, 0.f};
    } else {
#pragma unroll
        for (int vb = 0; vb < 5; ++vb) Cst[vb] = (f32x4){0.f, 0.f, 0.f, 0.f};
    }
#pragma unroll
    for (int vb = 0; vb < 5; ++vb) { u32x2 w; w.x = cvtpk_n(Cst[vb][0], Cst[vb][1]); w.y = cvtpk_n(Cst[vb][2], Cst[vb][3]); *(LAS u32x2*)(lds + ML_CB + (16 * vb + fr) * 272 + (16 * wave + 4 * fq) * 2) = w; }
    v4u pq[2], pk[2], pv; f32x4 psc = (f32x4){0.f, 0.f, 0.f, 0.f};
#define ML_ISSUE(c_) do { \
        const size_t r0_ = (size_t)row0 + (size_t)(c_) * CH; \
        _Pragma("unroll") for (int i = 0; i < 2; ++i) { const int e = tid + 512 * i, r = e >> 4, ch = e & 15; \
            if (r < L) { pq[i] = *(const GAS v4u*)(Qg + (r0_ + r) * 512 + 128 * h + 8 * ch); pk[i] = *(const GAS v4u*)(Kg + (r0_ + r) * 512 + 128 * h + 8 * ch); } \
            else { pq[i] = (v4u){0u, 0u, 0u, 0u}; pk[i] = (v4u){0u, 0u, 0u, 0u}; } } \
        { const int r = tid >> 3, ch = tid & 7; if (r < L) pv = *(const GAS v4u*)(Vg + (r0_ + r) * 1024 + DV * h + DVS * sl + 8 * ch); else pv = (v4u){0u, 0u, 0u, 0u}; } \
        if (tid < 96) psc = *(const GAS f32x4*)(SCAL + ((size_t)(sc0 + (c_)) * 4 + h) * 384 + 4 * tid); \
    } while (0)
#define ML_COMMIT(so_) do { LAS unsigned char* wl_ = lds + (so_); \
        _Pragma("unroll") for (int i = 0; i < 2; ++i) { const int e = tid + 512 * i, r = e >> 4, ch = e & 15; \
            *(LAS v4u*)(wl_ + ML_QS + r * 272 + ch * 16) = pq[i]; *(LAS v4u*)(wl_ + ML_KS + r * 272 + ch * 16) = pk[i]; } \
        { const int r = tid >> 3, ch = tid & 7; *(LAS v4u*)(wl_ + ML_VS + r * 176 + ch * 16) = pv; } \
        if (tid < 96) *(LAS f32x4*)((LAS float*)(wl_ + ML_SC) + 4 * tid) = psc; \
    } while (0)
    ML_ISSUE(0); ML_COMMIT(0);
    LBAR();
    const int tb = wave & 3, wh = wave >> 2, t = 16 * tb + fr;
    u32x2 hsw[2] = {(u32x2){0u, 0u}, (u32x2){0u, 0u}}; float hsp = 0.f;
#define ML_FLUSH(c_) do { const size_t grow = (size_t)row0 + (size_t)(c_) * CH + t; \
        if (t < L) { *(GAS u32x2*)(HS + grow * 1024 + h * DV + DVS * sl + 16 * (2 * wh) + 4 * fq) = hsw[0]; *(GAS u32x2*)(HS + grow * 1024 + h * DV + DVS * sl + 16 * (2 * wh + 1) + 4 * fq) = hsw[1]; \
                     if (fq == 0) HSS[grow * 32 + h * 8 + sl * 2 + wh] = hsp; } } while (0)
    DBG_BEGIN(8);
    for (int c = 0; c < nch; ++c) {
        if (c + 1 < nch) ML_ISSUE(c + 1);
        if (c > 0) ML_FLUSH(c - 1);
        const LAS unsigned char* cbr = lds + ML_CB + (c & 1) * ML_CBSZ; LAS unsigned char* cbw = lds + ML_CB + ((c + 1) & 1) * ML_CBSZ;
        const LAS unsigned char* tl = lds + (c & 1) * ML_SET; const LAS float* SC = (const LAS float*)(tl + ML_SC);
        DBG_BEGIN(4);
        bf16x8 qf[4];
#pragma unroll
        for (int ks = 0; ks < 4; ++ks) qf[ks] = ldsfrag(tl + ML_QS + t * 272 + ks * 64 + fq * 16);
        { bf16x8 kf[2][4];
#pragma unroll
          for (int i = 0; i < 2; ++i)
#pragma unroll
              for (int ks = 0; ks < 4; ++ks) kf[i][ks] = ldsfrag(tl + ML_KS + (16 * (2 * wh + i) + fr) * 272 + ks * 64 + fq * 16);
          const float mmt = SC[SC_MM + t]; f32x4 a4[2];
#pragma unroll
          for (int i = 0; i < 2; ++i) a4[i] = *(const LAS f32x4*)(SC + SC_A + 16 * (2 * wh + i) + 4 * fq);
          f32x4 g[2] = {(f32x4){0.f, 0.f, 0.f, 0.f}, (f32x4){0.f, 0.f, 0.f, 0.f}};
#pragma unroll
          for (int ks = 0; ks < 4; ++ks)
#pragma unroll
              for (int i = 0; i < 2; ++i) g[i] = mfma16(kf[i][ks], qf[ks], g[i]);
#pragma unroll
          for (int i = 0; i < 2; ++i) { const int s0 = 16 * (2 * wh + i) + 4 * fq; float v[4];
#pragma unroll
              for (int r = 0; r < 4; ++r) v[r] = (s0 + r <= t) ? g[i][r] * __expf(a4[i][r] - mmt) : 0.f;
              u32x2 w; w.x = cvtpk_n(v[0], v[1]); w.y = cvtpk_n(v[2], v[3]); *(LAS u32x2*)(lds + ML_SS + t * 144 + s0 * 2) = w; } }
        DBG_END(4);
        LBAR();
        DBG_BEGIN(5);
        { bf16x8 sf[2], vf[3][2], cf[3][4];
#pragma unroll
          for (int ks = 0; ks < 2; ++ks) sf[ks] = ldsfrag(lds + ML_SS + t * 144 + ks * 64 + fq * 16);
#pragma unroll
          for (int i = 0; i < 3; ++i) { const int vb = (i == 2) ? 4 : 2 * wh + i;
#pragma unroll
              for (int ks = 0; ks < 2; ++ks) vf[i][ks] = trfrag(tl + ML_VS, 176, 32 * ks, 16 * vb, lane);
#pragma unroll
              for (int ks = 0; ks < 4; ++ks) cf[i][ks] = ldsfrag(cbr + (16 * vb + fr) * 272 + ks * 64 + fq * 16); }
          const float git = SC[SC_GI + t], ent = SC[SC_EN + t];
          f32x4 ai[3], ae[3];
#pragma unroll
          for (int i = 0; i < 3; ++i) { ai[i] = (f32x4){0.f, 0.f, 0.f, 0.f}; ae[i] = (f32x4){0.f, 0.f, 0.f, 0.f}; }
#pragma unroll
          for (int ks = 0; ks < 4; ++ks)
#pragma unroll
              for (int i = 0; i < 3; ++i) { ae[i] = mfma16(cf[i][ks], qf[ks], ae[i]); if (ks < 2) ai[i] = mfma16(vf[i][ks], sf[ks], ai[i]); }
          f32x4 hh[3];
#pragma unroll
          for (int i = 0; i < 3; ++i) hh[i] = ai[i] + ae[i] * git;
          const float den = __shfl(hh[2][0], fr);
          const float isc = 1.0f / fmaxf(fabsf(den), ent); float p = 0.f;
#pragma unroll
          for (int i = 0; i < 2; ++i) { const f32x4 o = hh[i] * isc; p += (o[0] * o[0] + o[1] * o[1]) + (o[2] * o[2] + o[3] * o[3]);
              hsw[i].x = cvtpk_n(o[0], o[1]); hsw[i].y = cvtpk_n(o[2], o[3]); }
          p += __shfl_xor(p, 16); p += __shfl_xor(p, 32); hsp = p; }
        DBG_END(5); DBG_BEGIN(6);
        { const float decay = SC[SC_MISC];
          bf16x8 kw[2], vf[5][2];
#pragma unroll
          for (int vb = 0; vb < 5; ++vb)
#pragma unroll
              for (int ks = 0; ks < 2; ++ks) vf[vb][ks] = trfrag(tl + ML_VS, 176, 32 * ks, 16 * vb, lane);
#pragma unroll
          for (int ks = 0; ks < 2; ++ks) { const v4u kr = __builtin_bit_cast(v4u, trfrag(tl + ML_KS, 272, 32 * ks, 16 * wave, lane));
              const f32x4 w0 = *(const LAS f32x4*)(SC + SC_WS + 32 * ks + 8 * fq), w1 = *(const LAS f32x4*)(SC + SC_WS + 32 * ks + 8 * fq + 4);
              v4u o; o.x = cvtpk_n(bflo(kr.x) * w0[0], bfhi(kr.x) * w0[1]); o.y = cvtpk_n(bflo(kr.y) * w0[2], bfhi(kr.y) * w0[3]); o.z = cvtpk_n(bflo(kr.z) * w1[0], bfhi(kr.z) * w1[1]); o.w = cvtpk_n(bflo(kr.w) * w1[2], bfhi(kr.w) * w1[3]);
              kw[ks] = __builtin_bit_cast(bf16x8, o); }
#pragma unroll
          for (int vb = 0; vb < 5; ++vb) Cst[vb] = Cst[vb] * decay;
#pragma unroll
          for (int ks = 0; ks < 2; ++ks)
#pragma unroll
              for (int vb = 0; vb < 5; ++vb) Cst[vb] = mfma16(kw[ks], vf[vb][ks], Cst[vb]);
#pragma unroll
          for (int vb = 0; vb < 5; ++vb) { u32x2 w; w.x = cvtpk_n(Cst[vb][0], Cst[vb][1]); w.y = cvtpk_n(Cst[vb][2], Cst[vb][3]); *(LAS u32x2*)(cbw + (16 * vb + fr) * 272 + (16 * wave + 4 * fq) * 2) = w; } }
        DBG_END(6);
        DBG_BEGIN(7);
        if (c + 1 < nch) ML_COMMIT(((c + 1) & 1) * ML_SET);
        DBG_END(7);
        LBAR();
    }
    DBG_END(8); DBG_REPORT(item == 0);
    ML_FLUSH(nch - 1);
    { float* co = A.out + (sample ? O_CS : O_CP) + ((size_t)(b * NH + h) * DV + DVS * sl) * DQK;
#pragma unroll
      for (int vb = 0; vb < 4; ++vb) *(f32x4*)(co + (size_t)(16 * vb + fr) * DQK + 16 * wave + 4 * fq) = Cst[vb];
      if (sl == 0 && fr == 0) *(f32x4*)(A.out + (sample ? O_NS : O_NP) + (size_t)(b * NH + h) * DQK + 16 * wave + 4 * fq) = Cst[4]; }
    LBAR();
#undef ML_ISSUE
#undef ML_FLUSH
#undef ML_COMMIT
}

__device__ __forceinline__ float gelu_tanh(float y) { const float t = y * y, p = fmaf(t, 0.044715f, 1.0f);
    const float e = __builtin_amdgcn_exp2f(y * p * -2.302208198f); return y * __builtin_amdgcn_rcpf(1.0f + e); }
typedef float f32x2 __attribute__((ext_vector_type(2)));
__device__ __forceinline__ void s5_item(const Args& A, LAS unsigned char* slds, int lane, int role, int item) {
    DBG_DECL
    unsigned char* ws = A.ws;
    const int fr = lane & 15, fq = lane >> 4;
    const bool sample = item >= NBATCH * NG; const int ii = sample ? item - NBATCH * NG : item;
    const int b = ii / NG, g = ii % NG;
    const int T = sample ? SLEN : SEQ, row0 = sample ? MP + b * SLEN : b * SEQ;
    const bf16* U = (const bf16*)(ws + WS_U); bf16* Z = (bf16*)(ws + WS_Z);
    const float* LAM = (const float*)(ws + WS_S5P + S5P_LAM); const bf16* BBT = (const bf16*)(ws + WS_S5P + S5P_BBT); const bf16* CC = (const bf16*)(ws + WS_S5P + S5P_CC);
    const bf16x8 zf = (bf16x8){0, 0, 0, 0, 0, 0, 0, 0}; const f32x4 z4 = (f32x4){0.f, 0.f, 0.f, 0.f};
    const int nblk = T / 16;
    const bf16* ubase = U + (size_t)(row0 + fr) * 1024 + 16 * g + 8 * (fq & 1);
#define S5_LOADU(k_) (*(const bf16x8*)(ubase + (size_t)((k_) < nblk ? (k_) : nblk - 1) * 16 * 1024))
#define S5_BU(P_) ((LAS float*)(slds + (P_) * 8448))
#define S5_SB(P_) ((LAS bf16*)(slds + 16896 + (P_) * 4352))
    if (role == 0) {
        bf16x8 bbA[8];
#pragma unroll
        for (int rb = 0; rb < 8; ++rb) bbA[rb] = (fq < 2) ? *(const bf16x8*)(BBT + ((size_t)g * 128 + 16 * rb + fr) * 16 + 8 * fq) : zf;
        const float lr = LAM[(g * 64 + lane) * 2], li = LAM[(g * 64 + lane) * 2 + 1];
        float sr, si;
        if (sample) { sr = A.in[6][(size_t)(b * NG + g) * PST + lane]; si = A.in[7][(size_t)(b * NG + g) * PST + lane]; } else { sr = 0.f; si = 0.f; }
        bf16x8 ub = S5_LOADU(0), uc = S5_LOADU(1), ud = S5_LOADU(2);
#pragma unroll
        for (int rb = 0; rb < 8; ++rb) { const f32x4 d = mfma16(bbA[rb], ub, z4); *(LAS f32x4*)(S5_BU(0) + fr * 132 + 16 * rb + 4 * fq) = d; }
        LBAR();
#define S5_ITER_A(k_, P_) do { const int k = (k_); DBG_BEGIN(1); \
            f32x4 d[8]; \
            _Pragma("unroll") for (int rb = 0; rb < 8; ++rb) d[rb] = mfma16(bbA[rb], uc, z4);                                 \
            f32x2 bu[16]; { const LAS float* bc = S5_BU(P_); \
            _Pragma("unroll") for (int tt = 0; tt < 16; ++tt) bu[tt] = *(const LAS f32x2*)(bc + tt * 132 + 2 * lane); } \
            { LAS float* bn = S5_BU(1 - (P_)); \
            _Pragma("unroll") for (int rb = 0; rb < 8; ++rb) *(LAS f32x4*)(bn + fr * 132 + 16 * rb + 4 * fq) = d[rb]; } \
            { LAS bf16* sbc = S5_SB(P_); \
            f32x2 s2 = (f32x2){sr, si}; const f32x2 lr2 = (f32x2){lr, lr}, li2 = (f32x2){-li, li}; \
            _Pragma("unroll") for (int tt = 0; tt < 16; ++tt) { const f32x2 sw = __builtin_shufflevector(s2, s2, 1, 0); s2 = lr2 * s2 + (li2 * sw + bu[tt]);     \
                *(LAS unsigned*)(sbc + tt * 136 + 2 * lane) = cvtpk_n(s2[0], s2[1]); } sr = s2[0]; si = s2[1]; }                \
            uc = ud; ud = S5_LOADU(k + 3); DBG_END(1); \
            LBAR(); } while (0)
        DBG_BEGIN(2);
        for (int k2 = 0; k2 + 1 < nblk; k2 += 2) { S5_ITER_A(k2, 0); S5_ITER_A(k2 + 1, 1); }
        if (nblk & 1) S5_ITER_A(nblk - 1, 0);
        DBG_END(2); DBG_REPORT(!sample && item == 0);
#undef S5_ITER_A
        float* so = A.out + (sample ? O_SRS : O_SRP) + (size_t)(b * NG + g) * PST; float* io = A.out + (sample ? O_SIS : O_SIP) + (size_t)(b * NG + g) * PST;
        so[lane] = sr; io[lane] = si;
    } else {
        bf16x8 ccA[4], dA;
#pragma unroll
        for (int ks = 0; ks < 4; ++ks) ccA[ks] = *(const bf16x8*)(CC + ((size_t)g * 16 + fr) * 128 + 32 * ks + 8 * fq);
        { const short dv = (short)f2bf(A.in[22][g * 16 + fr]); dA = zf;
#pragma unroll
          for (int j = 0; j < 8; ++j) dA[j] = (fq < 2 && 8 * fq + j == fr) ? dv : (short)0; }
        bf16x8 ua = S5_LOADU(0), ub = S5_LOADU(0), uc = S5_LOADU(1);
        LBAR();
#define S5_Y(km1_, P_) do { const LAS bf16* sbp = S5_SB(P_); f32x4 y = z4; \
            _Pragma("unroll") for (int ks = 0; ks < 4; ++ks) y = mfma16(ccA[ks], *(const LAS bf16x8*)(sbp + fr * 136 + 32 * ks + 8 * fq), y); \
            y = mfma16(dA, ua, y); \
            u32x2 w; w.x = cvtpk_n(gelu_tanh(y[0]), gelu_tanh(y[1])); w.y = cvtpk_n(gelu_tanh(y[2]), gelu_tanh(y[3])); \
            *(GAS u32x2*)(Z + ((size_t)row0 + 16 * (km1_) + fr) * 1024 + 16 * g + 4 * fq) = w; } while (0)
#define S5_ITER_B(k_, P_) do { const int k = (k_); DBG_BEGIN(3); if (k >= 1) S5_Y(k - 1, 1 - (P_)); ua = ub; ub = uc; uc = S5_LOADU(k + 2); DBG_END(3); LBAR(); } while (0)
        for (int k2 = 0; k2 + 1 < nblk; k2 += 2) { S5_ITER_B(k2, 0); S5_ITER_B(k2 + 1, 1); }
        if (nblk & 1) S5_ITER_B(nblk - 1, 0);
        if ((nblk - 1) & 1) S5_Y(nblk - 1, 1); else S5_Y(nblk - 1, 0);
        DBG_REPORT(!sample && item == 0);
#undef S5_ITER_B
#undef S5_Y
    }
    LBAR();
#undef S5_BU
#undef S5_SB
#undef S5_LOADU
}

__device__ __forceinline__ void outa_rows(const Args& A, int lane, int gw, int NGW) {
    unsigned char* ws = A.ws;
    const bf16* HS = (const bf16*)(ws + WS_HS); const bf16* OG = (const bf16*)(ws + WS_OG); const float* HSS = (const float*)(ws + WS_HSS); bf16* MIXIN = (bf16*)(ws + WS_MIXIN);
    f32x4 gm[2][2];
#pragma unroll
    for (int i = 0; i < 2; ++i) { gm[i][0] = *(const f32x4*)(A.in[14] + 512 * i + 8 * lane); gm[i][1] = *(const f32x4*)(A.in[14] + 512 * i + 8 * lane + 4); }
    for (int m = gw; m < MT; m += NGW) {
        f32x4 p0[2], p1[2]; v4u hv[2], ov[2];
#pragma unroll
        for (int i = 0; i < 2; ++i) { const int col = 512 * i + 8 * lane, hh = col >> 8;
            p0[i] = *(const GAS f32x4*)(HSS + (size_t)m * 32 + hh * 8); p1[i] = *(const GAS f32x4*)(HSS + (size_t)m * 32 + hh * 8 + 4);
            hv[i] = *(const GAS v4u*)(HS + (size_t)m * 1024 + col); ov[i] = *(const GAS v4u*)(OG + (size_t)m * 1024 + col); }
        v4u o[2];
#pragma unroll
        for (int i = 0; i < 2; ++i) {
            const float ss = (p0[i][0] + p0[i][1]) + (p0[i][2] + p0[i][3]) + (p1[i][0] + p1[i][1]) + (p1[i][2] + p1[i][3]);
            const float rstd = 1.0f / sqrtf(ss * (1.0f / DV) + EPS);
            o[i].x = cvtpk(bflo(hv[i].x) * rstd * gm[i][0][0] * sigmoidf_(bflo(ov[i].x)), bfhi(hv[i].x) * rstd * gm[i][0][1] * sigmoidf_(bfhi(ov[i].x)));
            o[i].y = cvtpk(bflo(hv[i].y) * rstd * gm[i][0][2] * sigmoidf_(bflo(ov[i].y)), bfhi(hv[i].y) * rstd * gm[i][0][3] * sigmoidf_(bfhi(ov[i].y)));
            o[i].z = cvtpk(bflo(hv[i].z) * rstd * gm[i][1][0] * sigmoidf_(bflo(ov[i].z)), bfhi(hv[i].z) * rstd * gm[i][1][1] * sigmoidf_(bfhi(ov[i].z)));
            o[i].w = cvtpk(bflo(hv[i].w) * rstd * gm[i][1][2] * sigmoidf_(bflo(ov[i].w)), bfhi(hv[i].w) * rstd * gm[i][1][3] * sigmoidf_(bfhi(ov[i].w))); }
#pragma unroll
        for (int i = 0; i < 2; ++i) *(GAS v4u*)(MIXIN + (size_t)m * 2048 + 512 * i + 8 * lane) = o[i];
    }
}
__device__ __forceinline__ float row_ss_part(const float* SSp, const float* SSs, int m, int lane) {
    if (m < MP) return (lane < 32) ? SSp[(size_t)m * 32 + lane] : 0.f;
    return SSs[(size_t)(m - MP) * 128 + lane] + SSs[(size_t)(m - MP) * 128 + 64 + lane];
}
__device__ __forceinline__ void rowpass1(const Args& A, int lane, int gw, int NGW) {
    unsigned char* ws = A.ws;
    const bf16* MIX = (const bf16*)(ws + WS_MIX); bf16* X1B = (bf16*)(ws + WS_X1B); float* RSTD2 = (float*)(ws + WS_SSS + SSS_RSTD2);
    const float* SSp = (const float*)(ws + WS_SS1); const float* SSs = (const float*)(ws + WS_SSS + SSS_1);
    const float* RSTD1 = (const float*)(ws + WS_SSS + SSS_RSTD1);
    f32x4 g1[8], gi[8];
#pragma unroll
    for (int j = 0; j < 8; ++j) { g1[j] = *(const f32x4*)(A.in[26] + 256 * j + 4 * lane); const f32x4 g0 = *(const f32x4*)(A.in[8] + 256 * j + 4 * lane);
        gi[j] = (f32x4){1.0f / g0[0], 1.0f / g0[1], 1.0f / g0[2], 1.0f / g0[3]}; }
    u32x2 va[8], vb[8], ma[8], mb[8]; float sa = 0.f, sb = 0.f, ra = 0.f, rb = 0.f;
#define RP1_LOAD(V, M, S, R, m_) do { const int mm_ = (m_); \
        S = row_ss_part(SSp, SSs, mm_, lane); R = RSTD1[mm_]; \
        _Pragma("unroll") for (int j = 0; j < 8; ++j) { const int k = 256 * j + 4 * lane; V[j] = *(const GAS u32x2*)(X1B + (size_t)mm_ * DM + k); M[j] = *(const GAS u32x2*)(MIX + (size_t)mm_ * DM + k); } } while (0)
#define RP1_PROC(V, M, S, R, m_) do { const int mm_ = (m_); \
        const float rstd1 = 1.0f / sqrtf(wave_sum(S) * (1.0f / DM) + EPS); float s = 0.f; f32x4 O[8]; \
        _Pragma("unroll") for (int j = 0; j < 8; ++j) { f32x4 o; o[0] = bflo(V[j].x) * R * gi[j][0] + bflo(M[j].x) * rstd1 * g1[j][0]; o[1] = bfhi(V[j].x) * R * gi[j][1] + bfhi(M[j].x) * rstd1 * g1[j][1]; \
            o[2] = bflo(V[j].y) * R * gi[j][2] + bflo(M[j].y) * rstd1 * g1[j][2]; o[3] = bfhi(V[j].y) * R * gi[j][3] + bfhi(M[j].y) * rstd1 * g1[j][3]; \
            s += (o[0] * o[0] + o[1] * o[1]) + (o[2] * o[2] + o[3] * o[3]); O[j] = o; } \
        const float ms2 = wave_sum(s) * (1.0f / DM) + EPS, rstd2 = 1.0f / sqrtf(ms2); \
        _Pragma("unroll") for (int j = 0; j < 8; ++j) { u32x2 o; o.x = cvtpk(O[j][0] * rstd2, O[j][1] * rstd2); o.y = cvtpk(O[j][2] * rstd2, O[j][3] * rstd2); \
            *(GAS u32x2*)(X1B + (size_t)mm_ * DM + 256 * j + 4 * lane) = o; } \
        if (lane == 0) RSTD2[mm_] = sqrtf(ms2); } while (0)
    int m = gw;
    if (m < MT) { RP1_LOAD(va, ma, sa, ra, m);
        for (;;) { const int m2 = m + NGW; if (m2 < MT) RP1_LOAD(vb, mb, sb, rb, m2); RP1_PROC(va, ma, sa, ra, m); if (m2 >= MT) break;
                   m = m2 + NGW; if (m < MT) RP1_LOAD(va, ma, sa, ra, m); RP1_PROC(vb, mb, sb, rb, m2); if (m >= MT) break; } }
#undef RP1_LOAD
#undef RP1_PROC
}
__device__ __forceinline__ void rowpass2(const Args& A, int lane, int gw, int NGW) {
    unsigned char* ws = A.ws;
    const bf16* FF = (const bf16*)(ws + WS_FF); const bf16* X1B = (const bf16*)(ws + WS_X1B);
    const float* SSp = (const float*)(ws + WS_SS2); const float* SSs = (const float*)(ws + WS_SSS + SSS_2);
    f32x4 g3[8];
#pragma unroll
    for (int j = 0; j < 8; ++j) g3[j] = *(const f32x4*)(A.in[31] + 256 * j + 4 * lane);
    u32x2 xa[8], xb[8], fa[8], fb[8]; float sa = 0.f, sb = 0.f;
    const float* RSTD2 = (const float*)(ws + WS_SSS + SSS_RSTD2); float ra = 0.f, rb = 0.f;
#define RP2_LOAD(X, F, S, R, m_) do { const int mm_ = (m_); S = row_ss_part(SSp, SSs, mm_, lane); R = RSTD2[mm_]; \
        _Pragma("unroll") for (int j = 0; j < 8; ++j) { const int k = 256 * j + 4 * lane; X[j] = *(const GAS u32x2*)(X1B + (size_t)mm_ * DM + k); F[j] = *(const GAS u32x2*)(FF + (size_t)mm_ * DM + k); } } while (0)
#define RP2_PROC(X, F, S, R, m_) do { const int mm_ = (m_); float* orow = A.out + O_Y + (size_t)mm_ * DM; const float rstd = 1.0f / sqrtf(wave_sum(S) * (1.0f / DM) + EPS); f32x4 V[8]; \
        _Pragma("unroll") for (int j = 0; j < 8; ++j) { V[j][0] = bflo(X[j].x) * R + bflo(F[j].x) * rstd * g3[j][0]; V[j][1] = bfhi(X[j].x) * R + bfhi(F[j].x) * rstd * g3[j][1]; V[j][2] = bflo(X[j].y) * R + bflo(F[j].y) * rstd * g3[j][2]; V[j][3] = bfhi(X[j].y) * R + bfhi(F[j].y) * rstd * g3[j][3]; } \
        DBG_PERTURB(V, mm_); \
        _Pragma("unroll") for (int j = 0; j < 8; ++j) __builtin_nontemporal_store(V[j], (GAS f32x4*)(orow + 256 * j + 4 * lane)); } while (0)
    int m = gw;
    if (m < MT) { RP2_LOAD(xa, fa, sa, ra, m);
        for (;;) { const int m2 = m + NGW; if (m2 < MT) RP2_LOAD(xb, fb, sb, rb, m2); RP2_PROC(xa, fa, sa, ra, m); if (m2 >= MT) break;
                   m = m2 + NGW; if (m < MT) RP2_LOAD(xa, fa, sa, ra, m); RP2_PROC(xb, fb, sb, rb, m2); if (m >= MT) break; } }
#undef RP2_LOAD
#undef RP2_PROC
}
#ifndef MK_AL_P4
#define MK_AL_P4 true
#endif
#ifndef MK_AL_SS
#define MK_AL_SS true
#endif
#ifndef MK_WGM_P5
#define MK_WGM_P5 4
#endif
#ifndef MK_WGM_P1
#define MK_WGM_P1 2
#endif
#ifndef MK_WGM_P7
#define MK_WGM_P7 4
#endif
#ifndef MK_WGM_P8
#define MK_WGM_P8 1
#endif
#ifndef MK_GU_ALIGN
#define MK_GU_ALIGN true
#endif
#ifndef MK_GU_SP2
#define MK_GU_SP2 true
#endif
__global__ void __launch_bounds__(NWAVES * 64, 2) hymba_fwd(Args args) {
    extern __shared__ __attribute__((aligned(16))) unsigned char lds_raw[];
    LAS unsigned char* lds = (LAS unsigned char*)lds_raw;
    volatile LAS unsigned* MISC = (volatile LAS unsigned*)(lds + MISC_OFF);
    const int tid = threadIdx.x, lane = tid & 63, wave = __builtin_amdgcn_readfirstlane(tid >> 6);
    const int G = gridDim.x; const int bx = blockIdx.x; const int vcu = (G % 8 == 0) ? (bx % 8) * (G / 8) + bx / 8 : bx;
    unsigned char* ws = args.ws;
    gu32* ctl = (gu32*)(ws + WS_CTL);
    for (int u = tid; u < (LDS_BYTES - LDSCTL_OFF) / 4; u += NWAVES * 64) ((LAS unsigned*)(lds + LDSCTL_OFF))[u] = 0u;
    __syncthreads();
    const XcdBarrier bar = xcd_barrier_post((unsigned*)(ctl + CW_BAR) + args.li * XCD_BAR_WORDS, MISC + 8);
#define GRID_BAR() xcd_barrier(bar)
    const int lo = args.ph_lo, hi = args.ph_hi;
#define IN(k) (lo <= (k) && (k) < hi)
#define BOTH(k) (IN(k) && IN((k) + 1))

    const int gw = vcu * NWAVES + wave, NGW = G * NWAVES;

    if (IN(0)) { PHASE_IDS p0_prologue(args, lds, tid, lane, wave, vcu, G); if (BOTH(0)) GRID_BAR(); }

    if (IN(1)) { PHASE_IDS
        { pg8::Gemm g{(const bf16*)(ws + WS_XN), (const bf16*)(ws + WS_WIN), MP, 4096, DM}; pg8::StaticOrder S; S.init(MP, 4096, G, bx, MK_WGM_P1);
          pg8::EpiBf16<0> E{(bf16*)(ws + WS_QKRAW), 1024, nullptr, 1024, (size_t)WS_RSTRIDE / 2, 1.f};
          pg8::gemm_phase<pg8::EpiBf16<0>, pg8::StaticOrder, true, true>(lds + RING_OFF, g, S, E); }
        { PHASE_IDS bf16* O = (bf16*)(ws + WS_QKRAW);
          skinny_ks<1, DM, 4>((const bf16*)(ws + WS_XN) + (size_t)MP * DM, (const bf16*)(ws + WS_WIN), (float*)(ws + WS_PARTA), 4096, (unsigned*)ctl + CW_KS1, lds, 4096 / 16, vcu, G, wave, lane,
              [](int it, int a, int fr) { return 16 * it + fr; },
              [O](int it, int row, int fq, const f32x4 (&acc)[1]) { const int col = 16 * it + 4 * fq, t = col >> 10;
                  u32x2 w; w.x = cvtpk_n(acc[0][0], acc[0][1]); w.y = cvtpk_n(acc[0][2], acc[0][3]);
                  *(GAS u32x2*)(O + (size_t)t * (WS_RSTRIDE / 2) + (size_t)(MP + row) * 1024 + (col & 1023)) = w; }); }
        if (BOTH(1)) GRID_BAR();
    }

    if (IN(2)) { PHASE_IDS if (vcu < 64) p2_scalars(args, lds, lane, wave, vcu); p2_conv(args, tid, vcu, G); if (BOTH(2)) GRID_BAR(); }

    if (IN(3)) { PHASE_IDS
        const int half = G / 2;
#ifndef MK_REP_M
#define MK_REP_M 1
#endif
#ifndef MK_REP_S
#define MK_REP_S 1
#endif
        if (vcu < half) { for (int rp_ = 0; rp_ < MK_REP_M; ++rp_) for (int it = vcu; it < NBATCH * NH * NSL; it += half) mlstm_item(args, lds, tid, lane, wave, it); }
        else { const int nb = G - half, bi = vcu - half;
               for (int rp_ = 0; rp_ < MK_REP_S; ++rp_)
               for (int it = bi * 4 + (wave & 3); it < 2 * NBATCH * NG; it += nb * 4) s5_item(args, lds + (wave & 3) * 25600, lane, wave >> 2, it); }
        if (vcu >= half) { __syncthreads(); for (int it = NBATCH * NH * NSL + (vcu - half); it < 2 * NBATCH * NH * NSL; it += G - half) mlstm_item(args, lds, tid, lane, wave, it); }
        if (BOTH(3)) GRID_BAR();
    }

    if (IN(4)) { PHASE_IDS
        { pg8::Gemm g{(const bf16*)(ws + WS_Z), (const bf16*)(ws + WS_WGLU), MP, 1024, 1024}; pg8::StaticOrder S; S.init(MP, 1024, G, bx);
          pg8::EpiGlu E{(const bf16*)(ws + WS_Z), (bf16*)(ws + WS_MIXIN), args.in[24]};
          pg8::gemm_phase<pg8::EpiGlu, pg8::StaticOrder, MK_AL_P4, true>(lds + RING_OFF, g, S, E); }
        { PHASE_IDS const bf16* Zb = (const bf16*)(ws + WS_Z); bf16* O = (bf16*)(ws + WS_MIXIN); const float* bias = args.in[24];
          skinny_ks<1, 1024, 4>(Zb + (size_t)MP * 1024, (const bf16*)(ws + WS_WGLU), (float*)(ws + WS_PARTA), 1024, (unsigned*)ctl + CW_KS4, lds, 1024 / 16, vcu, G, wave, lane,
              [](int it, int a, int fr) { return 16 * it + fr; },
              [Zb, O, bias](int it, int row, int fq, const f32x4 (&acc)[1]) { const int col = 16 * it + 4 * fq; const size_t m = (size_t)(MP + row);
                  const u32x2 z = *(const GAS u32x2*)(Zb + m * 1024 + col); const f32x4 bv = *(const f32x4*)(bias + col);
                  u32x2 w; w.x = cvtpk(bflo(z.x) * sigmoidf_(acc[0][0] + bv[0]), bfhi(z.x) * sigmoidf_(acc[0][1] + bv[1]));
                  w.y = cvtpk(bflo(z.y) * sigmoidf_(acc[0][2] + bv[2]), bfhi(z.y) * sigmoidf_(acc[0][3] + bv[3]));
                  *(GAS u32x2*)(O + m * 2048 + 1024 + col) = w; }); }
        { PHASE_IDS outa_rows(args, lane, gw, NGW); }
        if (BOTH(4)) GRID_BAR();
    }

    if (IN(5)) { PHASE_IDS
        { pg8::Gemm g{(const bf16*)(ws + WS_MIXIN), (const bf16*)(ws + WS_WOUT), MP, DM, DM}; pg8::StaticOrder S; S.init(MP, DM, G, bx, MK_WGM_P5);
          pg8::EpiSS<false> E{(bf16*)(ws + WS_MIX), DM, (float*)(ws + WS_SS1), 1.0f};
          pg8::gemm_phase<pg8::EpiSS<false>, pg8::StaticOrder, MK_AL_SS, true>(lds + RING_OFF, g, S, E); }
        { PHASE_IDS bf16* O = (bf16*)(ws + WS_MIX); float* SSs = (float*)(ws + WS_SSS + SSS_1);
          skinny_ks<1, DM, 4>((const bf16*)(ws + WS_MIXIN) + (size_t)MP * DM, (const bf16*)(ws + WS_WOUT), (float*)(ws + WS_PARTA), 2048, (unsigned*)ctl + CW_KS5, lds, DM / 16, vcu, G, wave, lane,
              [](int it, int a, int fr) { return 16 * it + fr; },
              [O, SSs](int it, int row, int fq, const f32x4 (&acc)[1]) { const int col = 16 * it + 4 * fq;
                  u32x2 w; w.x = cvtpk_n(acc[0][0], acc[0][1]); w.y = cvtpk_n(acc[0][2], acc[0][3]);
                  *(GAS u32x2*)(O + (size_t)(MP + row) * DM + col) = w;
                  float s = (acc[0][0] * acc[0][0] + acc[0][1] * acc[0][1]) + (acc[0][2] * acc[0][2] + acc[0][3] * acc[0][3]);
                  s += __shfl_xor(s, 16); s += __shfl_xor(s, 32);
                  if (fq == 0) SSs[(size_t)row * 128 + it] = s; }); }
        if (BOTH(5)) GRID_BAR();
    }

    if (IN(6)) { PHASE_IDS rowpass1(args, lane, gw, NGW); if (BOTH(6)) GRID_BAR(); }

    if (IN(7)) { PHASE_IDS
        { pg8::Gemm g{(const bf16*)(ws + WS_X1B), (const bf16*)(ws + WS_WGU), MP, 2 * DFF, DM}; pg8::StaticOrder S; S.init(MP, 2 * DFF, G, bx, MK_WGM_P7);
          pg8::EpiGU8 E{ws + WS_ACT8, DFF};
          pg8::gemm_phase<pg8::EpiGU8, pg8::StaticOrder, MK_GU_ALIGN, MK_GU_SP2>(lds + RING_OFF, g, S, E); }
        { PHASE_IDS bf16* O = (bf16*)(ws + WS_ACTS);
          skinny_ks<2, DM, 4>((const bf16*)(ws + WS_X1B) + (size_t)MP * DM, (const bf16*)(ws + WS_WGU), (float*)(ws + WS_PARTA), DFF, (unsigned*)ctl + CW_KS7, lds, DFF / 16, vcu, G, wave, lane,
              [](int it, int a, int fr) { const int j = 16 * it + fr; return 256 * (j >> 7) + 128 * a + (j & 127); },
              [O](int it, int row, int fq, const f32x4 (&acc)[2]) { const int col = 16 * it + 4 * fq; const f32x4 g = acc[0], up = acc[1];
                  u32x2 w; w.x = cvtpk(g[0] * sigmoidf_(g[0]) * up[0], g[1] * sigmoidf_(g[1]) * up[1]);
                  w.y = cvtpk(g[2] * sigmoidf_(g[2]) * up[2], g[3] * sigmoidf_(g[3]) * up[3]);
                  *(GAS u32x2*)(O + (size_t)row * DFF + col) = w; }); }
        if (BOTH(7)) GRID_BAR();
    }

    if (IN(8)) { PHASE_IDS
        { pg8::Gemm g{(const bf16*)(ws + WS_ACT8), (const bf16*)(ws + WS_WD8), MP, DM, DFF / 2}; pg8::StaticOrder S; S.init(MP, DM, G, bx, MK_WGM_P8);
          pg8::EpiSS<true> E{(bf16*)(ws + WS_FF), DM, (float*)(ws + WS_SS2), 0.0009765625f};
          pg8::gemm_phase<pg8::EpiSS<true>, pg8::StaticOrder, MK_AL_SS, true, true>(lds + RING_OFF, g, S, E); }
        { PHASE_IDS bf16* O = (bf16*)(ws + WS_FF); float* SSs = (float*)(ws + WS_SSS + SSS_2);
          skinny_ks<1, DFF, 8>((const bf16*)(ws + WS_ACTS), (const bf16*)(ws + WS_WD), (float*)(ws + WS_PARTB), 2048, (unsigned*)ctl + CW_KS8, lds, DM / 16, vcu, G, wave, lane,
              [](int it, int a, int fr) { return 16 * it + fr; },
              [O, SSs](int it, int row, int fq, const f32x4 (&acc)[1]) { const int col = 16 * it + 4 * fq;
                  u32x2 w; w.x = cvtpk_n(acc[0][0], acc[0][1]); w.y = cvtpk_n(acc[0][2], acc[0][3]);
                  *(GAS u32x2*)(O + (size_t)(MP + row) * DM + col) = w;
                  float s = (acc[0][0] * acc[0][0] + acc[0][1] * acc[0][1]) + (acc[0][2] * acc[0][2] + acc[0][3] * acc[0][3]);
                  s += __shfl_xor(s, 16); s += __shfl_xor(s, 32);
                  if (fq == 0) SSs[(size_t)row * 128 + it] = s; }); }
        if (BOTH(8)) GRID_BAR();
    }

    if (IN(9)) { PHASE_IDS rowpass2(args, lane, gw, NGW); }
#undef IN
#undef BOTH
}

#ifdef MK_DUMP_OFF
__global__ void dump_kernel(const unsigned short* src, float* dst, size_t n) {
    for (size_t i = (size_t)blockIdx.x * blockDim.x + threadIdx.x; i < n; i += (size_t)gridDim.x * blockDim.x) dst[i] = __uint_as_float((unsigned)src[i] << 16);
}
#endif
extern "C" void kernel_launch(void* const* d_in, const int* in_sizes, int n_in, void* d_out, int out_size, void* d_ws, size_t ws_size, hipStream_t stream) {
    static int grid = 0;
    if (grid == 0) {
        if (n_in != 32 || out_size != (int)O_END || ws_size < WS_END) { fprintf(stderr, "kernel_launch: unexpected problem: n_in %d out %d ws %zu\n", n_in, out_size, ws_size); grid = -1; return; }
        int dev = 0, cus = 0, per_cu = 0;
        if (hipGetDevice(&dev) != hipSuccess || hipDeviceGetAttribute(&cus, hipDeviceAttributeMultiprocessorCount, dev) != hipSuccess) { grid = -1; return; }
        if (hipFuncSetAttribute((const void*)hymba_fwd, hipFuncAttributeMaxDynamicSharedMemorySize, LDS_BYTES) != hipSuccess) { fprintf(stderr, "kernel_launch: hipFuncSetAttribute failed\n"); grid = -1; return; }
        if (hipOccupancyMaxActiveBlocksPerMultiprocessor(&per_cu, (const void*)hymba_fwd, NWAVES * 64, LDS_BYTES) != hipSuccess || per_cu < 1) { fprintf(stderr, "kernel_launch: occupancy query reports %d\n", per_cu); per_cu = 1; }
        (void)hipGetLastError();
        grid = cus;
    }
    if (grid < 0) return;
    Args a{};
    for (int i = 0; i < 32; ++i) a.in[i] = (const float*)d_in[i];
    a.out = (float*)d_out; a.ws = (unsigned char*)d_ws;
    int lo[N_PHASES + 2], hi[N_PHASES + 2], nl = 0;
#if defined(MK_REPEAT)
    lo[0] = 0; hi[0] = MK_REPEAT + 1; lo[1] = MK_REPEAT; hi[1] = MK_REPEAT + 1; lo[2] = MK_REPEAT + 1; hi[2] = N_PHASES; nl = 3;
#else
    if (N_LAUNCHES == 1) { lo[0] = 0; hi[0] = N_PHASES; nl = 1; } else { for (int k = 0; k < N_PHASES; ++k) { lo[k] = k; hi[k] = k + 1; } nl = N_PHASES; }
#endif
    if (hipMemsetAsync((char*)d_ws + WS_CTL, 0, (size_t)CW_END * 4, stream) != hipSuccess) return;
    for (int li = 0; li < nl; ++li) {
        a.ph_lo = lo[li]; a.ph_hi = hi[li]; a.li = li;
        hipLaunchKernelGGL(hymba_fwd, dim3(grid), dim3(NWAVES * 64), LDS_BYTES, stream, a);
    }
#ifdef MK_DUMP_OFF
    hipLaunchKernelGGL(dump_kernel, dim3(2048), dim3(256), 0, stream, (const unsigned short*)((const unsigned char*)d_ws + (size_t)(MK_DUMP_OFF) * MiB), (float*)d_out, (size_t)(MK_DUMP_N));
#endif
}
```

```cpp
#define MK_N_LAUNCHES 1
#include <hip/hip_runtime.h>
#include <cstdio>
#include <cstdint>
#include <cmath>
namespace pg8 {
#define PG8_LAS __attribute__((address_space(3)))
typedef unsigned short bf16_t;
typedef short bf16x8 __attribute__((ext_vector_type(8)));
typedef float f32x4 __attribute__((ext_vector_type(4)));
typedef unsigned u32x4 __attribute__((ext_vector_type(4)));
typedef int i32x4 __attribute__((ext_vector_type(4)));
typedef int i32x8 __attribute__((ext_vector_type(8)));
__device__ __forceinline__ i32x8 cat8(bf16x8 lo, bf16x8 hi) { return __builtin_shufflevector(__builtin_bit_cast(i32x4, lo), __builtin_bit_cast(i32x4, hi), 0, 1, 2, 3, 4, 5, 6, 7); }
constexpr int BM = 256, BK = 64, HALF = 128, HTB = HALF * BK * 2  , STAGE_BYTES = 8 * HTB, NXCD = 8, WGM = 4;

__host__ __device__ __forceinline__ int lds_byte(int r, int c) { const int st = (r >> 4) * 2 + (c >> 5), rr = r & 15, cc = c & 31, ob = rr * 64 + cc * 2; return st * 1024 + (ob ^ (((ob >> 9) & 1) << 5)); }
__host__ __device__ __forceinline__ void stage_rc(int b, int& R, int& C) { const int st = b / 1024, sb = b % 1024, swz = sb ^ (((sb >> 9) & 1) << 5); R = (st >> 1) * 16 + swz / 64; C = (st & 1) * 32 + (swz % 64) / 2; }
__host__ __device__ __forceinline__ int perm32(int rho) { const int n = rho >> 4, i = rho & 15; return 8 * (i >> 2) + 4 * n + (i & 3); }

struct Unit { int pm, pn; };
struct Gemm { const bf16_t* A; const bf16_t* Bt; int M, N, K; };

struct StaticOrder {
    int nM, nN, nwg, G, c, wgm;
    __host__ __device__ void init(int M, int N, int G_, int c_, int wgm_ = WGM) { nM = M / BM; nN = N / BM; nwg = nM * nN; G = G_; c = c_; wgm = wgm_; }
    __host__ __device__ bool next(int i, Unit& u) const {
        const long L = (long)i * G + c; if (L >= nwg) return false;
        int wgid = (int)L; { const int q = nwg / NXCD, r = nwg % NXCD, xcd = wgid % NXCD, off = wgid / NXCD; wgid = (xcd < r ? xcd * (q + 1) : r * (q + 1) + (xcd - r) * q) + off; }
        const int nig = wgm * nN, gid = wgid / nig, fm = gid * wgm, gsz = (nM - fm) < wgm ? (nM - fm) : wgm;
        u.pm = fm + ((wgid % nig) % gsz); u.pn = (wgid % nig) / gsz; return true;
    }
    __device__ __forceinline__ void a_ready(const Unit&) const {}
    __device__ __forceinline__ void done(const Unit&) const {}
};

__device__ __forceinline__ unsigned cvt_pk_bf16(float lo, float hi) { unsigned r; asm volatile("v_cvt_pk_bf16_f32 %0, %1, %2" : "=v"(r) : "v"(lo), "v"(hi)); return r; }
typedef float f32x2 __attribute__((ext_vector_type(2)));
__device__ __forceinline__ f32x2 gelu_pk(f32x2 v) {
    const f32x2 av = __builtin_elementwise_abs(v), d = av * 0.2316418882f + 1.0f;
    f32x2 t; t.x = __builtin_amdgcn_rcpf(d.x); t.y = __builtin_amdgcn_rcpf(d.y);
    f32x2 q = t * 0.5307027145f + (-0.7265760135f); q = q * t + 0.7107068705f; q = q * t + (-0.142248368f); q = q * t + 0.127414796f; q = q * t;
    const f32x2 s = (v * v) * (-0.72134752044f);
    f32x2 e; e.x = __builtin_amdgcn_exp2f(s.x); e.y = __builtin_amdgcn_exp2f(s.y);
    const f32x2 m = v * (q * e), r = v - m;
    f32x2 o; o.x = v.x < 0.f ? m.x : r.x; o.y = v.y < 0.f ? m.y : r.y; return o;
}

template <int ACT  > struct EpiBf16 {
    static constexpr bool PERM = true, AFTER_DRAIN = false; static_assert(ACT == 0 || ACT == 1, "EpiBf16: ACT is 0 (none) or 1 (gelu_pk)");
    bf16_t* O; int ldc; const float* bias; int split_cols; size_t split_stride; float scale0;
    __device__ __forceinline__ void operator()(const f32x4 (&acc)[2][2][4][2], const Unit& u, int wr, int wc, int fr, int fq) const {
        const int row0 = u.pm * BM + wr * 64 + fr; int colt = u.pn * BM; bf16_t* base = O;
        float sc = 1.f; if (split_cols) { const int t = colt / split_cols; base += (size_t)t * split_stride; colt -= t * split_cols; if (t == 0) sc = scale0; }
        const int col0 = colt + wc * 32 + 8 * fq, bcol0 = u.pn * BM + wc * 32 + 8 * fq;
        f32x4 bv[2][2];
#pragma unroll
        for (int bj = 0; bj < 2; ++bj)
#pragma unroll
            for (int n = 0; n < 2; ++n) bv[bj][n] = bias ? *(const f32x4*)(bias + bcol0 + bj * HALF + 4 * n) : (f32x4){0.f, 0.f, 0.f, 0.f};
#pragma unroll
        for (int ai = 0; ai < 2; ++ai)
#pragma unroll
            for (int m = 0; m < 4; ++m) { bf16_t* rowp = base + (size_t)(row0 + ai * HALF + m * 16) * ldc + col0;
#pragma unroll
                for (int bj = 0; bj < 2; ++bj) { f32x4 v0 = acc[ai][bj][m][0] + bv[bj][0], v1 = acc[ai][bj][m][1] + bv[bj][1];
                    if (ACT == 1) { f32x2 a = gelu_pk((f32x2){v0[0], v0[1]}), b = gelu_pk((f32x2){v0[2], v0[3]}), c = gelu_pk((f32x2){v1[0], v1[1]}), d = gelu_pk((f32x2){v1[2], v1[3]});
                        v0 = (f32x4){a.x, a.y, b.x, b.y}; v1 = (f32x4){c.x, c.y, d.x, d.y}; }
                    v0 = v0 * sc; v1 = v1 * sc; u32x4 w; w.x = cvt_pk_bf16(v0[0], v0[1]); w.y = cvt_pk_bf16(v0[2], v0[3]); w.z = cvt_pk_bf16(v1[0], v1[1]); w.w = cvt_pk_bf16(v1[2], v1[3]);
                    *(u32x4*)(rowp + bj * HALF) = w; } }
    }
};
__device__ __forceinline__ float fast_sigmoid(float v) { return __builtin_amdgcn_rcpf(1.0f + __expf(-v)); }
__device__ __forceinline__ float bf_lo(unsigned w) { return __uint_as_float(w << 16); }
__device__ __forceinline__ float bf_hi(unsigned w) { return __uint_as_float(w & 0xffff0000u); }
struct EpiGlu {
    static constexpr bool PERM = true, AFTER_DRAIN = false;
    const bf16_t* Z; bf16_t* O; const float* bias;
    __device__ __forceinline__ void operator()(const f32x4 (&acc)[2][2][4][2], const Unit& u, int wr, int wc, int fr, int fq) const {
        const int row0 = u.pm * BM + wr * 64 + fr, col0 = u.pn * BM + wc * 32 + 8 * fq;
        f32x4 bv[2][2];
#pragma unroll
        for (int bj = 0; bj < 2; ++bj)
#pragma unroll
            for (int n = 0; n < 2; ++n) bv[bj][n] = *(const f32x4*)(bias + col0 + bj * HALF + 4 * n);
#pragma unroll
        for (int ai = 0; ai < 2; ++ai) {
            u32x4 z[4][2];
#pragma unroll
            for (int m = 0; m < 4; ++m)
#pragma unroll
                for (int bj = 0; bj < 2; ++bj) z[m][bj] = *(const u32x4*)(Z + (size_t)(row0 + ai * HALF + m * 16) * 1024 + col0 + bj * HALF);
#pragma unroll
            for (int m = 0; m < 4; ++m) { const size_t row = (size_t)(row0 + ai * HALF + m * 16);
#pragma unroll
                for (int bj = 0; bj < 2; ++bj) { const int col = col0 + bj * HALF; const u32x4 zz = z[m][bj];
                    const f32x4 v0 = acc[ai][bj][m][0] + bv[bj][0], v1 = acc[ai][bj][m][1] + bv[bj][1];
                    u32x4 w;
                    w.x = cvt_pk_bf16(bf_lo(zz.x) * fast_sigmoid(v0[0]), bf_hi(zz.x) * fast_sigmoid(v0[1]));
                    w.y = cvt_pk_bf16(bf_lo(zz.y) * fast_sigmoid(v0[2]), bf_hi(zz.y) * fast_sigmoid(v0[3]));
                    w.z = cvt_pk_bf16(bf_lo(zz.z) * fast_sigmoid(v1[0]), bf_hi(zz.z) * fast_sigmoid(v1[1]));
                    w.w = cvt_pk_bf16(bf_lo(zz.w) * fast_sigmoid(v1[2]), bf_hi(zz.w) * fast_sigmoid(v1[3]));
                    *(u32x4*)(O + row * 2048 + 1024 + col) = w; } } }
    }
};
template <bool SCALED> struct EpiSS {
    static constexpr bool PERM = true, AFTER_DRAIN = false;
    bf16_t* O; int ldc; float* SS; float scale;
    __device__ __forceinline__ void operator()(const f32x4 (&acc)[2][2][4][2], const Unit& u, int wr, int wc, int fr, int fq) const {
        const int row0 = u.pm * BM + wr * 64 + fr, col0 = u.pn * BM + wc * 32 + 8 * fq;
        float s[2][4];
#pragma unroll
        for (int ai = 0; ai < 2; ++ai)
#pragma unroll
            for (int m = 0; m < 4; ++m) { const size_t row = (size_t)(row0 + ai * HALF + m * 16); float t = 0.f;
#pragma unroll
                for (int bj = 0; bj < 2; ++bj) { f32x4 v0 = acc[ai][bj][m][0], v1 = acc[ai][bj][m][1]; if (SCALED) { v0 = v0 * scale; v1 = v1 * scale; }
                    t += (v0[0] * v0[0] + v0[1] * v0[1]) + (v0[2] * v0[2] + v0[3] * v0[3]) + (v1[0] * v1[0] + v1[1] * v1[1]) + (v1[2] * v1[2] + v1[3] * v1[3]);
                    u32x4 w; w.x = cvt_pk_bf16(v0[0], v0[1]); w.y = cvt_pk_bf16(v0[2], v0[3]); w.z = cvt_pk_bf16(v1[0], v1[1]); w.w = cvt_pk_bf16(v1[2], v1[3]);
                    *(u32x4*)(O + row * ldc + col0 + bj * HALF) = w; }
                s[ai][m] = t; }
#pragma unroll
        for (int ai = 0; ai < 2; ++ai)
#pragma unroll
            for (int m = 0; m < 4; ++m) s[ai][m] += __shfl_xor(s[ai][m], 16);
#pragma unroll
        for (int ai = 0; ai < 2; ++ai)
#pragma unroll
            for (int m = 0; m < 4; ++m) s[ai][m] += __shfl_xor(s[ai][m], 32);
        if (fq == 0) {
#pragma unroll
            for (int ai = 0; ai < 2; ++ai)
#pragma unroll
                for (int m = 0; m < 4; ++m) SS[(size_t)(row0 + ai * HALF + m * 16) * 32 + u.pn * 4 + wc] = s[ai][m]; }
    }
};
struct EpiGU {
    static constexpr bool PERM = true, AFTER_DRAIN = false;
    bf16_t* O; int ldc;
    static __device__ __forceinline__ unsigned swiglu_pk(f32x2 g, f32x2 u) {
        const f32x2 t = g * -1.4426950408889634f; f32x2 e; e.x = __builtin_amdgcn_exp2f(t.x); e.y = __builtin_amdgcn_exp2f(t.y);
        const f32x2 d = e + 1.0f; f32x2 s; s.x = __builtin_amdgcn_rcpf(d.x); s.y = __builtin_amdgcn_rcpf(d.y);
        const f32x2 o = (g * u) * s; return cvt_pk_bf16(o.x, o.y);
    }
    __device__ __forceinline__ void operator()(const f32x4 (&acc)[2][2][4][2], const Unit& u, int wr, int wc, int fr, int fq) const {
        const int row0 = u.pm * BM + wr * 64 + fr, col0 = u.pn * HALF + wc * 32 + 8 * fq;
#pragma unroll
        for (int ai = 0; ai < 2; ++ai)
#pragma unroll
            for (int m = 0; m < 4; ++m) { const size_t row = (size_t)(row0 + ai * HALF + m * 16);
                const f32x4 g0 = acc[ai][0][m][0], g1 = acc[ai][0][m][1], u0 = acc[ai][1][m][0], u1 = acc[ai][1][m][1];
                u32x4 w;
                w.x = swiglu_pk((f32x2){g0[0], g0[1]}, (f32x2){u0[0], u0[1]});
                w.y = swiglu_pk((f32x2){g0[2], g0[3]}, (f32x2){u0[2], u0[3]});
                w.z = swiglu_pk((f32x2){g1[0], g1[1]}, (f32x2){u1[0], u1[1]});
                w.w = swiglu_pk((f32x2){g1[2], g1[3]}, (f32x2){u1[2], u1[3]});
                *(u32x4*)(O + row * ldc + col0) = w; }
    }
};
struct EpiGU8 {
    static constexpr bool PERM = true, AFTER_DRAIN = false;
    unsigned char* O; int ldc;
    static __device__ __forceinline__ f32x2 swiglu2(f32x2 g, f32x2 u) {
        const f32x2 t = g * -1.4426950408889634f; f32x2 e; e.x = __builtin_amdgcn_exp2f(t.x); e.y = __builtin_amdgcn_exp2f(t.y);
        const f32x2 d = e + 1.0f; f32x2 s; s.x = __builtin_amdgcn_rcpf(d.x); s.y = __builtin_amdgcn_rcpf(d.y);
        f32x2 o = (g * u) * s; o.x = __builtin_amdgcn_fmed3f(o.x, -448.f, 448.f); o.y = __builtin_amdgcn_fmed3f(o.y, -448.f, 448.f); return o;
    }
    __device__ __forceinline__ void operator()(const f32x4 (&acc)[2][2][4][2], const Unit& u, int wr, int wc, int fr, int fq) const {
        const int row0 = u.pm * BM + wr * 64 + fr, col0 = u.pn * HALF + wc * 32 + 8 * fq;
#pragma unroll
        for (int ai = 0; ai < 2; ++ai)
#pragma unroll
            for (int m = 0; m < 4; ++m) { const size_t row = (size_t)(row0 + ai * HALF + m * 16);
                const f32x4 g0 = acc[ai][0][m][0], g1 = acc[ai][0][m][1], u0 = acc[ai][1][m][0], u1 = acc[ai][1][m][1];
                const f32x2 a = swiglu2((f32x2){g0[0], g0[1]}, (f32x2){u0[0], u0[1]}), b = swiglu2((f32x2){g0[2], g0[3]}, (f32x2){u0[2], u0[3]});
                const f32x2 c = swiglu2((f32x2){g1[0], g1[1]}, (f32x2){u1[0], u1[1]}), d = swiglu2((f32x2){g1[2], g1[3]}, (f32x2){u1[2], u1[3]});
                int w0 = 0, w1 = 0;
                w0 = __builtin_amdgcn_cvt_pk_fp8_f32(a.x, a.y, w0, false); w0 = __builtin_amdgcn_cvt_pk_fp8_f32(b.x, b.y, w0, true);
                w1 = __builtin_amdgcn_cvt_pk_fp8_f32(c.x, c.y, w1, false); w1 = __builtin_amdgcn_cvt_pk_fp8_f32(d.x, d.y, w1, true);
                typedef unsigned u32x2_t __attribute__((ext_vector_type(2)));
                *(u32x2_t*)(O + row * ldc + col0) = (u32x2_t){(unsigned)w0, (unsigned)w1}; }
    }
};
template <class Epi, class Sched, bool ALIGN_EPI = false, bool SP2 = false, bool F8 = false>
__device__ __forceinline__ void gemm_phase(PG8_LAS unsigned char* lds, const Gemm g, const Sched& S, const Epi& E) {
    int tid = threadIdx.x; asm volatile("" : "+v"(tid));
    const int wid = __builtin_amdgcn_readfirstlane(tid >> 6), lane = tid & 63, wr = wid >> 2, wc = wid & 3, fr = lane & 15, fq = lane >> 4;
    const int K = g.K, nt = K / BK;
    unsigned voffA[2], voffB[2];
#pragma unroll
    for (int i = 0; i < 2; ++i) { int R, C; stage_rc(tid * 16 + i * 8192, R, C); const int Rb = Epi::PERM ? ((R & ~31) + perm32(R & 31)) : R;
        voffA[i] = (unsigned)(R * K + C) * 2u; voffB[i] = (unsigned)(Rb * K + C) * 2u; }
    const size_t kstep = (size_t)(BK * 2);
    const size_t hstep = (size_t)HALF * K * 2;
    const size_t tstep = 2 * hstep;
    const unsigned ldsw = (unsigned)wid * 1024u;
    const int aoff = lds_byte(wr * 64 + fr, fq * 8), boff = lds_byte(wc * 32 + fr, fq * 8);
#define PG8_SA(b, h) (((b) * 2 + (h)) * HTB)
#define PG8_SB(b, h) ((4 + (b) * 2 + (h)) * HTB)
#define PG8_STAGE(bufoff, gbase, voff) do { _Pragma("unroll") for (int _i = 0; _i < 2; ++_i) { unsigned _vo = (voff)[_i]; asm volatile("" : "+v"(_vo));     \
        __builtin_amdgcn_global_load_lds((const unsigned*)((const char*)(gbase) + _vo), (PG8_LAS unsigned*)(lds + (bufoff) + ldsw + _i * 8192), 16, 0, 0); } } while (0)
#define PG8_LDA(dst, b, h) do { _Pragma("unroll") for (int m = 0; m < 4; ++m) _Pragma("unroll") for (int k = 0; k < 2; ++k) dst[m][k] = *(const PG8_LAS bf16x8*)(lds + PG8_SA(b, h) + aoff + m * 2048 + k * 1024); } while (0)
#define PG8_LDB(dst, b, h) do { _Pragma("unroll") for (int n = 0; n < 2; ++n) _Pragma("unroll") for (int k = 0; k < 2; ++k) dst[n][k] = *(const PG8_LAS bf16x8*)(lds + PG8_SB(b, h) + boff + n * 2048 + k * 1024); } while (0)
#define PG8_MMA(ai, bj, At, Bt) do { __builtin_amdgcn_s_setprio(1); \
        if constexpr (F8) { _Pragma("unroll") for (int m = 0; m < 4; ++m) _Pragma("unroll") for (int n = 0; n < 2; ++n) \
            acc[ai][bj][m][n] = __builtin_amdgcn_mfma_scale_f32_16x16x128_f8f6f4(cat8(Bt[n][0], Bt[n][1]), cat8(At[m][0], At[m][1]), acc[ai][bj][m][n], 0, 0, 0, 0, 0, 0); } \
        else { _Pragma("unroll") for (int m = 0; m < 4; ++m) _Pragma("unroll") for (int n = 0; n < 2; ++n) _Pragma("unroll") for (int k = 0; k < 2; ++k) \
            acc[ai][bj][m][n] = __builtin_amdgcn_mfma_f32_16x16x32_bf16(Bt[n][k], At[m][k], acc[ai][bj][m][n], 0, 0, 0); } \
        __builtin_amdgcn_s_setprio(0); } while (0)
#define PG8_WAIT_V(n) asm volatile("s_waitcnt vmcnt(" #n ")" ::: "memory")
#define PG8_WAIT_L(n) asm volatile("s_waitcnt lgkmcnt(" #n ")" ::: "memory")
#define PG8_BAR __builtin_amdgcn_s_barrier()
#define PG8_SCHED __builtin_amdgcn_sched_barrier(0)
    Unit cur, nxt; int ui = 0;
    if (!S.next(0, cur)) return;
    f32x4 acc[2][2][4][2];
#pragma unroll
    for (int a = 0; a < 2; ++a)
#pragma unroll
        for (int b = 0; b < 2; ++b)
#pragma unroll
            for (int m = 0; m < 4; ++m)
#pragma unroll
                for (int n = 0; n < 2; ++n) acc[a][b][m][n] = (f32x4){0.f, 0.f, 0.f, 0.f};
    bf16x8 At[4][2], B0[2][2], B1[2][2];
    const char* cA = (const char*)g.A + (size_t)cur.pm * tstep; const char* cB = (const char*)g.Bt + (size_t)cur.pn * tstep;
    S.a_ready(cur);
    if constexpr (SP2) {
        PG8_STAGE(PG8_SB(0, 0), cB, voffB); PG8_STAGE(PG8_SB(0, 1), cB + hstep, voffB); PG8_STAGE(PG8_SA(0, 0), cA, voffA); PG8_STAGE(PG8_SA(0, 1), cA + hstep, voffA);
        if (wr == 1) PG8_BAR;
        PG8_WAIT_V(2); PG8_BAR;
        PG8_STAGE(PG8_SB(1, 0), cB + kstep, voffB); PG8_STAGE(PG8_SA(1, 0), cA + kstep, voffA); PG8_STAGE(PG8_SB(1, 1), cB + hstep + kstep, voffB);
        PG8_WAIT_V(6); PG8_BAR;
    } else {
        PG8_STAGE(PG8_SB(0, 0), cB, voffB); PG8_STAGE(PG8_SA(0, 0), cA, voffA); PG8_STAGE(PG8_SB(0, 1), cB + hstep, voffB); PG8_STAGE(PG8_SA(0, 1), cA + hstep, voffA);
        if (wr == 1) PG8_BAR;
        PG8_WAIT_V(4); PG8_BAR;
        PG8_STAGE(PG8_SB(1, 0), cB + kstep, voffB); PG8_STAGE(PG8_SA(1, 0), cA + kstep, voffA); PG8_STAGE(PG8_SB(1, 1), cB + hstep + kstep, voffB);
        PG8_WAIT_V(6); PG8_BAR;
    }
    for (;;) {
        const bool has_next = S.next(ui + 1, nxt);
        const char* nA = has_next ? (const char*)g.A + (size_t)nxt.pm * tstep : cA; const char* nB = has_next ? (const char*)g.Bt + (size_t)nxt.pn * tstep : cB;
        for (int t = 0; t < nt; t += 2) {
            const bool last = (t == nt - 2);
            const char* a1 = cA + (size_t)(t + 1) * kstep;
            const char* a2 = last ? nA : cA + (size_t)(t + 2) * kstep; const char* b2 = last ? nB : cB + (size_t)(t + 2) * kstep;
            const char* a3 = a2 + kstep; const char* b3 = b2 + kstep;
            if (last && has_next) S.a_ready(nxt);
            if constexpr (SP2) {
            PG8_LDB(B0, 0, 0); PG8_LDB(B1, 0, 1); PG8_SCHED; PG8_LDA(At, 0, 0); PG8_STAGE(PG8_SA(1, 1), a1 + hstep, voffA);
            PG8_WAIT_V(8); PG8_WAIT_L(0); PG8_BAR; PG8_MMA(0, 0, At, B0); PG8_MMA(0, 1, At, B1); PG8_BAR; PG8_SCHED;
            PG8_LDA(At, 0, 1); PG8_STAGE(PG8_SB(0, 0), b2, voffB); PG8_STAGE(PG8_SB(0, 1), b2 + hstep, voffB); PG8_STAGE(PG8_SA(0, 0), a2, voffA);
            PG8_WAIT_V(8); PG8_WAIT_L(0); PG8_BAR; PG8_MMA(1, 0, At, B0); PG8_MMA(1, 1, At, B1); PG8_BAR; PG8_SCHED;
            PG8_LDB(B0, 1, 0); PG8_LDB(B1, 1, 1); PG8_SCHED; PG8_LDA(At, 1, 0); PG8_STAGE(PG8_SA(0, 1), a2 + hstep, voffA);
            PG8_WAIT_V(8); PG8_WAIT_L(0); PG8_BAR; PG8_MMA(0, 0, At, B0); PG8_MMA(0, 1, At, B1); PG8_BAR; PG8_SCHED;
            PG8_LDA(At, 1, 1); PG8_STAGE(PG8_SB(1, 0), b3, voffB); PG8_STAGE(PG8_SB(1, 1), b3 + hstep, voffB); PG8_STAGE(PG8_SA(1, 0), a3, voffA);
            PG8_WAIT_V(8); PG8_WAIT_L(0); PG8_BAR; PG8_MMA(1, 0, At, B0); PG8_MMA(1, 1, At, B1); PG8_BAR; PG8_SCHED;
            } else {
            PG8_LDB(B0, 0, 0); PG8_SCHED; PG8_LDA(At, 0, 0); PG8_STAGE(PG8_SA(1, 1), a1 + hstep, voffA);
            PG8_WAIT_L(8); PG8_BAR; PG8_WAIT_L(0); PG8_MMA(0, 0, At, B0); PG8_BAR; PG8_SCHED;
            PG8_LDB(B1, 0, 1); PG8_STAGE(PG8_SB(0, 0), b2, voffB);
            PG8_BAR; PG8_WAIT_L(0); PG8_MMA(0, 1, At, B1); PG8_BAR;
            PG8_LDA(At, 0, 1); PG8_STAGE(PG8_SA(0, 0), a2, voffA);
            PG8_BAR; PG8_WAIT_L(0); PG8_MMA(1, 0, At, B0); PG8_BAR; PG8_SCHED;
            PG8_STAGE(PG8_SB(0, 1), b2 + hstep, voffB);
            PG8_WAIT_V(6); PG8_BAR; PG8_MMA(1, 1, At, B1); PG8_BAR;
            PG8_LDB(B0, 1, 0); PG8_SCHED; PG8_LDA(At, 1, 0); PG8_STAGE(PG8_SA(0, 1), a2 + hstep, voffA);
            PG8_WAIT_L(8); PG8_BAR; PG8_WAIT_L(0); PG8_MMA(0, 0, At, B0); PG8_BAR; PG8_SCHED;
            PG8_LDB(B1, 1, 1); PG8_STAGE(PG8_SB(1, 0), b3, voffB);
            PG8_BAR; PG8_WAIT_L(0); PG8_MMA(0, 1, At, B1); PG8_BAR;
            PG8_LDA(At, 1, 1); PG8_STAGE(PG8_SA(1, 0), a3, voffA);
            PG8_BAR; PG8_WAIT_L(0); PG8_MMA(1, 0, At, B0); PG8_BAR; PG8_SCHED;
            PG8_STAGE(PG8_SB(1, 1), b3 + hstep, voffB);
            PG8_WAIT_V(6); PG8_BAR; PG8_MMA(1, 1, At, B1); PG8_BAR;
            }
        }
        if constexpr (ALIGN_EPI) { if (wr == 0) PG8_BAR; }
        if constexpr (!Epi::AFTER_DRAIN) { int t2 = threadIdx.x; asm volatile("" : "+v"(t2)); E(acc, cur, wr, wc, t2 & 15, (t2 >> 4) & 3); S.done(cur); }
        if (!has_next) break;
#pragma unroll
        for (int a = 0; a < 2; ++a)
#pragma unroll
            for (int b = 0; b < 2; ++b)
#pragma unroll
                for (int m = 0; m < 4; ++m)
#pragma unroll
                    for (int n = 0; n < 2; ++n) acc[a][b][m][n] = (f32x4){0.f, 0.f, 0.f, 0.f};
        cur = nxt; cA = nA; cB = nB; ++ui;
        if constexpr (ALIGN_EPI) { if (wr == 1) PG8_BAR; }
    }
    PG8_WAIT_V(0);
    if constexpr (!ALIGN_EPI) { if (wr == 0) PG8_BAR; }
    PG8_BAR;
    if constexpr (Epi::AFTER_DRAIN) { E.fused(acc, cur, wr, wc, fr, fq, lds, wid, lane); S.done(cur); }
#undef PG8_SA
#undef PG8_SB
#undef PG8_STAGE
#undef PG8_LDA
#undef PG8_LDB
#undef PG8_MMA
#undef PG8_WAIT_V
#undef PG8_WAIT_L
#undef PG8_BAR
#undef PG8_SCHED
}
}
#define GAS __attribute__((address_space(1)))
#define LAS __attribute__((address_space(3)))
typedef unsigned short bf16;
typedef unsigned v4u __attribute__((ext_vector_type(4)));
typedef float f32x4 __attribute__((ext_vector_type(4)));
typedef short bf16x8 __attribute__((ext_vector_type(8)));
typedef GAS unsigned gu32;
typedef GAS unsigned long long gu64;
#define RLX_AGENT __ATOMIC_RELAXED, __HIP_MEMORY_SCOPE_AGENT
#define LDS_WAIT() asm volatile("s_waitcnt lgkmcnt(0)" ::: "memory")
#define VM_WAIT() asm volatile("s_waitcnt vmcnt(0)" ::: "memory")
__device__ __forceinline__ unsigned long long rt() { return __builtin_amdgcn_s_memrealtime(); }
__device__ __forceinline__ unsigned f2bf(float f) { unsigned u = __builtin_bit_cast(unsigned, f); return (u + 0x7fffu + ((u >> 16) & 1u)) >> 16; }
__device__ __forceinline__ unsigned pk2(float lo, float hi) { return f2bf(lo) | (f2bf(hi) << 16); }
#define XB_TMO      128
#define XB_XCNT(j)  (256  + 64 * (j))
#define XB_XSUB(j)  (1280 + 64 * (j))
#define XB_XGEN(j)  (2304 + 64 * (j))
#define XB_TOP      3328
#define XB_TOPGEN   3392
#define XCD_BAR_WORDS 3456
#define XB_SPIN_CAP (1u << 18)

__device__ __forceinline__ unsigned xb_ld(unsigned* p)              { return __hip_atomic_load(p, __ATOMIC_RELAXED, __HIP_MEMORY_SCOPE_AGENT); }
__device__ __forceinline__ unsigned xb_add(unsigned* p, unsigned v) { return __hip_atomic_fetch_add(p, v, __ATOMIC_RELAXED, __HIP_MEMORY_SCOPE_AGENT); }
__device__ __forceinline__ unsigned xb_xcc_id() { return (unsigned)__builtin_amdgcn_s_getreg((3 << 11) | 20) & 0xFu; }
#define XB_SPIN(cond, bar) do { unsigned _sp = 0; while (cond) { __builtin_amdgcn_s_sleep(1); \
    if ((++_sp & 255u) == 0u) { if (xb_ld(&(bar)[XB_TMO])) break; if (_sp > XB_SPIN_CAP) { atomicAdd(&(bar)[XB_TMO], 1u); break; } } } } while (0)

struct XcdBarrier {
    unsigned* bar; unsigned x;
    volatile LAS unsigned* st;
};

__device__ __forceinline__ XcdBarrier xcd_barrier_post(unsigned* bar, volatile LAS unsigned* st) {
    XcdBarrier b; b.bar = bar; b.x = xb_xcc_id(); b.st = st;
    if (threadIdx.x == 0) (void)xb_add(&bar[XB_XCNT(b.x)], 1u);
    return b;
}
__device__ __forceinline__ void xcd_barrier_complete(unsigned* bar, unsigned x, unsigned& nloc, unsigned& nx) {
    const unsigned G = gridDim.x * gridDim.y * gridDim.z;
    unsigned sum, cnt, mine, sp = 0u;
    for (;;) {
        sum = 0u; cnt = 0u; mine = 0u;
#pragma unroll
        for (unsigned j = 0; j < 16; ++j) { const unsigned c = xb_ld(&bar[XB_XCNT(j)]); sum += c; cnt += (c > 0u) ? 1u : 0u; mine = (j == x) ? c : mine; }
        if (sum == G) break;
        __builtin_amdgcn_s_sleep(1);
        if ((++sp & 255u) == 0u) { if (xb_ld(&bar[XB_TMO])) break; if (sp > XB_SPIN_CAP) { atomicAdd(&bar[XB_TMO], 1u); break; } }
    }
    nloc = mine > 0u ? mine : 1u; nx = cnt > 0u ? cnt : 1u;
}

__device__ __forceinline__ void xcd_barrier(const XcdBarrier& b) {
    asm volatile("s_waitcnt vmcnt(0)" ::: "memory");
    __syncthreads();
    if (threadIdx.x == 0) {
        unsigned* bar = b.bar;
        __builtin_amdgcn_s_waitcnt(0);
        unsigned nloc = b.st[0], nx = b.st[1];
        if (nloc == 0u) { xcd_barrier_complete(bar, b.x, nloc, nx); b.st[0] = nloc; b.st[1] = nx; }
        const unsigned old = xb_add(&bar[XB_XSUB(b.x)], 1u);
        const unsigned gen = old / nloc;
        if (old + 1u == (gen + 1u) * nloc) {
            __builtin_amdgcn_fence(__ATOMIC_RELEASE, "agent");
            asm volatile("s_waitcnt vmcnt(0)" ::: "memory");
            const unsigned og = xb_add(&bar[XB_TOP], 1u);
            const unsigned tg = og / nx;
            if (og + 1u == (tg + 1u) * nx) xb_add(&bar[XB_TOPGEN], 1u);
            else XB_SPIN(xb_ld(&bar[XB_TOPGEN]) == tg, bar);
            __builtin_amdgcn_fence(__ATOMIC_ACQUIRE, "agent");
            asm volatile("s_waitcnt vmcnt(0)" ::: "memory");
        } else {
            __builtin_amdgcn_fence(__ATOMIC_ACQUIRE, "agent");
            XB_SPIN(xb_ld(&bar[XB_TOPGEN]) == gen, bar);
            asm volatile("s_waitcnt vmcnt(0)" ::: "memory");
        }
    }
    __syncthreads();
}
constexpr int NWAVES = 8;
#ifndef MK_N_LAUNCHES
#define MK_N_LAUNCHES 1
#endif
constexpr int N_PHASES = 10;
constexpr int N_LAUNCHES = MK_N_LAUNCHES;

constexpr int DM = 2048, NBATCH = 8, SEQ = 2048, MP = NBATCH * SEQ, SBATCH = 8, SLEN = 16, MS = SBATCH * SLEN, MT = MP + MS;
constexpr int NH = 4, DV = 256, DQK = 128, QKW = 1024, NG = 64, GCH = 16, PST = 64, DFF = 5632, NIN = 4104;
constexpr int CH = 64, NCH = SEQ / CH;
constexpr int NSC = NBATCH * NCH + SBATCH;
constexpr float EPS = 1e-6f;
constexpr int DVS = 64, NSL = DV / DVS;

constexpr size_t O_Y = 0, O_CONVP = (size_t)MT * DM, O_CP = O_CONVP + 8 * 3 * 1024, O_NP = O_CP + 8 * 4 * 256 * 128, O_MP = O_NP + 8 * 4 * 128,
                 O_SRP = O_MP + 32, O_SIP = O_SRP + 8 * 64 * 64, O_CONVS = O_SIP + 8 * 64 * 64, O_CS = O_CONVS + 8 * 3 * 1024, O_NS = O_CS + 8 * 4 * 256 * 128,
                 O_MS = O_NS + 8 * 4 * 128, O_SRS = O_MS + 32, O_SIS = O_SRS + 8 * 64 * 64, O_END = O_SIS + 8 * 64 * 64;
static_assert(O_END == 36102208, "d_out map");

constexpr size_t MiB = 1u << 20;
constexpr size_t WS_CTL = 0, CTL_ZERO_BYTES = 1 * MiB;
constexpr size_t WS_WIN = 2 * MiB, WS_WGLU = 18 * MiB, WS_WOUT = 20 * MiB, WS_WGU = 28 * MiB, WS_WD = 72 * MiB;
constexpr size_t WS_XN = 96 * MiB;
constexpr size_t WS_R0 = 162 * MiB, WS_RSTRIDE = 33 * MiB;
constexpr size_t WS_QKRAW = WS_R0, WS_V = WS_R0 + WS_RSTRIDE, WS_OG = WS_R0 + 2 * WS_RSTRIDE, WS_U = WS_R0 + 3 * WS_RSTRIDE;
constexpr size_t WS_Q = 294 * MiB, WS_K = 311 * MiB;
constexpr size_t WS_Z = WS_QKRAW;
constexpr size_t WS_MIXIN = WS_Q;
constexpr size_t WS_MIX = WS_R0;
constexpr size_t WS_ACT8 = WS_R0;
constexpr size_t WS_ACTS = WS_R0 + 90 * MiB;
constexpr size_t WS_X1B = WS_XN;
constexpr size_t WS_FF = 427 * MiB;
constexpr size_t WS_GATES = 378 * MiB, WS_HSS = 379 * MiB, WS_SS1 = 382 * MiB, WS_SS2 = 385 * MiB, WS_S5P = 388 * MiB, WS_SSS = 389 * MiB;
constexpr size_t WS_HS = 390 * MiB;
constexpr size_t WS_SCAL = 423 * MiB, WS_WD8 = 492 * MiB, WS_END = 504 * MiB;
static_assert(WS_XN + (size_t)MT * DM * 2 <= WS_R0 && WS_QKRAW + (size_t)MT * 1024 * 2 <= WS_V && WS_U + (size_t)MT * 1024 * 2 <= WS_Q && WS_Q + (size_t)MT * 512 * 2 <= WS_K &&
              WS_K + (size_t)MT * 512 * 2 <= WS_GATES && WS_MIXIN + (size_t)MT * DM * 2 <= WS_GATES && WS_MIX + (size_t)MT * DM * 2 <= WS_OG && WS_ACT8 + (size_t)MP * DFF <= WS_ACTS && WS_ACTS + (size_t)MS * DFF * 2 <= WS_GATES && WS_FF + (size_t)MT * DM * 2 <= WS_WD8 && WS_WD8 + (size_t)DM * DFF <= WS_END &&
              WS_WD + (size_t)DM * DFF * 2 <= WS_XN && WS_WGU + (size_t)2 * DFF * DM * 2 <= WS_WD && WS_HSS + (size_t)MT * 32 * 4 <= WS_SS1 && WS_SS1 + (size_t)MT * 32 * 4 <= WS_SS2 &&
              WS_SS2 + (size_t)MT * 32 * 4 <= WS_S5P && WS_GATES + (size_t)MT * 8 * 4 <= WS_HSS && WS_HS + (size_t)MT * 1024 * 2 <= WS_SCAL && WS_SCAL + (size_t)NSC * 4 * 384 * 4 <= WS_FF && WS_FF + (size_t)MT * DM * 2 <= WS_END, "d_ws map");
constexpr size_t S5P_LAM = 0, S5P_BBT = 64 * 1024, S5P_CC = S5P_BBT + 64 * 128 * 16 * 2;
constexpr size_t SSS_1 = 0, SSS_2 = 128 * 128 * 4, SSS_RSTD2 = 256 * 1024, SSS_RSTD1 = 384 * 1024;
constexpr int CW_TMO = 0, CW_CODE = 1, CW_BAR = 4096;
constexpr int CW_KS = 49152, CW_KS1 = CW_KS, CW_KS4 = CW_KS + 256, CW_KS5 = CW_KS4 + 64, CW_KS7 = CW_KS5 + 128, CW_KS8 = CW_KS7 + 352, CW_END = CW_KS8 + 128;
constexpr size_t WS_PARTA = 427 * MiB, WS_PARTB = 294 * MiB;
static_assert((size_t)8 * 2 * MS * DFF * 4 <= 65 * MiB && (size_t)8 * MS * 2048 * 4 <= 64 * MiB, "partial-sum arrays");

constexpr int RING_OFF = 0, RING_BYTES = 131072;
constexpr int LDSCTL_OFF = 151552, MISC_OFF = LDSCTL_OFF + 320;
constexpr int LDS_BYTES = 155648;
typedef short s16x4 __attribute__((ext_vector_type(4)));
typedef unsigned u32x2 __attribute__((ext_vector_type(2)));
struct Frame {
    LAS unsigned char* lds;
    volatile LAS unsigned* MISC;
    gu32* ctl;
    int tid, lane, wave;
    int vcu, G;
    const float* const* in;
    float* out; unsigned char* ws;
};
__device__ __forceinline__ float wave_sum(float v) {
#pragma unroll
    for (int o = 1; o < 64; o <<= 1) v += __shfl_xor(v, o);
    return v;
}
__device__ __forceinline__ unsigned cvtpk(float lo, float hi) { unsigned r; asm volatile("v_cvt_pk_bf16_f32 %0, %1, %2" : "=v"(r) : "v"(lo), "v"(hi)); return r; }
typedef __bf16 bf16x2n_t __attribute__((ext_vector_type(2)));
__device__ __forceinline__ unsigned cvtpk_n(float lo, float hi) { const bf16x2n_t v = {(__bf16)lo, (__bf16)hi}; return __builtin_bit_cast(unsigned, v); }
__device__ __forceinline__ float bflo(unsigned w) { return __uint_as_float(w << 16); }
__device__ __forceinline__ float bfhi(unsigned w) { return __uint_as_float(w & 0xffff0000u); }
__device__ __forceinline__ float bf2f(bf16 h) { return __uint_as_float((unsigned)h << 16); }
__device__ __forceinline__ float sigmoidf_(float v) { return __builtin_amdgcn_rcpf(1.0f + __expf(-v)); }
__device__ __forceinline__ f32x4 mfma16(bf16x8 a, bf16x8 b, f32x4 c) { return __builtin_amdgcn_mfma_f32_16x16x32_bf16(a, b, c, 0, 0, 0); }
#define WAVE_SYNC() do { asm volatile("s_waitcnt lgkmcnt(0)" ::: "memory"); __builtin_amdgcn_wave_barrier(); } while (0)
#define LBAR() do { asm volatile("s_waitcnt lgkmcnt(0)" ::: "memory"); __builtin_amdgcn_s_barrier(); asm volatile("" ::: "memory"); } while (0)

#ifdef MK_STAMP
#ifndef MK_STAMP_SCALE
#define MK_STAMP_SCALE 0.002f
#endif
#define DBG_DECL unsigned long long dbg_acc_ = 0, dbg_t0_ = 0;
__device__ __forceinline__ unsigned long long dbg_rt() { unsigned long long t; __builtin_amdgcn_sched_barrier(0);
#ifdef MK_STAMP_CYC
    asm volatile("s_memtime %0\n\ts_waitcnt lgkmcnt(0)" : "=s"(t) :: "memory");
#else
    asm volatile("s_memrealtime %0\n\ts_waitcnt lgkmcnt(0)" : "=s"(t) :: "memory");
#endif
 __builtin_amdgcn_sched_barrier(0); return t; }
#define DBG_BEGIN(id) do { if ((id) == MK_STAMP) dbg_t0_ = dbg_rt(); } while (0)
#define DBG_END(id) do { if ((id) == MK_STAMP) dbg_acc_ += dbg_rt() - dbg_t0_; } while (0)
#define DBG_REPORT(cond) do { if ((cond) && (threadIdx.x & 63) == 0 && (threadIdx.x >> 6) == MK_STAMP_WAVE) ((unsigned*)(A.ws + WS_CTL))[16] = (unsigned)dbg_acc_; } while (0)
#define DBG_PERTURB(V, m_) do { if ((m_) == 0 && lane == 0) V[0][0] += (float)__hip_atomic_load((unsigned*)(A.ws + WS_CTL) + 16, __ATOMIC_RELAXED, __HIP_MEMORY_SCOPE_AGENT) * MK_STAMP_SCALE; } while (0)
#else
#define DBG_DECL
#define DBG_BEGIN(id)
#define DBG_END(id)
#define DBG_REPORT(cond)
#define DBG_PERTURB(V, m_)
#endif
struct Args { const float* in[32]; float* out; unsigned char* ws; int ph_lo, ph_hi, li, pad; };
__device__ __forceinline__ int fresh_tid() { int t = threadIdx.x; asm volatile("" : "+v"(t)); return t; }
#define PHASE_IDS const int tid = fresh_tid(), lane = tid & 63; (void)tid; (void)lane;

__device__ __forceinline__ void p0_transpose_item(const float* W, int ldw, int src_col0, int k0, bf16* WT, int K, int out_row0, LAS float* scr, int lane, const float* kscale = nullptr) {
    if (kscale) {
#pragma unroll 8
        for (int i = 0; i < 32; ++i) { const int kk = 2 * i + (lane >> 5); scr[kk * 33 + (lane & 31)] = __builtin_nontemporal_load(W + (size_t)(k0 + kk) * ldw + src_col0 + (lane & 31)) * kscale[k0 + kk]; }
    } else {
#pragma unroll 8
    for (int i = 0; i < 32; ++i) { const int kk = 2 * i + (lane >> 5); scr[kk * 33 + (lane & 31)] = __builtin_nontemporal_load(W + (size_t)(k0 + kk) * ldw + src_col0 + (lane & 31)); }
    }
    LDS_WAIT(); asm volatile("" ::: "memory");
    const int c = lane & 7;
#pragma unroll
    for (int j = 0; j < 4; ++j) { const int n = (lane >> 3) + 8 * j; const LAS float* s = scr + (8 * c) * 33 + n;
        v4u o; o.x = pk2(s[0 * 33], s[1 * 33]); o.y = pk2(s[2 * 33], s[3 * 33]); o.z = pk2(s[4 * 33], s[5 * 33]); o.w = pk2(s[6 * 33], s[7 * 33]);
        *(GAS v4u*)(WT + (size_t)(out_row0 + n) * K + k0 + 8 * c) = o; }
    LDS_WAIT(); asm volatile("" ::: "memory");
}
__device__ __forceinline__ float log_sigmoid(float x) { return fminf(x, 0.f) - log1pf(__expf(-fabsf(x))); }

struct CvtItem { const float* W; int ldw, sc, k0; bf16* WT; int K, orow; const float* ks; unsigned char* W8; };
constexpr int CV_I_IN = (DM / 64) * (4096 / 32), CV_I_GLU = (1024 / 64) * (1024 / 32), CV_I_OUT = (DM / 64) * (DM / 32), CV_I_GU = (DM / 64) * (2 * DFF / 32), CV_I_D = (DFF / 64) * (DM / 32);
__device__ __forceinline__ CvtItem cvt_item(const Args& A, int it) {
    unsigned char* ws = A.ws; int r = it; CvtItem c;
    if (r < CV_I_IN) { const int nnb = 4096 / 32, kb = r / nnb, nb = r % nnb, orow = 32 * nb; c = CvtItem{A.in[9], NIN, orow < 3072 ? orow : orow + 8, 64 * kb, (bf16*)(ws + WS_WIN), DM, orow, nullptr, nullptr}; return c; } r -= CV_I_IN;
    if (r < CV_I_GLU) { const int nnb = 1024 / 32, kb = r / nnb, nb = r % nnb; c = CvtItem{A.in[23], 1024, 32 * nb, 64 * kb, (bf16*)(ws + WS_WGLU), 1024, 32 * nb, nullptr, nullptr}; return c; } r -= CV_I_GLU;
    if (r < CV_I_OUT) { const int nnb = DM / 32, kb = r / nnb, nb = r % nnb; c = CvtItem{A.in[25], DM, 32 * nb, 64 * kb, (bf16*)(ws + WS_WOUT), DM, 32 * nb, nullptr, nullptr}; return c; } r -= CV_I_OUT;
    if (r < CV_I_GU) { const int nnb = 2 * DFF / 32, kb = r / nnb, nb = r % nnb, orow = 32 * nb, pn = orow >> 8, cc = orow & 255;
        c = CvtItem{cc < 128 ? A.in[28] : A.in[29], DFF, 128 * pn + (cc & 127), 64 * kb, (bf16*)(ws + WS_WGU), DM, orow, A.in[27], nullptr}; return c; } r -= CV_I_GU;
    { const int nnb = DM / 32, kb = r / nnb, nb = r % nnb; c = CvtItem{A.in[30], DM, 32 * nb, 64 * kb, (bf16*)(ws + WS_WD), DFF, 32 * nb, nullptr, ws + WS_WD8}; return c; }
}
__device__ __forceinline__ void p0_prologue(const Args& A, LAS unsigned char* lds, int tid, int lane, int wave, int vcu, int G) {
    unsigned char* ws = A.ws;
    LAS float* WG = (LAS float*)lds;
    LAS float* scr = (LAS float*)(lds + wave * 8448);
    const int gw = vcu * NWAVES + wave, NGW = G * NWAVES;
    { constexpr int NIT = CV_I_IN + CV_I_GLU + CV_I_OUT + CV_I_GU + CV_I_D;
      float ra[32], rb[32]; CvtItem ia, ib;
#define CV_LOAD(R, I, it_) do { I = cvt_item(A, (it_)); \
        _Pragma("unroll") for (int i = 0; i < 32; ++i) { const int kk = 2 * i + (lane >> 5); R[i] = __builtin_nontemporal_load(I.W + (size_t)(I.k0 + kk) * I.ldw + I.sc + (lane & 31)); } } while (0)
#define F8C(v_) __builtin_amdgcn_fmed3f((v_) * 1024.0f, -448.f, 448.f)
#define CV_PROC(R, I) do { \
        if (I.ks) { _Pragma("unroll") for (int i = 0; i < 32; ++i) { const int kk = 2 * i + (lane >> 5); scr[kk * 33 + (lane & 31)] = R[i] * I.ks[I.k0 + kk]; } } \
        else { _Pragma("unroll") for (int i = 0; i < 32; ++i) { const int kk = 2 * i + (lane >> 5); scr[kk * 33 + (lane & 31)] = R[i]; } } \
        LDS_WAIT(); asm volatile("" ::: "memory"); \
        { const int c = lane & 7; \
          _Pragma("unroll") for (int j = 0; j < 4; ++j) { const int n = (lane >> 3) + 8 * j; const LAS float* s = scr + (8 * c) * 33 + n; \
              v4u o; o.x = pk2(s[0 * 33], s[1 * 33]); o.y = pk2(s[2 * 33], s[3 * 33]); o.z = pk2(s[4 * 33], s[5 * 33]); o.w = pk2(s[6 * 33], s[7 * 33]); \
              *(GAS v4u*)(I.WT + (size_t)(I.orow + n) * I.K + I.k0 + 8 * c) = o; \
              if (I.W8) { int w0 = 0, w1 = 0; \
                  w0 = __builtin_amdgcn_cvt_pk_fp8_f32(F8C(s[0 * 33]), F8C(s[1 * 33]), w0, false); w0 = __builtin_amdgcn_cvt_pk_fp8_f32(F8C(s[2 * 33]), F8C(s[3 * 33]), w0, true); \
                  w1 = __builtin_amdgcn_cvt_pk_fp8_f32(F8C(s[4 * 33]), F8C(s[5 * 33]), w1, false); w1 = __builtin_amdgcn_cvt_pk_fp8_f32(F8C(s[6 * 33]), F8C(s[7 * 33]), w1, true); \
                  *(GAS u32x2*)(I.W8 + (size_t)(I.orow + n) * I.K + I.k0 + 8 * c) = (u32x2){(unsigned)w0, (unsigned)w1}; } } } \
        LDS_WAIT(); asm volatile("" ::: "memory"); } while (0)
      int it = gw;
      if (it < NIT) { CV_LOAD(ra, ia, it);
          for (;;) { const int it2 = it + NGW; if (it2 < NIT) CV_LOAD(rb, ib, it2); CV_PROC(ra, ia); if (it2 >= NIT) break;
                     it = it2 + NGW; if (it < NIT) CV_LOAD(ra, ia, it); CV_PROC(rb, ib); if (it >= NIT) break; } }
#undef CV_LOAD
#undef CV_PROC
#undef F8C
    }
    { const int gt = vcu * (NWAVES * 64) + tid;
      if (gt < NG * PST) {
        const int g = gt >> 6, p = gt & 63;
        const double lr = (double)A.in[15][gt], li = (double)A.in[16][gt], dt = exp((double)A.in[17][g]);
        const double mag = exp(lr * dt), ang = li * dt, lbr = mag * cos(ang), lbi = mag * sin(ang);
        const double den = lr * lr + li * li, nr = lbr - 1.0, fre = (nr * lr + lbi * li) / den, fim = (lbi * lr - nr * li) / den;
        float* LAM = (float*)(ws + WS_S5P + S5P_LAM); LAM[gt * 2] = (float)lbr; LAM[gt * 2 + 1] = (float)lbi;
        bf16* BBT = (bf16*)(ws + WS_S5P + S5P_BBT); bf16* CC = (bf16*)(ws + WS_S5P + S5P_CC);
        const float* bre = A.in[18] + (size_t)gt * 16; const float* bim = A.in[19] + (size_t)gt * 16;
#pragma unroll
        for (int i = 0; i < 16; ++i) { const double br = bre[i], bi = bim[i];
            BBT[((size_t)g * 128 + 2 * p) * 16 + i] = (bf16)f2bf((float)(fre * br - fim * bi));
            BBT[((size_t)g * 128 + 2 * p + 1) * 16 + i] = (bf16)f2bf((float)(fre * bi + fim * br));
            CC[((size_t)g * 16 + i) * 128 + 2 * p] = (bf16)f2bf(A.in[20][((size_t)g * 16 + i) * 64 + p]);
            CC[((size_t)g * 16 + i) * 128 + 2 * p + 1] = (bf16)f2bf(-A.in[21][((size_t)g * 16 + i) * 64 + p]); }
      } }
    __syncthreads();
    { const float* win = A.in[9];
      for (int e = tid; e < 8 * 2048; e += NWAVES * 64) { const int k = e >> 3, c = e & 7; WG[c * 2048 + k] = win[(size_t)k * NIN + 3072 + c]; } }
    __syncthreads();
    { const GAS f32x4* gp = (const GAS f32x4*)A.in[8] + lane; f32x4 gv[8];
#pragma unroll
      for (int j = 0; j < 8; ++j) gv[j] = gp[64 * j];
      bf16* XN = (bf16*)(ws + WS_XN); float* GATES = (float*)(ws + WS_GATES);
      f32x4 va[8], vb[8];
#define P0R_LOAD(V, m_) do { const int mm_ = (m_); const float* xrow = mm_ < MP ? A.in[0] + (size_t)mm_ * DM : A.in[1] + (size_t)(mm_ - MP) * DM; const GAS f32x4* xr = (const GAS f32x4*)xrow + lane; \
        _Pragma("unroll") for (int j = 0; j < 8; ++j) V[j] = __builtin_nontemporal_load(xr + 64 * j); } while (0)
#define P0R_PROC(V, m_) do { const int mm_ = (m_); float s = 0.f; \
        _Pragma("unroll") for (int j = 0; j < 8; ++j) s += (V[j].x * V[j].x + V[j].y * V[j].y) + (V[j].z * V[j].z + V[j].w * V[j].w); \
        const float ms = wave_sum(s) * (1.0f / DM) + EPS, rstd = 1.0f / sqrtf(ms); \
        if (lane == 0) ((float*)(ws + WS_SSS + SSS_RSTD1))[mm_] = sqrtf(ms); \
        GAS u32x2* o8 = (GAS u32x2*)(XN + (size_t)mm_ * DM) + lane; \
        float ga[8] = {0.f, 0.f, 0.f, 0.f, 0.f, 0.f, 0.f, 0.f}; \
        _Pragma("unroll") for (int j = 0; j < 8; ++j) { V[j] = V[j] * rstd * gv[j]; u32x2 o; o.x = cvtpk(V[j].x, V[j].y); o.y = cvtpk(V[j].z, V[j].w); o8[64 * j] = o; \
            _Pragma("unroll") for (int c = 0; c < 8; ++c) { const f32x4 w = *(const LAS f32x4*)(WG + c * 2048 + 256 * j + 4 * lane); ga[c] += (V[j].x * w.x + V[j].y * w.y) + (V[j].z * w.z + V[j].w * w.w); } } \
        _Pragma("unroll") for (int c = 0; c < 8; ++c) ga[c] = wave_sum(ga[c]); \
        if (lane < 8) { float val = 0.f; \
            _Pragma("unroll") for (int c = 0; c < 8; ++c) if (lane == c) val = ga[c]; \
            if (lane < 4) val += A.in[12][lane]; else val = log_sigmoid(val + A.in[13][lane - 4]); \
            GATES[(size_t)mm_ * 8 + lane] = val; } } while (0)
      int m = gw;
      if (m < MT) { P0R_LOAD(va, m);
          for (;;) { const int m2 = m + NGW; if (m2 < MT) P0R_LOAD(vb, m2); P0R_PROC(va, m); if (m2 >= MT) break;
                     m = m2 + NGW; if (m < MT) P0R_LOAD(va, m); P0R_PROC(vb, m2); if (m >= MT) break; } }
#undef P0R_LOAD
#undef P0R_PROC
    }
}

template <int NACC, int K, int RBN = 8, class RowMap, class Epi>
__device__ __forceinline__ void skinny_gemm(const bf16* Arows, const bf16* Bt, LAS unsigned char* lds, int nitems, int first, int stride, int tid, int wave, int lane, RowMap rm, Epi epi) {
    const int fr = lane & 15, fq = lane >> 4;
    constexpr int KW = K / 8, NS = KW / 32, NSPLIT = 8 / RBN;
    static_assert(KW % 32 == 0, "skinny_gemm: K must be a multiple of 256");
    const bf16* abase = Arows + (size_t)fr * K + wave * KW + 16 * fq;
    LAS f32x4* red = (LAS f32x4*)lds;
    for (int piece = first; piece < nitems * NSPLIT; piece += stride) {
        const int it = piece / NSPLIT, rh = piece % NSPLIT;
        const bf16* brow[NACC]; f32x4 acc[NACC][RBN];
#pragma unroll
        for (int a = 0; a < NACC; ++a) { brow[a] = Bt + (size_t)rm(it, a, fr) * K + wave * KW + 16 * fq;
#pragma unroll
            for (int rb = 0; rb < RBN; ++rb) acc[a][rb] = (f32x4){0.f, 0.f, 0.f, 0.f}; }
        const bf16* ab = abase + (size_t)(16 * RBN * rh) * K;
        { constexpr int UN = 2, NSET = NS / UN, FR = UN * (RBN + NACC), R0 = 48 / FR, R = R0 < 2 ? 2 : (R0 > NSET ? NSET : R0);
          static_assert(NS % UN == 0 && NSET >= 2, "skinny_gemm: an even number (>= 4) of 32-deep steps per wave");
          bf16x8 av[R][UN][RBN], bv[R][UN][NACC];
#define SK_LOAD(q_) do { _Pragma("unroll") for (int a = 0; a < NACC; ++a) _Pragma("unroll") for (int u = 0; u < UN; ++u) bv[(q_) % R][u][a] = *(const bf16x8*)(brow[a] + 64 * (q_) + 8 * u); \
              _Pragma("unroll") for (int rb = 0; rb < RBN; ++rb) _Pragma("unroll") for (int u = 0; u < UN; ++u) av[(q_) % R][u][rb] = *(const bf16x8*)(ab + (size_t)(16 * rb) * K + 64 * (q_) + 8 * u); } while (0)
#pragma unroll
          for (int q = 0; q < R - 1; ++q) SK_LOAD(q);
          __builtin_amdgcn_sched_barrier(0);
#pragma unroll
          for (int q = 0; q < NSET; ++q) {
              if (q + R - 1 < NSET) SK_LOAD(q + R - 1);
              __builtin_amdgcn_sched_barrier(0);
#pragma unroll
              for (int u = 0; u < UN; ++u)
#pragma unroll
                  for (int rb = 0; rb < RBN; ++rb)
#pragma unroll
                      for (int a = 0; a < NACC; ++a) acc[a][rb] = mfma16(bv[q % R][u][a], av[q % R][u][rb], acc[a][rb]);
              __builtin_amdgcn_sched_barrier(0);
          }
#undef SK_LOAD
        }
#pragma unroll
        for (int a = 0; a < NACC; ++a)
#pragma unroll
            for (int rb = 0; rb < RBN; ++rb) red[((a * 8 + wave) * RBN + rb) * 64 + lane] = acc[a][rb];
        __syncthreads();
        if (wave < RBN) {
            f32x4 fin[NACC];
#pragma unroll
            for (int a = 0; a < NACC; ++a) { f32x4 t = red[((a * 8 + 0) * RBN + wave) * 64 + lane];
#pragma unroll
                for (int w2 = 1; w2 < 8; ++w2) t += red[((a * 8 + w2) * RBN + wave) * 64 + lane];
                fin[a] = t; }
            epi(it, 16 * (RBN * rh + wave) + fr, fq, fin);
        }
        __syncthreads();
    }
}

template <int NACC, int K, int S, int NMAX  , class RowMap, class Epi>
__device__ __forceinline__ void skinny_ks(const bf16* Arows, const bf16* Bt, float* PART, int ldacc, unsigned* CNT, LAS unsigned char* lds, int ncb, int vcu, int G, int wave, int lane, RowMap rm, Epi epi) {
    constexpr int KS = K / S, NS = KS / 32, NF = NACC * NS, FPW = (NF + 7) / 8;
    static_assert(K % (32 * S) == 0, "skinny_ks: K must be a multiple of 32 S");
    const int fr = lane & 15, fq = lane >> 4;
    const int sl = vcu % S, j = vcu / S, nj = (G - sl + S - 1) / S;
    const int nmine0 = (j < ncb) ? (ncb - j + nj - 1) / nj : 0, nmine = nmine0 < NMAX ? nmine0 : NMAX;
    const size_t koff = (size_t)sl * KS + 8 * fq;
    bf16x8 af[NS];
    { const bf16* ap = Arows + (size_t)(16 * wave + fr) * K + koff;
#pragma unroll
      for (int s2 = 0; s2 < NS; ++s2) af[s2] = *(const bf16x8*)(ap + 32 * s2); }
    LAS bf16x8* fb = (LAS bf16x8*)lds;
    LAS unsigned* flag = (LAS unsigned*)(lds + 2 * NF * 1024);
    const __amdgpu_buffer_rsrc_t prs = __builtin_amdgcn_make_buffer_rsrc((void*)PART, 0, 0x7FFFFFFF, 0x00020000);
    const unsigned rowoff = (unsigned)((16 * wave + fr) * ldacc + 4 * fq) * 4u, astr = (unsigned)(MS * ldacc) * 4u;
    bf16x8 pre[NMAX][FPW];
#pragma unroll
    for (int i = 0; i < NMAX; ++i) if (i < nmine) {
#pragma unroll
        for (int i2 = 0; i2 < FPW; ++i2) { const int f = wave + 8 * i2; if (f < NF) { const int a = f / NS, s2 = f % NS;
            pre[i][i2] = *(const bf16x8*)(Bt + (size_t)rm(j + nj * i, a, fr) * K + koff + 32 * s2); } } }
    __builtin_amdgcn_sched_barrier(0);
#pragma unroll
    for (int i = 0; i < NMAX; ++i) if (i < nmine) {
        const int cb = j + nj * i, buf = i & 1;
#pragma unroll
        for (int i2 = 0; i2 < FPW; ++i2) { const int f = wave + 8 * i2; if (f < NF) fb[(buf * NF + f) * 64 + lane] = pre[i][i2]; }
        LBAR();
#pragma unroll
        for (int a = 0; a < NACC; ++a) { f32x4 acc = (f32x4){0.f, 0.f, 0.f, 0.f};
#pragma unroll
            for (int s2 = 0; s2 < NS; ++s2) acc = mfma16(fb[(buf * NF + a * NS + s2) * 64 + lane], af[s2], acc);
            __builtin_amdgcn_raw_buffer_store_b128(__builtin_bit_cast(v4u, acc), prs, (unsigned)(sl * NACC + a) * astr + rowoff + (unsigned)cb * 64u, 0, 16); }
    }
    VM_WAIT();
    __syncthreads();
    if (wave == 0) { unsigned last = 0u;
        if (lane < nmine) last = (__hip_atomic_fetch_add(CNT + j + nj * lane, 1u, __ATOMIC_RELAXED, __HIP_MEMORY_SCOPE_AGENT) == (unsigned)(S - 1)) ? 1u : 0u;
        const unsigned long long m = __ballot(last != 0u);
        if (lane == 0) { flag[0] = (unsigned)m; flag[1] = (unsigned)(m >> 32); } }
    __syncthreads();
    unsigned long long m = ((unsigned long long)flag[1] << 32) | flag[0];
    while (m) { const int i = __builtin_ctzll(m); m &= m - 1; const int cb = j + nj * i;
        f32x4 fin[NACC];
#pragma unroll
        for (int a = 0; a < NACC; ++a) { v4u p[S];
#pragma unroll
            for (int s2 = 0; s2 < S; ++s2) p[s2] = __builtin_amdgcn_raw_buffer_load_b128(prs, (unsigned)(s2 * NACC + a) * astr + rowoff + (unsigned)cb * 64u, 0, 16);
            f32x4 t = __builtin_bit_cast(f32x4, p[0]);
#pragma unroll
            for (int s2 = 1; s2 < S; ++s2) t += __builtin_bit_cast(f32x4, p[s2]);
            fin[a] = t; }
        epi(cb, 16 * wave + fr, fq, fin); }
    __syncthreads();
}

__device__ __forceinline__ void p2_scalars(const Args& A, LAS unsigned char* lds, int lane, int wave, int item) {
    unsigned char* ws = A.ws;
    const float* GATES = (const float*)(ws + WS_GATES); float* SCAL = (float*)(ws + WS_SCAL);
    const int seq = item >> 2, h = item & 3; const bool sample = seq >= NBATCH; const int b = sample ? seq - NBATCH : seq;
    const int nch = sample ? 1 : NCH, L = sample ? SLEN : CH, row0 = sample ? MP + b * SLEN : b * SEQ, sc0 = sample ? NBATCH * NCH + b : b * NCH;
    LAS float* fl = (LAS float*)lds;
    float fc[4], a[4], pm[4];
#pragma unroll
    for (int i = 0; i < 4; ++i) { const int c = 4 * wave + i; float li = -INFINITY, lf = 0.f;
        if (c < nch && lane < L) { li = GATES[((size_t)row0 + c * CH + lane) * 8 + h]; lf = GATES[((size_t)row0 + c * CH + lane) * 8 + 4 + h]; }
        float f = lf;
#pragma unroll
        for (int d = 1; d < 64; d <<= 1) { const float o = __shfl_up(f, d); if (lane >= d) f += o; }
        const float aa = li - f; float p = aa;
#pragma unroll
        for (int d = 1; d < 64; d <<= 1) { const float o = __shfl_up(p, d); if (lane >= d) p = fmaxf(p, o); }
        fc[i] = f; a[i] = aa; pm[i] = p;
        if (lane == 63) { fl[c] = f; fl[32 + c] = p; } }
    __syncthreads();
    float m0c = 0.f, m0 = sample ? A.in[5][b * NH + h] : 0.f;
    for (int c = 0; c < nch; ++c) { if (lane == c) m0c = m0; m0 = fl[c] + fmaxf(fl[32 + c], m0); }
#pragma unroll
    for (int i = 0; i < 4; ++i) { const int c = 4 * wave + i;
        if (c < nch) { const float m0i = __shfl(m0c, c); const float mm = fmaxf(pm[i], m0i), mml = __shfl(mm, 63);
            float* o = SCAL + ((size_t)(sc0 + c) * 4 + h) * 384;
            o[lane] = a[i]; o[64 + lane] = mm; o[128 + lane] = __expf(m0i - mm); o[192 + lane] = __expf(-(fc[i] + mm)); o[256 + lane] = __expf(a[i] - mml);
            o[320 + lane] = (lane == 0) ? __expf(m0i - mml) : (__shfl(fc[i], 63) + mml); } }
    if (wave == 0 && lane == 0) A.out[(sample ? O_MS : O_MP) + b * NH + h] = m0;
    __syncthreads();
}
__device__ __forceinline__ void p2_conv(const Args& A, int tid, int vcu, int G) {
    unsigned char* ws = A.ws;
    const bf16* QKRAW = (const bf16*)(ws + WS_QKRAW); bf16* Q = (bf16*)(ws + WS_Q); bf16* Kb = (bf16*)(ws + WS_K);
    const int nthreads = G * NWAVES * 64;
    for (int it = vcu * (NWAVES * 64) + tid; it < (MT / 8) * 128; it += nthreads) {
        const int rb = it >> 7, ch = it & 127, rs = 8 * rb, col = 8 * ch;
        bool first, sample = rs >= MP; int b, tl, Lseq;
        if (!sample) { b = rs / SEQ; tl = rs % SEQ; Lseq = SEQ; } else { b = (rs - MP) / SLEN; tl = (rs - MP) % SLEN; Lseq = SLEN; }
        first = (tl == 0);
        float w[4][8], bc[8];
#pragma unroll
        for (int j = 0; j < 4; ++j) { const f32x4 a0 = *(const f32x4*)(A.in[10] + j * 1024 + col), a1 = *(const f32x4*)(A.in[10] + j * 1024 + col + 4);
            w[j][0] = a0[0]; w[j][1] = a0[1]; w[j][2] = a0[2]; w[j][3] = a0[3]; w[j][4] = a1[0]; w[j][5] = a1[1]; w[j][6] = a1[2]; w[j][7] = a1[3]; }
        { const f32x4 a0 = *(const f32x4*)(A.in[11] + col), a1 = *(const f32x4*)(A.in[11] + col + 4);
          bc[0] = a0[0]; bc[1] = a0[1]; bc[2] = a0[2]; bc[3] = a0[3]; bc[4] = a1[0]; bc[5] = a1[1]; bc[6] = a1[2]; bc[7] = a1[3]; }
        v4u raw[11];
#pragma unroll
        for (int r = 0; r < 11; ++r) { if (r >= 3 || !first) raw[r] = *(const GAS v4u*)(QKRAW + (size_t)(rs + r - 3) * 1024 + col); else raw[r] = (v4u){0u, 0u, 0u, 0u}; }
        float x0[8], x1[8], x2[8];
#define UNPK(dst, v) do { dst[0] = bflo(v.x); dst[1] = bfhi(v.x); dst[2] = bflo(v.y); dst[3] = bfhi(v.y); dst[4] = bflo(v.z); dst[5] = bfhi(v.z); dst[6] = bflo(v.w); dst[7] = bfhi(v.w); } while (0)
        if (first && sample) {
            const float* sp = A.in[2] + (size_t)b * 3 * 1024 + col;
#pragma unroll
            for (int i = 0; i < 8; ++i) { x0[i] = sp[i]; x1[i] = sp[1024 + i]; x2[i] = sp[2048 + i]; }
        } else { UNPK(x0, raw[0]); UNPK(x1, raw[1]); UNPK(x2, raw[2]); }
#pragma unroll
        for (int r = 0; r < 8; ++r) {
            float x3[8]; UNPK(x3, raw[r + 3]);
            float o[8];
#pragma unroll
            for (int i = 0; i < 8; ++i) { const float val = bc[i] + w[0][i] * x0[i] + w[1][i] * x1[i] + w[2][i] * x2[i] + w[3][i] * x3[i]; o[i] = val * sigmoidf_(val); }
            const size_t row = (size_t)rs + r;
            if (ch < 64) {
#pragma unroll
                for (int i = 0; i < 8; ++i) o[i] *= 0.08838834764831845f;
                v4u pk; pk.x = cvtpk(o[0], o[1]); pk.y = cvtpk(o[2], o[3]); pk.z = cvtpk(o[4], o[5]); pk.w = cvtpk(o[6], o[7]);
                *(GAS v4u*)(Q + row * 512 + col) = pk;
            } else {
                v4u pk; pk.x = cvtpk(o[0], o[1]); pk.y = cvtpk(o[2], o[3]); pk.z = cvtpk(o[4], o[5]); pk.w = cvtpk(o[6], o[7]);
                *(GAS v4u*)(Kb + row * 512 + (col - 512)) = pk;
            }
            const int tt = tl + r;
            if (tt >= Lseq - 3) { float* cv = A.out + (sample ? O_CONVS : O_CONVP) + ((size_t)b * 3 + (tt - (Lseq - 3))) * 1024 + col;
                *(f32x4*)cv = (f32x4){x3[0], x3[1], x3[2], x3[3]}; *(f32x4*)(cv + 4) = (f32x4){x3[4], x3[5], x3[6], x3[7]}; }
#pragma unroll
            for (int i = 0; i < 8; ++i) { x0[i] = x1[i]; x1[i] = x2[i]; x2[i] = x3[i]; }
        }
#undef UNPK
    }
}
constexpr int ML_QS = 0, ML_KS = 17408, ML_VS = 34816, ML_SC = 46080, ML_SET = 47616, ML_SS = 2 * ML_SET, ML_CB = ML_SS + 9216, ML_CBSZ = 21760;
static_assert(ML_CB + 2 * ML_CBSZ <= LDSCTL_OFF, "mLSTM LDS map");
constexpr int SC_A = 0, SC_MM = 64, SC_GI = 128, SC_EN = 192, SC_WS = 256, SC_MISC = 320;
__device__ __forceinline__ bf16x8 ldsfrag(const LAS unsigned char* p) { return *(const LAS bf16x8*)p; }
typedef __attribute__((address_space(3))) s16x4 lds_s16x4;
__device__ __forceinline__ bf16x8 trfrag(const LAS unsigned char* tile, int stride, int k0, int c0, int lane) {
    const int g = lane >> 4, q = (lane & 15) >> 2, p = lane & 3;
    const LAS unsigned char* a0 = tile + (k0 + 8 * g + q) * stride + (c0 + 4 * p) * 2;
    const s16x4 lo = __builtin_amdgcn_ds_read_tr16_b64_v4i16((lds_s16x4*)a0), hi = __builtin_amdgcn_ds_read_tr16_b64_v4i16((lds_s16x4*)(a0 + 4 * stride));
    return (bf16x8){lo[0], lo[1], lo[2], lo[3], hi[0], hi[1], hi[2], hi[3]};
}

__device__ __forceinline__ void mlstm_item(const Args& A, LAS unsigned char* lds, int tid, int lane, int wave, int item) {
    DBG_DECL
    unsigned char* ws = A.ws;
    const int fr = lane & 15, fq = lane >> 4;
    const bool sample = item >= NBATCH * NH * NSL; const int ii = sample ? item - NBATCH * NH * NSL : item;
    const int b = ii / (NH * NSL), h = (ii / NSL) % NH, sl = ii % NSL;
    const int nch = sample ? 1 : NCH, L = sample ? SLEN : CH;
    const int row0 = sample ? MP + b * SLEN : b * SEQ, sc0 = sample ? NBATCH * NCH + b : b * NCH;
    const bf16* Qg = (const bf16*)(ws + WS_Q); const bf16* Kg = (const bf16*)(ws + WS_K); const bf16* Vg = (const bf16*)(ws + WS_V);
    const float* SCAL = (const float*)(ws + WS_SCAL); bf16* HS = (bf16*)(ws + WS_HS); float* HSS = (float*)(ws + WS_HSS);
    if (tid < 256) { const int r = (tid >> 1) & 63, hf = tid & 1, st = tid >> 7; *(LAS v4u*)(lds + st * ML_SET + ML_VS + r * 176 + 128 + 16 * hf) = (v4u){hf == 0 ? 0x00003F80u : 0u, 0u, 0u, 0u}; }
    f32x4 Cst[5];
    if (sample) {
        const float* c0 = A.in[3] + ((size_t)(b * NH + h) * DV + DVS * sl) * DQK; const float* n0 = A.in[4] + (size_t)(b * NH + h) * DQK;
#pragma unroll
        for (int vb = 0; vb < 4; ++vb) Cst[vb] = *(const f32x4*)(c0 + (size_t)(16 * vb + fr) * DQK + 16 * wave + 4 * fq);
        Cst[4] = (fr == 0) ? *(const f32x4*)(n0 + 16 * wave + 4 * fq) : (f32x4){0.f, 0.f, 0.f, 0.f};
    } else {
#pragma unroll
        for (int vb = 0; vb < 5; ++vb) Cst[vb] = (f32x4){0.f, 0.f, 0.f, 0.f};
    }
#pragma unroll
    for (int vb = 0; vb < 5; ++vb) { u32x2 w; w.x = cvtpk_n(Cst[vb][0], Cst[vb][1]); w.y = cvtpk_n(Cst[vb][2], Cst[vb][3]); *(LAS u32x2*)(lds + ML_CB + (16 * vb + fr) * 272 + (16 * wave + 4 * fq) * 2) = w; }
    v4u pq[2], pk[2], pv; f32x4 psc = (f32x4){0.f, 0.f, 0.f, 0.f};
#define ML_ISSUE(c_) do { \
        const size_t r0_ = (size_t)row0 + (size_t)(c_) * CH; \
        _Pragma("unroll") for (int i = 0; i < 2; ++i) { const int e = tid + 512 * i, r = e >> 4, ch = e & 15; \
            if (r < L) { pq[i] = *(const GAS v4u*)(Qg + (r0_ + r) * 512 + 128 * h + 8 * ch); pk[i] = *(const GAS v4u*)(Kg + (r0_ + r) * 512 + 128 * h + 8 * ch); } \
            else { pq[i] = (v4u){0u, 0u, 0u, 0u}; pk[i] = (v4u){0u, 0u, 0u, 0u}; } } \
        { const int r = tid >> 3, ch = tid & 7; if (r < L) pv = *(const GAS v4u*)(Vg + (r0_ + r) * 1024 + DV * h + DVS * sl + 8 * ch); else pv = (v4u){0u, 0u, 0u, 0u}; } \
        if (tid < 96) psc = *(const GAS f32x4*)(SCAL + ((size_t)(sc0 + (c_)) * 4 + h) * 384 + 4 * tid); \
    } while (0)
#define ML_COMMIT(so_) do { LAS unsigned char* wl_ = lds + (so_); \
        _Pragma("unroll") for (int i = 0; i < 2; ++i) { const int e = tid + 512 * i, r = e >> 4, ch = e & 15; \
            *(LAS v4u*)(wl_ + ML_QS + r * 272 + ch * 16) = pq[i]; *(LAS v4u*)(wl_ + ML_KS + r * 272 + ch * 16) = pk[i]; } \
        { const int r = tid >> 3, ch = tid & 7; *(LAS v4u*)(wl_ + ML_VS + r * 176 + ch * 16) = pv; } \
        if (tid < 96) *(LAS f32x4*)((LAS float*)(wl_ + ML_SC) + 4 * tid) = psc; \
    } while (0)
    ML_ISSUE(0); ML_COMMIT(0);
    LBAR();
    const int tb = wave & 3, wh = wave >> 2, t = 16 * tb + fr;
    u32x2 hsw[2] = {(u32x2){0u, 0u}, (u32x2){0u, 0u}}; float hsp = 0.f;
#define ML_FLUSH(c_) do { const size_t grow = (size_t)row0 + (size_t)(c_) * CH + t; \
        if (t < L) { *(GAS u32x2*)(HS + grow * 1024 + h * DV + DVS * sl + 16 * (2 * wh) + 4 * fq) = hsw[0]; *(GAS u32x2*)(HS + grow * 1024 + h * DV + DVS * sl + 16 * (2 * wh + 1) + 4 * fq) = hsw[1]; \
                     if (fq == 0) HSS[grow * 32 + h * 8 + sl * 2 + wh] = hsp; } } while (0)
    DBG_BEGIN(8);
    for (int c = 0; c < nch; ++c) {
        if (c + 1 < nch) ML_ISSUE(c + 1);
        if (c > 0) ML_FLUSH(c - 1);
        const LAS unsigned char* cbr = lds + ML_CB + (c & 1) * ML_CBSZ; LAS unsigned char* cbw = lds + ML_CB + ((c + 1) & 1) * ML_CBSZ;
        const LAS unsigned char* tl = lds + (c & 1) * ML_SET; const LAS float* SC = (const LAS float*)(tl + ML_SC);
        DBG_BEGIN(4);
        bf16x8 qf[4];
#pragma unroll
        for (int ks = 0; ks < 4; ++ks) qf[ks] = ldsfrag(tl + ML_QS + t * 272 + ks * 64 + fq * 16);
        { bf16x8 kf[2][4];
#pragma unroll
          for (int i = 0; i < 2; ++i)
#pragma unroll
              for (int ks = 0; ks < 4; ++ks) kf[i][ks] = ldsfrag(tl + ML_KS + (16 * (2 * wh + i) + fr) * 272 + ks * 64 + fq * 16);
          const float mmt = SC[SC_MM + t]; f32x4 a4[2];
#pragma unroll
          for (int i = 0; i < 2; ++i) a4[i] = *(const LAS f32x4*)(SC + SC_A + 16 * (2 * wh + i) + 4 * fq);
          f32x4 g[2] = {(f32x4){0.f, 0.f, 0.f, 0.f}, (f32x4){0.f, 0.f, 0.f, 0.f}};
#pragma unroll
          for (int ks = 0; ks < 4; ++ks)
#pragma unroll
              for (int i = 0; i < 2; ++i) g[i] = mfma16(kf[i][ks], qf[ks], g[i]);
#pragma unroll
          for (int i = 0; i < 2; ++i) { const int s0 = 16 * (2 * wh + i) + 4 * fq; float v[4];
#pragma unroll
              for (int r = 0; r < 4; ++r) v[r] = (s0 + r <= t) ? g[i][r] * __expf(a4[i][r] - mmt) : 0.f;
              u32x2 w; w.x = cvtpk_n(v[0], v[1]); w.y = cvtpk_n(v[2], v[3]); *(LAS u32x2*)(lds + ML_SS + t * 144 + s0 * 2) = w; } }
        DBG_END(4);
        LBAR();
        DBG_BEGIN(5);
        { bf16x8 sf[2], vf[3][2], cf[3][4];
#pragma unroll
          for (int ks = 0; ks < 2; ++ks) sf[ks] = ldsfrag(lds + ML_SS + t * 144 + ks * 64 + fq * 16);
#pragma unroll
          for (int i = 0; i < 3; ++i) { const int vb = (i == 2) ? 4 : 2 * wh + i;
#pragma unroll
              for (int ks = 0; ks < 2; ++ks) vf[i][ks] = trfrag(tl + ML_VS, 176, 32 * ks, 16 * vb, lane);
#pragma unroll
              for (int ks = 0; ks < 4; ++ks) cf[i][ks] = ldsfrag(cbr + (16 * vb + fr) * 272 + ks * 64 + fq * 16); }
          const float git = SC[SC_GI + t], ent = SC[SC_EN + t];
          f32x4 ai[3], ae[3];
#pragma unroll
          for (int i = 0; i < 3; ++i) { ai[i] = (f32x4){0.f, 0.f, 0.f, 0.f}; ae[i] = (f32x4){0.f, 0.f, 0.f, 0.f}; }
#pragma unroll
          for (int ks = 0; ks < 4; ++ks)
#pragma unroll
              for (int i = 0; i < 3; ++i) { ae[i] = mfma16(cf[i][ks], qf[ks], ae[i]); if (ks < 2) ai[i] = mfma16(vf[i][ks], sf[ks], ai[i]); }
          f32x4 hh[3];
#pragma unroll
          for (int i = 0; i < 3; ++i) hh[i] = ai[i] + ae[i] * git;
          const float den = __shfl(hh[2][0], fr);
          const float isc = 1.0f / fmaxf(fabsf(den), ent); float p = 0.f;
#pragma unroll
          for (int i = 0; i < 2; ++i) { const f32x4 o = hh[i] * isc; p += (o[0] * o[0] + o[1] * o[1]) + (o[2] * o[2] + o[3] * o[3]);
              hsw[i].x = cvtpk_n(o[0], o[1]); hsw[i].y = cvtpk_n(o[2], o[3]); }
          p += __shfl_xor(p, 16); p += __shfl_xor(p, 32); hsp = p; }
        DBG_END(5); DBG_BEGIN(6);
        { const float decay = SC[SC_MISC];
          bf16x8 kw[2], vf[5][2];
#pragma unroll
          for (int vb = 0; vb < 5; ++vb)
#pragma unroll
              for (int ks = 0; ks < 2; ++ks) vf[vb][ks] = trfrag(tl + ML_VS, 176, 32 * ks, 16 * vb, lane);
#pragma unroll
          for (int ks = 0; ks < 2; ++ks) { const v4u kr = __builtin_bit_cast(v4u, trfrag(tl + ML_KS, 272, 32 * ks, 16 * wave, lane));
              const f32x4 w0 = *(const LAS f32x4*)(SC + SC_WS + 32 * ks + 8 * fq), w1 = *(const LAS f32x4*)(SC + SC_WS + 32 * ks + 8 * fq + 4);
              v4u o; o.x = cvtpk_n(bflo(kr.x) * w0[0], bfhi(kr.x) * w0[1]); o.y = cvtpk_n(bflo(kr.y) * w0[2], bfhi(kr.y) * w0[3]); o.z = cvtpk_n(bflo(kr.z) * w1[0], bfhi(kr.z) * w1[1]); o.w = cvtpk_n(bflo(kr.w) * w1[2], bfhi(kr.w) * w1[3]);
              kw[ks] = __builtin_bit_cast(bf16x8, o); }
#pragma unroll
          for (int vb = 0; vb < 5; ++vb) Cst[vb] = Cst[vb] * decay;
#pragma unroll
          for (int ks = 0; ks < 2; ++ks)
#pragma unroll
              for (int vb = 0; vb < 5; ++vb) Cst[vb] = mfma16(kw[ks], vf[vb][ks], Cst[vb]);
#pragma unroll
          for (int vb = 0; vb < 5; ++vb) { u32x2 w; w.x = cvtpk_n(Cst[vb][0], Cst[vb][1]); w.y = cvtpk_n(Cst[vb][2], Cst[vb][3]); *(LAS u32x2*)(cbw + (16 * vb + fr) * 272 + (16 * wave + 4 * fq) * 2) = w; } }
        DBG_END(6);
        DBG_BEGIN(7);
        if (c + 1 < nch) ML_COMMIT(((c + 1) & 1) * ML_SET);
        DBG_END(7);
        LBAR();
    }
    DBG_END(8); DBG_REPORT(item == 0);
    ML_FLUSH(nch - 1);
    { float* co = A.out + (sample ? O_CS : O_CP) + ((size_t)(b * NH + h) * DV + DVS * sl) * DQK;
#pragma unroll
      for (int vb = 0; vb < 4; ++vb) *(f32x4*)(co + (size_t)(16 * vb + fr) * DQK + 16 * wave + 4 * fq) = Cst[vb];
      if (sl == 0 && fr == 0) *(f32x4*)(A.out + (sample ? O_NS : O_NP) + (size_t)(b * NH + h) * DQK + 16 * wave + 4 * fq) = Cst[4]; }
    LBAR();
#undef ML_ISSUE
#undef ML_FLUSH
#undef ML_COMMIT
}

__device__ __forceinline__ float gelu_tanh(float y) { const float t = y * y, p = fmaf(t, 0.044715f, 1.0f);
    const float e = __builtin_amdgcn_exp2f(y * p * -2.302208198f); return y * __builtin_amdgcn_rcpf(1.0f + e); }
typedef float f32x2 __attribute__((ext_vector_type(2)));
__device__ __forceinline__ void s5_item(const Args& A, LAS unsigned char* slds, int lane, int role, int item) {
    DBG_DECL
    unsigned char* ws = A.ws;
    const int fr = lane & 15, fq = lane >> 4;
    const bool sample = item >= NBATCH * NG; const int ii = sample ? item - NBATCH * NG : item;
    const int b = ii / NG, g = ii % NG;
    const int T = sample ? SLEN : SEQ, row0 = sample ? MP + b * SLEN : b * SEQ;
    const bf16* U = (const bf16*)(ws + WS_U); bf16* Z = (bf16*)(ws + WS_Z);
    const float* LAM = (const float*)(ws + WS_S5P + S5P_LAM); const bf16* BBT = (const bf16*)(ws + WS_S5P + S5P_BBT); const bf16* CC = (const bf16*)(ws + WS_S5P + S5P_CC);
    const bf16x8 zf = (bf16x8){0, 0, 0, 0, 0, 0, 0, 0}; const f32x4 z4 = (f32x4){0.f, 0.f, 0.f, 0.f};
    const int nblk = T / 16;
    const bf16* ubase = U + (size_t)(row0 + fr) * 1024 + 16 * g + 8 * (fq & 1);
#define S5_LOADU(k_) (*(const bf16x8*)(ubase + (size_t)((k_) < nblk ? (k_) : nblk - 1) * 16 * 1024))
#define S5_BU(P_) ((LAS float*)(slds + (P_) * 8448))
#define S5_SB(P_) ((LAS bf16*)(slds + 16896 + (P_) * 4352))
    if (role == 0) {
        bf16x8 bbA[8];
#pragma unroll
        for (int rb = 0; rb < 8; ++rb) bbA[rb] = (fq < 2) ? *(const bf16x8*)(BBT + ((size_t)g * 128 + 16 * rb + fr) * 16 + 8 * fq) : zf;
        const float lr = LAM[(g * 64 + lane) * 2], li = LAM[(g * 64 + lane) * 2 + 1];
        float sr, si;
        if (sample) { sr = A.in[6][(size_t)(b * NG + g) * PST + lane]; si = A.in[7][(size_t)(b * NG + g) * PST + lane]; } else { sr = 0.f; si = 0.f; }
        bf16x8 ub = S5_LOADU(0), uc = S5_LOADU(1), ud = S5_LOADU(2);
#pragma unroll
        for (int rb = 0; rb < 8; ++rb) { const f32x4 d = mfma16(bbA[rb], ub, z4); *(LAS f32x4*)(S5_BU(0) + fr * 132 + 16 * rb + 4 * fq) = d; }
        LBAR();
#define S5_ITER_A(k_, P_) do { const int k = (k_); DBG_BEGIN(1); \
            f32x4 d[8]; \
            _Pragma("unroll") for (int rb = 0; rb < 8; ++rb) d[rb] = mfma16(bbA[rb], uc, z4);                                 \
            f32x2 bu[16]; { const LAS float* bc = S5_BU(P_); \
            _Pragma("unroll") for (int tt = 0; tt < 16; ++tt) bu[tt] = *(const LAS f32x2*)(bc + tt * 132 + 2 * lane); } \
            { LAS float* bn = S5_BU(1 - (P_)); \
            _Pragma("unroll") for (int rb = 0; rb < 8; ++rb) *(LAS f32x4*)(bn + fr * 132 + 16 * rb + 4 * fq) = d[rb]; } \
            { LAS bf16* sbc = S5_SB(P_); \
            f32x2 s2 = (f32x2){sr, si}; const f32x2 lr2 = (f32x2){lr, lr}, li2 = (f32x2){-li, li}; \
            _Pragma("unroll") for (int tt = 0; tt < 16; ++tt) { const f32x2 sw = __builtin_shufflevector(s2, s2, 1, 0); s2 = lr2 * s2 + (li2 * sw + bu[tt]);     \
                *(LAS unsigned*)(sbc + tt * 136 + 2 * lane) = cvtpk_n(s2[0], s2[1]); } sr = s2[0]; si = s2[1]; }                \
            uc = ud; ud = S5_LOADU(k + 3); DBG_END(1); \
            LBAR(); } while (0)
        DBG_BEGIN(2);
        for (int k2 = 0; k2 + 1 < nblk; k2 += 2) { S5_ITER_A(k2, 0); S5_ITER_A(k2 + 1, 1); }
        if (nblk & 1) S5_ITER_A(nblk - 1, 0);
        DBG_END(2); DBG_REPORT(!sample && item == 0);
#undef S5_ITER_A
        float* so = A.out + (sample ? O_SRS : O_SRP) + (size_t)(b * NG + g) * PST; float* io = A.out + (sample ? O_SIS : O_SIP) + (size_t)(b * NG + g) * PST;
        so[lane] = sr; io[lane] = si;
    } else {
        bf16x8 ccA[4], dA;
#pragma unroll
        for (int ks = 0; ks < 4; ++ks) ccA[ks] = *(const bf16x8*)(CC + ((size_t)g * 16 + fr) * 128 + 32 * ks + 8 * fq);
        { const short dv = (short)f2bf(A.in[22][g * 16 + fr]); dA = zf;
#pragma unroll
          for (int j = 0; j < 8; ++j) dA[j] = (fq < 2 && 8 * fq + j == fr) ? dv : (short)0; }
        bf16x8 ua = S5_LOADU(0), ub = S5_LOADU(0), uc = S5_LOADU(1);
        LBAR();
#define S5_Y(km1_, P_) do { const LAS bf16* sbp = S5_SB(P_); f32x4 y = z4; \
            _Pragma("unroll") for (int ks = 0; ks < 4; ++ks) y = mfma16(ccA[ks], *(const LAS bf16x8*)(sbp + fr * 136 + 32 * ks + 8 * fq), y); \
            y = mfma16(dA, ua, y); \
            u32x2 w; w.x = cvtpk_n(gelu_tanh(y[0]), gelu_tanh(y[1])); w.y = cvtpk_n(gelu_tanh(y[2]), gelu_tanh(y[3])); \
            *(GAS u32x2*)(Z + ((size_t)row0 + 16 * (km1_) + fr) * 1024 + 16 * g + 4 * fq) = w; } while (0)
#define S5_ITER_B(k_, P_) do { const int k = (k_); DBG_BEGIN(3); if (k >= 1) S5_Y(k - 1, 1 - (P_)); ua = ub; ub = uc; uc = S5_LOADU(k + 2); DBG_END(3); LBAR(); } while (0)
        for (int k2 = 0; k2 + 1 < nblk; k2 += 2) { S5_ITER_B(k2, 0); S5_ITER_B(k2 + 1, 1); }
        if (nblk & 1) S5_ITER_B(nblk - 1, 0);
        if ((nblk - 1) & 1) S5_Y(nblk - 1, 1); else S5_Y(nblk - 1, 0);
        DBG_REPORT(!sample && item == 0);
#undef S5_ITER_B
#undef S5_Y
    }
    LBAR();
#undef S5_BU
#undef S5_SB
#undef S5_LOADU
}

__device__ __forceinline__ void outa_rows(const Args& A, int lane, int gw, int NGW) {
    unsigned char* ws = A.ws;
    const bf16* HS = (const bf16*)(ws + WS_HS); const bf16* OG = (const bf16*)(ws + WS_OG); const float* HSS = (const float*)(ws + WS_HSS); bf16* MIXIN = (bf16*)(ws + WS_MIXIN);
    f32x4 gm[2][2];
#pragma unroll
    for (int i = 0; i < 2; ++i) { gm[i][0] = *(const f32x4*)(A.in[14] + 512 * i + 8 * lane); gm[i][1] = *(const f32x4*)(A.in[14] + 512 * i + 8 * lane + 4); }
    for (int m = gw; m < MT; m += NGW) {
        f32x4 p0[2], p1[2]; v4u hv[2], ov[2];
#pragma unroll
        for (int i = 0; i < 2; ++i) { const int col = 512 * i + 8 * lane, hh = col >> 8;
            p0[i] = *(const GAS f32x4*)(HSS + (size_t)m * 32 + hh * 8); p1[i] = *(const GAS f32x4*)(HSS + (size_t)m * 32 + hh * 8 + 4);
            hv[i] = *(const GAS v4u*)(HS + (size_t)m * 1024 + col); ov[i] = *(const GAS v4u*)(OG + (size_t)m * 1024 + col); }
        v4u o[2];
#pragma unroll
        for (int i = 0; i < 2; ++i) {
            const float ss = (p0[i][0] + p0[i][1]) + (p0[i][2] + p0[i][3]) + (p1[i][0] + p1[i][1]) + (p1[i][2] + p1[i][3]);
            const float rstd = 1.0f / sqrtf(ss * (1.0f / DV) + EPS);
            o[i].x = cvtpk(bflo(hv[i].x) * rstd * gm[i][0][0] * sigmoidf_(bflo(ov[i].x)), bfhi(hv[i].x) * rstd * gm[i][0][1] * sigmoidf_(bfhi(ov[i].x)));
            o[i].y = cvtpk(bflo(hv[i].y) * rstd * gm[i][0][2] * sigmoidf_(bflo(ov[i].y)), bfhi(hv[i].y) * rstd * gm[i][0][3] * sigmoidf_(bfhi(ov[i].y)));
            o[i].z = cvtpk(bflo(hv[i].z) * rstd * gm[i][1][0] * sigmoidf_(bflo(ov[i].z)), bfhi(hv[i].z) * rstd * gm[i][1][1] * sigmoidf_(bfhi(ov[i].z)));
            o[i].w = cvtpk(bflo(hv[i].w) * rstd * gm[i][1][2] * sigmoidf_(bflo(ov[i].w)), bfhi(hv[i].w) * rstd * gm[i][1][3] * sigmoidf_(bfhi(ov[i].w))); }
#pragma unroll
        for (int i = 0; i < 2; ++i) *(GAS v4u*)(MIXIN + (size_t)m * 2048 + 512 * i + 8 * lane) = o[i];
    }
}
__device__ __forceinline__ float row_ss_part(const float* SSp, const float* SSs, int m, int lane) {
    if (m < MP) return (lane < 32) ? SSp[(size_t)m * 32 + lane] : 0.f;
    return SSs[(size_t)(m - MP) * 128 + lane] + SSs[(size_t)(m - MP) * 128 + 64 + lane];
}
__device__ __forceinline__ void rowpass1(const Args& A, int lane, int gw, int NGW) {
    unsigned char* ws = A.ws;
    const bf16* MIX = (const bf16*)(ws + WS_MIX); bf16* X1B = (bf16*)(ws + WS_X1B); float* RSTD2 = (float*)(ws + WS_SSS + SSS_RSTD2);
    const float* SSp = (const float*)(ws + WS_SS1); const float* SSs = (const float*)(ws + WS_SSS + SSS_1);
    const float* RSTD1 = (const float*)(ws + WS_SSS + SSS_RSTD1);
    f32x4 g1[8], gi[8];
#pragma unroll
    for (int j = 0; j < 8; ++j) { g1[j] = *(const f32x4*)(A.in[26] + 256 * j + 4 * lane); const f32x4 g0 = *(const f32x4*)(A.in[8] + 256 * j + 4 * lane);
        gi[j] = (f32x4){1.0f / g0[0], 1.0f / g0[1], 1.0f / g0[2], 1.0f / g0[3]}; }
    u32x2 va[8], vb[8], ma[8], mb[8]; float sa = 0.f, sb = 0.f, ra = 0.f, rb = 0.f;
#define RP1_LOAD(V, M, S, R, m_) do { const int mm_ = (m_); \
        S = row_ss_part(SSp, SSs, mm_, lane); R = RSTD1[mm_]; \
        _Pragma("unroll") for (int j = 0; j < 8; ++j) { const int k = 256 * j + 4 * lane; V[j] = *(const GAS u32x2*)(X1B + (size_t)mm_ * DM + k); M[j] = *(const GAS u32x2*)(MIX + (size_t)mm_ * DM + k); } } while (0)
#define RP1_PROC(V, M, S, R, m_) do { const int mm_ = (m_); \
        const float rstd1 = 1.0f / sqrtf(wave_sum(S) * (1.0f / DM) + EPS); float s = 0.f; f32x4 O[8]; \
        _Pragma("unroll") for (int j = 0; j < 8; ++j) { f32x4 o; o[0] = bflo(V[j].x) * R * gi[j][0] + bflo(M[j].x) * rstd1 * g1[j][0]; o[1] = bfhi(V[j].x) * R * gi[j][1] + bfhi(M[j].x) * rstd1 * g1[j][1]; \
            o[2] = bflo(V[j].y) * R * gi[j][2] + bflo(M[j].y) * rstd1 * g1[j][2]; o[3] = bfhi(V[j].y) * R * gi[j][3] + bfhi(M[j].y) * rstd1 * g1[j][3]; \
            s += (o[0] * o[0] + o[1] * o[1]) + (o[2] * o[2] + o[3] * o[3]); O[j] = o; } \
        const float ms2 = wave_sum(s) * (1.0f / DM) + EPS, rstd2 = 1.0f / sqrtf(ms2); \
        _Pragma("unroll") for (int j = 0; j < 8; ++j) { u32x2 o; o.x = cvtpk(O[j][0] * rstd2, O[j][1] * rstd2); o.y = cvtpk(O[j][2] * rstd2, O[j][3] * rstd2); \
            *(GAS u32x2*)(X1B + (size_t)mm_ * DM + 256 * j + 4 * lane) = o; } \
        if (lane == 0) RSTD2[mm_] = sqrtf(ms2); } while (0)
    int m = gw;
    if (m < MT) { RP1_LOAD(va, ma, sa, ra, m);
        for (;;) { const int m2 = m + NGW; if (m2 < MT) RP1_LOAD(vb, mb, sb, rb, m2); RP1_PROC(va, ma, sa, ra, m); if (m2 >= MT) break;
                   m = m2 + NGW; if (m < MT) RP1_LOAD(va, ma, sa, ra, m); RP1_PROC(vb, mb, sb, rb, m2); if (m >= MT) break; } }
#undef RP1_LOAD
#undef RP1_PROC
}
__device__ __forceinline__ void rowpass2(const Args& A, int lane, int gw, int NGW) {
    unsigned char* ws = A.ws;
    const bf16* FF = (const bf16*)(ws + WS_FF); const bf16* X1B = (const bf16*)(ws + WS_X1B);
    const float* SSp = (const float*)(ws + WS_SS2); const float* SSs = (const float*)(ws + WS_SSS + SSS_2);
    f32x4 g3[8];
#pragma unroll
    for (int j = 0; j < 8; ++j) g3[j] = *(const f32x4*)(A.in[31] + 256 * j + 4 * lane);
    u32x2 xa[8], xb[8], fa[8], fb[8]; float sa = 0.f, sb = 0.f;
    const float* RSTD2 = (const float*)(ws + WS_SSS + SSS_RSTD2); float ra = 0.f, rb = 0.f;
#define RP2_LOAD(X, F, S, R, m_) do { const int mm_ = (m_); S = row_ss_part(SSp, SSs, mm_, lane); R = RSTD2[mm_]; \
        _Pragma("unroll") for (int j = 0; j < 8; ++j) { const int k = 256 * j + 4 * lane; X[j] = *(const GAS u32x2*)(X1B + (size_t)mm_ * DM + k); F[j] = *(const GAS u32x2*)(FF + (size_t)mm_ * DM + k); } } while (0)
#define RP2_PROC(X, F, S, R, m_) do { const int mm_ = (m_); float* orow = A.out + O_Y + (size_t)mm_ * DM; const float rstd = 1.0f / sqrtf(wave_sum(S) * (1.0f / DM) + EPS); f32x4 V[8]; \
        _Pragma("unroll") for (int j = 0; j < 8; ++j) { V[j][0] = bflo(X[j].x) * R + bflo(F[j].x) * rstd * g3[j][0]; V[j][1] = bfhi(X[j].x) * R + bfhi(F[j].x) * rstd * g3[j][1]; V[j][2] = bflo(X[j].y) * R + bflo(F[j].y) * rstd * g3[j][2]; V[j][3] = bfhi(X[j].y) * R + bfhi(F[j].y) * rstd * g3[j][3]; } \
        DBG_PERTURB(V, mm_); \
        _Pragma("unroll") for (int j = 0; j < 8; ++j) __builtin_nontemporal_store(V[j], (GAS f32x4*)(orow + 256 * j + 4 * lane)); } while (0)
    int m = gw;
    if (m < MT) { RP2_LOAD(xa, fa, sa, ra, m);
        for (;;) { const int m2 = m + NGW; if (m2 < MT) RP2_LOAD(xb, fb, sb, rb, m2); RP2_PROC(xa, fa, sa, ra, m); if (m2 >= MT) break;
                   m = m2 + NGW; if (m < MT) RP2_LOAD(xa, fa, sa, ra, m); RP2_PROC(xb, fb, sb, rb, m2); if (m >= MT) break; } }
#undef RP2_LOAD
#undef RP2_PROC
}
#ifndef MK_AL_P4
#define MK_AL_P4 true
#endif
#ifndef MK_AL_SS
#define MK_AL_SS true
#endif
#ifndef MK_WGM_P5
#define MK_WGM_P5 4
#endif
#ifndef MK_WGM_P1
#define MK_WGM_P1 2
#endif
#ifndef MK_WGM_P7
#define MK_WGM_P7 4
#endif
#ifndef MK_WGM_P8
#define MK_WGM_P8 1
#endif
#ifndef MK_GU_ALIGN
#define MK_GU_ALIGN true
#endif
#ifndef MK_GU_SP2
#define MK_GU_SP2 true
#endif
__global__ void __launch_bounds__(NWAVES * 64, 2) hymba_fwd(Args args) {
    extern __shared__ __attribute__((aligned(16))) unsigned char lds_raw[];
    LAS unsigned char* lds = (LAS unsigned char*)lds_raw;
    volatile LAS unsigned* MISC = (volatile LAS unsigned*)(lds + MISC_OFF);
    const int tid = threadIdx.x, lane = tid & 63, wave = __builtin_amdgcn_readfirstlane(tid >> 6);
    const int G = gridDim.x; const int bx = blockIdx.x; const int vcu = (G % 8 == 0) ? (bx % 8) * (G / 8) + bx / 8 : bx;
    unsigned char* ws = args.ws;
    gu32* ctl = (gu32*)(ws + WS_CTL);
    for (int u = tid; u < (LDS_BYTES - LDSCTL_OFF) / 4; u += NWAVES * 64) ((LAS unsigned*)(lds + LDSCTL_OFF))[u] = 0u;
    __syncthreads();
    const XcdBarrier bar = xcd_barrier_post((unsigned*)(ctl + CW_BAR) + args.li * XCD_BAR_WORDS, MISC + 8);
#define GRID_BAR() xcd_barrier(bar)
    const int lo = args.ph_lo, hi = args.ph_hi;
#define IN(k) (lo <= (k) && (k) < hi)
#define BOTH(k) (IN(k) && IN((k) + 1))

    const int gw = vcu * NWAVES + wave, NGW = G * NWAVES;

    if (IN(0)) { PHASE_IDS p0_prologue(args, lds, tid, lane, wave, vcu, G); if (BOTH(0)) GRID_BAR(); }

    if (IN(1)) { PHASE_IDS
        { pg8::Gemm g{(const bf16*)(ws + WS_XN), (const bf16*)(ws + WS_WIN), MP, 4096, DM}; pg8::StaticOrder S; S.init(MP, 4096, G, bx, MK_WGM_P1);
          pg8::EpiBf16<0> E{(bf16*)(ws + WS_QKRAW), 1024, nullptr, 1024, (size_t)WS_RSTRIDE / 2, 1.f};
          pg8::gemm_phase<pg8::EpiBf16<0>, pg8::StaticOrder, true, true>(lds + RING_OFF, g, S, E); }
        { PHASE_IDS bf16* O = (bf16*)(ws + WS_QKRAW);
          skinny_ks<1, DM, 4, 4>((const bf16*)(ws + WS_XN) + (size_t)MP * DM, (const bf16*)(ws + WS_WIN), (float*)(ws + WS_PARTA), 4096, (unsigned*)ctl + CW_KS1, lds, 4096 / 16, vcu, G, wave, lane,
              [](int it, int a, int fr) { return 16 * it + fr; },
              [O](int it, int row, int fq, const f32x4 (&acc)[1]) { const int col = 16 * it + 4 * fq, t = col >> 10;
                  u32x2 w; w.x = cvtpk_n(acc[0][0], acc[0][1]); w.y = cvtpk_n(acc[0][2], acc[0][3]);
                  *(GAS u32x2*)(O + (size_t)t * (WS_RSTRIDE / 2) + (size_t)(MP + row) * 1024 + (col & 1023)) = w; }); }
        if (BOTH(1)) GRID_BAR();
    }

    if (IN(2)) { PHASE_IDS if (vcu < 64) p2_scalars(args, lds, lane, wave, vcu); p2_conv(args, tid, vcu, G); if (BOTH(2)) GRID_BAR(); }

    if (IN(3)) { PHASE_IDS
        const int half = G / 2;
#ifndef MK_REP_M
#define MK_REP_M 1
#endif
#ifndef MK_REP_S
#define MK_REP_S 1
#endif
        if (vcu < half) { for (int rp_ = 0; rp_ < MK_REP_M; ++rp_) for (int it = vcu; it < NBATCH * NH * NSL; it += half) mlstm_item(args, lds, tid, lane, wave, it); }
        else { const int nb = G - half, bi = vcu - half;
               for (int rp_ = 0; rp_ < MK_REP_S; ++rp_)
               for (int it = bi * 4 + (wave & 3); it < 2 * NBATCH * NG; it += nb * 4) s5_item(args, lds + (wave & 3) * 25600, lane, wave >> 2, it); }
        if (vcu >= half) { __syncthreads(); for (int it = NBATCH * NH * NSL + (vcu - half); it < 2 * NBATCH * NH * NSL; it += G - half) mlstm_item(args, lds, tid, lane, wave, it); }
        if (BOTH(3)) GRID_BAR();
    }

    if (IN(4)) { PHASE_IDS
        { pg8::Gemm g{(const bf16*)(ws + WS_Z), (const bf16*)(ws + WS_WGLU), MP, 1024, 1024}; pg8::StaticOrder S; S.init(MP, 1024, G, bx);
          pg8::EpiGlu E{(const bf16*)(ws + WS_Z), (bf16*)(ws + WS_MIXIN), args.in[24]};
          pg8::gemm_phase<pg8::EpiGlu, pg8::StaticOrder, MK_AL_P4, true>(lds + RING_OFF, g, S, E); }
        { PHASE_IDS const bf16* Zb = (const bf16*)(ws + WS_Z); bf16* O = (bf16*)(ws + WS_MIXIN); const float* bias = args.in[24];
          skinny_ks<1, 1024, 4, 1>(Zb + (size_t)MP * 1024, (const bf16*)(ws + WS_WGLU), (float*)(ws + WS_PARTA), 1024, (unsigned*)ctl + CW_KS4, lds, 1024 / 16, vcu, G, wave, lane,
              [](int it, int a, int fr) { return 16 * it + fr; },
              [Zb, O, bias](int it, int row, int fq, const f32x4 (&acc)[1]) { const int col = 16 * it + 4 * fq; const size_t m = (size_t)(MP + row);
                  const u32x2 z = *(const GAS u32x2*)(Zb + m * 1024 + col); const f32x4 bv = *(const f32x4*)(bias + col);
                  u32x2 w; w.x = cvtpk(bflo(z.x) * sigmoidf_(acc[0][0] + bv[0]), bfhi(z.x) * sigmoidf_(acc[0][1] + bv[1]));
                  w.y = cvtpk(bflo(z.y) * sigmoidf_(acc[0][2] + bv[2]), bfhi(z.y) * sigmoidf_(acc[0][3] + bv[3]));
                  *(GAS u32x2*)(O + m * 2048 + 1024 + col) = w; }); }
        { PHASE_IDS outa_rows(args, lane, gw, NGW); }
        if (BOTH(4)) GRID_BAR();
    }

    if (IN(5)) { PHASE_IDS
        { pg8::Gemm g{(const bf16*)(ws + WS_MIXIN), (const bf16*)(ws + WS_WOUT), MP, DM, DM}; pg8::StaticOrder S; S.init(MP, DM, G, bx, MK_WGM_P5);
          pg8::EpiSS<false> E{(bf16*)(ws + WS_MIX), DM, (float*)(ws + WS_SS1), 1.0f};
          pg8::gemm_phase<pg8::EpiSS<false>, pg8::StaticOrder, MK_AL_SS, true>(lds + RING_OFF, g, S, E); }
        { PHASE_IDS bf16* O = (bf16*)(ws + WS_MIX); float* SSs = (float*)(ws + WS_SSS + SSS_1);
          skinny_ks<1, DM, 4, 2>((const bf16*)(ws + WS_MIXIN) + (size_t)MP * DM, (const bf16*)(ws + WS_WOUT), (float*)(ws + WS_PARTA), 2048, (unsigned*)ctl + CW_KS5, lds, DM / 16, vcu, G, wave, lane,
              [](int it, int a, int fr) { return 16 * it + fr; },
              [O, SSs](int it, int row, int fq, const f32x4 (&acc)[1]) { const int col = 16 * it + 4 * fq;
                  u32x2 w; w.x = cvtpk_n(acc[0][0], acc[0][1]); w.y = cvtpk_n(acc[0][2], acc[0][3]);
                  *(GAS u32x2*)(O + (size_t)(MP + row) * DM + col) = w;
                  float s = (acc[0][0] * acc[0][0] + acc[0][1] * acc[0][1]) + (acc[0][2] * acc[0][2] + acc[0][3] * acc[0][3]);
                  s += __shfl_xor(s, 16); s += __shfl_xor(s, 32);
                  if (fq == 0) SSs[(size_t)row * 128 + it] = s; }); }
        if (BOTH(5)) GRID_BAR();
    }

    if (IN(6)) { PHASE_IDS rowpass1(args, lane, gw, NGW); if (BOTH(6)) GRID_BAR(); }

    if (IN(7)) { PHASE_IDS
        { pg8::Gemm g{(const bf16*)(ws + WS_X1B), (const bf16*)(ws + WS_WGU), MP, 2 * DFF, DM}; pg8::StaticOrder S; S.init(MP, 2 * DFF, G, bx, MK_WGM_P7);
          pg8::EpiGU8 E{ws + WS_ACT8, DFF};
          pg8::gemm_phase<pg8::EpiGU8, pg8::StaticOrder, MK_GU_ALIGN, MK_GU_SP2>(lds + RING_OFF, g, S, E); }
        { PHASE_IDS bf16* O = (bf16*)(ws + WS_ACTS);
          skinny_ks<2, DM, 4, 6>((const bf16*)(ws + WS_X1B) + (size_t)MP * DM, (const bf16*)(ws + WS_WGU), (float*)(ws + WS_PARTA), DFF, (unsigned*)ctl + CW_KS7, lds, DFF / 16, vcu, G, wave, lane,
              [](int it, int a, int fr) { const int j = 16 * it + fr; return 256 * (j >> 7) + 128 * a + (j & 127); },
              [O](int it, int row, int fq, const f32x4 (&acc)[2]) { const int col = 16 * it + 4 * fq; const f32x4 g = acc[0], up = acc[1];
                  u32x2 w; w.x = cvtpk(g[0] * sigmoidf_(g[0]) * up[0], g[1] * sigmoidf_(g[1]) * up[1]);
                  w.y = cvtpk(g[2] * sigmoidf_(g[2]) * up[2], g[3] * sigmoidf_(g[3]) * up[3]);
                  *(GAS u32x2*)(O + (size_t)row * DFF + col) = w; }); }
        if (BOTH(7)) GRID_BAR();
    }

    if (IN(8)) { PHASE_IDS
        { pg8::Gemm g{(const bf16*)(ws + WS_ACT8), (const bf16*)(ws + WS_WD8), MP, DM, DFF / 2}; pg8::StaticOrder S; S.init(MP, DM, G, bx, MK_WGM_P8);
          pg8::EpiSS<true> E{(bf16*)(ws + WS_FF), DM, (float*)(ws + WS_SS2), 0.0009765625f};
          pg8::gemm_phase<pg8::EpiSS<true>, pg8::StaticOrder, MK_AL_SS, true, true>(lds + RING_OFF, g, S, E); }
        { PHASE_IDS bf16* O = (bf16*)(ws + WS_FF); float* SSs = (float*)(ws + WS_SSS + SSS_2);
          skinny_ks<1, DFF, 8, 4>((const bf16*)(ws + WS_ACTS), (const bf16*)(ws + WS_WD), (float*)(ws + WS_PARTB), 2048, (unsigned*)ctl + CW_KS8, lds, DM / 16, vcu, G, wave, lane,
              [](int it, int a, int fr) { return 16 * it + fr; },
              [O, SSs](int it, int row, int fq, const f32x4 (&acc)[1]) { const int col = 16 * it + 4 * fq;
                  u32x2 w; w.x = cvtpk_n(acc[0][0], acc[0][1]); w.y = cvtpk_n(acc[0][2], acc[0][3]);
                  *(GAS u32x2*)(O + (size_t)(MP + row) * DM + col) = w;
                  float s = (acc[0][0] * acc[0][0] + acc[0][1] * acc[0][1]) + (acc[0][2] * acc[0][2] + acc[0][3] * acc[0][3]);
                  s += __shfl_xor(s, 16); s += __shfl_xor(s, 32);
                  if (fq == 0) SSs[(size_t)row * 128 + it] = s; }); }
        if (BOTH(8)) GRID_BAR();
    }

    if (IN(9)) { PHASE_IDS rowpass2(args, lane, gw, NGW); }
#undef IN
#undef BOTH
}

#ifdef MK_DUMP_OFF
__global__ void dump_kernel(const unsigned short* src, float* dst, size_t n) {
    for (size_t i = (size_t)blockIdx.x * blockDim.x + threadIdx.x; i < n; i += (size_t)gridDim.x * blockDim.x) dst[i] = __uint_as_float((unsigned)src[i] << 16);
}
#endif
extern "C" void kernel_launch(void* const* d_in, const int* in_sizes, int n_in, void* d_out, int out_size, void* d_ws, size_t ws_size, hipStream_t stream) {
    static int grid = 0;
    if (grid == 0) {
        if (n_in != 32 || out_size != (int)O_END || ws_size < WS_END) { fprintf(stderr, "kernel_launch: unexpected problem: n_in %d out %d ws %zu\n", n_in, out_size, ws_size); grid = -1; return; }
        int dev = 0, cus = 0, per_cu = 0;
        if (hipGetDevice(&dev) != hipSuccess || hipDeviceGetAttribute(&cus, hipDeviceAttributeMultiprocessorCount, dev) != hipSuccess) { grid = -1; return; }
        if (hipFuncSetAttribute((const void*)hymba_fwd, hipFuncAttributeMaxDynamicSharedMemorySize, LDS_BYTES) != hipSuccess) { fprintf(stderr, "kernel_launch: hipFuncSetAttribute failed\n"); grid = -1; return; }
        if (hipOccupancyMaxActiveBlocksPerMultiprocessor(&per_cu, (const void*)hymba_fwd, NWAVES * 64, LDS_BYTES) != hipSuccess || per_cu < 1) { fprintf(stderr, "kernel_launch: occupancy query reports %d\n", per_cu); per_cu = 1; }
        (void)hipGetLastError();
        if (cus < 256) { fprintf(stderr, "kernel_launch: %d CUs; the K-sliced sample GEMMs are sized for at least 256\n", cus); grid = -1; return; }
        grid = cus;
    }
    if (grid < 0) return;
    Args a{};
    for (int i = 0; i < 32; ++i) a.in[i] = (const float*)d_in[i];
    a.out = (float*)d_out; a.ws = (unsigned char*)d_ws;
    int lo[N_PHASES + 2], hi[N_PHASES + 2], nl = 0;
#if defined(MK_REPEAT)
    lo[0] = 0; hi[0] = MK_REPEAT + 1; lo[1] = MK_REPEAT; hi[1] = MK_REPEAT + 1; lo[2] = MK_REPEAT + 1; hi[2] = N_PHASES; nl = 3;
#else
    if (N_LAUNCHES == 1) { lo[0] = 0; hi[0] = N_PHASES; nl = 1; } else { for (int k = 0; k < N_PHASES; ++k) { lo[k] = k; hi[k] = k + 1; } nl = N_PHASES; }
#endif
    if (hipMemsetAsync((char*)d_ws + WS_CTL, 0, (size_t)CW_END * 4, stream) != hipSuccess) return;
    for (int li = 0; li < nl; ++li) {
        a.ph_lo = lo[li]; a.ph_hi = hi[li]; a.li = li;
        hipLaunchKernelGGL(hymba_fwd, dim3(grid), dim3(NWAVES * 64), LDS_BYTES, stream, a);
    }
#ifdef MK_DUMP_OFF
    hipLaunchKernelGGL(dump_kernel, dim3(2048), dim3(256), 0, stream, (const unsigned short*)((const unsigned char*)d_ws + (size_t)(MK_DUMP_OFF) * MiB), (float*)d_out, (size_t)(MK_DUMP_N));
#endif
}
```

```cpp
#define MK_N_LAUNCHES 1
#include <hip/hip_runtime.h>
#include <cstdio>
#include <cstdint>
#include <cmath>
namespace pg8 {
#define PG8_LAS __attribute__((address_space(3)))
typedef unsigned short bf16_t;
typedef short bf16x8 __attribute__((ext_vector_type(8)));
typedef float f32x4 __attribute__((ext_vector_type(4)));
typedef unsigned u32x4 __attribute__((ext_vector_type(4)));
typedef int i32x4 __attribute__((ext_vector_type(4)));
typedef int i32x8 __attribute__((ext_vector_type(8)));
__device__ __forceinline__ i32x8 cat8(bf16x8 lo, bf16x8 hi) { return __builtin_shufflevector(__builtin_bit_cast(i32x4, lo), __builtin_bit_cast(i32x4, hi), 0, 1, 2, 3, 4, 5, 6, 7); }
constexpr int BM = 256, BK = 64, HALF = 128, HTB = HALF * BK * 2  , STAGE_BYTES = 8 * HTB, NXCD = 8, WGM = 4;

__host__ __device__ __forceinline__ int lds_byte(int r, int c) { const int st = (r >> 4) * 2 + (c >> 5), rr = r & 15, cc = c & 31, ob = rr * 64 + cc * 2; return st * 1024 + (ob ^ (((ob >> 9) & 1) << 5)); }
__host__ __device__ __forceinline__ void stage_rc(int b, int& R, int& C) { const int st = b / 1024, sb = b % 1024, swz = sb ^ (((sb >> 9) & 1) << 5); R = (st >> 1) * 16 + swz / 64; C = (st & 1) * 32 + (swz % 64) / 2; }
__host__ __device__ __forceinline__ int perm32(int rho) { const int n = rho >> 4, i = rho & 15; return 8 * (i >> 2) + 4 * n + (i & 3); }

struct Unit { int pm, pn; };
struct Gemm { const bf16_t* A; const bf16_t* Bt; int M, N, K; };

struct StaticOrder {
    int nM, nN, nwg, G, c, wgm;
    __host__ __device__ void init(int M, int N, int G_, int c_, int wgm_ = WGM) { nM = M / BM; nN = N / BM; nwg = nM * nN; G = G_; c = c_; wgm = wgm_; }
    __host__ __device__ bool next(int i, Unit& u) const {
        const long L = (long)i * G + c; if (L >= nwg) return false;
        int wgid = (int)L; { const int q = nwg / NXCD, r = nwg % NXCD, xcd = wgid % NXCD, off = wgid / NXCD; wgid = (xcd < r ? xcd * (q + 1) : r * (q + 1) + (xcd - r) * q) + off; }
        const int nig = wgm * nN, gid = wgid / nig, fm = gid * wgm, gsz = (nM - fm) < wgm ? (nM - fm) : wgm;
        u.pm = fm + ((wgid % nig) % gsz); u.pn = (wgid % nig) / gsz; return true;
    }
    __device__ __forceinline__ void a_ready(const Unit&) const {}
    __device__ __forceinline__ void done(const Unit&) const {}
};

__device__ __forceinline__ unsigned cvt_pk_bf16(float lo, float hi) { unsigned r; asm volatile("v_cvt_pk_bf16_f32 %0, %1, %2" : "=v"(r) : "v"(lo), "v"(hi)); return r; }
typedef float f32x2 __attribute__((ext_vector_type(2)));
__device__ __forceinline__ f32x2 gelu_pk(f32x2 v) {
    const f32x2 av = __builtin_elementwise_abs(v), d = av * 0.2316418882f + 1.0f;
    f32x2 t; t.x = __builtin_amdgcn_rcpf(d.x); t.y = __builtin_amdgcn_rcpf(d.y);
    f32x2 q = t * 0.5307027145f + (-0.7265760135f); q = q * t + 0.7107068705f; q = q * t + (-0.142248368f); q = q * t + 0.127414796f; q = q * t;
    const f32x2 s = (v * v) * (-0.72134752044f);
    f32x2 e; e.x = __builtin_amdgcn_exp2f(s.x); e.y = __builtin_amdgcn_exp2f(s.y);
    const f32x2 m = v * (q * e), r = v - m;
    f32x2 o; o.x = v.x < 0.f ? m.x : r.x; o.y = v.y < 0.f ? m.y : r.y; return o;
}

template <int ACT  > struct EpiBf16 {
    static constexpr bool PERM = true, AFTER_DRAIN = false; static_assert(ACT == 0 || ACT == 1, "EpiBf16: ACT is 0 (none) or 1 (gelu_pk)");
    bf16_t* O; int ldc; const float* bias; int split_cols; size_t split_stride; float scale0;
    __device__ __forceinline__ void operator()(const f32x4 (&acc)[2][2][4][2], const Unit& u, int wr, int wc, int fr, int fq) const {
        const int row0 = u.pm * BM + wr * 64 + fr; int colt = u.pn * BM; bf16_t* base = O;
        float sc = 1.f; if (split_cols) { const int t = colt / split_cols; base += (size_t)t * split_stride; colt -= t * split_cols; if (t == 0) sc = scale0; }
        const int col0 = colt + wc * 32 + 8 * fq, bcol0 = u.pn * BM + wc * 32 + 8 * fq;
        f32x4 bv[2][2];
#pragma unroll
        for (int bj = 0; bj < 2; ++bj)
#pragma unroll
            for (int n = 0; n < 2; ++n) bv[bj][n] = bias ? *(const f32x4*)(bias + bcol0 + bj * HALF + 4 * n) : (f32x4){0.f, 0.f, 0.f, 0.f};
#pragma unroll
        for (int ai = 0; ai < 2; ++ai)
#pragma unroll
            for (int m = 0; m < 4; ++m) { bf16_t* rowp = base + (size_t)(row0 + ai * HALF + m * 16) * ldc + col0;
#pragma unroll
                for (int bj = 0; bj < 2; ++bj) { f32x4 v0 = acc[ai][bj][m][0] + bv[bj][0], v1 = acc[ai][bj][m][1] + bv[bj][1];
                    if (ACT == 1) { f32x2 a = gelu_pk((f32x2){v0[0], v0[1]}), b = gelu_pk((f32x2){v0[2], v0[3]}), c = gelu_pk((f32x2){v1[0], v1[1]}), d = gelu_pk((f32x2){v1[2], v1[3]});
                        v0 = (f32x4){a.x, a.y, b.x, b.y}; v1 = (f32x4){c.x, c.y, d.x, d.y}; }
                    v0 = v0 * sc; v1 = v1 * sc; u32x4 w; w.x = cvt_pk_bf16(v0[0], v0[1]); w.y = cvt_pk_bf16(v0[2], v0[3]); w.z = cvt_pk_bf16(v1[0], v1[1]); w.w = cvt_pk_bf16(v1[2], v1[3]);
                    *(u32x4*)(rowp + bj * HALF) = w; } }
    }
};
__device__ __forceinline__ float fast_sigmoid(float v) { return __builtin_amdgcn_rcpf(1.0f + __expf(-v)); }
__device__ __forceinline__ float bf_lo(unsigned w) { return __uint_as_float(w << 16); }
__device__ __forceinline__ float bf_hi(unsigned w) { return __uint_as_float(w & 0xffff0000u); }
struct EpiGlu {
    static constexpr bool PERM = true, AFTER_DRAIN = false;
    const bf16_t* Z; bf16_t* O; const float* bias;
    __device__ __forceinline__ void operator()(const f32x4 (&acc)[2][2][4][2], const Unit& u, int wr, int wc, int fr, int fq) const {
        const int row0 = u.pm * BM + wr * 64 + fr, col0 = u.pn * BM + wc * 32 + 8 * fq;
        f32x4 bv[2][2];
#pragma unroll
        for (int bj = 0; bj < 2; ++bj)
#pragma unroll
            for (int n = 0; n < 2; ++n) bv[bj][n] = *(const f32x4*)(bias + col0 + bj * HALF + 4 * n);
#pragma unroll
        for (int ai = 0; ai < 2; ++ai) {
            u32x4 z[4][2];
#pragma unroll
            for (int m = 0; m < 4; ++m)
#pragma unroll
                for (int bj = 0; bj < 2; ++bj) z[m][bj] = *(const u32x4*)(Z + (size_t)(row0 + ai * HALF + m * 16) * 1024 + col0 + bj * HALF);
#pragma unroll
            for (int m = 0; m < 4; ++m) { const size_t row = (size_t)(row0 + ai * HALF + m * 16);
#pragma unroll
                for (int bj = 0; bj < 2; ++bj) { const int col = col0 + bj * HALF; const u32x4 zz = z[m][bj];
                    const f32x4 v0 = acc[ai][bj][m][0] + bv[bj][0], v1 = acc[ai][bj][m][1] + bv[bj][1];
                    u32x4 w;
                    w.x = cvt_pk_bf16(bf_lo(zz.x) * fast_sigmoid(v0[0]), bf_hi(zz.x) * fast_sigmoid(v0[1]));
                    w.y = cvt_pk_bf16(bf_lo(zz.y) * fast_sigmoid(v0[2]), bf_hi(zz.y) * fast_sigmoid(v0[3]));
                    w.z = cvt_pk_bf16(bf_lo(zz.z) * fast_sigmoid(v1[0]), bf_hi(zz.z) * fast_sigmoid(v1[1]));
                    w.w = cvt_pk_bf16(bf_lo(zz.w) * fast_sigmoid(v1[2]), bf_hi(zz.w) * fast_sigmoid(v1[3]));
                    *(u32x4*)(O + row * 2048 + 1024 + col) = w; } } }
    }
};
template <bool SCALED> struct EpiSS {
    static constexpr bool PERM = true, AFTER_DRAIN = false;
    bf16_t* O; int ldc; float* SS; float scale;
    __device__ __forceinline__ void operator()(const f32x4 (&acc)[2][2][4][2], const Unit& u, int wr, int wc, int fr, int fq) const {
        const int row0 = u.pm * BM + wr * 64 + fr, col0 = u.pn * BM + wc * 32 + 8 * fq;
        float s[2][4];
#pragma unroll
        for (int ai = 0; ai < 2; ++ai)
#pragma unroll
            for (int m = 0; m < 4; ++m) { const size_t row = (size_t)(row0 + ai * HALF + m * 16); float t = 0.f;
#pragma unroll
                for (int bj = 0; bj < 2; ++bj) { f32x4 v0 = acc[ai][bj][m][0], v1 = acc[ai][bj][m][1]; if (SCALED) { v0 = v0 * scale; v1 = v1 * scale; }
                    t += (v0[0] * v0[0] + v0[1] * v0[1]) + (v0[2] * v0[2] + v0[3] * v0[3]) + (v1[0] * v1[0] + v1[1] * v1[1]) + (v1[2] * v1[2] + v1[3] * v1[3]);
                    u32x4 w; w.x = cvt_pk_bf16(v0[0], v0[1]); w.y = cvt_pk_bf16(v0[2], v0[3]); w.z = cvt_pk_bf16(v1[0], v1[1]); w.w = cvt_pk_bf16(v1[2], v1[3]);
                    *(u32x4*)(O + row * ldc + col0 + bj * HALF) = w; }
                s[ai][m] = t; }
#pragma unroll
        for (int ai = 0; ai < 2; ++ai)
#pragma unroll
            for (int m = 0; m < 4; ++m) s[ai][m] += __shfl_xor(s[ai][m], 16);
#pragma unroll
        for (int ai = 0; ai < 2; ++ai)
#pragma unroll
            for (int m = 0; m < 4; ++m) s[ai][m] += __shfl_xor(s[ai][m], 32);
        if (fq == 0) {
#pragma unroll
            for (int ai = 0; ai < 2; ++ai)
#pragma unroll
                for (int m = 0; m < 4; ++m) SS[(size_t)(row0 + ai * HALF + m * 16) * 32 + u.pn * 4 + wc] = s[ai][m]; }
    }
};
struct EpiGU {
    static constexpr bool PERM = true, AFTER_DRAIN = false;
    bf16_t* O; int ldc;
    static __device__ __forceinline__ unsigned swiglu_pk(f32x2 g, f32x2 u) {
        const f32x2 t = g * -1.4426950408889634f; f32x2 e; e.x = __builtin_amdgcn_exp2f(t.x); e.y = __builtin_amdgcn_exp2f(t.y);
        const f32x2 d = e + 1.0f; f32x2 s; s.x = __builtin_amdgcn_rcpf(d.x); s.y = __builtin_amdgcn_rcpf(d.y);
        const f32x2 o = (g * u) * s; return cvt_pk_bf16(o.x, o.y);
    }
    __device__ __forceinline__ void operator()(const f32x4 (&acc)[2][2][4][2], const Unit& u, int wr, int wc, int fr, int fq) const {
        const int row0 = u.pm * BM + wr * 64 + fr, col0 = u.pn * HALF + wc * 32 + 8 * fq;
#pragma unroll
        for (int ai = 0; ai < 2; ++ai)
#pragma unroll
            for (int m = 0; m < 4; ++m) { const size_t row = (size_t)(row0 + ai * HALF + m * 16);
                const f32x4 g0 = acc[ai][0][m][0], g1 = acc[ai][0][m][1], u0 = acc[ai][1][m][0], u1 = acc[ai][1][m][1];
                u32x4 w;
                w.x = swiglu_pk((f32x2){g0[0], g0[1]}, (f32x2){u0[0], u0[1]});
                w.y = swiglu_pk((f32x2){g0[2], g0[3]}, (f32x2){u0[2], u0[3]});
                w.z = swiglu_pk((f32x2){g1[0], g1[1]}, (f32x2){u1[0], u1[1]});
                w.w = swiglu_pk((f32x2){g1[2], g1[3]}, (f32x2){u1[2], u1[3]});
                *(u32x4*)(O + row * ldc + col0) = w; }
    }
};
struct EpiGU8 {
    static constexpr bool PERM = true, AFTER_DRAIN = false;
    unsigned char* O; int ldc;
    static __device__ __forceinline__ f32x2 swiglu2(f32x2 g, f32x2 u) {
        const f32x2 t = g * -1.4426950408889634f; f32x2 e; e.x = __builtin_amdgcn_exp2f(t.x); e.y = __builtin_amdgcn_exp2f(t.y);
        const f32x2 d = e + 1.0f; f32x2 s; s.x = __builtin_amdgcn_rcpf(d.x); s.y = __builtin_amdgcn_rcpf(d.y);
        f32x2 o = (g * u) * s; o.x = __builtin_amdgcn_fmed3f(o.x, -448.f, 448.f); o.y = __builtin_amdgcn_fmed3f(o.y, -448.f, 448.f); return o;
    }
    __device__ __forceinline__ void operator()(const f32x4 (&acc)[2][2][4][2], const Unit& u, int wr, int wc, int fr, int fq) const {
        const int row0 = u.pm * BM + wr * 64 + fr, col0 = u.pn * HALF + wc * 32 + 8 * fq;
#pragma unroll
        for (int ai = 0; ai < 2; ++ai)
#pragma unroll
            for (int m = 0; m < 4; ++m) { const size_t row = (size_t)(row0 + ai * HALF + m * 16);
                const f32x4 g0 = acc[ai][0][m][0], g1 = acc[ai][0][m][1], u0 = acc[ai][1][m][0], u1 = acc[ai][1][m][1];
                const f32x2 a = swiglu2((f32x2){g0[0], g0[1]}, (f32x2){u0[0], u0[1]}), b = swiglu2((f32x2){g0[2], g0[3]}, (f32x2){u0[2], u0[3]});
                const f32x2 c = swiglu2((f32x2){g1[0], g1[1]}, (f32x2){u1[0], u1[1]}), d = swiglu2((f32x2){g1[2], g1[3]}, (f32x2){u1[2], u1[3]});
                int w0 = 0, w1 = 0;
                w0 = __builtin_amdgcn_cvt_pk_fp8_f32(a.x, a.y, w0, false); w0 = __builtin_amdgcn_cvt_pk_fp8_f32(b.x, b.y, w0, true);
                w1 = __builtin_amdgcn_cvt_pk_fp8_f32(c.x, c.y, w1, false); w1 = __builtin_amdgcn_cvt_pk_fp8_f32(d.x, d.y, w1, true);
                typedef unsigned u32x2_t __attribute__((ext_vector_type(2)));
                *(u32x2_t*)(O + row * ldc + col0) = (u32x2_t){(unsigned)w0, (unsigned)w1}; }
    }
};
template <class Epi, class Sched, bool ALIGN_EPI = false, bool SP2 = false, bool F8 = false>
__device__ __forceinline__ void gemm_phase(PG8_LAS unsigned char* lds, const Gemm g, const Sched& S, const Epi& E) {
    int tid = threadIdx.x; asm volatile("" : "+v"(tid));
    const int wid = __builtin_amdgcn_readfirstlane(tid >> 6), lane = tid & 63, wr = wid >> 2, wc = wid & 3, fr = lane & 15, fq = lane >> 4;
    const int K = g.K, nt = K / BK;
    unsigned voffA[2], voffB[2];
#pragma unroll
    for (int i = 0; i < 2; ++i) { int R, C; stage_rc(tid * 16 + i * 8192, R, C); const int Rb = Epi::PERM ? ((R & ~31) + perm32(R & 31)) : R;
        voffA[i] = (unsigned)(R * K + C) * 2u; voffB[i] = (unsigned)(Rb * K + C) * 2u; }
    const size_t kstep = (size_t)(BK * 2);
    const size_t hstep = (size_t)HALF * K * 2;
    const size_t tstep = 2 * hstep;
    const unsigned ldsw = (unsigned)wid * 1024u;
    const int aoff = lds_byte(wr * 64 + fr, fq * 8), boff = lds_byte(wc * 32 + fr, fq * 8);
#define PG8_SA(b, h) (((b) * 2 + (h)) * HTB)
#define PG8_SB(b, h) ((4 + (b) * 2 + (h)) * HTB)
#define PG8_STAGE(bufoff, gbase, voff) do { _Pragma("unroll") for (int _i = 0; _i < 2; ++_i) { unsigned _vo = (voff)[_i]; asm volatile("" : "+v"(_vo));     \
        __builtin_amdgcn_global_load_lds((const unsigned*)((const char*)(gbase) + _vo), (PG8_LAS unsigned*)(lds + (bufoff) + ldsw + _i * 8192), 16, 0, 0); } } while (0)
#define PG8_LDA(dst, b, h) do { _Pragma("unroll") for (int m = 0; m < 4; ++m) _Pragma("unroll") for (int k = 0; k < 2; ++k) dst[m][k] = *(const PG8_LAS bf16x8*)(lds + PG8_SA(b, h) + aoff + m * 2048 + k * 1024); } while (0)
#define PG8_LDB(dst, b, h) do { _Pragma("unroll") for (int n = 0; n < 2; ++n) _Pragma("unroll") for (int k = 0; k < 2; ++k) dst[n][k] = *(const PG8_LAS bf16x8*)(lds + PG8_SB(b, h) + boff + n * 2048 + k * 1024); } while (0)
#define PG8_MMA(ai, bj, At, Bt) do { __builtin_amdgcn_s_setprio(1); \
        if constexpr (F8) { _Pragma("unroll") for (int m = 0; m < 4; ++m) _Pragma("unroll") for (int n = 0; n < 2; ++n) \
            acc[ai][bj][m][n] = __builtin_amdgcn_mfma_scale_f32_16x16x128_f8f6f4(cat8(Bt[n][0], Bt[n][1]), cat8(At[m][0], At[m][1]), acc[ai][bj][m][n], 0, 0, 0, 0, 0, 0); } \
        else { _Pragma("unroll") for (int m = 0; m < 4; ++m) _Pragma("unroll") for (int n = 0; n < 2; ++n) _Pragma("unroll") for (int k = 0; k < 2; ++k) \
            acc[ai][bj][m][n] = __builtin_amdgcn_mfma_f32_16x16x32_bf16(Bt[n][k], At[m][k], acc[ai][bj][m][n], 0, 0, 0); } \
        __builtin_amdgcn_s_setprio(0); } while (0)
#define PG8_WAIT_V(n) asm volatile("s_waitcnt vmcnt(" #n ")" ::: "memory")
#define PG8_WAIT_L(n) asm volatile("s_waitcnt lgkmcnt(" #n ")" ::: "memory")
#define PG8_BAR __builtin_amdgcn_s_barrier()
#define PG8_SCHED __builtin_amdgcn_sched_barrier(0)
    Unit cur, nxt; int ui = 0;
    if (!S.next(0, cur)) return;
    f32x4 acc[2][2][4][2];
#pragma unroll
    for (int a = 0; a < 2; ++a)
#pragma unroll
        for (int b = 0; b < 2; ++b)
#pragma unroll
            for (int m = 0; m < 4; ++m)
#pragma unroll
                for (int n = 0; n < 2; ++n) acc[a][b][m][n] = (f32x4){0.f, 0.f, 0.f, 0.f};
    bf16x8 At[4][2], B0[2][2], B1[2][2];
    const char* cA = (const char*)g.A + (size_t)cur.pm * tstep; const char* cB = (const char*)g.Bt + (size_t)cur.pn * tstep;
    S.a_ready(cur);
    if constexpr (SP2) {
        PG8_STAGE(PG8_SB(0, 0), cB, voffB); PG8_STAGE(PG8_SB(0, 1), cB + hstep, voffB); PG8_STAGE(PG8_SA(0, 0), cA, voffA); PG8_STAGE(PG8_SA(0, 1), cA + hstep, voffA);
        if (wr == 1) PG8_BAR;
        PG8_WAIT_V(2); PG8_BAR;
        PG8_STAGE(PG8_SB(1, 0), cB + kstep, voffB); PG8_STAGE(PG8_SA(1, 0), cA + kstep, voffA); PG8_STAGE(PG8_SB(1, 1), cB + hstep + kstep, voffB);
        PG8_WAIT_V(6); PG8_BAR;
    } else {
        PG8_STAGE(PG8_SB(0, 0), cB, voffB); PG8_STAGE(PG8_SA(0, 0), cA, voffA); PG8_STAGE(PG8_SB(0, 1), cB + hstep, voffB); PG8_STAGE(PG8_SA(0, 1), cA + hstep, voffA);
        if (wr == 1) PG8_BAR;
        PG8_WAIT_V(4); PG8_BAR;
        PG8_STAGE(PG8_SB(1, 0), cB + kstep, voffB); PG8_STAGE(PG8_SA(1, 0), cA + kstep, voffA); PG8_STAGE(PG8_SB(1, 1), cB + hstep + kstep, voffB);
        PG8_WAIT_V(6); PG8_BAR;
    }
    for (;;) {
        const bool has_next = S.next(ui + 1, nxt);
        const char* nA = has_next ? (const char*)g.A + (size_t)nxt.pm * tstep : cA; const char* nB = has_next ? (const char*)g.Bt + (size_t)nxt.pn * tstep : cB;
        for (int t = 0; t < nt; t += 2) {
            const bool last = (t == nt - 2);
            const char* a1 = cA + (size_t)(t + 1) * kstep;
            const char* a2 = last ? nA : cA + (size_t)(t + 2) * kstep; const char* b2 = last ? nB : cB + (size_t)(t + 2) * kstep;
            const char* a3 = a2 + kstep; const char* b3 = b2 + kstep;
            if (last && has_next) S.a_ready(nxt);
            if constexpr (SP2) {
            PG8_LDB(B0, 0, 0); PG8_LDB(B1, 0, 1); PG8_SCHED; PG8_LDA(At, 0, 0); PG8_STAGE(PG8_SA(1, 1), a1 + hstep, voffA);
            PG8_WAIT_V(8); PG8_WAIT_L(0); PG8_BAR; PG8_MMA(0, 0, At, B0); PG8_MMA(0, 1, At, B1); PG8_BAR; PG8_SCHED;
            PG8_LDA(At, 0, 1); PG8_STAGE(PG8_SB(0, 0), b2, voffB); PG8_STAGE(PG8_SB(0, 1), b2 + hstep, voffB); PG8_STAGE(PG8_SA(0, 0), a2, voffA);
            PG8_WAIT_V(8); PG8_WAIT_L(0); PG8_BAR; PG8_MMA(1, 0, At, B0); PG8_MMA(1, 1, At, B1); PG8_BAR; PG8_SCHED;
            PG8_LDB(B0, 1, 0); PG8_LDB(B1, 1, 1); PG8_SCHED; PG8_LDA(At, 1, 0); PG8_STAGE(PG8_SA(0, 1), a2 + hstep, voffA);
            PG8_WAIT_V(8); PG8_WAIT_L(0); PG8_BAR; PG8_MMA(0, 0, At, B0); PG8_MMA(0, 1, At, B1); PG8_BAR; PG8_SCHED;
            PG8_LDA(At, 1, 1); PG8_STAGE(PG8_SB(1, 0), b3, voffB); PG8_STAGE(PG8_SB(1, 1), b3 + hstep, voffB); PG8_STAGE(PG8_SA(1, 0), a3, voffA);
            PG8_WAIT_V(8); PG8_WAIT_L(0); PG8_BAR; PG8_MMA(1, 0, At, B0); PG8_MMA(1, 1, At, B1); PG8_BAR; PG8_SCHED;
            } else {
            PG8_LDB(B0, 0, 0); PG8_SCHED; PG8_LDA(At, 0, 0); PG8_STAGE(PG8_SA(1, 1), a1 + hstep, voffA);
            PG8_WAIT_L(8); PG8_BAR; PG8_WAIT_L(0); PG8_MMA(0, 0, At, B0); PG8_BAR; PG8_SCHED;
            PG8_LDB(B1, 0, 1); PG8_STAGE(PG8_SB(0, 0), b2, voffB);
            PG8_BAR; PG8_WAIT_L(0); PG8_MMA(0, 1, At, B1); PG8_BAR;
            PG8_LDA(At, 0, 1); PG8_STAGE(PG8_SA(0, 0), a2, voffA);
            PG8_BAR; PG8_WAIT_L(0); PG8_MMA(1, 0, At, B0); PG8_BAR; PG8_SCHED;
            PG8_STAGE(PG8_SB(0, 1), b2 + hstep, voffB);
            PG8_WAIT_V(6); PG8_BAR; PG8_MMA(1, 1, At, B1); PG8_BAR;
            PG8_LDB(B0, 1, 0); PG8_SCHED; PG8_LDA(At, 1, 0); PG8_STAGE(PG8_SA(0, 1), a2 + hstep, voffA);
            PG8_WAIT_L(8); PG8_BAR; PG8_WAIT_L(0); PG8_MMA(0, 0, At, B0); PG8_BAR; PG8_SCHED;
            PG8_LDB(B1, 1, 1); PG8_STAGE(PG8_SB(1, 0), b3, voffB);
            PG8_BAR; PG8_WAIT_L(0); PG8_MMA(0, 1, At, B1); PG8_BAR;
            PG8_LDA(At, 1, 1); PG8_STAGE(PG8_SA(1, 0), a3, voffA);
            PG8_BAR; PG8_WAIT_L(0); PG8_MMA(1, 0, At, B0); PG8_BAR; PG8_SCHED;
            PG8_STAGE(PG8_SB(1, 1), b3 + hstep, voffB);
            PG8_WAIT_V(6); PG8_BAR; PG8_MMA(1, 1, At, B1); PG8_BAR;
            }
        }
        if constexpr (ALIGN_EPI) { if (wr == 0) PG8_BAR; }
        if constexpr (!Epi::AFTER_DRAIN) { int t2 = threadIdx.x; asm volatile("" : "+v"(t2)); E(acc, cur, wr, wc, t2 & 15, (t2 >> 4) & 3); S.done(cur); }
        if (!has_next) break;
#pragma unroll
        for (int a = 0; a < 2; ++a)
#pragma unroll
            for (int b = 0; b < 2; ++b)
#pragma unroll
                for (int m = 0; m < 4; ++m)
#pragma unroll
                    for (int n = 0; n < 2; ++n) acc[a][b][m][n] = (f32x4){0.f, 0.f, 0.f, 0.f};
        cur = nxt; cA = nA; cB = nB; ++ui;
        if constexpr (ALIGN_EPI) { if (wr == 1) PG8_BAR; }
    }
    PG8_WAIT_V(0);
    if constexpr (!ALIGN_EPI) { if (wr == 0) PG8_BAR; }
    PG8_BAR;
    if constexpr (Epi::AFTER_DRAIN) { E.fused(acc, cur, wr, wc, fr, fq, lds, wid, lane); S.done(cur); }
#undef PG8_SA
#undef PG8_SB
#undef PG8_STAGE
#undef PG8_LDA
#undef PG8_LDB
#undef PG8_MMA
#undef PG8_WAIT_V
#undef PG8_WAIT_L
#undef PG8_BAR
#undef PG8_SCHED
}
}
#define GAS __attribute__((address_space(1)))
#define LAS __attribute__((address_space(3)))
typedef unsigned short bf16;
typedef unsigned v4u __attribute__((ext_vector_type(4)));
typedef float f32x4 __attribute__((ext_vector_type(4)));
typedef short bf16x8 __attribute__((ext_vector_type(8)));
typedef GAS unsigned gu32;
typedef GAS unsigned long long gu64;
#define RLX_AGENT __ATOMIC_RELAXED, __HIP_MEMORY_SCOPE_AGENT
#define LDS_WAIT() asm volatile("s_waitcnt lgkmcnt(0)" ::: "memory")
#define VM_WAIT() asm volatile("s_waitcnt vmcnt(0)" ::: "memory")
__device__ __forceinline__ unsigned long long rt() { return __builtin_amdgcn_s_memrealtime(); }
__device__ __forceinline__ unsigned f2bf(float f) { unsigned u = __builtin_bit_cast(unsigned, f); return (u + 0x7fffu + ((u >> 16) & 1u)) >> 16; }
__device__ __forceinline__ unsigned pk2(float lo, float hi) { return f2bf(lo) | (f2bf(hi) << 16); }
#define XB_TMO      128
#define XB_XCNT(j)  (256  + 64 * (j))
#define XB_XSUB(j)  (1280 + 64 * (j))
#define XB_XGEN(j)  (2304 + 64 * (j))
#define XB_TOP      3328
#define XB_TOPGEN   3392
#define XCD_BAR_WORDS 3456
#define XB_SPIN_CAP (1u << 18)

__device__ __forceinline__ unsigned xb_ld(unsigned* p)              { return __hip_atomic_load(p, __ATOMIC_RELAXED, __HIP_MEMORY_SCOPE_AGENT); }
__device__ __forceinline__ unsigned xb_add(unsigned* p, unsigned v) { return __hip_atomic_fetch_add(p, v, __ATOMIC_RELAXED, __HIP_MEMORY_SCOPE_AGENT); }
__device__ __forceinline__ unsigned xb_xcc_id() { return (unsigned)__builtin_amdgcn_s_getreg((3 << 11) | 20) & 0xFu; }
#define XB_SPIN(cond, bar) do { unsigned _sp = 0; while (cond) { __builtin_amdgcn_s_sleep(1); \
    if ((++_sp & 255u) == 0u) { if (xb_ld(&(bar)[XB_TMO])) break; if (_sp > XB_SPIN_CAP) { atomicAdd(&(bar)[XB_TMO], 1u); break; } } } } while (0)

struct XcdBarrier {
    unsigned* bar; unsigned x;
    volatile LAS unsigned* st;
};

__device__ __forceinline__ XcdBarrier xcd_barrier_post(unsigned* bar, volatile LAS unsigned* st) {
    XcdBarrier b; b.bar = bar; b.x = xb_xcc_id(); b.st = st;
    if (threadIdx.x == 0) (void)xb_add(&bar[XB_XCNT(b.x)], 1u);
    return b;
}
__device__ __forceinline__ void xcd_barrier_complete(unsigned* bar, unsigned x, unsigned& nloc, unsigned& nx) {
    const unsigned G = gridDim.x * gridDim.y * gridDim.z;
    unsigned sum, cnt, mine, sp = 0u;
    for (;;) {
        sum = 0u; cnt = 0u; mine = 0u;
#pragma unroll
        for (unsigned j = 0; j < 16; ++j) { const unsigned c = xb_ld(&bar[XB_XCNT(j)]); sum += c; cnt += (c > 0u) ? 1u : 0u; mine = (j == x) ? c : mine; }
        if (sum == G) break;
        __builtin_amdgcn_s_sleep(1);
        if ((++sp & 255u) == 0u) { if (xb_ld(&bar[XB_TMO])) break; if (sp > XB_SPIN_CAP) { atomicAdd(&bar[XB_TMO], 1u); break; } }
    }
    nloc = mine > 0u ? mine : 1u; nx = cnt > 0u ? cnt : 1u;
}

__device__ __forceinline__ void xcd_barrier(const XcdBarrier& b) {
    asm volatile("s_waitcnt vmcnt(0)" ::: "memory");
    __syncthreads();
    if (threadIdx.x == 0) {
        unsigned* bar = b.bar;
        __builtin_amdgcn_s_waitcnt(0);
        unsigned nloc = b.st[0], nx = b.st[1];
        if (nloc == 0u) { xcd_barrier_complete(bar, b.x, nloc, nx); b.st[0] = nloc; b.st[1] = nx; }
        const unsigned old = xb_add(&bar[XB_XSUB(b.x)], 1u);
        const unsigned gen = old / nloc;
        if (old + 1u == (gen + 1u) * nloc) {
            __builtin_amdgcn_fence(__ATOMIC_RELEASE, "agent");
            __builtin_amdgcn_fence(__ATOMIC_ACQUIRE, "agent");
            asm volatile("s_waitcnt vmcnt(0)" ::: "memory");
            const unsigned og = xb_add(&bar[XB_TOP], 1u);
            const unsigned tg = og / nx;
            if (og + 1u == (tg + 1u) * nx) xb_add(&bar[XB_TOPGEN], 1u);
            else XB_SPIN(xb_ld(&bar[XB_TOPGEN]) == tg, bar);
        } else {
            __builtin_amdgcn_fence(__ATOMIC_ACQUIRE, "agent");
            XB_SPIN(xb_ld(&bar[XB_TOPGEN]) == gen, bar);
            asm volatile("s_waitcnt vmcnt(0)" ::: "memory");
        }
    }
    __syncthreads();
}
constexpr int NWAVES = 8;
#ifndef MK_N_LAUNCHES
#define MK_N_LAUNCHES 1
#endif
constexpr int N_PHASES = 10;
constexpr int N_LAUNCHES = MK_N_LAUNCHES;

constexpr int DM = 2048, NBATCH = 8, SEQ = 2048, MP = NBATCH * SEQ, SBATCH = 8, SLEN = 16, MS = SBATCH * SLEN, MT = MP + MS;
constexpr int NH = 4, DV = 256, DQK = 128, QKW = 1024, NG = 64, GCH = 16, PST = 64, DFF = 5632, NIN = 4104;
constexpr int CH = 64, NCH = SEQ / CH;
constexpr int NSC = NBATCH * NCH + SBATCH;
constexpr float EPS = 1e-6f;
constexpr int DVS = 64, NSL = DV / DVS;

constexpr size_t O_Y = 0, O_CONVP = (size_t)MT * DM, O_CP = O_CONVP + 8 * 3 * 1024, O_NP = O_CP + 8 * 4 * 256 * 128, O_MP = O_NP + 8 * 4 * 128,
                 O_SRP = O_MP + 32, O_SIP = O_SRP + 8 * 64 * 64, O_CONVS = O_SIP + 8 * 64 * 64, O_CS = O_CONVS + 8 * 3 * 1024, O_NS = O_CS + 8 * 4 * 256 * 128,
                 O_MS = O_NS + 8 * 4 * 128, O_SRS = O_MS + 32, O_SIS = O_SRS + 8 * 64 * 64, O_END = O_SIS + 8 * 64 * 64;
static_assert(O_END == 36102208, "d_out map");

constexpr size_t MiB = 1u << 20;
constexpr size_t WS_CTL = 0, CTL_ZERO_BYTES = 1 * MiB;
constexpr size_t WS_WIN = 2 * MiB, WS_WGLU = 18 * MiB, WS_WOUT = 20 * MiB, WS_WGU = 28 * MiB, WS_WD = 72 * MiB;
constexpr size_t WS_XN = 96 * MiB;
constexpr size_t WS_R0 = 162 * MiB, WS_RSTRIDE = 33 * MiB;
constexpr size_t WS_QKRAW = WS_R0, WS_V = WS_R0 + WS_RSTRIDE, WS_OG = WS_R0 + 2 * WS_RSTRIDE, WS_U = WS_R0 + 3 * WS_RSTRIDE;
constexpr size_t WS_Q = 294 * MiB, WS_K = 311 * MiB;
constexpr size_t WS_Z = WS_QKRAW;
constexpr size_t WS_MIXIN = WS_Q;
constexpr size_t WS_MIX = WS_R0;
constexpr size_t WS_ACT8 = WS_R0;
constexpr size_t WS_ACTS = WS_R0 + 90 * MiB;
constexpr size_t WS_X1B = WS_XN;
constexpr size_t WS_FF = 427 * MiB;
constexpr size_t WS_GATES = 378 * MiB, WS_HSS = 379 * MiB, WS_SS1 = 382 * MiB, WS_SS2 = 385 * MiB, WS_S5P = 388 * MiB, WS_SSS = 389 * MiB;
constexpr size_t WS_HS = 390 * MiB;
constexpr size_t WS_SCAL = 423 * MiB, WS_WD8 = 492 * MiB, WS_END = 504 * MiB;
static_assert(WS_XN + (size_t)MT * DM * 2 <= WS_R0 && WS_QKRAW + (size_t)MT * 1024 * 2 <= WS_V && WS_U + (size_t)MT * 1024 * 2 <= WS_Q && WS_Q + (size_t)MT * 512 * 2 <= WS_K &&
              WS_K + (size_t)MT * 512 * 2 <= WS_GATES && WS_MIXIN + (size_t)MT * DM * 2 <= WS_GATES && WS_MIX + (size_t)MT * DM * 2 <= WS_OG && WS_ACT8 + (size_t)MP * DFF <= WS_ACTS && WS_ACTS + (size_t)MS * DFF * 2 <= WS_GATES && WS_FF + (size_t)MT * DM * 2 <= WS_WD8 && WS_WD8 + (size_t)DM * DFF <= WS_END &&
              WS_WD + (size_t)DM * DFF * 2 <= WS_XN && WS_WGU + (size_t)2 * DFF * DM * 2 <= WS_WD && WS_HSS + (size_t)MT * 32 * 4 <= WS_SS1 && WS_SS1 + (size_t)MT * 32 * 4 <= WS_SS2 &&
              WS_SS2 + (size_t)MT * 32 * 4 <= WS_S5P && WS_GATES + (size_t)MT * 8 * 4 <= WS_HSS && WS_HS + (size_t)MT * 1024 * 2 <= WS_SCAL && WS_SCAL + (size_t)NSC * 4 * 384 * 4 <= WS_FF && WS_FF + (size_t)MT * DM * 2 <= WS_END, "d_ws map");
constexpr size_t S5P_LAM = 0, S5P_BBT = 64 * 1024, S5P_CC = S5P_BBT + 64 * 128 * 16 * 2;
constexpr size_t SSS_1 = 0, SSS_2 = 128 * 128 * 4, SSS_RSTD2 = 256 * 1024, SSS_RSTD1 = 384 * 1024;
constexpr int CW_TMO = 0, CW_CODE = 1, CW_BAR = 4096;
constexpr int CW_KS = 49152, CW_KS1 = CW_KS, CW_KS4 = CW_KS + 256, CW_KS5 = CW_KS4 + 64, CW_KS7 = CW_KS5 + 128, CW_KS8 = CW_KS7 + 352, CW_END = CW_KS8 + 128;
constexpr size_t WS_PARTA = 427 * MiB, WS_PARTB = 294 * MiB;
static_assert((size_t)8 * 2 * MS * DFF * 4 <= 65 * MiB && (size_t)8 * MS * 2048 * 4 <= 64 * MiB, "partial-sum arrays");

constexpr int RING_OFF = 0, RING_BYTES = 131072;
constexpr int LDSCTL_OFF = 151552, MISC_OFF = LDSCTL_OFF + 320;
constexpr int LDS_BYTES = 155648;
typedef short s16x4 __attribute__((ext_vector_type(4)));
typedef unsigned u32x2 __attribute__((ext_vector_type(2)));
struct Frame {
    LAS unsigned char* lds;
    volatile LAS unsigned* MISC;
    gu32* ctl;
    int tid, lane, wave;
    int vcu, G;
    const float* const* in;
    float* out; unsigned char* ws;
};
__device__ __forceinline__ float wave_sum(float v) {
#pragma unroll
    for (int o = 1; o < 64; o <<= 1) v += __shfl_xor(v, o);
    return v;
}
__device__ __forceinline__ unsigned cvtpk(float lo, float hi) { unsigned r; asm volatile("v_cvt_pk_bf16_f32 %0, %1, %2" : "=v"(r) : "v"(lo), "v"(hi)); return r; }
typedef __bf16 bf16x2n_t __attribute__((ext_vector_type(2)));
__device__ __forceinline__ unsigned cvtpk_n(float lo, float hi) { const bf16x2n_t v = {(__bf16)lo, (__bf16)hi}; return __builtin_bit_cast(unsigned, v); }
__device__ __forceinline__ void st_b64_hidden(const void* p, u32x2 v) { asm volatile("global_store_dwordx2 %0, %1, off" :: "v"(p), "v"(v) : "memory"); }
__device__ __forceinline__ float bflo(unsigned w) { return __uint_as_float(w << 16); }
__device__ __forceinline__ float bfhi(unsigned w) { return __uint_as_float(w & 0xffff0000u); }
__device__ __forceinline__ float bf2f(bf16 h) { return __uint_as_float((unsigned)h << 16); }
__device__ __forceinline__ float sigmoidf_(float v) { return __builtin_amdgcn_rcpf(1.0f + __expf(-v)); }
__device__ __forceinline__ f32x4 mfma16(bf16x8 a, bf16x8 b, f32x4 c) { return __builtin_amdgcn_mfma_f32_16x16x32_bf16(a, b, c, 0, 0, 0); }
#define WAVE_SYNC() do { asm volatile("s_waitcnt lgkmcnt(0)" ::: "memory"); __builtin_amdgcn_wave_barrier(); } while (0)
#define LBAR() do { asm volatile("s_waitcnt lgkmcnt(0)" ::: "memory"); __builtin_amdgcn_s_barrier(); asm volatile("" ::: "memory"); } while (0)

#ifdef MK_STAMP
#ifndef MK_STAMP_SCALE
#define MK_STAMP_SCALE 0.002f
#endif
#define DBG_DECL unsigned long long dbg_acc_ = 0, dbg_t0_ = 0;
__device__ __forceinline__ unsigned long long dbg_rt() { unsigned long long t; __builtin_amdgcn_sched_barrier(0);
#ifdef MK_STAMP_CYC
    asm volatile("s_memtime %0\n\ts_waitcnt lgkmcnt(0)" : "=s"(t) :: "memory");
#else
    asm volatile("s_memrealtime %0\n\ts_waitcnt lgkmcnt(0)" : "=s"(t) :: "memory");
#endif
 __builtin_amdgcn_sched_barrier(0); return t; }
#define DBG_BEGIN(id) do { if ((id) == MK_STAMP) dbg_t0_ = dbg_rt(); } while (0)
#define DBG_END(id) do { if ((id) == MK_STAMP) dbg_acc_ += dbg_rt() - dbg_t0_; } while (0)
#define DBG_REPORT(cond) do { if ((cond) && (threadIdx.x & 63) == 0 && (threadIdx.x >> 6) == MK_STAMP_WAVE) ((unsigned*)(A.ws + WS_CTL))[16] = (unsigned)dbg_acc_; } while (0)
#define DBG_PERTURB(V, m_) do { if ((m_) == 0 && lane == 0) V[0][0] += (float)__hip_atomic_load((unsigned*)(A.ws + WS_CTL) + 16, __ATOMIC_RELAXED, __HIP_MEMORY_SCOPE_AGENT) * MK_STAMP_SCALE; } while (0)
#else
#define DBG_DECL
#define DBG_BEGIN(id)
#define DBG_END(id)
#define DBG_REPORT(cond)
#define DBG_PERTURB(V, m_)
#endif
struct Args { const float* in[32]; float* out; unsigned char* ws; int ph_lo, ph_hi, li, pad; };
__device__ __forceinline__ int fresh_tid() { int t = threadIdx.x; asm volatile("" : "+v"(t)); return t; }
#define PHASE_IDS const int tid = fresh_tid(), lane = tid & 63; (void)tid; (void)lane;

__device__ __forceinline__ void p0_transpose_item(const float* W, int ldw, int src_col0, int k0, bf16* WT, int K, int out_row0, LAS float* scr, int lane, const float* kscale = nullptr) {
    if (kscale) {
#pragma unroll 8
        for (int i = 0; i < 32; ++i) { const int kk = 2 * i + (lane >> 5); scr[kk * 33 + (lane & 31)] = __builtin_nontemporal_load(W + (size_t)(k0 + kk) * ldw + src_col0 + (lane & 31)) * kscale[k0 + kk]; }
    } else {
#pragma unroll 8
    for (int i = 0; i < 32; ++i) { const int kk = 2 * i + (lane >> 5); scr[kk * 33 + (lane & 31)] = __builtin_nontemporal_load(W + (size_t)(k0 + kk) * ldw + src_col0 + (lane & 31)); }
    }
    LDS_WAIT(); asm volatile("" ::: "memory");
    const int c = lane & 7;
#pragma unroll
    for (int j = 0; j < 4; ++j) { const int n = (lane >> 3) + 8 * j; const LAS float* s = scr + (8 * c) * 33 + n;
        v4u o; o.x = pk2(s[0 * 33], s[1 * 33]); o.y = pk2(s[2 * 33], s[3 * 33]); o.z = pk2(s[4 * 33], s[5 * 33]); o.w = pk2(s[6 * 33], s[7 * 33]);
        *(GAS v4u*)(WT + (size_t)(out_row0 + n) * K + k0 + 8 * c) = o; }
    LDS_WAIT(); asm volatile("" ::: "memory");
}
__device__ __forceinline__ float log_sigmoid(float x) { return fminf(x, 0.f) - log1pf(__expf(-fabsf(x))); }

struct CvtItem { const float* W; int ldw, sc, k0; bf16* WT; int K, orow; const float* ks; unsigned char* W8; };
constexpr int CV_I_IN = (DM / 64) * (4096 / 32), CV_I_GLU = (1024 / 64) * (1024 / 32), CV_I_OUT = (DM / 64) * (DM / 32), CV_I_GU = (DM / 64) * (2 * DFF / 32), CV_I_D = (DFF / 64) * (DM / 32);
__device__ __forceinline__ CvtItem cvt_item(const Args& A, int it) {
    unsigned char* ws = A.ws; int r = it; CvtItem c;
    if (r < CV_I_IN) { const int nnb = 4096 / 32, kb = r / nnb, nb = r % nnb, orow = 32 * nb; c = CvtItem{A.in[9], NIN, orow < 3072 ? orow : orow + 8, 64 * kb, (bf16*)(ws + WS_WIN), DM, orow, nullptr, nullptr}; return c; } r -= CV_I_IN;
    if (r < CV_I_GLU) { const int nnb = 1024 / 32, kb = r / nnb, nb = r % nnb; c = CvtItem{A.in[23], 1024, 32 * nb, 64 * kb, (bf16*)(ws + WS_WGLU), 1024, 32 * nb, nullptr, nullptr}; return c; } r -= CV_I_GLU;
    if (r < CV_I_OUT) { const int nnb = DM / 32, kb = r / nnb, nb = r % nnb; c = CvtItem{A.in[25], DM, 32 * nb, 64 * kb, (bf16*)(ws + WS_WOUT), DM, 32 * nb, nullptr, nullptr}; return c; } r -= CV_I_OUT;
    if (r < CV_I_GU) { const int nnb = 2 * DFF / 32, kb = r / nnb, nb = r % nnb, orow = 32 * nb, pn = orow >> 8, cc = orow & 255;
        c = CvtItem{cc < 128 ? A.in[28] : A.in[29], DFF, 128 * pn + (cc & 127), 64 * kb, (bf16*)(ws + WS_WGU), DM, orow, A.in[27], nullptr}; return c; } r -= CV_I_GU;
    { const int nnb = DM / 32, kb = r / nnb, nb = r % nnb; c = CvtItem{A.in[30], DM, 32 * nb, 64 * kb, nullptr, DFF, 32 * nb, nullptr, ws + WS_WD8}; return c; }
}
__device__ __forceinline__ void p0_prologue(const Args& A, LAS unsigned char* lds, int tid, int lane, int wave, int vcu, int G) {
    unsigned char* ws = A.ws;
    LAS float* WG = (LAS float*)lds;
    LAS float* scr = (LAS float*)(lds + wave * 8448);
    const int gw = vcu * NWAVES + wave, NGW = G * NWAVES;
    { constexpr int NIT = CV_I_IN + CV_I_GLU + CV_I_OUT + CV_I_GU + CV_I_D;
      float ra[32], rb[32]; CvtItem ia, ib;
#define CV_LOAD(R, I, it_) do { I = cvt_item(A, (it_)); \
        _Pragma("unroll") for (int i = 0; i < 32; ++i) { const int kk = 2 * i + (lane >> 5); R[i] = __builtin_nontemporal_load(I.W + (size_t)(I.k0 + kk) * I.ldw + I.sc + (lane & 31)); } } while (0)
#define F8C(v_) __builtin_amdgcn_fmed3f((v_) * 1024.0f, -448.f, 448.f)
#define CV_PROC(R, I) do { \
        if (I.ks) { _Pragma("unroll") for (int i = 0; i < 32; ++i) { const int kk = 2 * i + (lane >> 5); scr[kk * 33 + (lane & 31)] = R[i] * I.ks[I.k0 + kk]; } } \
        else { _Pragma("unroll") for (int i = 0; i < 32; ++i) { const int kk = 2 * i + (lane >> 5); scr[kk * 33 + (lane & 31)] = R[i]; } } \
        LDS_WAIT(); asm volatile("" ::: "memory"); \
        { const int c = lane & 7; \
          _Pragma("unroll") for (int j = 0; j < 4; ++j) { const int n = (lane >> 3) + 8 * j; const LAS float* s = scr + (8 * c) * 33 + n; \
              v4u o; o.x = cvtpk_n(s[0 * 33], s[1 * 33]); o.y = cvtpk_n(s[2 * 33], s[3 * 33]); o.z = cvtpk_n(s[4 * 33], s[5 * 33]); o.w = cvtpk_n(s[6 * 33], s[7 * 33]); \
              if (I.WT) *(GAS v4u*)(I.WT + (size_t)(I.orow + n) * I.K + I.k0 + 8 * c) = o; \
              if (I.W8) { int w0 = 0, w1 = 0; \
                  w0 = __builtin_amdgcn_cvt_pk_fp8_f32(F8C(s[0 * 33]), F8C(s[1 * 33]), w0, false); w0 = __builtin_amdgcn_cvt_pk_fp8_f32(F8C(s[2 * 33]), F8C(s[3 * 33]), w0, true); \
                  w1 = __builtin_amdgcn_cvt_pk_fp8_f32(F8C(s[4 * 33]), F8C(s[5 * 33]), w1, false); w1 = __builtin_amdgcn_cvt_pk_fp8_f32(F8C(s[6 * 33]), F8C(s[7 * 33]), w1, true); \
                  *(GAS u32x2*)(I.W8 + (size_t)(I.orow + n) * I.K + I.k0 + 8 * c) = (u32x2){(unsigned)w0, (unsigned)w1}; } } } \
        LDS_WAIT(); asm volatile("" ::: "memory"); } while (0)
      int it = gw;
      if (it < NIT) { CV_LOAD(ra, ia, it);
          for (;;) { const int it2 = it + NGW; if (it2 < NIT) CV_LOAD(rb, ib, it2); CV_PROC(ra, ia); if (it2 >= NIT) break;
                     it = it2 + NGW; if (it < NIT) CV_LOAD(ra, ia, it); CV_PROC(rb, ib); if (it >= NIT) break; } }
#undef CV_LOAD
#undef CV_PROC
#undef F8C
    }
    { const int gt = vcu * (NWAVES * 64) + tid;
      if (gt < NG * PST) {
        const int g = gt >> 6, p = gt & 63;
        const double lr = (double)A.in[15][gt], li = (double)A.in[16][gt], dt = exp((double)A.in[17][g]);
        const double mag = exp(lr * dt), ang = li * dt, lbr = mag * cos(ang), lbi = mag * sin(ang);
        const double den = lr * lr + li * li, nr = lbr - 1.0, fre = (nr * lr + lbi * li) / den, fim = (lbi * lr - nr * li) / den;
        float* LAM = (float*)(ws + WS_S5P + S5P_LAM); LAM[gt * 2] = (float)lbr; LAM[gt * 2 + 1] = (float)lbi;
        bf16* BBT = (bf16*)(ws + WS_S5P + S5P_BBT); bf16* CC = (bf16*)(ws + WS_S5P + S5P_CC);
        const float* bre = A.in[18] + (size_t)gt * 16; const float* bim = A.in[19] + (size_t)gt * 16;
#pragma unroll
        for (int i = 0; i < 16; ++i) { const double br = bre[i], bi = bim[i];
            BBT[((size_t)g * 128 + 2 * p) * 16 + i] = (bf16)f2bf((float)(fre * br - fim * bi));
            BBT[((size_t)g * 128 + 2 * p + 1) * 16 + i] = (bf16)f2bf((float)(fre * bi + fim * br));
            CC[((size_t)g * 16 + i) * 128 + 2 * p] = (bf16)f2bf(A.in[20][((size_t)g * 16 + i) * 64 + p]);
            CC[((size_t)g * 16 + i) * 128 + 2 * p + 1] = (bf16)f2bf(-A.in[21][((size_t)g * 16 + i) * 64 + p]); }
      } }
    __syncthreads();
    { const float* win = A.in[9];
      for (int e = tid; e < 8 * 2048; e += NWAVES * 64) { const int k = e >> 3, c = e & 7; WG[c * 2048 + k] = win[(size_t)k * NIN + 3072 + c]; } }
    __syncthreads();
    { const GAS f32x4* gp = (const GAS f32x4*)A.in[8] + lane; f32x4 gv[8];
#pragma unroll
      for (int j = 0; j < 8; ++j) gv[j] = gp[64 * j];
      bf16* XN = (bf16*)(ws + WS_XN); float* GATES = (float*)(ws + WS_GATES);
      f32x4 va[8], vb[8];
#define P0R_LOAD(V, m_) do { const int mm_ = (m_); const float* xrow = mm_ < MP ? A.in[0] + (size_t)mm_ * DM : A.in[1] + (size_t)(mm_ - MP) * DM; const GAS f32x4* xr = (const GAS f32x4*)xrow + lane; \
        _Pragma("unroll") for (int j = 0; j < 8; ++j) V[j] = __builtin_nontemporal_load(xr + 64 * j); } while (0)
#define P0R_PROC(V, m_) do { const int mm_ = (m_); float s = 0.f; \
        _Pragma("unroll") for (int j = 0; j < 8; ++j) s += (V[j].x * V[j].x + V[j].y * V[j].y) + (V[j].z * V[j].z + V[j].w * V[j].w); \
        const float ms = wave_sum(s) * (1.0f / DM) + EPS, rstd = 1.0f / sqrtf(ms); \
        if (lane == 0) ((float*)(ws + WS_SSS + SSS_RSTD1))[mm_] = sqrtf(ms); \
        GAS u32x2* o8 = (GAS u32x2*)(XN + (size_t)mm_ * DM) + lane; \
        float ga[8] = {0.f, 0.f, 0.f, 0.f, 0.f, 0.f, 0.f, 0.f}; \
        _Pragma("unroll") for (int j = 0; j < 8; ++j) { V[j] = V[j] * rstd * gv[j]; u32x2 o; o.x = cvtpk(V[j].x, V[j].y); o.y = cvtpk(V[j].z, V[j].w); o8[64 * j] = o; \
            _Pragma("unroll") for (int c = 0; c < 8; ++c) { const f32x4 w = *(const LAS f32x4*)(WG + c * 2048 + 256 * j + 4 * lane); ga[c] += (V[j].x * w.x + V[j].y * w.y) + (V[j].z * w.z + V[j].w * w.w); } } \
        _Pragma("unroll") for (int c = 0; c < 8; ++c) ga[c] = wave_sum(ga[c]); \
        if (lane < 8) { float val = 0.f; \
            _Pragma("unroll") for (int c = 0; c < 8; ++c) if (lane == c) val = ga[c]; \
            if (lane < 4) val += A.in[12][lane]; else val = log_sigmoid(val + A.in[13][lane - 4]); \
            GATES[(size_t)mm_ * 8 + lane] = val; } } while (0)
      int m = gw;
      if (m < MP) P0R_LOAD(va, m);
      { LAS float* red = (LAS float*)(lds + 65536);
        for (int r = vcu; r < MS; r += G) { const int ms_ = MP + r, c0 = 256 * wave + 4 * lane;
            f32x4 xv = __builtin_nontemporal_load((const GAS f32x4*)(A.in[1] + (size_t)r * DM + c0));
            const f32x4 gs = *(const f32x4*)(A.in[8] + c0);
            const float sw = wave_sum((xv.x * xv.x + xv.y * xv.y) + (xv.z * xv.z + xv.w * xv.w));
            if (lane == 0) red[wave * 9 + 8] = sw;
            __syncthreads();
            float tot = 0.f;
#pragma unroll
            for (int w2 = 0; w2 < NWAVES; ++w2) tot += red[w2 * 9 + 8];
            const float ms = tot * (1.0f / DM) + EPS, rstd = 1.0f / sqrtf(ms);
            if (wave == 0 && lane == 0) ((float*)(ws + WS_SSS + SSS_RSTD1))[ms_] = sqrtf(ms);
            xv = xv * rstd * gs;
            { u32x2 o; o.x = cvtpk(xv.x, xv.y); o.y = cvtpk(xv.z, xv.w); *(GAS u32x2*)(XN + (size_t)ms_ * DM + c0) = o; }
            float ga[8];
#pragma unroll
            for (int c = 0; c < 8; ++c) { const f32x4 w = *(const LAS f32x4*)(WG + c * 2048 + c0); ga[c] = wave_sum((xv.x * w.x + xv.y * w.y) + (xv.z * w.z + xv.w * w.w)); }
            if (lane == 0) {
#pragma unroll
                for (int c = 0; c < 8; ++c) red[wave * 9 + c] = ga[c]; }
            __syncthreads();
            if (wave == 0 && lane < 8) { float val = 0.f;
#pragma unroll
                for (int w2 = 0; w2 < NWAVES; ++w2) val += red[w2 * 9 + lane];
                if (lane < 4) val += A.in[12][lane]; else val = log_sigmoid(val + A.in[13][lane - 4]);
                GATES[(size_t)ms_ * 8 + lane] = val; }
            __syncthreads(); } }
      if (m < MP) {
          for (;;) { const int m2 = m + NGW; if (m2 < MP) P0R_LOAD(vb, m2); P0R_PROC(va, m); if (m2 >= MP) break;
                     m = m2 + NGW; if (m < MP) P0R_LOAD(va, m); P0R_PROC(vb, m2); if (m >= MP) break; } }
#undef P0R_LOAD
#undef P0R_PROC
    }
}

template <int NACC, int K, int RBN = 8, class RowMap, class Epi>
__device__ __forceinline__ void skinny_gemm(const bf16* Arows, const bf16* Bt, LAS unsigned char* lds, int nitems, int first, int stride, int tid, int wave, int lane, RowMap rm, Epi epi) {
    const int fr = lane & 15, fq = lane >> 4;
    constexpr int KW = K / 8, NS = KW / 32, NSPLIT = 8 / RBN;
    static_assert(KW % 32 == 0, "skinny_gemm: K must be a multiple of 256");
    const bf16* abase = Arows + (size_t)fr * K + wave * KW + 16 * fq;
    LAS f32x4* red = (LAS f32x4*)lds;
    for (int piece = first; piece < nitems * NSPLIT; piece += stride) {
        const int it = piece / NSPLIT, rh = piece % NSPLIT;
        const bf16* brow[NACC]; f32x4 acc[NACC][RBN];
#pragma unroll
        for (int a = 0; a < NACC; ++a) { brow[a] = Bt + (size_t)rm(it, a, fr) * K + wave * KW + 16 * fq;
#pragma unroll
            for (int rb = 0; rb < RBN; ++rb) acc[a][rb] = (f32x4){0.f, 0.f, 0.f, 0.f}; }
        const bf16* ab = abase + (size_t)(16 * RBN * rh) * K;
        { constexpr int UN = 2, NSET = NS / UN, FR = UN * (RBN + NACC), R0 = 48 / FR, R = R0 < 2 ? 2 : (R0 > NSET ? NSET : R0);
          static_assert(NS % UN == 0 && NSET >= 2, "skinny_gemm: an even number (>= 4) of 32-deep steps per wave");
          bf16x8 av[R][UN][RBN], bv[R][UN][NACC];
#define SK_LOAD(q_) do { _Pragma("unroll") for (int a = 0; a < NACC; ++a) _Pragma("unroll") for (int u = 0; u < UN; ++u) bv[(q_) % R][u][a] = *(const bf16x8*)(brow[a] + 64 * (q_) + 8 * u); \
              _Pragma("unroll") for (int rb = 0; rb < RBN; ++rb) _Pragma("unroll") for (int u = 0; u < UN; ++u) av[(q_) % R][u][rb] = *(const bf16x8*)(ab + (size_t)(16 * rb) * K + 64 * (q_) + 8 * u); } while (0)
#pragma unroll
          for (int q = 0; q < R - 1; ++q) SK_LOAD(q);
          __builtin_amdgcn_sched_barrier(0);
#pragma unroll
          for (int q = 0; q < NSET; ++q) {
              if (q + R - 1 < NSET) SK_LOAD(q + R - 1);
              __builtin_amdgcn_sched_barrier(0);
#pragma unroll
              for (int u = 0; u < UN; ++u)
#pragma unroll
                  for (int rb = 0; rb < RBN; ++rb)
#pragma unroll
                      for (int a = 0; a < NACC; ++a) acc[a][rb] = mfma16(bv[q % R][u][a], av[q % R][u][rb], acc[a][rb]);
              __builtin_amdgcn_sched_barrier(0);
          }
#undef SK_LOAD
        }
#pragma unroll
        for (int a = 0; a < NACC; ++a)
#pragma unroll
            for (int rb = 0; rb < RBN; ++rb) red[((a * 8 + wave) * RBN + rb) * 64 + lane] = acc[a][rb];
        __syncthreads();
        if (wave < RBN) {
            f32x4 fin[NACC];
#pragma unroll
            for (int a = 0; a < NACC; ++a) { f32x4 t = red[((a * 8 + 0) * RBN + wave) * 64 + lane];
#pragma unroll
                for (int w2 = 1; w2 < 8; ++w2) t += red[((a * 8 + w2) * RBN + wave) * 64 + lane];
                fin[a] = t; }
            epi(it, 16 * (RBN * rh + wave) + fr, fq, fin);
        }
        __syncthreads();
    }
}

template <int NACC, int K, int S, int NMAX  , bool W8 = false  , class RowMap, class Epi>
__device__ __forceinline__ void skinny_ks(const bf16* Arows, const bf16* Bt, float* PART, int ldacc, unsigned* CNT, LAS unsigned char* lds, int ncb, int vcu, int G, int wave, int lane, RowMap rm, Epi epi) {
    constexpr int KS = K / S, NS = KS / 32, NF = NACC * NS, FPW = (NF + 7) / 8;
    static_assert(K % (32 * S) == 0, "skinny_ks: K must be a multiple of 32 S");
    const int fr = lane & 15, fq = lane >> 4;
    const int sl = vcu % S, j = vcu / S, nj = (G - sl + S - 1) / S;
    const int nmine0 = (j < ncb) ? (ncb - j + nj - 1) / nj : 0, nmine = nmine0 < NMAX ? nmine0 : NMAX;
    const size_t koff = (size_t)sl * KS + 8 * fq;
    bf16x8 af[NS];
    { const bf16* ap = Arows + (size_t)(16 * wave + fr) * K + koff;
#pragma unroll
      for (int s2 = 0; s2 < NS; ++s2) af[s2] = *(const bf16x8*)(ap + 32 * s2); }
    LAS bf16x8* fb = (LAS bf16x8*)lds;
    LAS unsigned* flag = (LAS unsigned*)(lds + 2 * NF * 1024);
    const __amdgpu_buffer_rsrc_t prs = __builtin_amdgcn_make_buffer_rsrc((void*)PART, 0, 0x7FFFFFFF, 0x00020000);
    const unsigned rowoff = (unsigned)((16 * wave + fr) * ldacc + 4 * fq) * 4u, astr = (unsigned)(MS * ldacc) * 4u;
    bf16x8 pre[NMAX][FPW];
#pragma unroll
    for (int i = 0; i < NMAX; ++i) if (i < nmine) {
#pragma unroll
        for (int i2 = 0; i2 < FPW; ++i2) { const int f = wave + 8 * i2; if (f < NF) { const int a = f / NS, s2 = f % NS;
            if constexpr (W8) { const u32x2 r8 = *(const GAS u32x2*)((const unsigned char*)Bt + (size_t)rm(j + nj * i, a, fr) * K + koff + 32 * s2); pre[i][i2] = __builtin_bit_cast(bf16x8, (v4u){r8.x, r8.y, 0u, 0u}); }
            else pre[i][i2] = *(const bf16x8*)(Bt + (size_t)rm(j + nj * i, a, fr) * K + koff + 32 * s2); } } }
    __builtin_amdgcn_sched_barrier(0);
#pragma unroll
    for (int i = 0; i < NMAX; ++i) if (i < nmine) {
        const int cb = j + nj * i, buf = i & 1;
#pragma unroll
        for (int i2 = 0; i2 < FPW; ++i2) { const int f = wave + 8 * i2; if (f < NF) { bf16x8 fv = pre[i][i2];
            if constexpr (W8) { const v4u r8 = __builtin_bit_cast(v4u, fv); typedef float f32x2w __attribute__((ext_vector_type(2)));
                const f32x2w p0 = __builtin_amdgcn_cvt_pk_f32_fp8((int)r8.x, false), p1 = __builtin_amdgcn_cvt_pk_f32_fp8((int)r8.x, true), p2 = __builtin_amdgcn_cvt_pk_f32_fp8((int)r8.y, false), p3 = __builtin_amdgcn_cvt_pk_f32_fp8((int)r8.y, true);
                fv = __builtin_bit_cast(bf16x8, (v4u){cvtpk_n(p0[0], p0[1]), cvtpk_n(p1[0], p1[1]), cvtpk_n(p2[0], p2[1]), cvtpk_n(p3[0], p3[1])}); }
            fb[(buf * NF + f) * 64 + lane] = fv; } }
        LBAR();
#pragma unroll
        for (int a = 0; a < NACC; ++a) { f32x4 acc = (f32x4){0.f, 0.f, 0.f, 0.f};
#pragma unroll
            for (int s2 = 0; s2 < NS; ++s2) acc = mfma16(fb[(buf * NF + a * NS + s2) * 64 + lane], af[s2], acc);
            if constexpr (W8) acc = acc * 0.0009765625f;
            __builtin_amdgcn_raw_buffer_store_b128(__builtin_bit_cast(v4u, acc), prs, (unsigned)(sl * NACC + a) * astr + rowoff + (unsigned)cb * 64u, 0, 16); }
    }
    VM_WAIT();
    __syncthreads();
    if (wave == 0) { unsigned last = 0u;
        if (lane < nmine) last = (__hip_atomic_fetch_add(CNT + j + nj * lane, 1u, __ATOMIC_RELAXED, __HIP_MEMORY_SCOPE_AGENT) == (unsigned)(S - 1)) ? 1u : 0u;
        const unsigned long long m = __ballot(last != 0u);
        if (lane == 0) { flag[0] = (unsigned)m; flag[1] = (unsigned)(m >> 32); } }
    __syncthreads();
    unsigned long long m = ((unsigned long long)flag[1] << 32) | flag[0];
    while (m) { const int i = __builtin_ctzll(m); m &= m - 1; const int cb = j + nj * i;
        f32x4 fin[NACC];
#pragma unroll
        for (int a = 0; a < NACC; ++a) { v4u p[S];
#pragma unroll
            for (int s2 = 0; s2 < S; ++s2) p[s2] = __builtin_amdgcn_raw_buffer_load_b128(prs, (unsigned)(s2 * NACC + a) * astr + rowoff + (unsigned)cb * 64u, 0, 16);
            f32x4 t = __builtin_bit_cast(f32x4, p[0]);
#pragma unroll
            for (int s2 = 1; s2 < S; ++s2) t += __builtin_bit_cast(f32x4, p[s2]);
            fin[a] = t; }
        epi(cb, 16 * wave + fr, fq, fin); }
    __syncthreads();
}

__device__ __forceinline__ void p2_scalars(const Args& A, LAS unsigned char* lds, int lane, int wave, int item) {
    unsigned char* ws = A.ws;
    const float* GATES = (const float*)(ws + WS_GATES); float* SCAL = (float*)(ws + WS_SCAL);
    const int seq = item >> 2, h = item & 3; const bool sample = seq >= NBATCH; const int b = sample ? seq - NBATCH : seq;
    const int nch = sample ? 1 : NCH, L = sample ? SLEN : CH, row0 = sample ? MP + b * SLEN : b * SEQ, sc0 = sample ? NBATCH * NCH + b : b * NCH;
    LAS float* fl = (LAS float*)lds;
    float fc[4], a[4], pm[4];
#pragma unroll
    for (int i = 0; i < 4; ++i) { const int c = 4 * wave + i; float li = -INFINITY, lf = 0.f;
        if (c < nch && lane < L) { li = GATES[((size_t)row0 + c * CH + lane) * 8 + h]; lf = GATES[((size_t)row0 + c * CH + lane) * 8 + 4 + h]; }
        float f = lf;
#pragma unroll
        for (int d = 1; d < 64; d <<= 1) { const float o = __shfl_up(f, d); if (lane >= d) f += o; }
        const float aa = li - f; float p = aa;
#pragma unroll
        for (int d = 1; d < 64; d <<= 1) { const float o = __shfl_up(p, d); if (lane >= d) p = fmaxf(p, o); }
        fc[i] = f; a[i] = aa; pm[i] = p;
        if (lane == 63) { fl[c] = f; fl[32 + c] = p; } }
    __syncthreads();
    float m0c = 0.f, m0 = sample ? A.in[5][b * NH + h] : 0.f;
    for (int c = 0; c < nch; ++c) { if (lane == c) m0c = m0; m0 = fl[c] + fmaxf(fl[32 + c], m0); }
#pragma unroll
    for (int i = 0; i < 4; ++i) { const int c = 4 * wave + i;
        if (c < nch) { const float m0i = __shfl(m0c, c); const float mm = fmaxf(pm[i], m0i), mml = __shfl(mm, 63);
            float* o = SCAL + ((size_t)(sc0 + c) * 4 + h) * 384;
            o[lane] = a[i]; o[64 + lane] = mm; o[128 + lane] = __expf(m0i - mm); o[192 + lane] = __expf(-(fc[i] + mm)); o[256 + lane] = __expf(a[i] - mml);
            o[320 + lane] = (lane == 0) ? __expf(m0i - mml) : (__shfl(fc[i], 63) + mml); } }
    if (wave == 0 && lane == 0) A.out[(sample ? O_MS : O_MP) + b * NH + h] = m0;
    __syncthreads();
}
__device__ __forceinline__ void p2_conv(const Args& A, int tid, int vcu, int G) {
    unsigned char* ws = A.ws;
    const bf16* QKRAW = (const bf16*)(ws + WS_QKRAW); bf16* Q = (bf16*)(ws + WS_Q); bf16* Kb = (bf16*)(ws + WS_K);
    const int nthreads = G * NWAVES * 64, NITEM = (MT / 8) * 128;
    for (int rnd = 0; rnd * nthreads < NITEM; ++rnd) {
        const int rem = NITEM - rnd * nthreads, nblk = (rem + NWAVES * 64 - 1) / (NWAVES * 64);
        const int vb = (rem < nthreads && nblk + 64 <= G) ? vcu - 64 : vcu;
        if (vb < 0) continue;
        const int it = rnd * nthreads + vb * (NWAVES * 64) + tid; if (it >= NITEM) continue;
        const int rb = it >> 7, ch = it & 127, rs = 8 * rb, col = 8 * ch;
        bool first, sample = rs >= MP; int b, tl, Lseq;
        if (!sample) { b = rs / SEQ; tl = rs % SEQ; Lseq = SEQ; } else { b = (rs - MP) / SLEN; tl = (rs - MP) % SLEN; Lseq = SLEN; }
        first = (tl == 0);
        float w[4][8], bc[8];
#pragma unroll
        for (int j = 0; j < 4; ++j) { const f32x4 a0 = *(const f32x4*)(A.in[10] + j * 1024 + col), a1 = *(const f32x4*)(A.in[10] + j * 1024 + col + 4);
            w[j][0] = a0[0]; w[j][1] = a0[1]; w[j][2] = a0[2]; w[j][3] = a0[3]; w[j][4] = a1[0]; w[j][5] = a1[1]; w[j][6] = a1[2]; w[j][7] = a1[3]; }
        { const f32x4 a0 = *(const f32x4*)(A.in[11] + col), a1 = *(const f32x4*)(A.in[11] + col + 4);
          bc[0] = a0[0]; bc[1] = a0[1]; bc[2] = a0[2]; bc[3] = a0[3]; bc[4] = a1[0]; bc[5] = a1[1]; bc[6] = a1[2]; bc[7] = a1[3]; }
        v4u raw[11];
#pragma unroll
        for (int r = 0; r < 11; ++r) { if (r >= 3 || !first) raw[r] = *(const GAS v4u*)(QKRAW + (size_t)(rs + r - 3) * 1024 + col); else raw[r] = (v4u){0u, 0u, 0u, 0u}; }
        float x0[8], x1[8], x2[8];
#define UNPK(dst, v) do { dst[0] = bflo(v.x); dst[1] = bfhi(v.x); dst[2] = bflo(v.y); dst[3] = bfhi(v.y); dst[4] = bflo(v.z); dst[5] = bfhi(v.z); dst[6] = bflo(v.w); dst[7] = bfhi(v.w); } while (0)
        if (first && sample) {
            const float* sp = A.in[2] + (size_t)b * 3 * 1024 + col;
#pragma unroll
            for (int i = 0; i < 8; ++i) { x0[i] = sp[i]; x1[i] = sp[1024 + i]; x2[i] = sp[2048 + i]; }
        } else { UNPK(x0, raw[0]); UNPK(x1, raw[1]); UNPK(x2, raw[2]); }
#pragma unroll
        for (int r = 0; r < 8; ++r) {
            float x3[8]; UNPK(x3, raw[r + 3]);
            float o[8];
#pragma unroll
            for (int i = 0; i < 8; ++i) { const float val = bc[i] + w[0][i] * x0[i] + w[1][i] * x1[i] + w[2][i] * x2[i] + w[3][i] * x3[i]; o[i] = val * sigmoidf_(val); }
            const size_t row = (size_t)rs + r;
            if (ch < 64) {
#pragma unroll
                for (int i = 0; i < 8; ++i) o[i] *= 0.08838834764831845f;
                v4u pk; pk.x = cvtpk(o[0], o[1]); pk.y = cvtpk(o[2], o[3]); pk.z = cvtpk(o[4], o[5]); pk.w = cvtpk(o[6], o[7]);
                *(GAS v4u*)(Q + row * 512 + col) = pk;
            } else {
                v4u pk; pk.x = cvtpk(o[0], o[1]); pk.y = cvtpk(o[2], o[3]); pk.z = cvtpk(o[4], o[5]); pk.w = cvtpk(o[6], o[7]);
                *(GAS v4u*)(Kb + row * 512 + (col - 512)) = pk;
            }
            const int tt = tl + r;
            if (tt >= Lseq - 3) { float* cv = A.out + (sample ? O_CONVS : O_CONVP) + ((size_t)b * 3 + (tt - (Lseq - 3))) * 1024 + col;
                *(f32x4*)cv = (f32x4){x3[0], x3[1], x3[2], x3[3]}; *(f32x4*)(cv + 4) = (f32x4){x3[4], x3[5], x3[6], x3[7]}; }
#pragma unroll
            for (int i = 0; i < 8; ++i) { x0[i] = x1[i]; x1[i] = x2[i]; x2[i] = x3[i]; }
        }
#undef UNPK
    }
}
constexpr int ML_QS = 0, ML_KS = 17408, ML_VS = 34816, ML_SC = 46080, ML_SET = 47616, ML_SS = 2 * ML_SET, ML_CB = ML_SS + 9216, ML_CBSZ = 21760;
static_assert(ML_CB + 2 * ML_CBSZ <= LDSCTL_OFF, "mLSTM LDS map");
constexpr int SC_A = 0, SC_MM = 64, SC_GI = 128, SC_EN = 192, SC_WS = 256, SC_MISC = 320;
__device__ __forceinline__ bf16x8 ldsfrag(const LAS unsigned char* p) { return *(const LAS bf16x8*)p; }
typedef __attribute__((address_space(3))) s16x4 lds_s16x4;
__device__ __forceinline__ bf16x8 trfrag(const LAS unsigned char* tile, int stride, int k0, int c0, int lane) {
    const int g = lane >> 4, q = (lane & 15) >> 2, p = lane & 3;
    const LAS unsigned char* a0 = tile + (k0 + 8 * g + q) * stride + (c0 + 4 * p) * 2;
    const s16x4 lo = __builtin_amdgcn_ds_read_tr16_b64_v4i16((lds_s16x4*)a0), hi = __builtin_amdgcn_ds_read_tr16_b64_v4i16((lds_s16x4*)(a0 + 4 * stride));
    return (bf16x8){lo[0], lo[1], lo[2], lo[3], hi[0], hi[1], hi[2], hi[3]};
}

__device__ __forceinline__ void mlstm_item(const Args& A, LAS unsigned char* lds, int tid, int lane, int wave, int item) {
    DBG_DECL
    unsigned char* ws = A.ws;
    const int fr = lane & 15, fq = lane >> 4;
    const bool sample = item >= NBATCH * NH * NSL; const int ii = sample ? item - NBATCH * NH * NSL : item;
    const int b = ii / (NH * NSL), h = (ii / NSL) % NH, sl = ii % NSL;
    const int nch = sample ? 1 : NCH, L = sample ? SLEN : CH;
    const int row0 = sample ? MP + b * SLEN : b * SEQ, sc0 = sample ? NBATCH * NCH + b : b * NCH;
    const bf16* Qg = (const bf16*)(ws + WS_Q); const bf16* Kg = (const bf16*)(ws + WS_K); const bf16* Vg = (const bf16*)(ws + WS_V);
    const float* SCAL = (const float*)(ws + WS_SCAL); bf16* HS = (bf16*)(ws + WS_HS); float* HSS = (float*)(ws + WS_HSS);
    if (tid < 256) { const int r = (tid >> 1) & 63, hf = tid & 1, st = tid >> 7; *(LAS v4u*)(lds + st * ML_SET + ML_VS + r * 176 + 128 + 16 * hf) = (v4u){hf == 0 ? 0x00003F80u : 0u, 0u, 0u, 0u}; }
    const int whs = wave >> 2;
#define VBM(li) ((li) == 4 ? 4 : ((li) < 2 ? 2 * whs + (li) : 2 * (1 - whs) + (li) - 2))
    f32x4 Cst[5];
    if (sample) {
        const float* c0 = A.in[3] + ((size_t)(b * NH + h) * DV + DVS * sl) * DQK; const float* n0 = A.in[4] + (size_t)(b * NH + h) * DQK;
#pragma unroll
        for (int vb = 0; vb < 4; ++vb) Cst[vb] = *(const f32x4*)(c0 + (size_t)(16 * VBM(vb) + fr) * DQK + 16 * wave + 4 * fq);
        Cst[4] = (fr == 0) ? *(const f32x4*)(n0 + 16 * wave + 4 * fq) : (f32x4){0.f, 0.f, 0.f, 0.f};
    } else {
#pragma unroll
        for (int vb = 0; vb < 5; ++vb) Cst[vb] = (f32x4){0.f, 0.f, 0.f, 0.f};
    }
#pragma unroll
    for (int vb = 0; vb < 5; ++vb) { u32x2 w; w.x = cvtpk_n(Cst[vb][0], Cst[vb][1]); w.y = cvtpk_n(Cst[vb][2], Cst[vb][3]); *(LAS u32x2*)(lds + ML_CB + (16 * VBM(vb) + fr) * 272 + (16 * wave + 4 * fq) * 2) = w; }
    v4u pq[2], pk[2], pv; f32x4 psc = (f32x4){0.f, 0.f, 0.f, 0.f};
#define ML_ISSUE(c_) do { \
        const size_t r0_ = (size_t)row0 + (size_t)(c_) * CH; \
        _Pragma("unroll") for (int i = 0; i < 2; ++i) { const int e = tid + 512 * i, r = e >> 4, ch = e & 15; \
            if (r < L) { pq[i] = *(const GAS v4u*)(Qg + (r0_ + r) * 512 + 128 * h + 8 * ch); pk[i] = *(const GAS v4u*)(Kg + (r0_ + r) * 512 + 128 * h + 8 * ch); } \
            else { pq[i] = (v4u){0u, 0u, 0u, 0u}; pk[i] = (v4u){0u, 0u, 0u, 0u}; } } \
        { const int r = tid >> 3, ch = tid & 7; if (r < L) pv = *(const GAS v4u*)(Vg + (r0_ + r) * 1024 + DV * h + DVS * sl + 8 * ch); else pv = (v4u){0u, 0u, 0u, 0u}; } \
        if (tid < 96) psc = *(const GAS f32x4*)(SCAL + ((size_t)(sc0 + (c_)) * 4 + h) * 384 + 4 * tid); \
    } while (0)
#define ML_COMMIT(so_) do { LAS unsigned char* wl_ = lds + (so_); \
        _Pragma("unroll") for (int i = 0; i < 2; ++i) { const int e = tid + 512 * i, r = e >> 4, ch = e & 15; \
            *(LAS v4u*)(wl_ + ML_QS + r * 272 + ch * 16) = pq[i]; *(LAS v4u*)(wl_ + ML_KS + r * 272 + ch * 16) = pk[i]; } \
        { const int r = tid >> 3, ch = tid & 7; *(LAS v4u*)(wl_ + ML_VS + r * 176 + ch * 16) = pv; } \
        if (tid < 96) *(LAS f32x4*)((LAS float*)(wl_ + ML_SC) + 4 * tid) = psc; \
    } while (0)
    ML_ISSUE(0); ML_COMMIT(0);
    LBAR();
    const int tb = wave & 3, wh = wave >> 2, t = 16 * tb + fr;
    u32x2 hsw[2] = {(u32x2){0u, 0u}, (u32x2){0u, 0u}}; float hsp = 0.f;
#define ML_FLUSH(c_) do { const size_t grow = (size_t)row0 + (size_t)(c_) * CH + t; \
        if (t < L) { *(GAS u32x2*)(HS + grow * 1024 + h * DV + DVS * sl + 16 * (2 * wh) + 4 * fq) = hsw[0]; *(GAS u32x2*)(HS + grow * 1024 + h * DV + DVS * sl + 16 * (2 * wh + 1) + 4 * fq) = hsw[1]; \
                     if (fq == 0) HSS[grow * 32 + h * 8 + sl * 2 + wh] = hsp; } } while (0)
    DBG_BEGIN(8);
    for (int c = 0; c < nch; ++c) {
        if (c + 1 < nch) ML_ISSUE(c + 1);
        if (c > 0) ML_FLUSH(c - 1);
        const LAS unsigned char* cbr = lds + ML_CB + (c & 1) * ML_CBSZ; LAS unsigned char* cbw = lds + ML_CB + ((c + 1) & 1) * ML_CBSZ;
        const LAS unsigned char* tl = lds + (c & 1) * ML_SET; const LAS float* SC = (const LAS float*)(tl + ML_SC);
        DBG_BEGIN(4);
        bf16x8 qf[4];
#pragma unroll
        for (int ks = 0; ks < 4; ++ks) qf[ks] = ldsfrag(tl + ML_QS + t * 272 + ks * 64 + fq * 16);
        { bf16x8 kf[2][4];
#pragma unroll
          for (int i = 0; i < 2; ++i)
#pragma unroll
              for (int ks = 0; ks < 4; ++ks) kf[i][ks] = ldsfrag(tl + ML_KS + (16 * (2 * wh + i) + fr) * 272 + ks * 64 + fq * 16);
          const float mmt = SC[SC_MM + t]; f32x4 a4[2];
#pragma unroll
          for (int i = 0; i < 2; ++i) a4[i] = *(const LAS f32x4*)(SC + SC_A + 16 * (2 * wh + i) + 4 * fq);
          f32x4 g[2] = {(f32x4){0.f, 0.f, 0.f, 0.f}, (f32x4){0.f, 0.f, 0.f, 0.f}};
#pragma unroll
          for (int ks = 0; ks < 4; ++ks)
#pragma unroll
              for (int i = 0; i < 2; ++i) g[i] = mfma16(kf[i][ks], qf[ks], g[i]);
#pragma unroll
          for (int i = 0; i < 2; ++i) { const int s0 = 16 * (2 * wh + i) + 4 * fq; float v[4];
#pragma unroll
              for (int r = 0; r < 4; ++r) v[r] = (s0 + r <= t) ? g[i][r] * __expf(a4[i][r] - mmt) : 0.f;
              u32x2 w; w.x = cvtpk_n(v[0], v[1]); w.y = cvtpk_n(v[2], v[3]); *(LAS u32x2*)(lds + ML_SS + t * 144 + s0 * 2) = w; } }
        DBG_END(4);
        LBAR();
        DBG_BEGIN(5);
        bf16x8 vf[3][2];
        { bf16x8 sf[2], cf[3][4];
#pragma unroll
          for (int ks = 0; ks < 2; ++ks) sf[ks] = ldsfrag(lds + ML_SS + t * 144 + ks * 64 + fq * 16);
#pragma unroll
          for (int i = 0; i < 3; ++i) { const int vb = (i == 2) ? 4 : 2 * wh + i;
#pragma unroll
              for (int ks = 0; ks < 2; ++ks) vf[i][ks] = trfrag(tl + ML_VS, 176, 32 * ks, 16 * vb, lane);
#pragma unroll
              for (int ks = 0; ks < 4; ++ks) cf[i][ks] = ldsfrag(cbr + (16 * vb + fr) * 272 + ks * 64 + fq * 16); }
          const float git = SC[SC_GI + t], ent = SC[SC_EN + t];
          f32x4 ai[3], ae[3];
#pragma unroll
          for (int i = 0; i < 3; ++i) { ai[i] = (f32x4){0.f, 0.f, 0.f, 0.f}; ae[i] = (f32x4){0.f, 0.f, 0.f, 0.f}; }
#pragma unroll
          for (int ks = 0; ks < 4; ++ks)
#pragma unroll
              for (int i = 0; i < 3; ++i) { ae[i] = mfma16(cf[i][ks], qf[ks], ae[i]); if (ks < 2) ai[i] = mfma16(vf[i][ks], sf[ks], ai[i]); }
          f32x4 hh[3];
#pragma unroll
          for (int i = 0; i < 3; ++i) hh[i] = ai[i] + ae[i] * git;
          const float den = __shfl(hh[2][0], fr);
          const float isc = 1.0f / fmaxf(fabsf(den), ent); float p = 0.f;
#pragma unroll
          for (int i = 0; i < 2; ++i) { const f32x4 o = hh[i] * isc; p += (o[0] * o[0] + o[1] * o[1]) + (o[2] * o[2] + o[3] * o[3]);
              hsw[i].x = cvtpk_n(o[0], o[1]); hsw[i].y = cvtpk_n(o[2], o[3]); }
          p += __shfl_xor(p, 16); p += __shfl_xor(p, 32); hsp = p; }
        DBG_END(5); DBG_BEGIN(6);
        { const float decay = SC[SC_MISC];
          bf16x8 kw[2], vo[2][2];
#pragma unroll
          for (int i = 0; i < 2; ++i)
#pragma unroll
              for (int ks = 0; ks < 2; ++ks) vo[i][ks] = trfrag(tl + ML_VS, 176, 32 * ks, 16 * VBM(2 + i), lane);
#pragma unroll
          for (int ks = 0; ks < 2; ++ks) { const v4u kr = __builtin_bit_cast(v4u, trfrag(tl + ML_KS, 272, 32 * ks, 16 * wave, lane));
              const f32x4 w0 = *(const LAS f32x4*)(SC + SC_WS + 32 * ks + 8 * fq), w1 = *(const LAS f32x4*)(SC + SC_WS + 32 * ks + 8 * fq + 4);
              v4u o; o.x = cvtpk_n(bflo(kr.x) * w0[0], bfhi(kr.x) * w0[1]); o.y = cvtpk_n(bflo(kr.y) * w0[2], bfhi(kr.y) * w0[3]); o.z = cvtpk_n(bflo(kr.z) * w1[0], bfhi(kr.z) * w1[1]); o.w = cvtpk_n(bflo(kr.w) * w1[2], bfhi(kr.w) * w1[3]);
              kw[ks] = __builtin_bit_cast(bf16x8, o); }
#pragma unroll
          for (int vb = 0; vb < 5; ++vb) Cst[vb] = Cst[vb] * decay;
#pragma unroll
          for (int ks = 0; ks < 2; ++ks) { Cst[0] = mfma16(kw[ks], vf[0][ks], Cst[0]); Cst[1] = mfma16(kw[ks], vf[1][ks], Cst[1]); Cst[2] = mfma16(kw[ks], vo[0][ks], Cst[2]); Cst[3] = mfma16(kw[ks], vo[1][ks], Cst[3]); Cst[4] = mfma16(kw[ks], vf[2][ks], Cst[4]); }
#pragma unroll
          for (int vb = 0; vb < 5; ++vb) { u32x2 w; w.x = cvtpk_n(Cst[vb][0], Cst[vb][1]); w.y = cvtpk_n(Cst[vb][2], Cst[vb][3]); *(LAS u32x2*)(cbw + (16 * VBM(vb) + fr) * 272 + (16 * wave + 4 * fq) * 2) = w; } }
        DBG_END(6);
        DBG_BEGIN(7);
        if (c + 1 < nch) ML_COMMIT(((c + 1) & 1) * ML_SET);
        DBG_END(7);
        LBAR();
    }
    DBG_END(8); DBG_REPORT(item == 0);
    ML_FLUSH(nch - 1);
    { float* co = A.out + (sample ? O_CS : O_CP) + ((size_t)(b * NH + h) * DV + DVS * sl) * DQK;
#pragma unroll
      for (int vb = 0; vb < 4; ++vb) *(f32x4*)(co + (size_t)(16 * VBM(vb) + fr) * DQK + 16 * wave + 4 * fq) = Cst[vb];
      if (sl == 0 && fr == 0) *(f32x4*)(A.out + (sample ? O_NS : O_NP) + (size_t)(b * NH + h) * DQK + 16 * wave + 4 * fq) = Cst[4]; }
    LBAR();
#undef ML_ISSUE
#undef ML_FLUSH
#undef ML_COMMIT
#undef VBM
}

__device__ __forceinline__ float gelu_tanh(float y) { const float t = y * y, p = fmaf(t, 0.044715f, 1.0f);
    const float e = __builtin_amdgcn_exp2f(y * p * -2.302208198f); return y * __builtin_amdgcn_rcpf(1.0f + e); }
typedef float f32x2 __attribute__((ext_vector_type(2)));
__device__ __forceinline__ void s5_item(const Args& A, LAS unsigned char* slds, int lane, int role, int item) {
    DBG_DECL
    unsigned char* ws = A.ws;
    const int fr = lane & 15, fq = lane >> 4;
    const bool sample = item >= NBATCH * NG; const int ii = sample ? item - NBATCH * NG : item;
    const int b = ii / NG, g = ii % NG;
    const int T = sample ? SLEN : SEQ, row0 = sample ? MP + b * SLEN : b * SEQ;
    const bf16* U = (const bf16*)(ws + WS_U); bf16* Z = (bf16*)(ws + WS_Z);
    const float* LAM = (const float*)(ws + WS_S5P + S5P_LAM); const bf16* BBT = (const bf16*)(ws + WS_S5P + S5P_BBT); const bf16* CC = (const bf16*)(ws + WS_S5P + S5P_CC);
    const bf16x8 zf = (bf16x8){0, 0, 0, 0, 0, 0, 0, 0}; const f32x4 z4 = (f32x4){0.f, 0.f, 0.f, 0.f};
    const int nblk = T / 16;
    const bf16* ubase = U + (size_t)(row0 + fr) * 1024 + 16 * g + 8 * (fq & 1);
#define S5_LOADU(k_) (*(const bf16x8*)(ubase + (size_t)((k_) < nblk ? (k_) : nblk - 1) * 16 * 1024))
#define S5_BU(P_) ((LAS float*)(slds + (P_) * 8448))
#define S5_SB(P_) ((LAS bf16*)(slds + 16896 + (P_) * 4352))
    if (role == 0) {
        bf16x8 bbA[8];
#pragma unroll
        for (int rb = 0; rb < 8; ++rb) bbA[rb] = (fq < 2) ? *(const bf16x8*)(BBT + ((size_t)g * 128 + 16 * rb + fr) * 16 + 8 * fq) : zf;
        const float lr = LAM[(g * 64 + lane) * 2], li = LAM[(g * 64 + lane) * 2 + 1];
        float sr, si;
        if (sample) { sr = A.in[6][(size_t)(b * NG + g) * PST + lane]; si = A.in[7][(size_t)(b * NG + g) * PST + lane]; } else { sr = 0.f; si = 0.f; }
        bf16x8 ub = S5_LOADU(0), uc = S5_LOADU(1), ud = S5_LOADU(2);
#pragma unroll
        for (int rb = 0; rb < 8; ++rb) { const f32x4 d = mfma16(bbA[rb], ub, z4); *(LAS f32x4*)(S5_BU(0) + fr * 132 + 16 * rb + 4 * fq) = d; }
        LBAR();
#define S5_ITER_A(k_, P_) do { const int k = (k_); DBG_BEGIN(1); \
            f32x4 d[8]; \
            _Pragma("unroll") for (int rb = 0; rb < 8; ++rb) d[rb] = mfma16(bbA[rb], uc, z4);                                 \
            f32x2 bu[16]; { const LAS float* bc = S5_BU(P_); \
            _Pragma("unroll") for (int tt = 0; tt < 16; ++tt) bu[tt] = *(const LAS f32x2*)(bc + tt * 132 + 2 * lane); } \
            { LAS bf16* sbc = S5_SB(P_); \
            f32x2 s2 = (f32x2){sr, si}; const f32x2 lr2 = (f32x2){lr, lr}, li2 = (f32x2){-li, li}; \
            _Pragma("unroll") for (int tt = 0; tt < 16; ++tt) { const f32x2 sw = __builtin_shufflevector(s2, s2, 1, 0); s2 = lr2 * s2 + (li2 * sw + bu[tt]);     \
                *(LAS unsigned*)(sbc + tt * 136 + 2 * lane) = cvtpk_n(s2[0], s2[1]); } sr = s2[0]; si = s2[1]; }                \
            __builtin_amdgcn_sched_barrier(0);                                                                                   \
            { LAS float* bn = S5_BU(1 - (P_)); \
            _Pragma("unroll") for (int rb = 0; rb < 8; ++rb) *(LAS f32x4*)(bn + fr * 132 + 16 * rb + 4 * fq) = d[rb]; } \
            uc = ud; ud = S5_LOADU(k + 3); DBG_END(1); \
            LBAR(); } while (0)
        DBG_BEGIN(2);
        for (int k2 = 0; k2 + 1 < nblk; k2 += 2) { S5_ITER_A(k2, 0); S5_ITER_A(k2 + 1, 1); }
        if (nblk & 1) S5_ITER_A(nblk - 1, 0);
        DBG_END(2); DBG_REPORT(!sample && item == 0);
#undef S5_ITER_A
        float* so = A.out + (sample ? O_SRS : O_SRP) + (size_t)(b * NG + g) * PST; float* io = A.out + (sample ? O_SIS : O_SIP) + (size_t)(b * NG + g) * PST;
        so[lane] = sr; io[lane] = si;
    } else {
        bf16x8 ccA[4], dA;
#pragma unroll
        for (int ks = 0; ks < 4; ++ks) ccA[ks] = *(const bf16x8*)(CC + ((size_t)g * 16 + fr) * 128 + 32 * ks + 8 * fq);
        { const short dv = (short)f2bf(A.in[22][g * 16 + fr]); dA = zf;
#pragma unroll
          for (int j = 0; j < 8; ++j) dA[j] = (fq < 2 && 8 * fq + j == fr) ? dv : (short)0; }
        bf16x8 ua = S5_LOADU(0), ub = S5_LOADU(0), uc = S5_LOADU(1);
        LBAR();
#define S5_Y(km1_, P_) do { const LAS bf16* sbp = S5_SB(P_); f32x4 y = z4; \
            _Pragma("unroll") for (int ks = 0; ks < 4; ++ks) y = mfma16(ccA[ks], *(const LAS bf16x8*)(sbp + fr * 136 + 32 * ks + 8 * fq), y); \
            y = mfma16(dA, ua, y); \
            u32x2 w; w.x = cvtpk_n(gelu_tanh(y[0]), gelu_tanh(y[1])); w.y = cvtpk_n(gelu_tanh(y[2]), gelu_tanh(y[3])); \
            st_b64_hidden(Z + ((size_t)row0 + 16 * (km1_) + fr) * 1024 + 16 * g + 4 * fq, w); } while (0)
#define S5_ITER_B(k_, P_) do { const int k = (k_); DBG_BEGIN(3); if (k >= 1) S5_Y(k - 1, 1 - (P_)); ua = ub; ub = uc; uc = S5_LOADU(k + 2); DBG_END(3); LBAR(); } while (0)
        for (int k2 = 0; k2 + 1 < nblk; k2 += 2) { S5_ITER_B(k2, 0); S5_ITER_B(k2 + 1, 1); }
        if (nblk & 1) S5_ITER_B(nblk - 1, 0);
        if ((nblk - 1) & 1) S5_Y(nblk - 1, 1); else S5_Y(nblk - 1, 0);
        DBG_REPORT(!sample && item == 0);
#undef S5_ITER_B
#undef S5_Y
    }
    LBAR();
#undef S5_BU
#undef S5_SB
#undef S5_LOADU
}

__device__ __forceinline__ void outa_rows(const Args& A, int lane, int gw, int NGW) {
    unsigned char* ws = A.ws;
    const bf16* HS = (const bf16*)(ws + WS_HS); const bf16* OG = (const bf16*)(ws + WS_OG); const float* HSS = (const float*)(ws + WS_HSS); bf16* MIXIN = (bf16*)(ws + WS_MIXIN);
    f32x4 gm[2][2];
#pragma unroll
    for (int i = 0; i < 2; ++i) { gm[i][0] = *(const f32x4*)(A.in[14] + 512 * i + 8 * lane); gm[i][1] = *(const f32x4*)(A.in[14] + 512 * i + 8 * lane + 4); }
    for (int m = gw; m < MT; m += NGW) {
        f32x4 p0[2], p1[2]; v4u hv[2], ov[2];
#pragma unroll
        for (int i = 0; i < 2; ++i) { const int col = 512 * i + 8 * lane, hh = col >> 8;
            p0[i] = *(const GAS f32x4*)(HSS + (size_t)m * 32 + hh * 8); p1[i] = *(const GAS f32x4*)(HSS + (size_t)m * 32 + hh * 8 + 4);
            hv[i] = *(const GAS v4u*)(HS + (size_t)m * 1024 + col); ov[i] = *(const GAS v4u*)(OG + (size_t)m * 1024 + col); }
        v4u o[2];
#pragma unroll
        for (int i = 0; i < 2; ++i) {
            const float ss = (p0[i][0] + p0[i][1]) + (p0[i][2] + p0[i][3]) + (p1[i][0] + p1[i][1]) + (p1[i][2] + p1[i][3]);
            const float rstd = 1.0f / sqrtf(ss * (1.0f / DV) + EPS);
            o[i].x = cvtpk(bflo(hv[i].x) * rstd * gm[i][0][0] * sigmoidf_(bflo(ov[i].x)), bfhi(hv[i].x) * rstd * gm[i][0][1] * sigmoidf_(bfhi(ov[i].x)));
            o[i].y = cvtpk(bflo(hv[i].y) * rstd * gm[i][0][2] * sigmoidf_(bflo(ov[i].y)), bfhi(hv[i].y) * rstd * gm[i][0][3] * sigmoidf_(bfhi(ov[i].y)));
            o[i].z = cvtpk(bflo(hv[i].z) * rstd * gm[i][1][0] * sigmoidf_(bflo(ov[i].z)), bfhi(hv[i].z) * rstd * gm[i][1][1] * sigmoidf_(bfhi(ov[i].z)));
            o[i].w = cvtpk(bflo(hv[i].w) * rstd * gm[i][1][2] * sigmoidf_(bflo(ov[i].w)), bfhi(hv[i].w) * rstd * gm[i][1][3] * sigmoidf_(bfhi(ov[i].w))); }
#pragma unroll
        for (int i = 0; i < 2; ++i) *(GAS v4u*)(MIXIN + (size_t)m * 2048 + 512 * i + 8 * lane) = o[i];
    }
}
__device__ __forceinline__ float row_ss_part(const float* SSp, const float* SSs, int m, int lane) {
    if (m < MP) return (lane < 32) ? SSp[(size_t)m * 32 + lane] : 0.f;
    return SSs[(size_t)(m - MP) * 128 + lane] + SSs[(size_t)(m - MP) * 128 + 64 + lane];
}
__device__ __forceinline__ void rowpass1(const Args& A, LAS unsigned char* lds, int lane, int gw, int NGW) {
    unsigned char* ws = A.ws;
    const bf16* MIX = (const bf16*)(ws + WS_MIX); bf16* X1B = (bf16*)(ws + WS_X1B); float* RSTD2 = (float*)(ws + WS_SSS + SSS_RSTD2);
    const float* SSp = (const float*)(ws + WS_SS1); const float* SSs = (const float*)(ws + WS_SSS + SSS_1);
    const float* RSTD1 = (const float*)(ws + WS_SSS + SSS_RSTD1);
    f32x4 g1[8], gi[8];
#pragma unroll
    for (int j = 0; j < 8; ++j) { g1[j] = *(const f32x4*)(A.in[26] + 256 * j + 4 * lane); const f32x4 g0 = *(const f32x4*)(A.in[8] + 256 * j + 4 * lane);
        gi[j] = (f32x4){1.0f / g0[0], 1.0f / g0[1], 1.0f / g0[2], 1.0f / g0[3]}; }
    u32x2 va[8], vb[8], ma[8], mb[8]; float sa = 0.f, sb = 0.f, ra = 0.f, rb = 0.f;
#define RP1_LOAD(V, M, S, R, m_) do { const int mm_ = (m_); \
        S = row_ss_part(SSp, SSs, mm_, lane); R = RSTD1[mm_]; \
        _Pragma("unroll") for (int j = 0; j < 8; ++j) { const int k = 256 * j + 4 * lane; V[j] = *(const GAS u32x2*)(X1B + (size_t)mm_ * DM + k); M[j] = *(const GAS u32x2*)(MIX + (size_t)mm_ * DM + k); } } while (0)
#define RP1_PROC(V, M, S, R, m_) do { const int mm_ = (m_); \
        const float rstd1 = 1.0f / sqrtf(wave_sum(S) * (1.0f / DM) + EPS); float s = 0.f; f32x4 O[8]; \
        _Pragma("unroll") for (int j = 0; j < 8; ++j) { f32x4 o; o[0] = bflo(V[j].x) * R * gi[j][0] + bflo(M[j].x) * rstd1 * g1[j][0]; o[1] = bfhi(V[j].x) * R * gi[j][1] + bfhi(M[j].x) * rstd1 * g1[j][1]; \
            o[2] = bflo(V[j].y) * R * gi[j][2] + bflo(M[j].y) * rstd1 * g1[j][2]; o[3] = bfhi(V[j].y) * R * gi[j][3] + bfhi(M[j].y) * rstd1 * g1[j][3]; \
            s += (o[0] * o[0] + o[1] * o[1]) + (o[2] * o[2] + o[3] * o[3]); O[j] = o; } \
        const float ms2 = wave_sum(s) * (1.0f / DM) + EPS, rstd2 = 1.0f / sqrtf(ms2); \
        _Pragma("unroll") for (int j = 0; j < 8; ++j) { u32x2 o; o.x = cvtpk(O[j][0] * rstd2, O[j][1] * rstd2); o.y = cvtpk(O[j][2] * rstd2, O[j][3] * rstd2); \
            *(GAS u32x2*)(X1B + (size_t)mm_ * DM + 256 * j + 4 * lane) = o; } \
        if (lane == 0) RSTD2[mm_] = sqrtf(ms2); } while (0)
    int m = gw;
    if (m < MP) RP1_LOAD(va, ma, sa, ra, m);
    { const int wv = gw % NWAVES, wg = gw / NWAVES, nwg = NGW / NWAVES; LAS float* red = (LAS float*)lds;
      for (int r = wg; r < MS; r += nwg) { const int ms = MP + r, c0 = 256 * wv + 4 * lane;
          const float S = row_ss_part(SSp, SSs, ms, lane), R = RSTD1[ms];
          const u32x2 xv = *(const GAS u32x2*)(X1B + (size_t)ms * DM + c0), mv = *(const GAS u32x2*)(MIX + (size_t)ms * DM + c0);
          const f32x4 gg = *(const f32x4*)(A.in[26] + c0), g0 = *(const f32x4*)(A.in[8] + c0);
          const float rstd1 = 1.0f / sqrtf(wave_sum(S) * (1.0f / DM) + EPS);
          f32x4 o; o[0] = bflo(xv.x) * R / g0[0] + bflo(mv.x) * rstd1 * gg[0]; o[1] = bfhi(xv.x) * R / g0[1] + bfhi(mv.x) * rstd1 * gg[1];
          o[2] = bflo(xv.y) * R / g0[2] + bflo(mv.y) * rstd1 * gg[2]; o[3] = bfhi(xv.y) * R / g0[3] + bfhi(mv.y) * rstd1 * gg[3];
          const float sw = wave_sum((o[0] * o[0] + o[1] * o[1]) + (o[2] * o[2] + o[3] * o[3]));
          if (lane == 0) red[wv] = sw;
          __syncthreads();
          float tot = 0.f;
#pragma unroll
          for (int w2 = 0; w2 < NWAVES; ++w2) tot += red[w2];
          const float ms2 = tot * (1.0f / DM) + EPS, rstd2 = 1.0f / sqrtf(ms2);
          u32x2 ow; ow.x = cvtpk(o[0] * rstd2, o[1] * rstd2); ow.y = cvtpk(o[2] * rstd2, o[3] * rstd2);
          *(GAS u32x2*)(X1B + (size_t)ms * DM + c0) = ow;
          if (wv == 0 && lane == 0) RSTD2[ms] = sqrtf(ms2);
          __syncthreads(); } }
    if (m < MP) {
        for (;;) { const int m2 = m + NGW; if (m2 < MP) RP1_LOAD(vb, mb, sb, rb, m2); RP1_PROC(va, ma, sa, ra, m); if (m2 >= MP) break;
                   m = m2 + NGW; if (m < MP) RP1_LOAD(va, ma, sa, ra, m); RP1_PROC(vb, mb, sb, rb, m2); if (m >= MP) break; } }
#undef RP1_LOAD
#undef RP1_PROC
}
__device__ __forceinline__ void rowpass2(const Args& A, int lane, int gw, int NGW) {
    unsigned char* ws = A.ws;
    const bf16* FF = (const bf16*)(ws + WS_FF); const bf16* X1B = (const bf16*)(ws + WS_X1B);
    const float* SSp = (const float*)(ws + WS_SS2); const float* SSs = (const float*)(ws + WS_SSS + SSS_2);
    f32x4 g3[8];
#pragma unroll
    for (int j = 0; j < 8; ++j) g3[j] = *(const f32x4*)(A.in[31] + 256 * j + 4 * lane);
    u32x2 xa[8], xb[8], fa[8], fb[8]; float sa = 0.f, sb = 0.f;
    const float* RSTD2 = (const float*)(ws + WS_SSS + SSS_RSTD2); float ra = 0.f, rb = 0.f;
#define RP2_LOAD(X, F, S, R, m_) do { const int mm_ = (m_); S = row_ss_part(SSp, SSs, mm_, lane); R = RSTD2[mm_]; \
        _Pragma("unroll") for (int j = 0; j < 8; ++j) { const int k = 256 * j + 4 * lane; X[j] = *(const GAS u32x2*)(X1B + (size_t)mm_ * DM + k); F[j] = *(const GAS u32x2*)(FF + (size_t)mm_ * DM + k); } } while (0)
#define RP2_PROC(X, F, S, R, m_) do { const int mm_ = (m_); float* orow = A.out + O_Y + (size_t)mm_ * DM; const float rstd = 1.0f / sqrtf(wave_sum(S) * (1.0f / DM) + EPS); f32x4 V[8]; \
        _Pragma("unroll") for (int j = 0; j < 8; ++j) { V[j][0] = bflo(X[j].x) * R + bflo(F[j].x) * rstd * g3[j][0]; V[j][1] = bfhi(X[j].x) * R + bfhi(F[j].x) * rstd * g3[j][1]; V[j][2] = bflo(X[j].y) * R + bflo(F[j].y) * rstd * g3[j][2]; V[j][3] = bfhi(X[j].y) * R + bfhi(F[j].y) * rstd * g3[j][3]; } \
        DBG_PERTURB(V, mm_); \
        _Pragma("unroll") for (int j = 0; j < 8; ++j) __builtin_nontemporal_store(V[j], (GAS f32x4*)(orow + 256 * j + 4 * lane)); } while (0)
    int m = gw;
    if (m < MP) RP2_LOAD(xa, fa, sa, ra, m);
    for (int t = gw; t < MS * 16; t += NGW) { const int ms = MP + (t >> 4), c0 = 128 * (t & 15) + 2 * lane;
        const float S = row_ss_part(SSp, SSs, ms, lane), R = RSTD2[ms];
        const unsigned xw = *(const GAS unsigned*)(X1B + (size_t)ms * DM + c0), fw = *(const GAS unsigned*)(FF + (size_t)ms * DM + c0);
        const float g0 = A.in[31][c0], g1 = A.in[31][c0 + 1];
        const float rstd = 1.0f / sqrtf(wave_sum(S) * (1.0f / DM) + EPS);
        u32x2 o; o.x = __float_as_uint(bflo(xw) * R + bflo(fw) * rstd * g0); o.y = __float_as_uint(bfhi(xw) * R + bfhi(fw) * rstd * g1);
        __builtin_nontemporal_store(o, (GAS u32x2*)(A.out + O_Y + (size_t)ms * DM + c0)); }
    if (m < MP) {
        for (;;) { const int m2 = m + NGW; if (m2 < MP) RP2_LOAD(xb, fb, sb, rb, m2); RP2_PROC(xa, fa, sa, ra, m); if (m2 >= MP) break;
                   m = m2 + NGW; if (m < MP) RP2_LOAD(xa, fa, sa, ra, m); RP2_PROC(xb, fb, sb, rb, m2); if (m >= MP) break; } }
#undef RP2_LOAD
#undef RP2_PROC
}
#ifndef MK_AL_P4
#define MK_AL_P4 true
#endif
#ifndef MK_AL_SS
#define MK_AL_SS true
#endif
#ifndef MK_WGM_P5
#define MK_WGM_P5 4
#endif
#ifndef MK_WGM_P1
#define MK_WGM_P1 2
#endif
#ifndef MK_WGM_P7
#define MK_WGM_P7 4
#endif
#ifndef MK_WGM_P8
#define MK_WGM_P8 1
#endif
#ifndef MK_GU_ALIGN
#define MK_GU_ALIGN true
#endif
#ifndef MK_GU_SP2
#define MK_GU_SP2 true
#endif
__global__ void __launch_bounds__(NWAVES * 64, 2) hymba_fwd(Args args) {
    extern __shared__ __attribute__((aligned(16))) unsigned char lds_raw[];
    LAS unsigned char* lds = (LAS unsigned char*)lds_raw;
    volatile LAS unsigned* MISC = (volatile LAS unsigned*)(lds + MISC_OFF);
    const int tid = threadIdx.x, lane = tid & 63, wave = __builtin_amdgcn_readfirstlane(tid >> 6);
    const int G = gridDim.x; const int bx = blockIdx.x; const int vcu = (G % 8 == 0) ? (bx % 8) * (G / 8) + bx / 8 : bx;
    unsigned char* ws = args.ws;
    gu32* ctl = (gu32*)(ws + WS_CTL);
    for (int u = tid; u < (LDS_BYTES - LDSCTL_OFF) / 4; u += NWAVES * 64) ((LAS unsigned*)(lds + LDSCTL_OFF))[u] = 0u;
    __syncthreads();
    const XcdBarrier bar = xcd_barrier_post((unsigned*)(ctl + CW_BAR) + args.li * XCD_BAR_WORDS, MISC + 8);
#define GRID_BAR() xcd_barrier(bar)
    const int lo = args.ph_lo, hi = args.ph_hi;
#define IN(k) (lo <= (k) && (k) < hi)
#define BOTH(k) (IN(k) && IN((k) + 1))

    const int gw = vcu * NWAVES + wave, NGW = G * NWAVES;

    if (IN(0)) { PHASE_IDS p0_prologue(args, lds, tid, lane, wave, vcu, G); if (BOTH(0)) GRID_BAR(); }

    if (IN(1)) { PHASE_IDS
        { pg8::Gemm g{(const bf16*)(ws + WS_XN), (const bf16*)(ws + WS_WIN), MP, 4096, DM}; pg8::StaticOrder S; S.init(MP, 4096, G, bx, MK_WGM_P1);
          pg8::EpiBf16<0> E{(bf16*)(ws + WS_QKRAW), 1024, nullptr, 1024, (size_t)WS_RSTRIDE / 2, 1.f};
          pg8::gemm_phase<pg8::EpiBf16<0>, pg8::StaticOrder, true, true>(lds + RING_OFF, g, S, E); }
        { PHASE_IDS bf16* O = (bf16*)(ws + WS_QKRAW);
          skinny_ks<1, DM, 4, 4>((const bf16*)(ws + WS_XN) + (size_t)MP * DM, (const bf16*)(ws + WS_WIN), (float*)(ws + WS_PARTA), 4096, (unsigned*)ctl + CW_KS1, lds, 4096 / 16, vcu, G, wave, lane,
              [](int it, int a, int fr) { return 16 * it + fr; },
              [O](int it, int row, int fq, const f32x4 (&acc)[1]) { const int col = 16 * it + 4 * fq, t = col >> 10;
                  u32x2 w; w.x = cvtpk_n(acc[0][0], acc[0][1]); w.y = cvtpk_n(acc[0][2], acc[0][3]);
                  *(GAS u32x2*)(O + (size_t)t * (WS_RSTRIDE / 2) + (size_t)(MP + row) * 1024 + (col & 1023)) = w; }); }
        if (BOTH(1)) GRID_BAR();
    }

    if (IN(2)) { PHASE_IDS if (vcu < 64) p2_scalars(args, lds, lane, wave, vcu); p2_conv(args, tid, vcu, G); if (BOTH(2)) GRID_BAR(); }

    if (IN(3)) { PHASE_IDS
        const int half = G / 2;
#ifndef MK_REP_M
#define MK_REP_M 1
#endif
#ifndef MK_REP_S
#define MK_REP_S 1
#endif
        if (vcu < half) { for (int rp_ = 0; rp_ < MK_REP_M; ++rp_) for (int it = vcu; it < NBATCH * NH * NSL; it += half) mlstm_item(args, lds, tid, lane, wave, it); }
        else { const int nb = G - half, bi = vcu - half;
               for (int rp_ = 0; rp_ < MK_REP_S; ++rp_)
               for (int it = bi * 4 + (wave & 3); it < 2 * NBATCH * NG; it += nb * 4) s5_item(args, lds + (wave & 3) * 25600, lane, wave >> 2, it); }
        if (vcu >= half) { __syncthreads(); for (int it = NBATCH * NH * NSL + (vcu - half); it < 2 * NBATCH * NH * NSL; it += G - half) mlstm_item(args, lds, tid, lane, wave, it); }
        if (BOTH(3)) GRID_BAR();
    }

    if (IN(4)) { PHASE_IDS
        { pg8::Gemm g{(const bf16*)(ws + WS_Z), (const bf16*)(ws + WS_WGLU), MP, 1024, 1024}; pg8::StaticOrder S; S.init(MP, 1024, G, bx);
          pg8::EpiGlu E{(const bf16*)(ws + WS_Z), (bf16*)(ws + WS_MIXIN), args.in[24]};
          pg8::gemm_phase<pg8::EpiGlu, pg8::StaticOrder, MK_AL_P4, true>(lds + RING_OFF, g, S, E); }
        { PHASE_IDS const bf16* Zb = (const bf16*)(ws + WS_Z); bf16* O = (bf16*)(ws + WS_MIXIN); const float* bias = args.in[24];
          skinny_ks<1, 1024, 4, 1>(Zb + (size_t)MP * 1024, (const bf16*)(ws + WS_WGLU), (float*)(ws + WS_PARTA), 1024, (unsigned*)ctl + CW_KS4, lds, 1024 / 16, vcu, G, wave, lane,
              [](int it, int a, int fr) { return 16 * it + fr; },
              [Zb, O, bias](int it, int row, int fq, const f32x4 (&acc)[1]) { const int col = 16 * it + 4 * fq; const size_t m = (size_t)(MP + row);
                  const u32x2 z = *(const GAS u32x2*)(Zb + m * 1024 + col); const f32x4 bv = *(const f32x4*)(bias + col);
                  u32x2 w; w.x = cvtpk(bflo(z.x) * sigmoidf_(acc[0][0] + bv[0]), bfhi(z.x) * sigmoidf_(acc[0][1] + bv[1]));
                  w.y = cvtpk(bflo(z.y) * sigmoidf_(acc[0][2] + bv[2]), bfhi(z.y) * sigmoidf_(acc[0][3] + bv[3]));
                  *(GAS u32x2*)(O + m * 2048 + 1024 + col) = w; }); }
        { PHASE_IDS outa_rows(args, lane, gw, NGW); }
        if (BOTH(4)) GRID_BAR();
    }

    if (IN(5)) { PHASE_IDS
        { pg8::Gemm g{(const bf16*)(ws + WS_MIXIN), (const bf16*)(ws + WS_WOUT), MP, DM, DM}; pg8::StaticOrder S; S.init(MP, DM, G, bx, MK_WGM_P5);
          pg8::EpiSS<false> E{(bf16*)(ws + WS_MIX), DM, (float*)(ws + WS_SS1), 1.0f};
          pg8::gemm_phase<pg8::EpiSS<false>, pg8::StaticOrder, MK_AL_SS, true>(lds + RING_OFF, g, S, E); }
        { PHASE_IDS bf16* O = (bf16*)(ws + WS_MIX); float* SSs = (float*)(ws + WS_SSS + SSS_1);
          skinny_ks<1, DM, 4, 2>((const bf16*)(ws + WS_MIXIN) + (size_t)MP * DM, (const bf16*)(ws + WS_WOUT), (float*)(ws + WS_PARTA), 2048, (unsigned*)ctl + CW_KS5, lds, DM / 16, vcu, G, wave, lane,
              [](int it, int a, int fr) { return 16 * it + fr; },
              [O, SSs](int it, int row, int fq, const f32x4 (&acc)[1]) { const int col = 16 * it + 4 * fq;
                  u32x2 w; w.x = cvtpk_n(acc[0][0], acc[0][1]); w.y = cvtpk_n(acc[0][2], acc[0][3]);
                  *(GAS u32x2*)(O + (size_t)(MP + row) * DM + col) = w;
                  float s = (acc[0][0] * acc[0][0] + acc[0][1] * acc[0][1]) + (acc[0][2] * acc[0][2] + acc[0][3] * acc[0][3]);
                  s += __shfl_xor(s, 16); s += __shfl_xor(s, 32);
                  if (fq == 0) SSs[(size_t)row * 128 + it] = s; }); }
        if (BOTH(5)) GRID_BAR();
    }

    if (IN(6)) { PHASE_IDS rowpass1(args, lds, lane, gw, NGW); if (BOTH(6)) GRID_BAR(); }

    if (IN(7)) { PHASE_IDS
        { pg8::Gemm g{(const bf16*)(ws + WS_X1B), (const bf16*)(ws + WS_WGU), MP, 2 * DFF, DM}; pg8::StaticOrder S; S.init(MP, 2 * DFF, G, bx, MK_WGM_P7);
          pg8::EpiGU8 E{ws + WS_ACT8, DFF};
          pg8::gemm_phase<pg8::EpiGU8, pg8::StaticOrder, MK_GU_ALIGN, MK_GU_SP2>(lds + RING_OFF, g, S, E); }
        { PHASE_IDS bf16* O = (bf16*)(ws + WS_ACTS);
          skinny_ks<2, DM, 4, 6>((const bf16*)(ws + WS_X1B) + (size_t)MP * DM, (const bf16*)(ws + WS_WGU), (float*)(ws + WS_PARTA), DFF, (unsigned*)ctl + CW_KS7, lds, DFF / 16, vcu, G, wave, lane,
              [](int it, int a, int fr) { const int j = 16 * it + fr; return 256 * (j >> 7) + 128 * a + (j & 127); },
              [O](int it, int row, int fq, const f32x4 (&acc)[2]) { const int col = 16 * it + 4 * fq; const f32x4 g = acc[0], up = acc[1];
                  u32x2 w; w.x = cvtpk(g[0] * sigmoidf_(g[0]) * up[0], g[1] * sigmoidf_(g[1]) * up[1]);
                  w.y = cvtpk(g[2] * sigmoidf_(g[2]) * up[2], g[3] * sigmoidf_(g[3]) * up[3]);
                  *(GAS u32x2*)(O + (size_t)row * DFF + col) = w; }); }
        if (BOTH(7)) GRID_BAR();
    }

    if (IN(8)) { PHASE_IDS
        { pg8::Gemm g{(const bf16*)(ws + WS_ACT8), (const bf16*)(ws + WS_WD8), MP, DM, DFF / 2}; pg8::StaticOrder S; S.init(MP, DM, G, bx, MK_WGM_P8);
          pg8::EpiSS<true> E{(bf16*)(ws + WS_FF), DM, (float*)(ws + WS_SS2), 0.0009765625f};
          pg8::gemm_phase<pg8::EpiSS<true>, pg8::StaticOrder, MK_AL_SS, true, true>(lds + RING_OFF, g, S, E); }
        { PHASE_IDS bf16* O = (bf16*)(ws + WS_FF); float* SSs = (float*)(ws + WS_SSS + SSS_2);
          skinny_ks<1, DFF, 8, 4, true>((const bf16*)(ws + WS_ACTS), (const bf16*)(ws + WS_WD8), (float*)(ws + WS_PARTB), 2048, (unsigned*)ctl + CW_KS8, lds, DM / 16, vcu, G, wave, lane,
              [](int it, int a, int fr) { return 16 * it + fr; },
              [O, SSs](int it, int row, int fq, const f32x4 (&acc)[1]) { const int col = 16 * it + 4 * fq;
                  u32x2 w; w.x = cvtpk_n(acc[0][0], acc[0][1]); w.y = cvtpk_n(acc[0][2], acc[0][3]);
                  *(GAS u32x2*)(O + (size_t)(MP + row) * DM + col) = w;
                  float s = (acc[0][0] * acc[0][0] + acc[0][1] * acc[0][1]) + (acc[0][2] * acc[0][2] + acc[0][3] * acc[0][3]);
                  s += __shfl_xor(s, 16); s += __shfl_xor(s, 32);
                  if (fq == 0) SSs[(size_t)row * 128 + it] = s; }); }
        if (BOTH(8)) GRID_BAR();
    }

    if (IN(9)) { PHASE_IDS rowpass2(args, lane, gw, NGW); }
#undef IN
#undef BOTH
}

#ifdef MK_DUMP_OFF
__global__ void dump_kernel(const unsigned short* src, float* dst, size_t n) {
    for (size_t i = (size_t)blockIdx.x * blockDim.x + threadIdx.x; i < n; i += (size_t)gridDim.x * blockDim.x) dst[i] = __uint_as_float((unsigned)src[i] << 16);
}
#endif
extern "C" void kernel_launch(void* const* d_in, const int* in_sizes, int n_in, void* d_out, int out_size, void* d_ws, size_t ws_size, hipStream_t stream) {
    static int grid = 0;
    if (grid == 0) {
        if (n_in != 32 || out_size != (int)O_END || ws_size < WS_END) { fprintf(stderr, "kernel_launch: unexpected problem: n_in %d out %d ws %zu\n", n_in, out_size, ws_size); grid = -1; return; }
        int dev = 0, cus = 0, per_cu = 0;
        if (hipGetDevice(&dev) != hipSuccess || hipDeviceGetAttribute(&cus, hipDeviceAttributeMultiprocessorCount, dev) != hipSuccess) { grid = -1; return; }
        if (hipFuncSetAttribute((const void*)hymba_fwd, hipFuncAttributeMaxDynamicSharedMemorySize, LDS_BYTES) != hipSuccess) { fprintf(stderr, "kernel_launch: hipFuncSetAttribute failed\n"); grid = -1; return; }
        if (hipOccupancyMaxActiveBlocksPerMultiprocessor(&per_cu, (const void*)hymba_fwd, NWAVES * 64, LDS_BYTES) != hipSuccess || per_cu < 1) { fprintf(stderr, "kernel_launch: occupancy query reports %d\n", per_cu); per_cu = 1; }
        (void)hipGetLastError();
        if (cus < 256) { fprintf(stderr, "kernel_launch: %d CUs; the K-sliced sample GEMMs are sized for at least 256\n", cus); grid = -1; return; }
        grid = cus;
    }
    if (grid < 0) return;
    Args a{};
    for (int i = 0; i < 32; ++i) a.in[i] = (const float*)d_in[i];
    a.out = (float*)d_out; a.ws = (unsigned char*)d_ws;
    int lo[N_PHASES + 2], hi[N_PHASES + 2], nl = 0;
#if defined(MK_REPEAT)
    lo[0] = 0; hi[0] = MK_REPEAT + 1; lo[1] = MK_REPEAT; hi[1] = MK_REPEAT + 1; lo[2] = MK_REPEAT + 1; hi[2] = N_PHASES; nl = 3;
#else
    if (N_LAUNCHES == 1) { lo[0] = 0; hi[0] = N_PHASES; nl = 1; } else { for (int k = 0; k < N_PHASES; ++k) { lo[k] = k; hi[k] = k + 1; } nl = N_PHASES; }
#endif
    if (hipMemsetAsync((char*)d_ws + WS_CTL, 0, (size_t)CW_END * 4, stream) != hipSuccess) return;
    for (int li = 0; li < nl; ++li) {
        a.ph_lo = lo[li]; a.ph_hi = hi[li]; a.li = li;
        hipLaunchKernelGGL(hymba_fwd, dim3(grid), dim3(NWAVES * 64), LDS_BYTES, stream, a);
    }
#ifdef MK_DUMP_OFF
    hipLaunchKernelGGL(dump_kernel, dim3(2048), dim3(256), 0, stream, (const unsigned short*)((const unsigned char*)d_ws + (size_t)(MK_DUMP_OFF) * MiB), (float*)d_out, (size_t)(MK_DUMP_N));
#endif
}
```
